# Optimizing an MI355X kernel written in HIP

```python
import math
import jax, jax.numpy as jnp
from jax import lax
import numpy as np

D_MODEL = 1024
BATCH = 8
SEQ = 4096
DEPTH = 1

HEAD_DIM = 64
BLOCK = 128
A_PAIRS = ((128, 1), (512, 4), (2048, 16))
A_GROUPS = 3
A_HEADS_PER_GROUP = 4
A_WIDTH = A_GROUPS * A_HEADS_PER_GROUP * HEAD_DIM
A_OUT_WIDTH = A_HEADS_PER_GROUP * HEAD_DIM
B_Q_HEADS = 8
B_KV_HEADS = 2
B_WINDOW = 128
B_Q_WIDTH = B_Q_HEADS * HEAD_DIM
B_KV_WIDTH = B_KV_HEADS * HEAD_DIM
C_HEADS = 4
C_HEAD_DIM = 128
C_WIDTH = C_HEADS * C_HEAD_DIM
MEM_LEN = 256
N_GATES = 3
IN_WIDTH = 3 * A_WIDTH + B_Q_WIDTH + 2 * B_KV_WIDTH + C_WIDTH + N_GATES * D_MODEL
N_BUCKETS = 32
MAX_DISTANCE = 2048
N_BIAS_HEADS = A_GROUPS * A_HEADS_PER_GROUP + B_Q_HEADS
PEER_HEADS = 8
N_KEYS = 128
N_EXPERTS = N_KEYS * N_KEYS
PEER_TOPK = 16
PEER_DKEY = 128
PEER_CHUNK = 128
ALPHA = (2.0 * DEPTH) ** 0.25
BETA = (8.0 * DEPTH) ** -0.25
LN_EPS = 1e-5
NEG = -1e30

kernel_name = "hybrid_dilated_swa_sink_mem_peer_deepnorm"


def _layer_norm(x, g, b):
    xf = x.astype(jnp.float32)
    mu = jnp.mean(xf, axis=-1, keepdims=True)
    xc = xf - mu
    var = jnp.mean(xc * xc, axis=-1, keepdims=True)
    y = xc * lax.rsqrt(var + LN_EPS) * g.astype(jnp.float32) + b.astype(jnp.float32)
    return y.astype(x.dtype)


def _t5_bucket(dist):
    n = np.asarray(dist, dtype=np.int32)
    max_exact = N_BUCKETS // 2
    nf = np.maximum(n, 1).astype(np.float32)
    scale = np.float32(math.log(MAX_DISTANCE / max_exact))
    large = max_exact + (np.log(nf / np.float32(max_exact)) / scale
                         * np.float32(N_BUCKETS - max_exact)).astype(np.int32)
    large = np.minimum(large, N_BUCKETS - 1)
    return np.where(n < max_exact, n, large).astype(np.int32)


def _with_prev(t, axis):
    pad = [(0, 0)] * t.ndim
    pad[axis] = (1, 0)
    prev = lax.slice_in_dim(jnp.pad(t, pad), 0, t.shape[axis], axis=axis)
    return jnp.concatenate([prev, t], axis=axis + 1)


def _dilated_group(q, k, v, table, window, dilation):
    Bn, S, H, dh = q.shape
    r = dilation
    L = S // r
    nblk = -(-L // BLOCK)
    Lp = nblk * BLOCK
    W = window // r

    def strided(t):
        t = t.reshape(Bn, L, r, H, dh).transpose(0, 2, 1, 3, 4)
        t = jnp.pad(t, ((0, 0), (0, 0), (0, Lp - L), (0, 0), (0, 0)))
        return t.reshape(Bn, r, nblk, BLOCK, H, dh)

    qb = strided(q)
    kc = _with_prev(strided(k), axis=2)
    vc = _with_prev(strided(v), axis=2)
    logits = jnp.einsum('brnqhd,brnkhd->brnhqk', qb, kc).astype(jnp.float32) * (dh ** -0.5)

    i = np.arange(BLOCK)[:, None]
    j = np.arange(2 * BLOCK)[None, :]
    off = BLOCK + i - j
    bucket = _t5_bucket(np.clip(off, 0, W) * r)
    bias = jnp.take(table.astype(jnp.float32), bucket, axis=0).transpose(2, 0, 1)
    valid = ((off >= 0) & (off <= W))[None] & ~((np.arange(nblk)[:, None, None] == 0) & (j[None] < BLOCK))
    logits = jnp.where(valid[None, None, :, None], logits + bias[None, None, None], NEG)

    lse = jax.nn.logsumexp(logits, axis=-1)
    p = jnp.exp(logits - lse[..., None]).astype(v.dtype)
    o = jnp.einsum('brnhqk,brnkhd->brnqhd', p, vc)
    o = o.reshape(Bn, r, Lp, H, dh)[:, :, :L].transpose(0, 2, 1, 3, 4).reshape(Bn, S, H, dh)
    lse = lse.transpose(0, 1, 2, 4, 3).reshape(Bn, r, Lp, H)[:, :, :L].transpose(0, 2, 1, 3).reshape(Bn, S, H)
    return o, lse


def _swa_sinks(q, k, v, table, sinks):
    Bn, S, Hq, dh = q.shape
    Hkv = k.shape[2]
    G = Hq // Hkv
    nb = S // BLOCK
    qb = q.reshape(Bn, nb, BLOCK, Hkv, G, dh)
    kc = _with_prev(k.reshape(Bn, nb, BLOCK, Hkv, dh), axis=1)
    vc = _with_prev(v.reshape(Bn, nb, BLOCK, Hkv, dh), axis=1)
    logits = jnp.einsum('bnqkgd,bnjkd->bnkgqj', qb, kc).astype(jnp.float32) * (dh ** -0.5)

    i = np.arange(BLOCK)[:, None]
    j = np.arange(2 * BLOCK)[None, :]
    off = BLOCK + i - j
    bucket = _t5_bucket(np.clip(off, 0, B_WINDOW - 1))
    bias = jnp.take(table.astype(jnp.float32), bucket, axis=0).transpose(2, 0, 1)
    bias = bias.reshape(Hkv, G, BLOCK, 2 * BLOCK)
    valid = ((off >= 0) & (off < B_WINDOW))[None] & ~((np.arange(nb)[:, None, None] == 0) & (j[None] < BLOCK))
    logits = jnp.where(valid[None, :, None, None], logits + bias[None, None], NEG)

    s = sinks.astype(jnp.float32).reshape(Hkv, G)[None, None, :, :, None, None]
    m = jnp.maximum(jnp.max(logits, axis=-1, keepdims=True), s)
    e = jnp.exp(logits - m)
    denom = jnp.sum(e, axis=-1, keepdims=True) + jnp.exp(s - m)
    p = (e / denom).astype(v.dtype)
    o = jnp.einsum('bnkgqj,bnjkd->bnqkgd', p, vc)
    return o.reshape(Bn, S, Hq * dh)


def _memory_attn(q, k_mem, v_mem):
    Bn, S, H, dc = q.shape
    logits = jnp.einsum('bshd,bmhd->bhsm', q, k_mem).astype(jnp.float32) * (dc ** -0.5)
    p = jax.nn.softmax(logits, axis=-1).astype(v_mem.dtype)
    return jnp.einsum('bhsm,bmhd->bshd', p, v_mem).reshape(Bn, S, H * dc)


def _peer(x, w_query, sub_keys, u_table, v_table):
    Bn, S, D = x.shape
    q = (x @ w_query).reshape(Bn, S, PEER_HEADS, 2, PEER_DKEY // 2)
    scores = jnp.einsum('bshcd,hckd->bshck', q, sub_keys).astype(jnp.float32)
    sv, si = lax.top_k(scores, PEER_TOPK)
    cand = (sv[..., 0, :, None] + sv[..., 1, None, :]).reshape(Bn, S, PEER_HEADS, PEER_TOPK * PEER_TOPK)
    cidx = (si[..., 0, :, None] * N_KEYS + si[..., 1, None, :]).reshape(Bn, S, PEER_HEADS, PEER_TOPK * PEER_TOPK)
    top, pos = lax.top_k(cand, PEER_TOPK)
    eidx = jnp.take_along_axis(cidx, pos, axis=-1)
    gate = jax.nn.softmax(top, axis=-1).astype(x.dtype)

    T = Bn * S
    nchunk = T // PEER_CHUNK
    xs = x.reshape(nchunk, PEER_CHUNK, D)
    es = eidx.reshape(nchunk, PEER_CHUNK, PEER_HEADS * PEER_TOPK)
    gs = gate.reshape(nchunk, PEER_CHUNK, PEER_HEADS * PEER_TOPK)

    def expert_chunk(args):
        xc, ec, gc = args
        u = jnp.take(u_table, ec, axis=0)
        h = jax.nn.gelu(jnp.einsum('td,tkd->tk', xc, u), approximate=False)
        vv = jnp.take(v_table, ec, axis=0)
        return jnp.einsum('tk,tkd->td', gc * h, vv)

    return lax.map(expert_chunk, (xs, es, gs)).reshape(Bn, S, D)


def setup_inputs(seed: int = 0) -> dict:
    key = jax.random.key(seed)
    ks = jax.random.split(key, 20)
    f32 = jnp.float32
    D = D_MODEL
    nrm = lambda k, shape, s: (jax.random.normal(k, shape, f32) * s)
    return {
        "x": nrm(ks[0], (BATCH, SEQ, D), 1.0),
        "mem": nrm(ks[1], (BATCH, MEM_LEN, D), 1.0),
        "rel_bias": nrm(ks[2], (N_BUCKETS, N_BIAS_HEADS), 0.5),
        "w_in": nrm(ks[3], (DEPTH, D, IN_WIDTH), D ** -0.5),
        "b_gate": nrm(ks[4], (DEPTH, N_GATES * D), 0.02),
        "w_mem_kv": nrm(ks[5], (DEPTH, D, 2 * C_WIDTH), D ** -0.5),
        "sinks": nrm(ks[6], (DEPTH, B_Q_HEADS), 0.5),
        "w_branch_a": nrm(ks[7], (DEPTH, A_OUT_WIDTH, D), A_OUT_WIDTH ** -0.5),
        "w_branch_b": nrm(ks[8], (DEPTH, B_Q_WIDTH, D), B_Q_WIDTH ** -0.5),
        "w_branch_c": nrm(ks[9], (DEPTH, C_WIDTH, D), C_WIDTH ** -0.5),
        "w_out": nrm(ks[10], (DEPTH, D, D), BETA * D ** -0.5),
        "ln1_g": 1.0 + nrm(ks[11], (DEPTH, D), 0.05),
        "ln1_b": nrm(ks[12], (DEPTH, D), 0.02),
        "peer_w_query": nrm(ks[13], (DEPTH, D, PEER_HEADS * PEER_DKEY), D ** -0.5),
        "peer_sub_keys": nrm(ks[14], (DEPTH, PEER_HEADS, 2, N_KEYS, PEER_DKEY // 2), (PEER_DKEY // 2) ** -0.5),
        "peer_u": nrm(ks[15], (DEPTH, N_EXPERTS, D), D ** -0.5),
        "peer_v": nrm(ks[16], (DEPTH, N_EXPERTS, D), BETA * 0.5),
        "ln2_g": 1.0 + nrm(ks[17], (DEPTH, D), 0.05),
        "ln2_b": nrm(ks[18], (DEPTH, D), 0.02),
    }


def reference(x, mem, rel_bias, w_in, b_gate, w_mem_kv, sinks, w_branch_a, w_branch_b, w_branch_c,
              w_out, ln1_g, ln1_b, peer_w_query, peer_sub_keys, peer_u, peer_v, ln2_g, ln2_b):
    Bn, S, D = x.shape
    M = mem.shape[1]
    widths = [A_WIDTH, A_WIDTH, A_WIDTH, B_Q_WIDTH, B_KV_WIDTH, B_KV_WIDTH, C_WIDTH, N_GATES * D_MODEL]
    split_idx = [int(c) for c in np.cumsum(widths)[:-1]]
    n_a = A_GROUPS * A_HEADS_PER_GROUP
    for l in range(DEPTH):
        h = x @ w_in[l]
        aq, ak, av, bq, bk, bv, cq, gates = jnp.split(h, split_idx, axis=-1)
        aq = aq.reshape(Bn, S, A_GROUPS, A_HEADS_PER_GROUP, HEAD_DIM)
        ak = ak.reshape(Bn, S, A_GROUPS, A_HEADS_PER_GROUP, HEAD_DIM)
        av = av.reshape(Bn, S, A_GROUPS, A_HEADS_PER_GROUP, HEAD_DIM)

        outs, lses = [], []
        for g, (win, dil) in enumerate(A_PAIRS):
            tbl = rel_bias[:, g * A_HEADS_PER_GROUP:(g + 1) * A_HEADS_PER_GROUP]
            o_g, l_g = _dilated_group(aq[:, :, g], ak[:, :, g], av[:, :, g], tbl, win, dil)
            outs.append(o_g)
            lses.append(l_g)
        mix = jax.nn.softmax(jnp.stack(lses, axis=0), axis=0).astype(x.dtype)
        y_a = jnp.sum(mix[..., None] * jnp.stack(outs, axis=0), axis=0).reshape(Bn, S, A_OUT_WIDTH)

        y_b = _swa_sinks(bq.reshape(Bn, S, B_Q_HEADS, HEAD_DIM),
                         bk.reshape(Bn, S, B_KV_HEADS, HEAD_DIM),
                         bv.reshape(Bn, S, B_KV_HEADS, HEAD_DIM),
                         rel_bias[:, n_a:n_a + B_Q_HEADS], sinks[l])

        kv_m = (mem @ w_mem_kv[l]).reshape(Bn, M, 2, C_HEADS, C_HEAD_DIM)
        y_c = _memory_attn(cq.reshape(Bn, S, C_HEADS, C_HEAD_DIM), kv_m[:, :, 0], kv_m[:, :, 1])

        gt = jax.nn.sigmoid((gates.reshape(Bn, S, N_GATES, D) + b_gate[l].reshape(N_GATES, D)).astype(jnp.float32)).astype(x.dtype)
        merged = (gt[:, :, 0] * (y_a @ w_branch_a[l])
                  + gt[:, :, 1] * (y_b @ w_branch_b[l])
                  + gt[:, :, 2] * (y_c @ w_branch_c[l]))
        x = _layer_norm(ALPHA * x + merged @ w_out[l], ln1_g[l], ln1_b[l])

        y_p = _peer(x, peer_w_query[l], peer_sub_keys[l], peer_u[l], peer_v[l])
        x = _layer_norm(ALPHA * x + y_p, ln2_g[l], ln2_b[l])
    return x
```

```cpp
#include <hip/hip_runtime.h>
#include <cstdio>
#include <cstdint>
namespace pg8 {
#define PG8_LAS __attribute__((address_space(3)))
typedef unsigned short bf16_t;
typedef short bf16x8 __attribute__((ext_vector_type(8)));
typedef float f32x4 __attribute__((ext_vector_type(4)));
typedef unsigned u32x4 __attribute__((ext_vector_type(4)));
constexpr int BM = 256, BK = 64, HALF = 128, HTB = HALF * BK * 2  , STAGE_BYTES = 8 * HTB, NXCD = 8, WGM = 8;

__host__ __device__ __forceinline__ int lds_byte(int r, int c) { const int st = (r >> 4) * 2 + (c >> 5), rr = r & 15, cc = c & 31, ob = rr * 64 + cc * 2; return st * 1024 + (ob ^ (((ob >> 9) & 1) << 5)); }
__host__ __device__ __forceinline__ void stage_rc(int b, int& R, int& C) { const int st = b / 1024, sb = b % 1024, swz = sb ^ (((sb >> 9) & 1) << 5); R = (st >> 1) * 16 + swz / 64; C = (st & 1) * 32 + (swz % 64) / 2; }
__host__ __device__ __forceinline__ int perm32(int rho) { const int n = rho >> 4, i = rho & 15; return 8 * (i >> 2) + 4 * n + (i & 3); }

struct Unit { int pm, pn; };
struct Gemm { const bf16_t* A; const bf16_t* Bt; int M, N, K; };

struct StaticOrder {
    int nM, nN, nwg, G, c;
    __host__ __device__ void init(int M, int N, int G_, int c_) { nM = M / BM; nN = N / BM; nwg = nM * nN; G = G_; c = c_; }
    __host__ __device__ bool next(int i, Unit& u) const {
        const long L = (long)i * G + c; if (L >= nwg) return false;
        int wgid = (int)L; { const int q = nwg / NXCD, r = nwg % NXCD, xcd = wgid % NXCD, off = wgid / NXCD; wgid = (xcd < r ? xcd * (q + 1) : r * (q + 1) + (xcd - r) * q) + off; }
        const int nig = WGM * nN, gid = wgid / nig, fm = gid * WGM, gsz = (nM - fm) < WGM ? (nM - fm) : WGM;
        u.pm = fm + ((wgid % nig) % gsz); u.pn = (wgid % nig) / gsz; return true;
    }
    __device__ __forceinline__ void a_ready(const Unit&) const {}
    __device__ __forceinline__ void done(const Unit&) const {}
};
__device__ __forceinline__ unsigned cvt_pk_bf16(float lo, float hi) { unsigned r; asm volatile("v_cvt_pk_bf16_f32 %0, %1, %2" : "=v"(r) : "v"(lo), "v"(hi)); return r; }
typedef float f32x2 __attribute__((ext_vector_type(2)));
__device__ __forceinline__ f32x2 gelu_pk(f32x2 v) {
    const f32x2 av = __builtin_elementwise_abs(v), d = av * 0.2316418882f + 1.0f;
    f32x2 t; t.x = __builtin_amdgcn_rcpf(d.x); t.y = __builtin_amdgcn_rcpf(d.y);
    f32x2 q = t * 0.5307027145f + (-0.7265760135f); q = q * t + 0.7107068705f; q = q * t + (-0.142248368f); q = q * t + 0.127414796f; q = q * t;
    const f32x2 s = (v * v) * (-0.72134752044f);
    f32x2 e; e.x = __builtin_amdgcn_exp2f(s.x); e.y = __builtin_amdgcn_exp2f(s.y);
    const f32x2 m = v * (q * e), r = v - m;
    f32x2 o; o.x = v.x < 0.f ? m.x : r.x; o.y = v.y < 0.f ? m.y : r.y; return o;
}
template <class Epi, class Sched, bool STAMP = false>
__device__ __forceinline__ void gemm_phase(PG8_LAS unsigned char* lds, const Gemm g, const Sched& S, const Epi& E, unsigned long long* stamps) {
    const int tid = threadIdx.x, wid = __builtin_amdgcn_readfirstlane(tid >> 6), lane = tid & 63, wr = wid >> 2, wc = wid & 3, fr = lane & 15, fq = lane >> 4;
    const int K = g.K, nt = K / BK;
    int ts_lo = 0, ts_hi = 0, nts = 0; const unsigned long long rt_entry = STAMP ? (unsigned long long)wall_clock64() : 0ull;
#define PG8_STAMP() do { if (STAMP && wid == 0 && nts < 64) { const unsigned long long _c = (unsigned long long)clock64(); \
        ts_lo = (lane == nts) ? (int)(unsigned)_c : ts_lo; ts_hi = (lane == nts) ? (int)(unsigned)(_c >> 32) : ts_hi; ++nts; } } while (0)
    PG8_STAMP();
    unsigned voffA[2], voffB[2];
#pragma unroll
    for (int i = 0; i < 2; ++i) { int R, C; stage_rc(tid * 16 + i * 8192, R, C); const int Rb = Epi::PERM ? ((R & ~31) + perm32(R & 31)) : R;
        voffA[i] = (unsigned)(R * K + C) * 2u; voffB[i] = (unsigned)(Rb * K + C) * 2u; }
    const size_t kstep = (size_t)(BK * 2);
    const size_t hstep = (size_t)HALF * K * 2;
    const size_t tstep = 2 * hstep;
    const unsigned ldsw = (unsigned)wid * 1024u;
    const int aoff = lds_byte(wr * 64 + fr, fq * 8), boff = lds_byte(wc * 32 + fr, fq * 8);
#define PG8_SA(b, h) (((b) * 2 + (h)) * HTB)
#define PG8_SB(b, h) ((4 + (b) * 2 + (h)) * HTB)
#define PG8_STAGE(bufoff, gbase, voff) do { _Pragma("unroll") for (int _i = 0; _i < 2; ++_i) \
        __builtin_amdgcn_global_load_lds((const unsigned*)((const char*)(gbase) + (voff)[_i]), (PG8_LAS unsigned*)(lds + (bufoff) + ldsw + _i * 8192), 16, 0, 0); } while (0)
#define PG8_LDA(dst, b, h) do { _Pragma("unroll") for (int m = 0; m < 4; ++m) _Pragma("unroll") for (int k = 0; k < 2; ++k) dst[m][k] = *(const PG8_LAS bf16x8*)(lds + PG8_SA(b, h) + aoff + m * 2048 + k * 1024); } while (0)
#define PG8_LDB(dst, b, h) do { _Pragma("unroll") for (int n = 0; n < 2; ++n) _Pragma("unroll") for (int k = 0; k < 2; ++k) dst[n][k] = *(const PG8_LAS bf16x8*)(lds + PG8_SB(b, h) + boff + n * 2048 + k * 1024); } while (0)
#define PG8_MMA(ai, bj, At, Bt) do { __builtin_amdgcn_s_setprio(1); _Pragma("unroll") for (int m = 0; m < 4; ++m) _Pragma("unroll") for (int n = 0; n < 2; ++n) _Pragma("unroll") for (int k = 0; k < 2; ++k) \
        acc[ai][bj][m][n] = __builtin_amdgcn_mfma_f32_16x16x32_bf16(Bt[n][k], At[m][k], acc[ai][bj][m][n], 0, 0, 0); __builtin_amdgcn_s_setprio(0); } while (0)
#define PG8_WAIT_V(n) asm volatile("s_waitcnt vmcnt(" #n ")" ::: "memory")
#define PG8_WAIT_L(n) asm volatile("s_waitcnt lgkmcnt(" #n ")" ::: "memory")
#define PG8_BAR __builtin_amdgcn_s_barrier()
#define PG8_SCHED __builtin_amdgcn_sched_barrier(0)
    Unit cur, nxt; int ui = 0;
    if (!S.next(0, cur)) return;
    f32x4 acc[2][2][4][2];
#pragma unroll
    for (int a = 0; a < 2; ++a)
#pragma unroll
        for (int b = 0; b < 2; ++b)
#pragma unroll
            for (int m = 0; m < 4; ++m)
#pragma unroll
                for (int n = 0; n < 2; ++n) acc[a][b][m][n] = (f32x4){0.f, 0.f, 0.f, 0.f};
    bf16x8 At[4][2], B0[2][2], B1[2][2];
    const char* cA = (const char*)g.A + (size_t)cur.pm * tstep; const char* cB = (const char*)g.Bt + (size_t)cur.pn * tstep;
    S.a_ready(cur);
    PG8_STAGE(PG8_SB(0, 0), cB, voffB); PG8_STAGE(PG8_SA(0, 0), cA, voffA); PG8_STAGE(PG8_SB(0, 1), cB + hstep, voffB); PG8_STAGE(PG8_SA(0, 1), cA + hstep, voffA);
    if (wr == 1) PG8_BAR;
    PG8_WAIT_V(4); PG8_BAR;
    PG8_STAGE(PG8_SB(1, 0), cB + kstep, voffB); PG8_STAGE(PG8_SA(1, 0), cA + kstep, voffA); PG8_STAGE(PG8_SB(1, 1), cB + hstep + kstep, voffB);
    PG8_WAIT_V(6); PG8_BAR;
    PG8_STAMP();
    for (;;) {
        const bool has_next = S.next(ui + 1, nxt);
        const char* nA = has_next ? (const char*)g.A + (size_t)nxt.pm * tstep : cA; const char* nB = has_next ? (const char*)g.Bt + (size_t)nxt.pn * tstep : cB;
        for (int t = 0; t < nt; t += 2) {
            const bool last = (t == nt - 2);
            const char* a1 = cA + (size_t)(t + 1) * kstep;
            const char* a2 = last ? nA : cA + (size_t)(t + 2) * kstep; const char* b2 = last ? nB : cB + (size_t)(t + 2) * kstep;
            const char* a3 = a2 + kstep; const char* b3 = b2 + kstep;
            if (last && has_next) S.a_ready(nxt);
            PG8_LDB(B0, 0, 0); PG8_SCHED; PG8_LDA(At, 0, 0); PG8_STAGE(PG8_SA(1, 1), a1 + hstep, voffA);
            PG8_WAIT_L(8); PG8_BAR; PG8_WAIT_L(0); PG8_MMA(0, 0, At, B0); PG8_BAR; PG8_SCHED;
            PG8_LDB(B1, 0, 1); PG8_STAGE(PG8_SB(0, 0), b2, voffB);
            PG8_BAR; PG8_WAIT_L(0); PG8_MMA(0, 1, At, B1); PG8_BAR;
            PG8_LDA(At, 0, 1); PG8_STAGE(PG8_SA(0, 0), a2, voffA);
            PG8_BAR; PG8_WAIT_L(0); PG8_MMA(1, 0, At, B0); PG8_BAR; PG8_SCHED;
            PG8_STAGE(PG8_SB(0, 1), b2 + hstep, voffB);
            PG8_WAIT_V(6); PG8_BAR; PG8_MMA(1, 1, At, B1); PG8_BAR;
            PG8_LDB(B0, 1, 0); PG8_SCHED; PG8_LDA(At, 1, 0); PG8_STAGE(PG8_SA(0, 1), a2 + hstep, voffA);
            PG8_WAIT_L(8); PG8_BAR; PG8_WAIT_L(0); PG8_MMA(0, 0, At, B0); PG8_BAR; PG8_SCHED;
            PG8_LDB(B1, 1, 1); PG8_STAGE(PG8_SB(1, 0), b3, voffB);
            PG8_BAR; PG8_WAIT_L(0); PG8_MMA(0, 1, At, B1); PG8_BAR;
            PG8_LDA(At, 1, 1); PG8_STAGE(PG8_SA(1, 0), a3, voffA);
            PG8_BAR; PG8_WAIT_L(0); PG8_MMA(1, 0, At, B0); PG8_BAR; PG8_SCHED;
            PG8_STAGE(PG8_SB(1, 1), b3 + hstep, voffB);
            PG8_WAIT_V(6); PG8_BAR; PG8_MMA(1, 1, At, B1); PG8_BAR;
        }
        PG8_STAMP();
        if constexpr (!Epi::AFTER_DRAIN) { E(acc, cur, wr, wc, fr, fq); S.done(cur); }
        PG8_STAMP();
        if (!has_next) break;
#pragma unroll
        for (int a = 0; a < 2; ++a)
#pragma unroll
            for (int b = 0; b < 2; ++b)
#pragma unroll
                for (int m = 0; m < 4; ++m)
#pragma unroll
                    for (int n = 0; n < 2; ++n) acc[a][b][m][n] = (f32x4){0.f, 0.f, 0.f, 0.f};
        cur = nxt; cA = nA; cB = nB; ++ui;
    }
    PG8_WAIT_V(0);
    if (wr == 0) PG8_BAR;
    PG8_BAR;
    if constexpr (Epi::AFTER_DRAIN) { E.fused(acc, cur, wr, wc, fr, fq, lds, wid, lane); S.done(cur); }
    PG8_STAMP();
    if (STAMP && wid == 0) { stamps[lane] = lane < nts ? (((unsigned long long)(unsigned)ts_hi << 32) | (unsigned)ts_lo) : 0ull;
        if (lane == 62) stamps[62] = rt_entry; if (lane == 63) stamps[63] = (unsigned long long)wall_clock64(); }
#undef PG8_STAMP
#undef PG8_SA
#undef PG8_SB
#undef PG8_STAGE
#undef PG8_LDA
#undef PG8_LDB
#undef PG8_MMA
#undef PG8_WAIT_V
#undef PG8_WAIT_L
#undef PG8_BAR
#undef PG8_SCHED
}
}

typedef unsigned short bf16_t;
typedef float f32x4 __attribute__((ext_vector_type(4)));
typedef unsigned u32x4 __attribute__((ext_vector_type(4)));
typedef unsigned u32x2 __attribute__((ext_vector_type(2)));
typedef __bf16 bf16x2_t __attribute__((ext_vector_type(2)));
constexpr int D = 1024, BATCH = 8, SEQ = 4096, T = BATCH * SEQ, MEMLEN = 256;
constexpr int HQW = 3584, GW = 3072, INW = 6656, NEXP = 16384;
constexpr int C_AQ = 0, C_AK = 768, C_AV = 1536, C_BQ = 2304, C_BK = 2816, C_BV = 2944, C_CQ = 3072;
constexpr float ALPHA = 1.189207115002721f, LOG2E = 1.4426950408889634f, LN2F = 0.6931471805599453f, LN_EPS = 1e-5f, NEGBIG = -1e30f;
constexpr size_t MiB = 1u << 20;
#ifndef DBG_CHECK
#define DBG_CHECK 0
#endif
#ifndef DBG_DROP
#define DBG_DROP 0
#endif
constexpr size_t WS_CTL = 0, WS_WMEMKV = 1 * MiB, WS_WA = 3 * MiB, WS_WB = WS_WA + MiB / 2, WS_WC = WS_WB + MiB, WS_WOUT = WS_WC + MiB, WS_WQ = WS_WOUT + 2 * MiB,
                 WS_SUBK = WS_WQ + 2 * MiB, WS_MEMB = 10 * MiB, WS_KVM = 14 * MiB, WS_STATS = 18 * MiB, WS_LSE = 19 * MiB;
constexpr size_t WS_RA = 24 * MiB, WS_RB = 248 * MiB, WS_RC = 440 * MiB, WS_END = 504 * MiB;
constexpr size_t WS_HQ = WS_RA, WS_GATES = WS_RB, WS_XB = WS_RC;
constexpr size_t WS_MF = WS_RA, WS_MB = WS_RA + 128 * MiB;
constexpr size_t WS_Z = WS_RB, WS_X1B = WS_RB + 128 * MiB;
constexpr size_t WS_Q = WS_RA, WS_EIDX = WS_RA + 88 * MiB - 24 * MiB, WS_GATE = WS_EIDX + 16 * MiB;
constexpr size_t WS_UB = WS_RC, WS_VB = WS_RC + 32 * MiB;
constexpr size_t DO_WINT = 0;
constexpr size_t DO_OA = 0, DO_YB = 48 * MiB, DO_YC = 80 * MiB, DO_YA = 112 * MiB;

__device__ const unsigned char kBucket[3][132] = {
{0,1,2,3,4,5,6,7,8,9,10,11,12,13,14,15,16,16,16,16,16,16,17,17,17,17,17,17,17,17,18,18,18,18,18,18,18,18,18,18,19,19,19,19,19,19,19,19,19,19,19,19,19,19,20,20,20,20,20,20,20,20,20,20,20,20,20,20,20,20,20,20,20,21,21,21,21,21,21,21,21,21,21,21,21,21,21,21,21,21,21,21,21,21,21,21,21,21,21,22,22,22,22,22,22,22,22,22,22,22,22,22,22,22,22,22,22,22,22,22,22,22,22,22,22,22,22,22,22,22,22,22},
{0,4,8,12,16,16,17,17,18,18,19,19,19,19,20,20,20,20,20,21,21,21,21,21,21,22,22,22,22,22,22,22,22,22,23,23,23,23,23,23,23,23,23,23,23,23,24,24,24,24,24,24,24,24,24,24,24,24,24,24,24,24,25,25,25,25,25,25,25,25,25,25,25,25,25,25,25,25,25,25,25,25,25,26,26,26,26,26,26,26,26,26,26,26,26,26,26,26,26,26,26,26,26,26,26,26,26,26,26,26,26,26,26,27,27,27,27,27,27,27,27,27,27,27,27,27,27,27,27,27,27,27},
{0,16,18,19,20,21,21,22,22,23,23,23,24,24,24,24,25,25,25,25,25,26,26,26,26,26,26,26,26,27,27,27,27,27,27,27,27,27,27,28,28,28,28,28,28,28,28,28,28,28,28,28,29,29,29,29,29,29,29,29,29,29,29,29,29,29,29,29,29,29,30,30,30,30,30,30,30,30,30,30,30,30,30,30,30,30,30,30,30,30,30,30,30,30,30,31,31,31,31,31,31,31,31,31,31,31,31,31,31,31,31,31,31,31,31,31,31,31,31,31,31,31,31,31,31,31,31,31,31,31,31,31}};

__device__ __forceinline__ bf16_t f2bf(float x) { unsigned u = __float_as_uint(x); u += 0x7fffu + ((u >> 16) & 1u); return (bf16_t)(u >> 16); }
__device__ __forceinline__ float bf2f(bf16_t h) { return __uint_as_float((unsigned)h << 16); }
__device__ __forceinline__ float bflo(unsigned w) { return __uint_as_float(w << 16); }
__device__ __forceinline__ float bfhi(unsigned w) { return __uint_as_float(w & 0xffff0000u); }
__device__ __forceinline__ unsigned pk2(float lo, float hi) { bf16x2_t v; v.x = (__bf16)lo; v.y = (__bf16)hi; return __builtin_bit_cast(unsigned, v); }
__device__ __forceinline__ float dot2bf(unsigned a, unsigned b, float acc) { return __builtin_amdgcn_fdot2_f32_bf16(__builtin_bit_cast(bf16x2_t, a), __builtin_bit_cast(bf16x2_t, b), acc, false); }
__device__ __forceinline__ float wave_sum(float v) { for (int o = 32; o >= 1; o >>= 1) v += __shfl_xor(v, o, 64); return v; }
__device__ __forceinline__ float wave_max(float v) { for (int o = 32; o >= 1; o >>= 1) v = fmaxf(v, __shfl_xor(v, o, 64)); return v; }

__global__ void k_cvt(const float* __restrict__ src, bf16_t* __restrict__ dst, size_t n8) {
    for (size_t i = (size_t)blockIdx.x * blockDim.x + threadIdx.x; i < n8; i += (size_t)gridDim.x * blockDim.x) {
        const f32x4 a = ((const f32x4*)src)[2 * i], b = ((const f32x4*)src)[2 * i + 1];
        u32x4 w; w.x = pk2(a[0], a[1]); w.y = pk2(a[2], a[3]); w.z = pk2(b[0], b[1]); w.w = pk2(b[2], b[3]);
        ((u32x4*)dst)[i] = w; }
}
__global__ void k_zero(float* p, size_t n) { for (size_t i = (size_t)blockIdx.x * blockDim.x + threadIdx.x; i < n; i += (size_t)gridDim.x * blockDim.x) p[i] = 0.f; }
__global__ void k_transpose_cvt(const float* __restrict__ src, int K, int N, bf16_t* __restrict__ dst) {
    __shared__ float tile[64][65];
    const int n0 = blockIdx.x * 64, k0 = blockIdx.y * 64;
    for (int i = threadIdx.x; i < 4096; i += 256) { const int r = i >> 6, c = i & 63; tile[r][c] = src[(size_t)(k0 + r) * N + n0 + c]; }
    __syncthreads();
    for (int i = threadIdx.x; i < 4096; i += 256) { const int n = i >> 6, k = i & 63; dst[(size_t)(n0 + n) * K + k0 + k] = f2bf(tile[k][n]); }
}

struct EpiIn {
    static constexpr bool PERM = true, AFTER_DRAIN = false;
    bf16_t* hq; bf16_t* gates; const float* bgate;
    __device__ __forceinline__ void operator()(const pg8::f32x4 (&acc)[2][2][4][2], const pg8::Unit& u, int wr, int wc, int fr, int fq) const {
        const int row0 = u.pm * 256 + wr * 64 + fr;
        if (u.pn < 14) {
            const float sc = (u.pn < 3 || u.pn == 9 || u.pn == 10) ? 0.125f * LOG2E : ((u.pn >= 12) ? 0.08838834764831845f * LOG2E : 1.0f);
            const int col0 = u.pn * 256 + wc * 32 + 8 * fq;
#pragma unroll
            for (int ai = 0; ai < 2; ++ai)
#pragma unroll
                for (int m = 0; m < 4; ++m) { bf16_t* rowp = hq + (size_t)(row0 + ai * 128 + m * 16) * HQW + col0;
#pragma unroll
                    for (int bj = 0; bj < 2; ++bj) { const pg8::f32x4 v0 = acc[ai][bj][m][0] * sc, v1 = acc[ai][bj][m][1] * sc;
                        u32x4 w; w.x = pk2(v0[0], v0[1]); w.y = pk2(v0[2], v0[3]); w.z = pk2(v1[0], v1[1]); w.w = pk2(v1[2], v1[3]);
                        *(u32x4*)(rowp + bj * 128) = w; } }
        } else {
            const int col0 = (u.pn - 14) * 256 + wc * 32 + 8 * fq;
            pg8::f32x4 bv[2][2];
#pragma unroll
            for (int bj = 0; bj < 2; ++bj)
#pragma unroll
                for (int n = 0; n < 2; ++n) bv[bj][n] = *(const pg8::f32x4*)(bgate + col0 + bj * 128 + 4 * n);
#pragma unroll
            for (int ai = 0; ai < 2; ++ai)
#pragma unroll
                for (int m = 0; m < 4; ++m) { bf16_t* rowp = gates + (size_t)(row0 + ai * 128 + m * 16) * GW + col0;
#pragma unroll
                    for (int bj = 0; bj < 2; ++bj) { pg8::f32x4 v0 = acc[ai][bj][m][0] + bv[bj][0], v1 = acc[ai][bj][m][1] + bv[bj][1];
#pragma unroll
                        for (int j = 0; j < 4; ++j) { v0[j] = __builtin_amdgcn_rcpf(1.0f + __builtin_amdgcn_exp2f(-LOG2E * v0[j])); v1[j] = __builtin_amdgcn_rcpf(1.0f + __builtin_amdgcn_exp2f(-LOG2E * v1[j])); }
                        u32x4 w; w.x = pk2(v0[0], v0[1]); w.y = pk2(v0[2], v0[3]); w.z = pk2(v1[0], v1[1]); w.w = pk2(v1[2], v1[3]);
                        *(u32x4*)(rowp + bj * 128) = w; } }
        }
    }
};
struct EpiPlain {
    static constexpr bool PERM = true, AFTER_DRAIN = false;
    bf16_t* O; int ldc;
    __device__ __forceinline__ void operator()(const pg8::f32x4 (&acc)[2][2][4][2], const pg8::Unit& u, int wr, int wc, int fr, int fq) const {
        const int row0 = u.pm * 256 + wr * 64 + fr, col0 = u.pn * 256 + wc * 32 + 8 * fq;
#pragma unroll
        for (int ai = 0; ai < 2; ++ai)
#pragma unroll
            for (int m = 0; m < 4; ++m) { bf16_t* rowp = O + (size_t)(row0 + ai * 128 + m * 16) * ldc + col0;
#pragma unroll
                for (int bj = 0; bj < 2; ++bj) { const pg8::f32x4 v0 = acc[ai][bj][m][0], v1 = acc[ai][bj][m][1];
                    u32x4 w; w.x = pk2(v0[0], v0[1]); w.y = pk2(v0[2], v0[3]); w.z = pk2(v1[0], v1[1]); w.w = pk2(v1[2], v1[3]);
                    *(u32x4*)(rowp + bj * 128) = w; } }
    }
};
template <int MODE> struct EpiMerge {
    static constexpr bool PERM = true, AFTER_DRAIN = false;
    const bf16_t* gates; float* mf; bf16_t* mb;
    __device__ __forceinline__ void operator()(const pg8::f32x4 (&acc)[2][2][4][2], const pg8::Unit& u, int wr, int wc, int fr, int fq) const {
        const int row0 = u.pm * 256 + wr * 64 + fr, col0 = u.pn * 256 + wc * 32 + 8 * fq;
#pragma unroll
        for (int ai = 0; ai < 2; ++ai)
#pragma unroll
            for (int m = 0; m < 4; ++m) { const size_t row = (size_t)(row0 + ai * 128 + m * 16);
#pragma unroll
                for (int bj = 0; bj < 2; ++bj) { const int col = col0 + bj * 128;
                    const u32x4 g = *(const u32x4*)(gates + row * GW + MODE * 1024 + col);
                    pg8::f32x4 v0 = acc[ai][bj][m][0], v1 = acc[ai][bj][m][1];
                    v0[0] *= bflo(g.x); v0[1] *= bfhi(g.x); v0[2] *= bflo(g.y); v0[3] *= bfhi(g.y); v1[0] *= bflo(g.z); v1[1] *= bfhi(g.z); v1[2] *= bflo(g.w); v1[3] *= bfhi(g.w);
                    float* mp = mf + row * D + col;
                    if (MODE >= 1) { v0 += *(const pg8::f32x4*)mp; v1 += *(const pg8::f32x4*)(mp + 4); }
                    if (MODE <= 1) { *(pg8::f32x4*)mp = v0; *(pg8::f32x4*)(mp + 4) = v1; }
                    else { u32x4 w; w.x = pk2(v0[0], v0[1]); w.y = pk2(v0[2], v0[3]); w.z = pk2(v1[0], v1[1]); w.w = pk2(v1[2], v1[3]); *(u32x4*)(mb + row * D + col) = w; } } }
    }
};
struct EpiOut {
    static constexpr bool PERM = true, AFTER_DRAIN = false;
    const float* x; float* z; float* stats;
    __device__ __forceinline__ void operator()(const pg8::f32x4 (&acc)[2][2][4][2], const pg8::Unit& u, int wr, int wc, int fr, int fq) const {
        const int row0 = u.pm * 256 + wr * 64 + fr, col0 = u.pn * 256 + wc * 32 + 8 * fq;
#pragma unroll
        for (int ai = 0; ai < 2; ++ai)
#pragma unroll
            for (int m = 0; m < 4; ++m) { const size_t row = (size_t)(row0 + ai * 128 + m * 16); float s = 0.f, ss = 0.f;
#pragma unroll
                for (int bj = 0; bj < 2; ++bj) { const size_t o = row * D + col0 + bj * 128;
                    pg8::f32x4 v0 = *(const pg8::f32x4*)(x + o) * ALPHA + acc[ai][bj][m][0], v1 = *(const pg8::f32x4*)(x + o + 4) * ALPHA + acc[ai][bj][m][1];
                    *(pg8::f32x4*)(z + o) = v0; *(pg8::f32x4*)(z + o + 4) = v1;
#pragma unroll
                    for (int j = 0; j < 4; ++j) { s += v0[j] + v1[j]; ss += v0[j] * v0[j] + v1[j] * v1[j]; } }
                s += __shfl_xor(s, 16, 64); ss += __shfl_xor(ss, 16, 64); s += __shfl_xor(s, 32, 64); ss += __shfl_xor(ss, 32, 64);
                if (fq == 0) { atomicAdd(stats + row * 2, s); atomicAdd(stats + row * 2 + 1, ss); } }
    }
};

template <class Epi> __global__ __launch_bounds__(512, 2) void k_gemm(pg8::Gemm g, Epi E) {
    extern __shared__ __attribute__((aligned(16))) unsigned char shm[];
    pg8::StaticOrder S; S.init(g.M, g.N, (int)gridDim.x, (int)blockIdx.x);
    pg8::gemm_phase<Epi, pg8::StaticOrder, false>((PG8_LAS unsigned char*)shm, g, S, E, nullptr);
}

template <int DH, int NPASS, class F>
__device__ __forceinline__ void attn_row(const bf16_t* qrow, const F& f, float m_init, float l_init, float* sP, float& m_out, float& l_out, float (&o)[DH / 64]) {
    const int lane = threadIdx.x & 63;
    u32x4 q[DH / 8];
#pragma unroll
    for (int i = 0; i < DH / 8; ++i) q[i] = ((const u32x4*)qrow)[i];
    float s[NPASS]; float m = m_init;
#pragma unroll
    for (int p = 0; p < NPASS; ++p) { const int j = p * 64 + lane; const bf16_t* kp; const bf16_t* vp; float bias;
        const bool valid = f(j, kp, vp, bias); float d = 0.f;
        if (valid) {
#pragma unroll
            for (int i = 0; i < DH / 8; ++i) { const u32x4 kk = ((const u32x4*)kp)[i]; d = dot2bf(q[i].x, kk.x, d); d = dot2bf(q[i].y, kk.y, d); d = dot2bf(q[i].z, kk.z, d); d = dot2bf(q[i].w, kk.w, d); }
            d += bias; } else d = NEGBIG;
        s[p] = d; m = fmaxf(m, d); }
    m = wave_max(m);
    float l = 0.f;
#pragma unroll
    for (int p = 0; p < NPASS; ++p) { const float pj = (s[p] > -1e29f) ? __builtin_amdgcn_exp2f(s[p] - m) : 0.f; sP[p * 64 + lane] = pj; l += pj; }
    l = wave_sum(l) + l_init * __builtin_amdgcn_exp2f(m_init - m);
    __builtin_amdgcn_s_waitcnt(0);
#pragma unroll
    for (int e = 0; e < DH / 64; ++e) o[e] = 0.f;
    for (int j = 0; j < NPASS * 64; ++j) { const float pj = sP[j]; if (pj == 0.f) continue; const bf16_t* kp; const bf16_t* vp; float bias; f(j, kp, vp, bias);
        if (DH == 64) o[0] += pj * bf2f(vp[lane]);
        else { const unsigned w = ((const unsigned*)vp)[lane]; o[0] += pj * bflo(w); o[DH / 64 - 1] += pj * bfhi(w); } }
    m_out = m; l_out = l;
}
__global__ __launch_bounds__(256) void k_attnA(const bf16_t* __restrict__ hq, const float* __restrict__ relb, bf16_t* __restrict__ oA, float* __restrict__ lseA) {
    __shared__ float sP[4][192];
    const int wv = threadIdx.x >> 6, lane = threadIdx.x & 63; const int id = blockIdx.x * 4 + wv;
    const int t = id / 12, hh = id % 12, g = hh >> 2, h = hh & 3, r = (g == 0) ? 1 : (g == 1 ? 4 : 16), s = t & (SEQ - 1), tb = t - s;
    const bf16_t* base = hq + g * 256 + h * 64;
    auto f = [&](int j, const bf16_t*& kp, const bf16_t*& vp, float& bias) -> bool { const int ks = s - j * r; if (j > 128 || ks < 0) return false;
        kp = base + (size_t)(tb + ks) * HQW + C_AK; vp = base + (size_t)(tb + ks) * HQW + C_AV; bias = relb[kBucket[g][j] * 20 + g * 4 + h] * LOG2E; return true; };
    float m, l, o[1];
    attn_row<64, 3>(base + (size_t)t * HQW + C_AQ, f, NEGBIG, 0.f, sP[wv], m, l, o);
    oA[((size_t)g * T + t) * 256 + h * 64 + lane] = f2bf(o[0] / l);
    if (lane == 0) lseA[((size_t)g * T + t) * 4 + h] = (m + __builtin_amdgcn_logf(l)) * LN2F;
}
__global__ __launch_bounds__(256) void k_attnB(const bf16_t* __restrict__ hq, const float* __restrict__ relb, const float* __restrict__ sinks, bf16_t* __restrict__ yb) {
    __shared__ float sP[4][128];
    const int wv = threadIdx.x >> 6, lane = threadIdx.x & 63; const int id = blockIdx.x * 4 + wv;
    const int t = id >> 3, head = id & 7, kvh = head >> 2, s = t & (SEQ - 1), tb = t - s;
    auto f = [&](int j, const bf16_t*& kp, const bf16_t*& vp, float& bias) -> bool { const int ks = s - j; if (j > 127 || ks < 0) return false;
        kp = hq + (size_t)(tb + ks) * HQW + C_BK + kvh * 64; vp = hq + (size_t)(tb + ks) * HQW + C_BV + kvh * 64; bias = relb[kBucket[0][j] * 20 + 12 + head] * LOG2E; return true; };
    float m, l, o[1];
    attn_row<64, 2>(hq + (size_t)t * HQW + C_BQ + head * 64, f, sinks[head] * LOG2E, 1.0f, sP[wv], m, l, o);
    yb[(size_t)t * 512 + head * 64 + lane] = (DBG_DROP & 2) ? (bf16_t)0 : f2bf(o[0] / l);
}
__global__ __launch_bounds__(256) void k_attnC(const bf16_t* __restrict__ hq, const bf16_t* __restrict__ kvm, bf16_t* __restrict__ yc) {
    __shared__ float sP[4][256];
    const int wv = threadIdx.x >> 6, lane = threadIdx.x & 63; const int id = blockIdx.x * 4 + wv;
    const int t = id >> 2, head = id & 3, b = t / SEQ;
    auto f = [&](int j, const bf16_t*& kp, const bf16_t*& vp, float& bias) -> bool {
        kp = kvm + (size_t)(b * MEMLEN + j) * 1024 + head * 128; vp = kp + 512; bias = 0.f; return true; };
    float m, l, o[2];
    attn_row<128, 4>(hq + (size_t)t * HQW + C_CQ + head * 128, f, NEGBIG, 0.f, sP[wv], m, l, o);
    ((unsigned*)(yc + (size_t)t * 512 + head * 128))[lane] = (DBG_DROP & 4) ? 0u : pk2(o[0] / l, o[1] / l);
}
__global__ void k_mix(const bf16_t* __restrict__ oA, const float* __restrict__ lseA, bf16_t* __restrict__ ya) {
    const size_t i = (size_t)blockIdx.x * blockDim.x + threadIdx.x; if (i >= (size_t)T * 256) return;
    const size_t t = i >> 8; const int col = (int)(i & 255), h = col >> 6;
    const float l0 = lseA[((size_t)0 * T + t) * 4 + h], l1 = lseA[((size_t)1 * T + t) * 4 + h], l2 = lseA[((size_t)2 * T + t) * 4 + h];
    const float mx = fmaxf(l0, fmaxf(l1, l2)), e0 = __expf(l0 - mx), e1 = __expf(l1 - mx), e2 = __expf(l2 - mx), inv = 1.f / (e0 + e1 + e2);
    ya[i] = (DBG_DROP & 1) ? (bf16_t)0 : f2bf((e0 * bf2f(oA[i]) + e1 * bf2f(oA[(size_t)T * 256 + i]) + e2 * bf2f(oA[(size_t)2 * T * 256 + i])) * inv);
}
__global__ void k_ln1(const float* __restrict__ z, const float* __restrict__ stats, const float* __restrict__ g, const float* __restrict__ b, bf16_t* __restrict__ x1b) {
    const size_t i = (size_t)blockIdx.x * blockDim.x + threadIdx.x; if (i >= (size_t)T * 128) return;
    const size_t t = i >> 7; const int c = (int)(i & 127) * 8;
    const float mean = stats[t * 2] * (1.f / D), var = stats[t * 2 + 1] * (1.f / D) - mean * mean, rstd = rsqrtf(var + LN_EPS);
    const f32x4 a0 = *(const f32x4*)(z + t * D + c), a1 = *(const f32x4*)(z + t * D + c + 4), g0 = *(const f32x4*)(g + c), g1 = *(const f32x4*)(g + c + 4), b0 = *(const f32x4*)(b + c), b1 = *(const f32x4*)(b + c + 4);
    const f32x4 y0 = (a0 - mean) * rstd * g0 + b0, y1 = (a1 - mean) * rstd * g1 + b1;
    u32x4 w; w.x = pk2(y0[0], y0[1]); w.y = pk2(y0[2], y0[3]); w.z = pk2(y1[0], y1[1]); w.w = pk2(y1[2], y1[3]);
    *(u32x4*)(x1b + t * D + c) = w;
}
__device__ __forceinline__ void wave_argmax(float v, int idx, float& bv, int& bi) {
    for (int o = 32; o >= 1; o >>= 1) { const float ov = __shfl_xor(v, o, 64); const int oi = __shfl_xor(idx, o, 64); if (ov > v || (ov == v && oi < idx)) { v = ov; idx = oi; } }
    bv = v; bi = idx;
}
__global__ __launch_bounds__(256) void k_topk(const bf16_t* __restrict__ qb, const bf16_t* __restrict__ subk, int* __restrict__ eidx, float* __restrict__ gate) {
    const int wv = threadIdx.x >> 6, lane = threadIdx.x & 63; const int id = blockIdx.x * 4 + wv;
    const int t = id >> 3, h = id & 7;
    float sv[2]; int si[2];
#pragma unroll
    for (int c = 0; c < 2; ++c) {
        const bf16_t* qp = qb + (size_t)t * D + h * 128 + c * 64; const bf16_t* kp = subk + ((size_t)(h * 2 + c) * 128) * 64;
        float s0 = 0.f, s1 = 0.f;
#pragma unroll
        for (int i = 0; i < 8; ++i) { const u32x4 q = ((const u32x4*)qp)[i], k0 = ((const u32x4*)(kp + (size_t)lane * 64))[i], k1 = ((const u32x4*)(kp + (size_t)(lane + 64) * 64))[i];
            s0 = dot2bf(q.x, k0.x, s0); s0 = dot2bf(q.y, k0.y, s0); s0 = dot2bf(q.z, k0.z, s0); s0 = dot2bf(q.w, k0.w, s0);
            s1 = dot2bf(q.x, k1.x, s1); s1 = dot2bf(q.y, k1.y, s1); s1 = dot2bf(q.z, k1.z, s1); s1 = dot2bf(q.w, k1.w, s1); }
        float myv = 0.f; int myi = 0;
        for (int it = 0; it < 16; ++it) { float lv; int li; if (s0 > s1 || (s0 == s1)) { lv = s0; li = lane; } else { lv = s1; li = lane + 64; }
            float bv; int bi; wave_argmax(lv, li, bv, bi);
            if (lane == it) { myv = bv; myi = bi; }
            if (bi == lane) s0 = -3.0e38f; if (bi == lane + 64) s1 = -3.0e38f; }
        sv[c] = myv; si[c] = myi; }
    float cv[4];
#pragma unroll
    for (int q = 0; q < 4; ++q) { const int ci = lane + 64 * q; cv[q] = __shfl(sv[0], ci >> 4, 64) + __shfl(sv[1], ci & 15, 64); }
    float topv = 0.f; int topc = 0;
    for (int it = 0; it < 16; ++it) { float lv = cv[0]; int li = lane;
#pragma unroll
        for (int q = 1; q < 4; ++q) if (cv[q] > lv) { lv = cv[q]; li = lane + 64 * q; }
        float bv; int bi; wave_argmax(lv, li, bv, bi);
        if (lane == it) { topv = bv; topc = bi; }
#pragma unroll
        for (int q = 0; q < 4; ++q) if (bi == lane + 64 * q) cv[q] = -3.0e38f; }
    const float mx = __shfl(topv, 0, 64);
    float e = (lane < 16) ? __expf(topv - mx) : 0.f; const float sum = wave_sum(e);
    const int e0 = __shfl(si[0], topc >> 4, 64), e1 = __shfl(si[1], topc & 15, 64);
    if (lane < 16) { eidx[(size_t)t * 128 + h * 16 + lane] = e0 * 128 + e1; gate[(size_t)t * 128 + h * 16 + lane] = e / sum; }
}
__global__ __launch_bounds__(256) void k_peer(const float* __restrict__ z, const float* __restrict__ stats, const float* __restrict__ g1, const float* __restrict__ b1, const bf16_t* __restrict__ x1b,
                                               const int* __restrict__ eidx, const float* __restrict__ gate, const bf16_t* __restrict__ ub, const bf16_t* __restrict__ vb,
                                               const float* __restrict__ g2, const float* __restrict__ b2, float* __restrict__ out) {
    const int wv = threadIdx.x >> 6, lane = threadIdx.x & 63; const size_t t = (size_t)blockIdx.x * 4 + wv;
    const u32x4 xa = *(const u32x4*)(x1b + t * D + 8 * lane), xc = *(const u32x4*)(x1b + t * D + 512 + 8 * lane);
    float acc[16];
#pragma unroll
    for (int i = 0; i < 16; ++i) acc[i] = 0.f;
    const int myE0 = eidx[t * 128 + lane], myE1 = eidx[t * 128 + 64 + lane]; const float myG0 = gate[t * 128 + lane], myG1 = gate[t * 128 + 64 + lane];
    for (int k0 = 0; k0 < 128; k0 += 4) {
        u32x4 ua[4], uc[4]; int e[4]; float gk[4];
#pragma unroll
        for (int i = 0; i < 4; ++i) { const int k = k0 + i; e[i] = __shfl(k < 64 ? myE0 : myE1, k & 63, 64); gk[i] = __shfl(k < 64 ? myG0 : myG1, k & 63, 64);
            ua[i] = *(const u32x4*)(ub + (size_t)e[i] * D + 8 * lane); uc[i] = *(const u32x4*)(ub + (size_t)e[i] * D + 512 + 8 * lane); }
        float hsum[4];
#pragma unroll
        for (int i = 0; i < 4; ++i) { float d = 0.f; d = dot2bf(ua[i].x, xa.x, d); d = dot2bf(ua[i].y, xa.y, d); d = dot2bf(ua[i].z, xa.z, d); d = dot2bf(ua[i].w, xa.w, d);
            d = dot2bf(uc[i].x, xc.x, d); d = dot2bf(uc[i].y, xc.y, d); d = dot2bf(uc[i].z, xc.z, d); d = dot2bf(uc[i].w, xc.w, d); hsum[i] = wave_sum(d); }
#pragma unroll
        for (int i = 0; i < 4; ++i) { const float hh = hsum[i]; const float c = (DBG_DROP & 8) ? 0.f : gk[i] * 0.5f * hh * (1.0f + erff(hh * 0.70710678118f));
            const u32x4 va = *(const u32x4*)(vb + (size_t)e[i] * D + 8 * lane), vc = *(const u32x4*)(vb + (size_t)e[i] * D + 512 + 8 * lane);
            acc[0] += c * bflo(va.x); acc[1] += c * bfhi(va.x); acc[2] += c * bflo(va.y); acc[3] += c * bfhi(va.y); acc[4] += c * bflo(va.z); acc[5] += c * bfhi(va.z); acc[6] += c * bflo(va.w); acc[7] += c * bfhi(va.w);
            acc[8] += c * bflo(vc.x); acc[9] += c * bfhi(vc.x); acc[10] += c * bflo(vc.y); acc[11] += c * bfhi(vc.y); acc[12] += c * bflo(vc.z); acc[13] += c * bfhi(vc.z); acc[14] += c * bflo(vc.w); acc[15] += c * bfhi(vc.w); }
    }
    const float mean1 = stats[t * 2] * (1.f / D), var1 = stats[t * 2 + 1] * (1.f / D) - mean1 * mean1, rstd1 = rsqrtf(var1 + LN_EPS);
    float y[16]; float s = 0.f;
#pragma unroll
    for (int hlf = 0; hlf < 2; ++hlf)
#pragma unroll
        for (int q = 0; q < 2; ++q) { const int c = hlf * 512 + 8 * lane + 4 * q; const f32x4 zz = *(const f32x4*)(z + t * D + c), gg = *(const f32x4*)(g1 + c), bb = *(const f32x4*)(b1 + c);
#pragma unroll
            for (int j = 0; j < 4; ++j) { const float x1 = (zz[j] - mean1) * rstd1 * gg[j] + bb[j]; const float v = ALPHA * x1 + acc[hlf * 8 + q * 4 + j]; y[hlf * 8 + q * 4 + j] = v; s += v; } }
    const float mean2 = wave_sum(s) * (1.f / D); float ss = 0.f;
#pragma unroll
    for (int i = 0; i < 16; ++i) { const float dlt = y[i] - mean2; ss += dlt * dlt; }
    const float rstd2 = rsqrtf(wave_sum(ss) * (1.f / D) + LN_EPS);
#pragma unroll
    for (int hlf = 0; hlf < 2; ++hlf)
#pragma unroll
        for (int q = 0; q < 2; ++q) { const int c = hlf * 512 + 8 * lane + 4 * q; const f32x4 gg = *(const f32x4*)(g2 + c), bb = *(const f32x4*)(b2 + c); f32x4 o;
#pragma unroll
            for (int j = 0; j < 4; ++j) o[j] = (y[hlf * 8 + q * 4 + j] - mean2) * rstd2 * gg[j] + bb[j];
            *(f32x4*)(out + t * D + c) = o; }
}


#if DBG_CHECK
__device__ __forceinline__ unsigned hash32(unsigned x) { x ^= x >> 16; x *= 0x7feb352du; x ^= x >> 15; x *= 0x846ca68bu; x ^= x >> 16; return x; }
__global__ void k_chk1(const float* x, const float* w_in, const float* bgate, const bf16_t* hq, const bf16_t* gates, unsigned* flags) {
    const unsigned i = blockIdx.x * blockDim.x + threadIdx.x; const unsigned hsh = hash32(i * 2654435761u + 12345u);
    const int row = hsh % T, col = (hsh >> 15) % INW;
    float acc = 0.f; for (int k = 0; k < D; ++k) acc += x[(size_t)row * D + k] * w_in[(size_t)k * INW + col];
    float ref, got;
    if (col < HQW) { const int pn = col >> 8; const float sc = (pn < 3 || pn == 9 || pn == 10) ? 0.125f * LOG2E : ((pn >= 12) ? 0.08838834764831845f * LOG2E : 1.0f); ref = acc * sc; got = bf2f(hq[(size_t)row * HQW + col]); }
    else { ref = 1.f / (1.f + expf(-(acc + bgate[col - HQW]))); got = bf2f(gates[(size_t)row * GW + col - HQW]); }
    if (!(fabsf(ref - got) <= 0.03f + 0.02f * fabsf(ref))) atomicOr(flags, (col < HQW) ? 1u : 2u);
}
__global__ void k_chk2(const bf16_t* ya, const bf16_t* yb, const bf16_t* yc, const bf16_t* gates, const float* w_a, const float* w_b, const float* w_c, const bf16_t* mb, unsigned* flags) {
    const unsigned i = blockIdx.x * blockDim.x + threadIdx.x; const unsigned hsh = hash32(i * 2654435761u + 777u);
    const int row = hsh % T, col = (hsh >> 15) % D;
    float pa = 0.f, pb = 0.f, pc = 0.f;
    for (int k = 0; k < 256; ++k) pa += bf2f(ya[(size_t)row * 256 + k]) * w_a[(size_t)k * D + col];
    for (int k = 0; k < 512; ++k) { pb += bf2f(yb[(size_t)row * 512 + k]) * w_b[(size_t)k * D + col]; pc += bf2f(yc[(size_t)row * 512 + k]) * w_c[(size_t)k * D + col]; }
    const float ref = bf2f(gates[(size_t)row * GW + col]) * pa + bf2f(gates[(size_t)row * GW + 1024 + col]) * pb + bf2f(gates[(size_t)row * GW + 2048 + col]) * pc;
    const float got = bf2f(mb[(size_t)row * D + col]);
    if (!(fabsf(ref - got) <= 0.01f + 0.02f * fabsf(ref))) atomicOr(flags, 4u);
}
__global__ void k_chk3(const float* x, const bf16_t* mb, const float* w_out, const float* z, unsigned* flags) {
    const unsigned i = blockIdx.x * blockDim.x + threadIdx.x; const unsigned hsh = hash32(i * 2654435761u + 999u);
    const int row = hsh % T, col = (hsh >> 15) % D;
    float acc = 0.f; for (int k = 0; k < D; ++k) acc += bf2f(mb[(size_t)row * D + k]) * w_out[(size_t)k * D + col];
    const float ref = ALPHA * x[(size_t)row * D + col] + acc, got = z[(size_t)row * D + col];
    if (!(fabsf(ref - got) <= 0.005f + 0.005f * fabsf(ref))) atomicOr(flags, 8u);
}
__global__ void k_chk4(const float* mem, const float* w_memkv, const bf16_t* kvm, unsigned* flags) {
    const unsigned i = blockIdx.x * blockDim.x + threadIdx.x; const unsigned hsh = hash32(i * 2654435761u + 4242u);
    const int row = hsh % (BATCH * MEMLEN), col = (hsh >> 15) % 1024;
    float acc = 0.f; for (int k = 0; k < D; ++k) acc += mem[(size_t)row * D + k] * w_memkv[(size_t)k * 1024 + col];
    const float got = bf2f(kvm[(size_t)row * 1024 + col]);
    if (!(fabsf(acc - got) <= 0.03f + 0.02f * fabsf(acc))) atomicOr(flags, 16u);
}
__global__ void k_chk_final(const unsigned* flags, float* out) {
    const unsigned f = flags[0]; if (!f) return;
    const float code = (f & 1u) ? 1.f : (f & 2u) ? 2.f : (f & 4u) ? 3.f : (f & 8u) ? 4.f : 5.f;
    for (size_t i = (size_t)blockIdx.x * blockDim.x + threadIdx.x; i < (size_t)T * D; i += (size_t)gridDim.x * blockDim.x) out[i] = code;
}
#endif

template <class Epi> static void launch_gemm(const bf16_t* A, const bf16_t* Bt, int M, int N, int K, const Epi& E, hipStream_t st) {
    static bool attr = false;
    if (!attr) { (void)hipFuncSetAttribute((const void*)k_gemm<Epi>, hipFuncAttributeMaxDynamicSharedMemorySize, pg8::STAGE_BYTES); attr = true; }
    pg8::Gemm g; g.A = A; g.Bt = Bt; g.M = M; g.N = N; g.K = K;
    int units = (M / 256) * (N / 256); int grid = units < 256 ? units : 256;
    hipLaunchKernelGGL(k_gemm<Epi>, dim3(grid), dim3(512), pg8::STAGE_BYTES, st, g, E);
}

extern "C" void kernel_launch(void* const* d_in, const int* in_sizes, int n_in, void* d_out, int out_size, void* d_ws, size_t ws_size, hipStream_t stream) {
    if (n_in != 19 || in_sizes[0] != T * D || out_size != T * D || ws_size < WS_END) { fprintf(stderr, "kernel_launch: unexpected shapes / workspace (%d inputs, ws %zu)\n", n_in, ws_size); return; }
    const float* x = (const float*)d_in[0]; const float* mem = (const float*)d_in[1]; const float* relb = (const float*)d_in[2]; const float* w_in = (const float*)d_in[3];
    const float* b_gate = (const float*)d_in[4]; const float* w_memkv = (const float*)d_in[5]; const float* sinks = (const float*)d_in[6];
    const float* w_a = (const float*)d_in[7]; const float* w_b = (const float*)d_in[8]; const float* w_c = (const float*)d_in[9]; const float* w_out = (const float*)d_in[10];
    const float* ln1g = (const float*)d_in[11]; const float* ln1b = (const float*)d_in[12]; const float* w_q = (const float*)d_in[13]; const float* subk = (const float*)d_in[14];
    const float* pu = (const float*)d_in[15]; const float* pv = (const float*)d_in[16]; const float* ln2g = (const float*)d_in[17]; const float* ln2b = (const float*)d_in[18];
    char* ws = (char*)d_ws; char* dout = (char*)d_out; float* out = (float*)d_out;
    bf16_t* wmemkv_t = (bf16_t*)(ws + WS_WMEMKV); bf16_t* wA_t = (bf16_t*)(ws + WS_WA); bf16_t* wB_t = (bf16_t*)(ws + WS_WB); bf16_t* wC_t = (bf16_t*)(ws + WS_WC);
    bf16_t* wout_t = (bf16_t*)(ws + WS_WOUT); bf16_t* wq_t = (bf16_t*)(ws + WS_WQ); bf16_t* subkb = (bf16_t*)(ws + WS_SUBK); bf16_t* memb = (bf16_t*)(ws + WS_MEMB);
    bf16_t* kvm = (bf16_t*)(ws + WS_KVM); float* stats = (float*)(ws + WS_STATS); float* lseA = (float*)(ws + WS_LSE);
    bf16_t* hq = (bf16_t*)(ws + WS_HQ); bf16_t* gates = (bf16_t*)(ws + WS_GATES); bf16_t* xb = (bf16_t*)(ws + WS_XB);
    float* mf = (float*)(ws + WS_MF); bf16_t* mb = (bf16_t*)(ws + WS_MB); float* z = (float*)(ws + WS_Z); bf16_t* x1b = (bf16_t*)(ws + WS_X1B);
    bf16_t* qb = (bf16_t*)(ws + WS_Q); int* eidx = (int*)(ws + WS_EIDX); float* gate = (float*)(ws + WS_GATE); bf16_t* ub = (bf16_t*)(ws + WS_UB); bf16_t* vb = (bf16_t*)(ws + WS_VB);
    bf16_t* w_in_t = (bf16_t*)(dout + DO_WINT); bf16_t* oA = (bf16_t*)(dout + DO_OA); bf16_t* yb = (bf16_t*)(dout + DO_YB); bf16_t* yc = (bf16_t*)(dout + DO_YC); bf16_t* ya = (bf16_t*)(dout + DO_YA);

    hipLaunchKernelGGL(k_cvt, dim3(2048), dim3(256), 0, stream, x, xb, (size_t)T * D / 8);
    hipLaunchKernelGGL(k_cvt, dim3(256), dim3(256), 0, stream, mem, memb, (size_t)BATCH * MEMLEN * D / 8);
    hipLaunchKernelGGL(k_cvt, dim3(64), dim3(256), 0, stream, subk, subkb, (size_t)8 * 2 * 128 * 64 / 8);
    hipLaunchKernelGGL(k_transpose_cvt, dim3(INW / 64, D / 64), dim3(256), 0, stream, w_in, D, INW, w_in_t);
    hipLaunchKernelGGL(k_transpose_cvt, dim3(1024 / 64, D / 64), dim3(256), 0, stream, w_memkv, D, 1024, wmemkv_t);
    hipLaunchKernelGGL(k_transpose_cvt, dim3(1024 / 64, 256 / 64), dim3(256), 0, stream, w_a, 256, 1024, wA_t);
    hipLaunchKernelGGL(k_transpose_cvt, dim3(1024 / 64, 512 / 64), dim3(256), 0, stream, w_b, 512, 1024, wB_t);
    hipLaunchKernelGGL(k_transpose_cvt, dim3(1024 / 64, 512 / 64), dim3(256), 0, stream, w_c, 512, 1024, wC_t);
    hipLaunchKernelGGL(k_transpose_cvt, dim3(1024 / 64, D / 64), dim3(256), 0, stream, w_out, D, 1024, wout_t);
    hipLaunchKernelGGL(k_transpose_cvt, dim3(1024 / 64, D / 64), dim3(256), 0, stream, w_q, D, 1024, wq_t);
    hipLaunchKernelGGL(k_zero, dim3(64), dim3(256), 0, stream, stats, (size_t)T * 2);
    { EpiPlain E; E.O = kvm; E.ldc = 1024; launch_gemm(memb, wmemkv_t, BATCH * MEMLEN, 1024, D, E, stream); }
    { EpiIn E; E.hq = hq; E.gates = gates; E.bgate = b_gate; launch_gemm(xb, w_in_t, T, INW, D, E, stream); }
#if DBG_CHECK
    unsigned* flags = (unsigned*)(ws + WS_CTL); hipMemsetAsync(flags, 0, 256, stream);
    hipLaunchKernelGGL(k_chk1, dim3(64), dim3(256), 0, stream, x, w_in, b_gate, hq, gates, flags);
    hipLaunchKernelGGL(k_chk4, dim3(16), dim3(256), 0, stream, mem, w_memkv, kvm, flags);
#endif
    hipLaunchKernelGGL(k_cvt, dim3(2048), dim3(256), 0, stream, pu, ub, (size_t)NEXP * D / 8);
    hipLaunchKernelGGL(k_cvt, dim3(2048), dim3(256), 0, stream, pv, vb, (size_t)NEXP * D / 8);
    hipLaunchKernelGGL(k_attnA, dim3(T * 12 / 4), dim3(256), 0, stream, hq, relb, oA, lseA);
    hipLaunchKernelGGL(k_attnB, dim3(T * 8 / 4), dim3(256), 0, stream, hq, relb, sinks, yb);
    hipLaunchKernelGGL(k_attnC, dim3(T * 4 / 4), dim3(256), 0, stream, hq, kvm, yc);
    hipLaunchKernelGGL(k_mix, dim3(T * 256 / 256), dim3(256), 0, stream, oA, lseA, ya);
    { EpiMerge<0> E; E.gates = gates; E.mf = mf; E.mb = mb; launch_gemm(ya, wA_t, T, D, 256, E, stream); }
    { EpiMerge<1> E; E.gates = gates; E.mf = mf; E.mb = mb; launch_gemm(yb, wB_t, T, D, 512, E, stream); }
    { EpiMerge<2> E; E.gates = gates; E.mf = mf; E.mb = mb; launch_gemm(yc, wC_t, T, D, 512, E, stream); }
#if DBG_CHECK
    hipLaunchKernelGGL(k_chk2, dim3(64), dim3(256), 0, stream, ya, yb, yc, gates, w_a, w_b, w_c, mb, flags);
#endif
    { EpiOut E; E.x = x; E.z = z; E.stats = stats; launch_gemm(mb, wout_t, T, D, D, E, stream); }
#if DBG_CHECK
    hipLaunchKernelGGL(k_chk3, dim3(64), dim3(256), 0, stream, x, mb, w_out, z, flags);
#endif
    hipLaunchKernelGGL(k_ln1, dim3(T * 128 / 256), dim3(256), 0, stream, z, stats, ln1g, ln1b, x1b);
    { EpiPlain E; E.O = qb; E.ldc = 1024; launch_gemm(x1b, wq_t, T, D, D, E, stream); }
    hipLaunchKernelGGL(k_topk, dim3(T * 8 / 4), dim3(256), 0, stream, qb, subkb, eidx, gate);
    hipLaunchKernelGGL(k_peer, dim3(T / 4), dim3(256), 0, stream, z, stats, ln1g, ln1b, x1b, eidx, gate, ub, vb, ln2g, ln2b, out);
#if DBG_CHECK
    hipLaunchKernelGGL(k_chk_final, dim3(1024), dim3(256), 0, stream, flags, out);
#endif
}
```

```cpp
#include <hip/hip_runtime.h>
#include <cstdio>
#include <cstdint>
namespace pg8 {
#define PG8_LAS __attribute__((address_space(3)))
typedef unsigned short bf16_t;
typedef short bf16x8 __attribute__((ext_vector_type(8)));
typedef float f32x4 __attribute__((ext_vector_type(4)));
typedef unsigned u32x4 __attribute__((ext_vector_type(4)));
constexpr int BM = 256, BK = 64, HALF = 128, HTB = HALF * BK * 2  , STAGE_BYTES = 8 * HTB, NXCD = 8, WGM = 8;

__host__ __device__ __forceinline__ int lds_byte(int r, int c) { const int st = (r >> 4) * 2 + (c >> 5), rr = r & 15, cc = c & 31, ob = rr * 64 + cc * 2; return st * 1024 + (ob ^ (((ob >> 9) & 1) << 5)); }
__host__ __device__ __forceinline__ void stage_rc(int b, int& R, int& C) { const int st = b / 1024, sb = b % 1024, swz = sb ^ (((sb >> 9) & 1) << 5); R = (st >> 1) * 16 + swz / 64; C = (st & 1) * 32 + (swz % 64) / 2; }
__host__ __device__ __forceinline__ int perm32(int rho) { const int n = rho >> 4, i = rho & 15; return 8 * (i >> 2) + 4 * n + (i & 3); }

struct Unit { int pm, pn; };
struct Gemm { const bf16_t* A; const bf16_t* Bt; int M, N, K; };

struct StaticOrder {
    int nM, nN, nwg, G, c;
    __host__ __device__ void init(int M, int N, int G_, int c_) { nM = M / BM; nN = N / BM; nwg = nM * nN; G = G_; c = c_; }
    __host__ __device__ bool next(int i, Unit& u) const {
        const long L = (long)i * G + c; if (L >= nwg) return false;
        int wgid = (int)L; { const int q = nwg / NXCD, r = nwg % NXCD, xcd = wgid % NXCD, off = wgid / NXCD; wgid = (xcd < r ? xcd * (q + 1) : r * (q + 1) + (xcd - r) * q) + off; }
        const int nig = WGM * nN, gid = wgid / nig, fm = gid * WGM, gsz = (nM - fm) < WGM ? (nM - fm) : WGM;
        u.pm = fm + ((wgid % nig) % gsz); u.pn = (wgid % nig) / gsz; return true;
    }
    __device__ __forceinline__ void a_ready(const Unit&) const {}
    __device__ __forceinline__ void done(const Unit&) const {}
};
__device__ __forceinline__ unsigned cvt_pk_bf16(float lo, float hi) { unsigned r; asm volatile("v_cvt_pk_bf16_f32 %0, %1, %2" : "=v"(r) : "v"(lo), "v"(hi)); return r; }
typedef float f32x2 __attribute__((ext_vector_type(2)));
__device__ __forceinline__ f32x2 gelu_pk(f32x2 v) {
    const f32x2 av = __builtin_elementwise_abs(v), d = av * 0.2316418882f + 1.0f;
    f32x2 t; t.x = __builtin_amdgcn_rcpf(d.x); t.y = __builtin_amdgcn_rcpf(d.y);
    f32x2 q = t * 0.5307027145f + (-0.7265760135f); q = q * t + 0.7107068705f; q = q * t + (-0.142248368f); q = q * t + 0.127414796f; q = q * t;
    const f32x2 s = (v * v) * (-0.72134752044f);
    f32x2 e; e.x = __builtin_amdgcn_exp2f(s.x); e.y = __builtin_amdgcn_exp2f(s.y);
    const f32x2 m = v * (q * e), r = v - m;
    f32x2 o; o.x = v.x < 0.f ? m.x : r.x; o.y = v.y < 0.f ? m.y : r.y; return o;
}
template <class Epi, class Sched, bool STAMP = false, bool FP8 = false>
__device__ __forceinline__ void gemm_phase(PG8_LAS unsigned char* lds, const Gemm g, const Sched& S, const Epi& E, unsigned long long* stamps) {
    int tid_l = threadIdx.x; asm volatile("" : "+v"(tid_l));
    const int tid = tid_l, wid = __builtin_amdgcn_readfirstlane(tid >> 6), lane = tid & 63, wr = wid >> 2, wc = wid & 3, fr = lane & 15, fq = lane >> 4;
    const int K = g.K, nt = K / BK;
    int ts_lo = 0, ts_hi = 0, nts = 0; const unsigned long long rt_entry = STAMP ? (unsigned long long)wall_clock64() : 0ull;
#define PG8_STAMP() do { if (STAMP && wid == 0 && nts < 64) { const unsigned long long _c = (unsigned long long)clock64(); \
        ts_lo = (lane == nts) ? (int)(unsigned)_c : ts_lo; ts_hi = (lane == nts) ? (int)(unsigned)(_c >> 32) : ts_hi; ++nts; } } while (0)
    PG8_STAMP();
    unsigned voffA[2], voffB[2];
#pragma unroll
    for (int i = 0; i < 2; ++i) { int R, C; stage_rc(tid * 16 + i * 8192, R, C); const int Rb = Epi::PERM ? ((R & ~31) + perm32(R & 31)) : R;
        voffA[i] = (unsigned)(R * K + C) * 2u; voffB[i] = (unsigned)(Rb * K + C) * 2u; }
    const size_t kstep = (size_t)(BK * 2);
    const size_t hstep = (size_t)HALF * K * 2;
    const size_t tstep = 2 * hstep;
    const unsigned ldsw = (unsigned)wid * 1024u;
    const int aoff = lds_byte(wr * 64 + fr, fq * 8), boff = lds_byte(wc * 32 + fr, fq * 8);
#define PG8_SA(b, h) (((b) * 2 + (h)) * HTB)
#define PG8_SB(b, h) ((4 + (b) * 2 + (h)) * HTB)
#define PG8_STAGE(bufoff, gbase, voff) do { _Pragma("unroll") for (int _i = 0; _i < 2; ++_i) \
        __builtin_amdgcn_global_load_lds((const unsigned*)((const char*)(gbase) + (voff)[_i]), (PG8_LAS unsigned*)(lds + (bufoff) + ldsw + _i * 8192), 16, 0, 0); } while (0)
#define PG8_LDA(dst, b, h) do { if constexpr (FP8) { _Pragma("unroll") for (int m = 0; m < 4; ++m) dst##8[m] = __builtin_shufflevector(*(const PG8_LAS i32x4_*)(lds + PG8_SA(b, h) + aoff + m * 2048), *(const PG8_LAS i32x4_*)(lds + PG8_SA(b, h) + aoff + m * 2048 + 1024), 0, 1, 2, 3, 4, 5, 6, 7); } \
        else { _Pragma("unroll") for (int m = 0; m < 4; ++m) _Pragma("unroll") for (int k = 0; k < 2; ++k) dst[m][k] = *(const PG8_LAS bf16x8*)(lds + PG8_SA(b, h) + aoff + m * 2048 + k * 1024); } } while (0)
#define PG8_LDB(dst, b, h) do { if constexpr (FP8) { _Pragma("unroll") for (int n = 0; n < 2; ++n) dst##8[n] = __builtin_shufflevector(*(const PG8_LAS i32x4_*)(lds + PG8_SB(b, h) + boff + n * 2048), *(const PG8_LAS i32x4_*)(lds + PG8_SB(b, h) + boff + n * 2048 + 1024), 0, 1, 2, 3, 4, 5, 6, 7); } \
        else { _Pragma("unroll") for (int n = 0; n < 2; ++n) _Pragma("unroll") for (int k = 0; k < 2; ++k) dst[n][k] = *(const PG8_LAS bf16x8*)(lds + PG8_SB(b, h) + boff + n * 2048 + k * 1024); } } while (0)
#define PG8_MMA(ai, bj, At, Bt) do { __builtin_amdgcn_s_setprio(1); _Pragma("unroll") for (int m = 0; m < 4; ++m) _Pragma("unroll") for (int n = 0; n < 2; ++n) { \
        if constexpr (FP8) asm volatile("v_mfma_scale_f32_16x16x128_f8f6f4 %0, %1, %2, %0, %3, %4 op_sel_hi:[0,0,0]" : "+v"(acc[ai][bj][m][n]) : "v"(Bt##8[n]), "v"(At##8[m]), "v"(scale_w), "v"(scale_x));        \
        else { _Pragma("unroll") for (int k = 0; k < 2; ++k) acc[ai][bj][m][n] = __builtin_amdgcn_mfma_f32_16x16x32_bf16(Bt[n][k], At[m][k], acc[ai][bj][m][n], 0, 0, 0); } } \
        __builtin_amdgcn_s_setprio(0); } while (0)
#define PG8_WAIT_V(n) asm volatile("s_waitcnt vmcnt(" #n ")" ::: "memory")
#define PG8_WAIT_L(n) asm volatile("s_waitcnt lgkmcnt(" #n ")" ::: "memory")
#define PG8_BAR __builtin_amdgcn_s_barrier()
#define PG8_SCHED __builtin_amdgcn_sched_barrier(0)
    Unit cur, nxt; int ui = 0;
    if (!S.next(0, cur)) return;
    f32x4 acc[2][2][4][2];
#pragma unroll
    for (int a = 0; a < 2; ++a)
#pragma unroll
        for (int b = 0; b < 2; ++b)
#pragma unroll
            for (int m = 0; m < 4; ++m)
#pragma unroll
                for (int n = 0; n < 2; ++n) acc[a][b][m][n] = (f32x4){0.f, 0.f, 0.f, 0.f};
    typedef int i32x4_ __attribute__((ext_vector_type(4))); typedef int i32x8_ __attribute__((ext_vector_type(8)));
    int scale_w = 122, scale_x = 127; asm volatile("" : "+v"(scale_w), "+v"(scale_x));
    bf16x8 At[4][2], B0[2][2], B1[2][2]; i32x8_ At8[4], B08[2], B18[2];
    const char* cA = (const char*)g.A + (size_t)cur.pm * tstep; const char* cB = (const char*)g.Bt + (size_t)cur.pn * tstep;
    S.a_ready(cur);
    PG8_STAGE(PG8_SB(0, 0), cB, voffB); PG8_STAGE(PG8_SA(0, 0), cA, voffA); PG8_STAGE(PG8_SB(0, 1), cB + hstep, voffB); PG8_STAGE(PG8_SA(0, 1), cA + hstep, voffA);
    if (wr == 1) PG8_BAR;
    PG8_WAIT_V(4); PG8_BAR;
    PG8_STAGE(PG8_SB(1, 0), cB + kstep, voffB); PG8_STAGE(PG8_SA(1, 0), cA + kstep, voffA); PG8_STAGE(PG8_SB(1, 1), cB + hstep + kstep, voffB);
    PG8_WAIT_V(6); PG8_BAR;
    PG8_STAMP();
    for (;;) {
        const bool has_next = S.next(ui + 1, nxt);
        const char* nA = has_next ? (const char*)g.A + (size_t)nxt.pm * tstep : cA; const char* nB = has_next ? (const char*)g.Bt + (size_t)nxt.pn * tstep : cB;
        for (int t = 0; t < nt; t += 2) {
            const bool last = (t == nt - 2);
            const char* a1 = cA + (size_t)(t + 1) * kstep;
            const char* a2 = last ? nA : cA + (size_t)(t + 2) * kstep; const char* b2 = last ? nB : cB + (size_t)(t + 2) * kstep;
            const char* a3 = a2 + kstep; const char* b3 = b2 + kstep;
            if (last && has_next) S.a_ready(nxt);
            PG8_LDB(B0, 0, 0); PG8_SCHED; PG8_LDA(At, 0, 0); PG8_STAGE(PG8_SA(1, 1), a1 + hstep, voffA);
            PG8_WAIT_L(8); PG8_BAR; PG8_WAIT_L(0); PG8_MMA(0, 0, At, B0); PG8_BAR; PG8_SCHED;
            PG8_LDB(B1, 0, 1); PG8_STAGE(PG8_SB(0, 0), b2, voffB);
            PG8_BAR; PG8_WAIT_L(0); PG8_MMA(0, 1, At, B1); PG8_BAR;
            PG8_LDA(At, 0, 1); PG8_STAGE(PG8_SA(0, 0), a2, voffA);
            PG8_BAR; PG8_WAIT_L(0); PG8_MMA(1, 0, At, B0); PG8_BAR; PG8_SCHED;
            PG8_STAGE(PG8_SB(0, 1), b2 + hstep, voffB);
            PG8_WAIT_V(6); PG8_BAR; PG8_MMA(1, 1, At, B1); PG8_BAR;
            PG8_LDB(B0, 1, 0); PG8_SCHED; PG8_LDA(At, 1, 0); PG8_STAGE(PG8_SA(0, 1), a2 + hstep, voffA);
            PG8_WAIT_L(8); PG8_BAR; PG8_WAIT_L(0); PG8_MMA(0, 0, At, B0); PG8_BAR; PG8_SCHED;
            PG8_LDB(B1, 1, 1); PG8_STAGE(PG8_SB(1, 0), b3, voffB);
            PG8_BAR; PG8_WAIT_L(0); PG8_MMA(0, 1, At, B1); PG8_BAR;
            PG8_LDA(At, 1, 1); PG8_STAGE(PG8_SA(1, 0), a3, voffA);
            PG8_BAR; PG8_WAIT_L(0); PG8_MMA(1, 0, At, B0); PG8_BAR; PG8_SCHED;
            PG8_STAGE(PG8_SB(1, 1), b3 + hstep, voffB);
            PG8_WAIT_V(6); PG8_BAR; PG8_MMA(1, 1, At, B1); PG8_BAR;
        }
        PG8_STAMP();
        if constexpr (FP8) { asm volatile("s_nop 15\n\ts_nop 15" ::: "memory");
#pragma unroll
            for (int a = 0; a < 2; ++a)
#pragma unroll
                for (int b = 0; b < 2; ++b)
#pragma unroll
                    for (int m = 0; m < 4; ++m)
#pragma unroll
                        for (int n = 0; n < 2; ++n) asm volatile("" : "+v"(acc[a][b][m][n])); }
        if constexpr (!Epi::AFTER_DRAIN) { E(acc, cur, wr, wc, fr, fq); S.done(cur); }
        PG8_STAMP();
        if (!has_next) break;
#pragma unroll
        for (int a = 0; a < 2; ++a)
#pragma unroll
            for (int b = 0; b < 2; ++b)
#pragma unroll
                for (int m = 0; m < 4; ++m)
#pragma unroll
                    for (int n = 0; n < 2; ++n) acc[a][b][m][n] = (f32x4){0.f, 0.f, 0.f, 0.f};
        cur = nxt; cA = nA; cB = nB; ++ui;
    }
    PG8_WAIT_V(0);
    if (wr == 0) PG8_BAR;
    PG8_BAR;
    if constexpr (Epi::AFTER_DRAIN) { E.fused(acc, cur, wr, wc, fr, fq, lds, wid, lane); S.done(cur); }
    PG8_STAMP();
    if (STAMP && wid == 0) { stamps[lane] = lane < nts ? (((unsigned long long)(unsigned)ts_hi << 32) | (unsigned)ts_lo) : 0ull;
        if (lane == 62) stamps[62] = rt_entry; if (lane == 63) stamps[63] = (unsigned long long)wall_clock64(); }
#undef PG8_STAMP
#undef PG8_SA
#undef PG8_SB
#undef PG8_STAGE
#undef PG8_LDA
#undef PG8_LDB
#undef PG8_MMA
#undef PG8_WAIT_V
#undef PG8_WAIT_L
#undef PG8_BAR
#undef PG8_SCHED
}
}

namespace pg8 {
struct MergeArgs { const bf16_t* A[3]; const bf16_t* Bt[3]; int K[3]; const bf16_t* gates; bf16_t* mb; };
template <class Sched>
__device__ __forceinline__ void gemm_phase_merge(PG8_LAS unsigned char* lds, const MergeArgs g, const Sched& S) {
    int tid_l = threadIdx.x; asm volatile("" : "+v"(tid_l));
    const int tid = tid_l, wid = __builtin_amdgcn_readfirstlane(tid >> 6), lane = tid & 63, wr = wid >> 2, wc = wid & 3, fr = lane & 15, fq = lane >> 4;
    unsigned R2A[2], R2B[2], C2[2];
#pragma unroll
    for (int i = 0; i < 2; ++i) { int R, C; stage_rc(tid * 16 + i * 8192, R, C); const int Rb = (R & ~31) + perm32(R & 31); R2A[i] = (unsigned)R * 2u; R2B[i] = (unsigned)Rb * 2u; C2[i] = (unsigned)C * 2u; }
    const size_t kstep = (size_t)(BK * 2);
    const unsigned ldsw = (unsigned)wid * 1024u;
    const int aoff = lds_byte(wr * 64 + fr, fq * 8), boff = lds_byte(wc * 32 + fr, fq * 8);
#define PG8_SA(b, h) (((b) * 2 + (h)) * HTB)
#define PG8_SB(b, h) ((4 + (b) * 2 + (h)) * HTB)
#define PG8_STAGEK(bufoff, gbase, R2, KK) do { _Pragma("unroll") for (int _i = 0; _i < 2; ++_i) \
        __builtin_amdgcn_global_load_lds((const unsigned*)((const char*)(gbase) + (R2)[_i] * (unsigned)(KK) + C2[_i]), (PG8_LAS unsigned*)(lds + (bufoff) + ldsw + _i * 8192), 16, 0, 0); } while (0)
#define PG8_LDA(dst, b, h) do { _Pragma("unroll") for (int m = 0; m < 4; ++m) _Pragma("unroll") for (int k = 0; k < 2; ++k) dst[m][k] = *(const PG8_LAS bf16x8*)(lds + PG8_SA(b, h) + aoff + m * 2048 + k * 1024); } while (0)
#define PG8_LDB(dst, b, h) do { _Pragma("unroll") for (int n = 0; n < 2; ++n) _Pragma("unroll") for (int k = 0; k < 2; ++k) dst[n][k] = *(const PG8_LAS bf16x8*)(lds + PG8_SB(b, h) + boff + n * 2048 + k * 1024); } while (0)
#define PG8_MMA(ai, bj, At, Bt) do { __builtin_amdgcn_s_setprio(1); _Pragma("unroll") for (int m = 0; m < 4; ++m) _Pragma("unroll") for (int n = 0; n < 2; ++n) _Pragma("unroll") for (int k = 0; k < 2; ++k) \
        acc[ai][bj][m][n] = __builtin_amdgcn_mfma_f32_16x16x32_bf16(Bt[n][k], At[m][k], acc[ai][bj][m][n], 0, 0, 0); __builtin_amdgcn_s_setprio(0); } while (0)
#define PG8_WAIT_V(n) asm volatile("s_waitcnt vmcnt(" #n ")" ::: "memory")
#define PG8_WAIT_L(n) asm volatile("s_waitcnt lgkmcnt(" #n ")" ::: "memory")
#define PG8_BAR __builtin_amdgcn_s_barrier()
#define PG8_SCHED __builtin_amdgcn_sched_barrier(0)
    Unit cur, nxt; int ui = 0, seg = 0;
    if (!S.next(0, cur)) return;
    f32x4 acc[2][2][4][2];
#pragma unroll
    for (int a = 0; a < 2; ++a)
#pragma unroll
        for (int b = 0; b < 2; ++b)
#pragma unroll
            for (int m = 0; m < 4; ++m)
#pragma unroll
                for (int n = 0; n < 2; ++n) acc[a][b][m][n] = (f32x4){0.f, 0.f, 0.f, 0.f};
    bf16x8 At[4][2], B0[2][2], B1[2][2];
    int Kc = g.K[0];
    const char* cA = (const char*)g.A[0] + (size_t)cur.pm * 512 * Kc; const char* cB = (const char*)g.Bt[0] + (size_t)cur.pn * 512 * Kc;
    {   const size_t hs = (size_t)256 * Kc;
        PG8_STAGEK(PG8_SB(0, 0), cB, R2B, Kc); PG8_STAGEK(PG8_SA(0, 0), cA, R2A, Kc); PG8_STAGEK(PG8_SB(0, 1), cB + hs, R2B, Kc); PG8_STAGEK(PG8_SA(0, 1), cA + hs, R2A, Kc);
        if (wr == 1) PG8_BAR;
        PG8_WAIT_V(4); PG8_BAR;
        PG8_STAGEK(PG8_SB(1, 0), cB + kstep, R2B, Kc); PG8_STAGEK(PG8_SA(1, 0), cA + kstep, R2A, Kc); PG8_STAGEK(PG8_SB(1, 1), cB + hs + kstep, R2B, Kc);
        PG8_WAIT_V(6); PG8_BAR; }
    for (;;) {
        bool has_next_tile = false; int nseg = seg + 1; Unit nu = cur;
        if (nseg == 3) { nseg = 0; has_next_tile = S.next(ui + 1, nxt); nu = nxt; }
        const bool more = (seg < 2) || has_next_tile;
        const int Kn = more ? (nseg == 0 ? g.K[0] : (nseg == 1 ? g.K[1] : g.K[2])) : Kc;
        const bf16_t* gA = nseg == 0 ? g.A[0] : (nseg == 1 ? g.A[1] : g.A[2]); const bf16_t* gB = nseg == 0 ? g.Bt[0] : (nseg == 1 ? g.Bt[1] : g.Bt[2]);
        const char* nA = more ? (const char*)gA + (size_t)nu.pm * 512 * Kn : cA; const char* nB = more ? (const char*)gB + (size_t)nu.pn * 512 * Kn : cB;
        const int nt = Kc / BK; const size_t hsc = (size_t)256 * Kc, hsn = (size_t)256 * Kn;
        for (int t = 0; t < nt; t += 2) {
            const bool last = (t == nt - 2);
            const char* a1 = cA + (size_t)(t + 1) * kstep;
            const char* a2 = last ? nA : cA + (size_t)(t + 2) * kstep; const char* b2 = last ? nB : cB + (size_t)(t + 2) * kstep;
            const char* a3 = a2 + kstep; const char* b3 = b2 + kstep;
            const int K2 = last ? Kn : Kc; const size_t hs2 = last ? hsn : hsc;
            PG8_LDB(B0, 0, 0); PG8_SCHED; PG8_LDA(At, 0, 0); PG8_STAGEK(PG8_SA(1, 1), a1 + hsc, R2A, Kc);
            PG8_WAIT_L(8); PG8_BAR; PG8_WAIT_L(0); PG8_MMA(0, 0, At, B0); PG8_BAR; PG8_SCHED;
            PG8_LDB(B1, 0, 1); PG8_STAGEK(PG8_SB(0, 0), b2, R2B, K2);
            PG8_BAR; PG8_WAIT_L(0); PG8_MMA(0, 1, At, B1); PG8_BAR;
            PG8_LDA(At, 0, 1); PG8_STAGEK(PG8_SA(0, 0), a2, R2A, K2);
            PG8_BAR; PG8_WAIT_L(0); PG8_MMA(1, 0, At, B0); PG8_BAR; PG8_SCHED;
            PG8_STAGEK(PG8_SB(0, 1), b2 + hs2, R2B, K2);
            PG8_WAIT_V(6); PG8_BAR; PG8_MMA(1, 1, At, B1); PG8_BAR;
            PG8_LDB(B0, 1, 0); PG8_SCHED; PG8_LDA(At, 1, 0); PG8_STAGEK(PG8_SA(0, 1), a2 + hs2, R2A, K2);
            PG8_WAIT_L(8); PG8_BAR; PG8_WAIT_L(0); PG8_MMA(0, 0, At, B0); PG8_BAR; PG8_SCHED;
            PG8_LDB(B1, 1, 1); PG8_STAGEK(PG8_SB(1, 0), b3, R2B, K2);
            PG8_BAR; PG8_WAIT_L(0); PG8_MMA(0, 1, At, B1); PG8_BAR;
            PG8_LDA(At, 1, 1); PG8_STAGEK(PG8_SA(1, 0), a3, R2A, K2);
            PG8_BAR; PG8_WAIT_L(0); PG8_MMA(1, 0, At, B0); PG8_BAR; PG8_SCHED;
            PG8_STAGEK(PG8_SB(1, 1), b3 + hs2, R2B, K2);
            PG8_WAIT_V(6); PG8_BAR; PG8_MMA(1, 1, At, B1); PG8_BAR;
        }
        {   const int row0 = cur.pm * 256 + wr * 64 + fr, col0 = cur.pn * 256 + wc * 32 + 8 * fq;
            const bf16_t* gb_s = g.gates + ((size_t)(seg * 128 + cur.pm) * 4 + cur.pn) * 65536 + (size_t)tid * 8;
            const bf16_t* gb_n = gb_s + (size_t)128 * 4 * 65536;
            u32x4 GS[2][4], GN[2][4];
#define MRG_LOAD(buf, bt) do { _Pragma("unroll") for (int c = 0; c < 4; ++c) { GS[buf][c] = *(const u32x4*)(gb_s + (size_t)(((bt) * 4 + c) * 512) * 8); \
                GN[buf][c] = (seg < 2) ? *(const u32x4*)(gb_n + (size_t)(((bt) * 4 + c) * 512) * 8) : (u32x4){0x3f803f80u, 0x3f803f80u, 0x3f803f80u, 0x3f803f80u}; } } while (0)
#define MRG_APPLY(buf, bt) do { _Pragma("unroll") for (int c = 0; c < 4; ++c) { const int idx = (bt) * 4 + c, ai = idx >> 3, m = (idx >> 1) & 3, bj = idx & 1; \
                const u32x4 gs = GS[buf][c], gn = GN[buf][c]; \
                float f[8] = {__uint_as_float(gs.x << 16), __uint_as_float(gs.x & 0xffff0000u), __uint_as_float(gs.y << 16), __uint_as_float(gs.y & 0xffff0000u), \
                              __uint_as_float(gs.z << 16), __uint_as_float(gs.z & 0xffff0000u), __uint_as_float(gs.w << 16), __uint_as_float(gs.w & 0xffff0000u)}; \
                const float d[8] = {__uint_as_float(gn.x << 16), __uint_as_float(gn.x & 0xffff0000u), __uint_as_float(gn.y << 16), __uint_as_float(gn.y & 0xffff0000u), \
                                    __uint_as_float(gn.z << 16), __uint_as_float(gn.z & 0xffff0000u), __uint_as_float(gn.w << 16), __uint_as_float(gn.w & 0xffff0000u)}; \
                _Pragma("unroll") for (int j = 0; j < 8; ++j) f[j] = f[j] * __builtin_amdgcn_rcpf(fmaxf(d[j], 1e-20f)); \
                f32x4 v0 = acc[ai][bj][m][0], v1 = acc[ai][bj][m][1]; \
                v0[0] *= f[0]; v0[1] *= f[1]; v0[2] *= f[2]; v0[3] *= f[3]; v1[0] *= f[4]; v1[1] *= f[5]; v1[2] *= f[6]; v1[3] *= f[7]; \
                if (seg < 2) { acc[ai][bj][m][0] = v0; acc[ai][bj][m][1] = v1; } \
                else { typedef __bf16 bf2_t __attribute__((ext_vector_type(2))); \
                    u32x4 w; { bf2_t t2; t2.x = (__bf16)v0[0]; t2.y = (__bf16)v0[1]; w.x = __builtin_bit_cast(unsigned, t2); t2.x = (__bf16)v0[2]; t2.y = (__bf16)v0[3]; w.y = __builtin_bit_cast(unsigned, t2); \
                                t2.x = (__bf16)v1[0]; t2.y = (__bf16)v1[1]; w.z = __builtin_bit_cast(unsigned, t2); t2.x = (__bf16)v1[2]; t2.y = (__bf16)v1[3]; w.w = __builtin_bit_cast(unsigned, t2); } \
                    *(u32x4*)(g.mb + (size_t)(row0 + ai * 128 + m * 16) * 1024 + col0 + bj * 128) = w; \
                    acc[ai][bj][m][0] = (f32x4){0.f, 0.f, 0.f, 0.f}; acc[ai][bj][m][1] = (f32x4){0.f, 0.f, 0.f, 0.f}; } } } while (0)
            MRG_LOAD(0, 0);
#pragma unroll
            for (int bt = 0; bt < 8; bt += 2) {
                MRG_LOAD(1, bt + 1); asm volatile("" ::: "memory"); MRG_APPLY(0, bt);
                if (bt + 2 < 8) { MRG_LOAD(0, bt + 2); } asm volatile("" ::: "memory"); MRG_APPLY(1, bt + 1); }
#undef MRG_LOAD
#undef MRG_APPLY
        }
        if (!more) break;
        if (nseg == 0) { cur = nxt; ++ui; }
        seg = nseg; Kc = Kn; cA = nA; cB = nB;
    }
    PG8_WAIT_V(0);
    if (wr == 0) PG8_BAR;
    PG8_BAR;
#undef PG8_SA
#undef PG8_SB
#undef PG8_STAGEK
#undef PG8_LDA
#undef PG8_LDB
#undef PG8_MMA
#undef PG8_WAIT_V
#undef PG8_WAIT_L
#undef PG8_BAR
#undef PG8_SCHED
}
}
#define XB_TMO      128
#define XB_XCNT(j)  (256  + 64 * (j))
#define XB_XSUB(j)  (1280 + 64 * (j))
#define XB_XGEN(j)  (2304 + 64 * (j))
#define XB_TOP      3328
#define XB_TOPGEN   3392
#define XCD_BAR_WORDS 3456
#define XB_SPIN_CAP (1u << 18)
#define LAS __attribute__((address_space(3)))

__device__ __forceinline__ unsigned xb_ld(unsigned* p)              { return __hip_atomic_load(p, __ATOMIC_RELAXED, __HIP_MEMORY_SCOPE_AGENT); }
__device__ __forceinline__ unsigned xb_add(unsigned* p, unsigned v) { return __hip_atomic_fetch_add(p, v, __ATOMIC_RELAXED, __HIP_MEMORY_SCOPE_AGENT); }
__device__ __forceinline__ unsigned xb_xcc_id() { return (unsigned)__builtin_amdgcn_s_getreg((3 << 11) | 20) & 0xFu; }
#define XB_SPIN(cond, bar) do { unsigned _sp = 0; while (cond) { __builtin_amdgcn_s_sleep(1); \
    if ((++_sp & 255u) == 0u) { if (xb_ld(&(bar)[XB_TMO])) break; if (_sp > XB_SPIN_CAP) { atomicAdd(&(bar)[XB_TMO], 1u); break; } } } } while (0)

struct XcdBarrier {
    unsigned* bar; unsigned x;
    volatile LAS unsigned* st;
};

__device__ __forceinline__ XcdBarrier xcd_barrier_post(unsigned* bar, volatile LAS unsigned* st) {
    XcdBarrier b; b.bar = bar; b.x = xb_xcc_id(); b.st = st;
    if (threadIdx.x == 0) (void)xb_add(&bar[XB_XCNT(b.x)], 1u);
    return b;
}
__device__ __forceinline__ void xcd_barrier_complete(unsigned* bar, unsigned x, unsigned& nloc, unsigned& nx) {
    const unsigned G = gridDim.x * gridDim.y * gridDim.z;
    unsigned sum, cnt, mine, sp = 0u;
    for (;;) {
        sum = 0u; cnt = 0u; mine = 0u;
#pragma unroll
        for (unsigned j = 0; j < 16; ++j) { const unsigned c = xb_ld(&bar[XB_XCNT(j)]); sum += c; cnt += (c > 0u) ? 1u : 0u; mine = (j == x) ? c : mine; }
        if (sum == G) break;
        __builtin_amdgcn_s_sleep(1);
        if ((++sp & 255u) == 0u) { if (xb_ld(&bar[XB_TMO])) break; if (sp > XB_SPIN_CAP) { atomicAdd(&bar[XB_TMO], 1u); break; } }
    }
    nloc = mine > 0u ? mine : 1u; nx = cnt > 0u ? cnt : 1u;
}

__device__ __forceinline__ void xcd_barrier(const XcdBarrier& b) {
    asm volatile("s_waitcnt vmcnt(0)" ::: "memory");
    __syncthreads();
    if (threadIdx.x == 0) {
        unsigned* bar = b.bar;
        __builtin_amdgcn_s_waitcnt(0);
        unsigned nloc = b.st[0], nx = b.st[1];
        if (nloc == 0u) { xcd_barrier_complete(bar, b.x, nloc, nx); b.st[0] = nloc; b.st[1] = nx; }
        const unsigned old = xb_add(&bar[XB_XSUB(b.x)], 1u);
        const unsigned gen = old / nloc;
        if (old + 1u == (gen + 1u) * nloc) {
            __builtin_amdgcn_fence(__ATOMIC_RELEASE, "agent");
            asm volatile("s_waitcnt vmcnt(0)" ::: "memory");
            const unsigned og = xb_add(&bar[XB_TOP], 1u);
            const unsigned tg = og / nx;
            if (og + 1u == (tg + 1u) * nx) xb_add(&bar[XB_TOPGEN], 1u);
            else XB_SPIN(xb_ld(&bar[XB_TOPGEN]) == tg, bar);
            __builtin_amdgcn_fence(__ATOMIC_ACQUIRE, "agent");
            xb_add(&bar[XB_XGEN(b.x)], 1u);
            asm volatile("s_waitcnt vmcnt(0)" ::: "memory");
        } else {
            XB_SPIN(xb_ld(&bar[XB_XGEN(b.x)]) == gen, bar);
            __builtin_amdgcn_fence(__ATOMIC_ACQUIRE, "agent");
            asm volatile("s_waitcnt vmcnt(0)" ::: "memory");
        }
    }
    __syncthreads();
}


typedef unsigned short bf16_t;
typedef float f32x4 __attribute__((ext_vector_type(4)));
typedef unsigned u32x4 __attribute__((ext_vector_type(4)));
typedef unsigned u32x2 __attribute__((ext_vector_type(2)));
typedef __bf16 bf16x2_t __attribute__((ext_vector_type(2)));
constexpr int D = 1024, BATCH = 8, SEQ = 4096, T = BATCH * SEQ, MEMLEN = 256;
constexpr int HQW = 3584, GW = 3072, INW = 6656, NEXP = 16384;
constexpr int C_AQ = 0, C_AK = 768, C_AV = 1536, C_BQ = 2304, C_BK = 2816, C_BV = 2944, C_CQ = 3072;
constexpr float ALPHA = 1.189207115002721f, LOG2E = 1.4426950408889634f, LN2F = 0.6931471805599453f, LN_EPS = 1e-5f, NEGBIG = -1e30f;
constexpr size_t MiB = 1u << 20;
#ifndef DBG_CHECK
#define DBG_CHECK 0
#endif
#ifndef DBG_DROP
#define DBG_DROP 0
#endif
constexpr size_t WS_CTL = 0, WS_WMEMKV = 1 * MiB, WS_WA = 3 * MiB, WS_WB = WS_WA + MiB / 2, WS_WC = WS_WB + MiB, WS_WOUT = WS_WC + MiB, WS_WQ = WS_WOUT + 2 * MiB,
                 WS_SUBK = WS_WQ + 2 * MiB, WS_MEMB = 10 * MiB, WS_KVM = 14 * MiB, WS_STATS = 18 * MiB, WS_LSE = 19 * MiB;
constexpr size_t WS_RA = 24 * MiB, WS_RB = 248 * MiB, WS_RC = 440 * MiB, WS_END = 504 * MiB;
constexpr size_t WS_HQ = WS_RA, WS_GATES = WS_RB, WS_XB = WS_RC;
constexpr size_t WS_MF = WS_RA, WS_MB = WS_RA + 128 * MiB;
constexpr size_t WS_Z = WS_RB, WS_X1B = WS_RB + 128 * MiB;
constexpr size_t WS_Q = WS_RA, WS_EIDX = WS_RA + 88 * MiB - 24 * MiB, WS_GATE = WS_EIDX + 16 * MiB;
constexpr size_t WS_UB = WS_RC, WS_VB = WS_RC + 32 * MiB;
constexpr size_t DO_WINT = 0;
constexpr size_t DO_OA = 0, DO_YB = 48 * MiB, DO_YC = 80 * MiB, DO_YA = 112 * MiB;

__device__ __forceinline__ size_t hq_off64(int slot, size_t tok) { return ((size_t)slot * T + tok) * 64; }
__device__ __forceinline__ size_t hq_offc(int head, size_t tok) { return (size_t)48 * T * 64 + ((size_t)head * T + tok) * 128; }
__device__ const unsigned char kBucket[3][132] = {
{0,1,2,3,4,5,6,7,8,9,10,11,12,13,14,15,16,16,16,16,16,16,17,17,17,17,17,17,17,17,18,18,18,18,18,18,18,18,18,18,19,19,19,19,19,19,19,19,19,19,19,19,19,19,20,20,20,20,20,20,20,20,20,20,20,20,20,20,20,20,20,20,20,21,21,21,21,21,21,21,21,21,21,21,21,21,21,21,21,21,21,21,21,21,21,21,21,21,21,22,22,22,22,22,22,22,22,22,22,22,22,22,22,22,22,22,22,22,22,22,22,22,22,22,22,22,22,22,22,22,22,22},
{0,4,8,12,16,16,17,17,18,18,19,19,19,19,20,20,20,20,20,21,21,21,21,21,21,22,22,22,22,22,22,22,22,22,23,23,23,23,23,23,23,23,23,23,23,23,24,24,24,24,24,24,24,24,24,24,24,24,24,24,24,24,25,25,25,25,25,25,25,25,25,25,25,25,25,25,25,25,25,25,25,25,25,26,26,26,26,26,26,26,26,26,26,26,26,26,26,26,26,26,26,26,26,26,26,26,26,26,26,26,26,26,26,27,27,27,27,27,27,27,27,27,27,27,27,27,27,27,27,27,27,27},
{0,16,18,19,20,21,21,22,22,23,23,23,24,24,24,24,25,25,25,25,25,26,26,26,26,26,26,26,26,27,27,27,27,27,27,27,27,27,27,28,28,28,28,28,28,28,28,28,28,28,28,28,29,29,29,29,29,29,29,29,29,29,29,29,29,29,29,29,29,29,30,30,30,30,30,30,30,30,30,30,30,30,30,30,30,30,30,30,30,30,30,30,30,30,30,31,31,31,31,31,31,31,31,31,31,31,31,31,31,31,31,31,31,31,31,31,31,31,31,31,31,31,31,31,31,31,31,31,31,31,31,31}};

__device__ __forceinline__ bf16_t f2bf(float x) { unsigned u = __float_as_uint(x); u += 0x7fffu + ((u >> 16) & 1u); return (bf16_t)(u >> 16); }
__device__ __forceinline__ float bf2f(bf16_t h) { return __uint_as_float((unsigned)h << 16); }
__device__ __forceinline__ float bflo(unsigned w) { return __uint_as_float(w << 16); }
__device__ __forceinline__ float bfhi(unsigned w) { return __uint_as_float(w & 0xffff0000u); }
__device__ __forceinline__ unsigned pk2(float lo, float hi) { bf16x2_t v; v.x = (__bf16)lo; v.y = (__bf16)hi; return __builtin_bit_cast(unsigned, v); }
__device__ __forceinline__ float dot2bf(unsigned a, unsigned b, float acc) { return __builtin_amdgcn_fdot2_f32_bf16(__builtin_bit_cast(bf16x2_t, a), __builtin_bit_cast(bf16x2_t, b), acc, false); }
__device__ __forceinline__ float wave_sum(float v) { for (int o = 32; o >= 1; o >>= 1) v += __shfl_xor(v, o, 64); return v; }
__device__ __forceinline__ float wave_max(float v) { for (int o = 32; o >= 1; o >>= 1) v = fmaxf(v, __shfl_xor(v, o, 64)); return v; }

struct EpiIn {
    static constexpr bool PERM = true, AFTER_DRAIN = false;
    bf16_t* hq; bf16_t* gates; const float* bgate;
    __device__ __forceinline__ void operator()(const pg8::f32x4 (&acc)[2][2][4][2], const pg8::Unit& u, int wr, int wc, int fr, int fq) const {
        const int row0 = u.pm * 256 + wr * 64 + fr;
        if (u.pn < 14) {
            const float sc = (u.pn < 3 || u.pn == 9 || u.pn == 10) ? 0.125f * LOG2E : ((u.pn >= 12) ? 0.08838834764831845f * LOG2E : 1.0f);
            const int col0 = u.pn * 256 + wc * 32 + 8 * fq;
#pragma unroll
            for (int ai = 0; ai < 2; ++ai)
#pragma unroll
                for (int m = 0; m < 4; ++m) { const size_t tok = (size_t)(row0 + ai * 128 + m * 16);
#pragma unroll
                    for (int bj = 0; bj < 2; ++bj) { const pg8::f32x4 v0 = acc[ai][bj][m][0] * sc, v1 = acc[ai][bj][m][1] * sc; const int col = col0 + bj * 128;
                        u32x4 w; w.x = pk2(v0[0], v0[1]); w.y = pk2(v0[2], v0[3]); w.z = pk2(v1[0], v1[1]); w.w = pk2(v1[2], v1[3]);
                        bf16_t* dst = (col < 3072) ? hq + hq_off64(col >> 6, tok) + (col & 63) : hq + hq_offc((col - 3072) >> 7, tok) + ((col - 3072) & 127);
                        *(u32x4*)dst = w; } }
        } else {
            const int gi = u.pn - 14, s = gi >> 2, pn = gi & 3, col0 = gi * 256 + wc * 32 + 8 * fq, tid = (wr * 4 + wc) * 64 + fq * 16 + fr;
            bf16_t* blk = gates + ((size_t)(s * 128 + u.pm) * 4 + pn) * 65536 + (size_t)tid * 8;
            pg8::f32x4 bv[2][2];
#pragma unroll
            for (int bj = 0; bj < 2; ++bj)
#pragma unroll
                for (int n = 0; n < 2; ++n) bv[bj][n] = *(const pg8::f32x4*)(bgate + col0 + bj * 128 + 4 * n);
#pragma unroll
            for (int ai = 0; ai < 2; ++ai)
#pragma unroll
                for (int m = 0; m < 4; ++m) {
#pragma unroll
                    for (int bj = 0; bj < 2; ++bj) { pg8::f32x4 v0 = acc[ai][bj][m][0] + bv[bj][0], v1 = acc[ai][bj][m][1] + bv[bj][1];
#pragma unroll
                        for (int j = 0; j < 4; ++j) { v0[j] = __builtin_amdgcn_rcpf(1.0f + __builtin_amdgcn_exp2f(-LOG2E * v0[j])); v1[j] = __builtin_amdgcn_rcpf(1.0f + __builtin_amdgcn_exp2f(-LOG2E * v1[j])); }
                        u32x4 w; w.x = pk2(v0[0], v0[1]); w.y = pk2(v0[2], v0[3]); w.z = pk2(v1[0], v1[1]); w.w = pk2(v1[2], v1[3]);
                        *(u32x4*)(blk + (size_t)(((ai * 4 + m) * 2 + bj) * 512) * 8) = w; } }
        }
    }
};
struct EpiPlain {
    static constexpr bool PERM = true, AFTER_DRAIN = false;
    bf16_t* O; int ldc;
    __device__ __forceinline__ void operator()(const pg8::f32x4 (&acc)[2][2][4][2], const pg8::Unit& u, int wr, int wc, int fr, int fq) const {
        const int row0 = u.pm * 256 + wr * 64 + fr, col0 = u.pn * 256 + wc * 32 + 8 * fq;
#pragma unroll
        for (int ai = 0; ai < 2; ++ai)
#pragma unroll
            for (int m = 0; m < 4; ++m) { bf16_t* rowp = O + (size_t)(row0 + ai * 128 + m * 16) * ldc + col0;
#pragma unroll
                for (int bj = 0; bj < 2; ++bj) { const pg8::f32x4 v0 = acc[ai][bj][m][0], v1 = acc[ai][bj][m][1];
                    u32x4 w; w.x = pk2(v0[0], v0[1]); w.y = pk2(v0[2], v0[3]); w.z = pk2(v1[0], v1[1]); w.w = pk2(v1[2], v1[3]);
                    *(u32x4*)(rowp + bj * 128) = w; } }
    }
};
struct EpiOut {
    static constexpr bool PERM = true, AFTER_DRAIN = false;
    const float* x; bf16_t* z; float* stats;
    __device__ __forceinline__ void operator()(const pg8::f32x4 (&acc)[2][2][4][2], const pg8::Unit& u, int wr, int wc, int fr, int fq) const {
        const int row0 = u.pm * 256 + wr * 64 + fr, col0 = u.pn * 256 + wc * 32 + 8 * fq;
#pragma unroll
        for (int ai = 0; ai < 2; ++ai)
#pragma unroll
            for (int m = 0; m < 4; ++m) { const size_t row = (size_t)(row0 + ai * 128 + m * 16); float s = 0.f, ss = 0.f;
#pragma unroll
                for (int bj = 0; bj < 2; ++bj) { const size_t o = row * D + col0 + bj * 128;
                    pg8::f32x4 v0 = *(const pg8::f32x4*)(x + o) * ALPHA + acc[ai][bj][m][0], v1 = *(const pg8::f32x4*)(x + o + 4) * ALPHA + acc[ai][bj][m][1];
                    { u32x4 w; w.x = pk2(v0[0], v0[1]); w.y = pk2(v0[2], v0[3]); w.z = pk2(v1[0], v1[1]); w.w = pk2(v1[2], v1[3]); *(u32x4*)(z + o) = w; }
#pragma unroll
                    for (int j = 0; j < 4; ++j) { s += v0[j] + v1[j]; ss += v0[j] * v0[j] + v1[j] * v1[j]; } }
                s += __shfl_xor(s, 16, 64); ss += __shfl_xor(ss, 16, 64); s += __shfl_xor(s, 32, 64); ss += __shfl_xor(ss, 32, 64);
                if (fq == 0) { atomicAdd(stats + row * 2, s); atomicAdd(stats + row * 2 + 1, ss); } }
    }
};

__device__ __forceinline__ void t_mix(size_t i, const bf16_t* __restrict__ oA, const float* __restrict__ lseA, bf16_t* __restrict__ ya) {
    const size_t t = i >> 5; const int col = (int)(i & 31) * 8, h = col >> 6; const size_t e = t * 256 + col;
    const float l0 = lseA[((size_t)0 * T + t) * 4 + h], l1 = lseA[((size_t)1 * T + t) * 4 + h], l2 = lseA[((size_t)2 * T + t) * 4 + h];
    const u32x4 a = *(const u32x4*)(oA + e), b = *(const u32x4*)(oA + (size_t)T * 256 + e), c = *(const u32x4*)(oA + (size_t)2 * T * 256 + e);
    const float mx = fmaxf(l0, fmaxf(l1, l2)), e0 = __expf(l0 - mx), e1 = __expf(l1 - mx), e2 = __expf(l2 - mx), inv = 1.f / (e0 + e1 + e2), w0 = e0 * inv, w1 = e1 * inv, w2 = e2 * inv;
    u32x4 o;
    o.x = pk2(w0 * bflo(a.x) + w1 * bflo(b.x) + w2 * bflo(c.x), w0 * bfhi(a.x) + w1 * bfhi(b.x) + w2 * bfhi(c.x)); o.y = pk2(w0 * bflo(a.y) + w1 * bflo(b.y) + w2 * bflo(c.y), w0 * bfhi(a.y) + w1 * bfhi(b.y) + w2 * bfhi(c.y));
    o.z = pk2(w0 * bflo(a.z) + w1 * bflo(b.z) + w2 * bflo(c.z), w0 * bfhi(a.z) + w1 * bfhi(b.z) + w2 * bfhi(c.z)); o.w = pk2(w0 * bflo(a.w) + w1 * bflo(b.w) + w2 * bflo(c.w), w0 * bfhi(a.w) + w1 * bfhi(b.w) + w2 * bfhi(c.w));
    *(u32x4*)(ya + e) = o;
}
__device__ __forceinline__ void t_ln1(size_t i, const bf16_t* __restrict__ z, const float* __restrict__ stats, const float* __restrict__ g, const float* __restrict__ b, bf16_t* __restrict__ x1b) {
    const size_t t = i >> 7; const int c = (int)(i & 127) * 8;
    const float mean = stats[t * 2] * (1.f / D), var = stats[t * 2 + 1] * (1.f / D) - mean * mean, rstd = rsqrtf(var + LN_EPS);
    const u32x4 zw = *(const u32x4*)(z + t * D + c);
    const f32x4 a0 = (f32x4){bflo(zw.x), bfhi(zw.x), bflo(zw.y), bfhi(zw.y)}, a1 = (f32x4){bflo(zw.z), bfhi(zw.z), bflo(zw.w), bfhi(zw.w)};
    const f32x4 g0 = *(const f32x4*)(g + c), g1 = *(const f32x4*)(g + c + 4), b0 = *(const f32x4*)(b + c), b1 = *(const f32x4*)(b + c + 4);
    const f32x4 y0 = (a0 - mean) * rstd * g0 + b0, y1 = (a1 - mean) * rstd * g1 + b1;
    u32x4 w; w.x = pk2(y0[0], y0[1]); w.y = pk2(y0[2], y0[3]); w.z = pk2(y1[0], y1[1]); w.w = pk2(y1[2], y1[3]);
    *(u32x4*)(x1b + t * D + c) = w;
}
typedef float f32x2 __attribute__((ext_vector_type(2)));
__device__ __forceinline__ void cvt_row_fp8_finish(const f32x4 a, const f32x4 b, const f32x4 c, const f32x4 d, unsigned char* __restrict__ dst, float* __restrict__ inv_scale, int row, int lane) {
    float mx = 0.f;
#pragma unroll
    for (int j = 0; j < 4; ++j) mx = fmaxf(mx, fmaxf(fmaxf(fabsf(a[j]), fabsf(b[j])), fmaxf(fabsf(c[j]), fabsf(d[j]))));
    mx = wave_max(mx);
    const unsigned E = (__float_as_uint(mx) >> 23) & 255u;
    const float sc = (E == 0u || E > 250u) ? 1.0f : __uint_as_float((260u - E) << 23), isc = (E == 0u || E > 250u) ? 1.0f : __uint_as_float((E - 6u) << 23);
    u32x4 w; int t;
    t = 0; t = __builtin_amdgcn_cvt_pk_fp8_f32(a[0] * sc, a[1] * sc, t, false); t = __builtin_amdgcn_cvt_pk_fp8_f32(a[2] * sc, a[3] * sc, t, true); w.x = (unsigned)t;
    t = 0; t = __builtin_amdgcn_cvt_pk_fp8_f32(b[0] * sc, b[1] * sc, t, false); t = __builtin_amdgcn_cvt_pk_fp8_f32(b[2] * sc, b[3] * sc, t, true); w.y = (unsigned)t;
    t = 0; t = __builtin_amdgcn_cvt_pk_fp8_f32(c[0] * sc, c[1] * sc, t, false); t = __builtin_amdgcn_cvt_pk_fp8_f32(c[2] * sc, c[3] * sc, t, true); w.z = (unsigned)t;
    t = 0; t = __builtin_amdgcn_cvt_pk_fp8_f32(d[0] * sc, d[1] * sc, t, false); t = __builtin_amdgcn_cvt_pk_fp8_f32(d[2] * sc, d[3] * sc, t, true); w.w = (unsigned)t;
    *(u32x4*)(dst + (size_t)row * D + 16 * lane) = w;
    if (lane == 0) inv_scale[row] = isc;
}
__device__ __forceinline__ void cvt_rows_fp8(const float* __restrict__ pu, const float* __restrict__ pv, unsigned char* __restrict__ ub8, unsigned char* __restrict__ vb8, float* __restrict__ usc, float* __restrict__ vsc, int r0, int r1) {
    const int lane = threadIdx.x & 63;
    const float* s0 = pu + (size_t)r0 * D + 16 * lane; const float* s1 = pv + (size_t)r0 * D + 16 * lane; const float* s2 = pu + (size_t)r1 * D + 16 * lane; const float* s3 = pv + (size_t)r1 * D + 16 * lane;
    f32x4 q[4][4];
#pragma unroll
    for (int j = 0; j < 4; ++j) { q[0][j] = ((const f32x4*)s0)[j]; q[1][j] = ((const f32x4*)s1)[j]; q[2][j] = ((const f32x4*)s2)[j]; q[3][j] = ((const f32x4*)s3)[j]; }
    cvt_row_fp8_finish(q[0][0], q[0][1], q[0][2], q[0][3], ub8, usc, r0, lane); cvt_row_fp8_finish(q[1][0], q[1][1], q[1][2], q[1][3], vb8, vsc, r0, lane);
    cvt_row_fp8_finish(q[2][0], q[2][1], q[2][2], q[2][3], ub8, usc, r1, lane); cvt_row_fp8_finish(q[3][0], q[3][1], q[3][2], q[3][3], vb8, vsc, r1, lane);
}
__device__ __forceinline__ float xsel_add(float keep_lo, float keep_hi, bool hi, int mask) {
    const float send = hi ? keep_lo : keep_hi, keep = hi ? keep_hi : keep_lo; return keep + __shfl_xor(send, mask, 64);
}

typedef short s16x4 __attribute__((ext_vector_type(4)));
constexpr int NTHREADS_ = 512;
#define ATT_M0 (-30000.0f)
__device__ __forceinline__ float red_max_16_32(float x) { typedef unsigned u2_ __attribute__((ext_vector_type(2)));
    u2_ r = __builtin_amdgcn_permlane16_swap(__float_as_uint(x), __float_as_uint(x), false, false); x = fmaxf(__uint_as_float(r.x), __uint_as_float(r.y));
    r = __builtin_amdgcn_permlane32_swap(__float_as_uint(x), __float_as_uint(x), false, false); return fmaxf(__uint_as_float(r.x), __uint_as_float(r.y)); }
__device__ __forceinline__ float red_sum_16_32(float x) { typedef unsigned u2_ __attribute__((ext_vector_type(2)));
    u2_ r = __builtin_amdgcn_permlane16_swap(__float_as_uint(x), __float_as_uint(x), false, false); x = __uint_as_float(r.x) + __uint_as_float(r.y);
    r = __builtin_amdgcn_permlane32_swap(__float_as_uint(x), __float_as_uint(x), false, false); return __uint_as_float(r.x) + __uint_as_float(r.y); }
template <int DH, int PITCH, class MaskF>
__device__ __forceinline__ void attn_step(const pg8::bf16x8 (&qf)[DH / 32], LAS unsigned char* kl, LAS unsigned char* vl, int t0, int t1, const MaskF& mf, float& m, float& l, f32x4 (&oT)[DH / 16]) {
    const int lane = threadIdx.x & 63, r16 = lane & 15, kq = lane >> 4;
    f32x4 s0 = {0.f, 0.f, 0.f, 0.f}, s1 = {0.f, 0.f, 0.f, 0.f};
    LAS unsigned char* ka0 = kl + (16 * t0 + r16) * PITCH + 16 * kq; LAS unsigned char* ka1 = kl + (16 * t1 + r16) * PITCH + 16 * kq;
#pragma unroll
    for (int s = 0; s < DH / 32; ++s) { const pg8::bf16x8 a0 = *(const LAS pg8::bf16x8*)(ka0 + 64 * s), a1 = *(const LAS pg8::bf16x8*)(ka1 + 64 * s);
        s0 = __builtin_amdgcn_mfma_f32_16x16x32_bf16(a0, qf[s], s0, 0, 0, 0); s1 = __builtin_amdgcn_mfma_f32_16x16x32_bf16(a1, qf[s], s1, 0, 0, 0); }
    float mx = -1e30f;
#pragma unroll
    for (int j = 0; j < 4; ++j) { s0[j] = mf(t0, 4 * kq + j, s0[j]); s1[j] = mf(t1, 4 * kq + j, s1[j]); mx = fmaxf(mx, fmaxf(s0[j], s1[j])); }
    mx = red_max_16_32(mx);
    const float mn = fmaxf(m, mx), sc = __builtin_amdgcn_exp2f(m - mn);
    float rs = 0.f;
#pragma unroll
    for (int j = 0; j < 4; ++j) { s0[j] = __builtin_amdgcn_exp2f(s0[j] - mn); s1[j] = __builtin_amdgcn_exp2f(s1[j] - mn); rs += s0[j] + s1[j]; }
    rs = red_sum_16_32(rs);
    l = l * sc + rs; m = mn;
    u32x4 pw; pw.x = pk2(s0[0], s0[1]); pw.y = pk2(s0[2], s0[3]); pw.z = pk2(s1[0], s1[1]); pw.w = pk2(s1[2], s1[3]);
    const pg8::bf16x8 pb = __builtin_bit_cast(pg8::bf16x8, pw);
    const int q = r16 >> 2, p = r16 & 3;
    LAS unsigned char* va0 = vl + (16 * t0 + 4 * kq + q) * PITCH + 8 * p; LAS unsigned char* va1 = vl + (16 * t1 + 4 * kq + q) * PITCH + 8 * p;
#pragma unroll
    for (int dt = 0; dt < DH / 16; ++dt) {
        const s16x4 lo = __builtin_amdgcn_ds_read_tr16_b64_v4i16((LAS s16x4*)(va0 + 32 * dt)), hi = __builtin_amdgcn_ds_read_tr16_b64_v4i16((LAS s16x4*)(va1 + 32 * dt));
        const pg8::bf16x8 va = __builtin_shufflevector(lo, hi, 0, 1, 2, 3, 4, 5, 6, 7);
        oT[dt] = oT[dt] * sc; oT[dt] = __builtin_amdgcn_mfma_f32_16x16x32_bf16(va, pb, oT[dt], 0, 0, 0); }
}
__device__ __forceinline__ void lds_put16(LAS unsigned char* dst, const bf16_t* src) { *(LAS u32x4*)dst = src ? *(const u32x4*)src : (u32x4){0u, 0u, 0u, 0u}; }

constexpr int ATT_KV64 = 272 * 160;
__device__ __forceinline__ void attnA_fetch(int u, int tid, u32x4 (&pfc)[8], float& tabv, const bf16_t* __restrict__ hq, const float* __restrict__ relb) {
    asm volatile("" : "+v"(tid));
    const int h = u & 3, rn = (u >> 2) & 31, b = (u >> 7) & 7, g = u >> 10;
    const int r = (g == 0) ? 1 : (g == 1 ? 4 : 16), nblk = 32 / r, rho = rn / nblk, n = rn % nblk, tb = b * SEQ;
    const bf16_t* kcol = hq + hq_off64(12 + g * 4 + h, 0); const bf16_t* vcol = hq + hq_off64(24 + g * 4 + h, 0);
#pragma unroll
    for (int i = 0; i < 8; ++i) { const int idx = tid + NTHREADS_ * i, isv = idx >> 11, i2 = idx & 2047, row = i2 >> 3, ch = i2 & 7, pos = (n - 1) * 128 + row;
        pfc[i] = (pos >= 0) ? *(const u32x4*)((isv ? vcol : kcol) + (size_t)(tb + rho + r * pos) * 64 + ch * 8) : (u32x4){0u, 0u, 0u, 0u}; }
    tabv = (tid < 129) ? relb[kBucket[g][tid] * 20 + g * 4 + h] * LOG2E : 0.f;
}
__device__ __forceinline__ void attnAB_store(int tid, const u32x4 (&pfc)[8], float tabv, LAS unsigned char* lds, int ntab) {
    asm volatile("" : "+v"(tid));
    LAS unsigned char* kl = lds; LAS unsigned char* vl = lds + ATT_KV64; LAS float* tab = (LAS float*)(lds + 2 * ATT_KV64);
#pragma unroll
    for (int i = 0; i < 8; ++i) { const int idx = tid + NTHREADS_ * i, isv = idx >> 11, i2 = idx & 2047, row = i2 >> 3, ch = i2 & 7; *(LAS u32x4*)((isv ? vl : kl) + row * 160 + ch * 16) = pfc[i]; }
    if (tid < 320) { const int isv = tid >= 160, i2 = isv ? tid - 160 : tid; *(LAS u32x4*)((isv ? vl : kl) + 256 * 160 + i2 * 16) = (u32x4){0u, 0u, 0u, 0u}; }
    if (tid < ntab) tab[tid] = tabv;
}
__device__ __forceinline__ void attnA_compute(int u, int tid, LAS unsigned char* lds, const bf16_t* __restrict__ hq, bf16_t* __restrict__ oA, float* __restrict__ lseA) {
    asm volatile("" : "+v"(tid));
    const int h = u & 3, rn = (u >> 2) & 31, b = (u >> 7) & 7, g = u >> 10;
    const int r = (g == 0) ? 1 : (g == 1 ? 4 : 16), nblk = 32 / r, rho = rn / nblk, n = rn % nblk, tb = b * SEQ;
    LAS unsigned char* kl = lds; LAS unsigned char* vl = lds + ATT_KV64; LAS float* tab = (LAS float*)(lds + 2 * ATT_KV64);
    const int w = tid >> 6, lane = tid & 63, r16 = lane & 15, kq = lane >> 4, qi = 16 * w + r16, kmin = (n == 0) ? 128 : 0;
    const size_t tq = (size_t)(tb + rho + r * (n * 128 + qi));
    pg8::bf16x8 qf[2];
#pragma unroll
    for (int s = 0; s < 2; ++s) qf[s] = *(const pg8::bf16x8*)(hq + hq_off64(g * 4 + h, tq) + 32 * s + 8 * kq);
    float m = ATT_M0, l = 0.f; f32x4 oT[4];
#pragma unroll
    for (int dt = 0; dt < 4; ++dt) oT[dt] = (f32x4){0.f, 0.f, 0.f, 0.f};
    auto mf = [&](int tile, int kr, float s) -> float { const int kk = 16 * tile + kr, off = qi + 128 - kk; const bool ok = (off >= 0) && (off <= 128) && (kk >= kmin);
        const int oc = off < 0 ? 0 : (off > 128 ? 128 : off); return ok ? s + tab[oc] : -1e30f; };
    auto mfi = [&](int tile, int kr, float s) -> float { return s + tab[qi + 128 - 16 * tile - kr]; };
    attn_step<64, 160>(qf, kl, vl, w, w + 1, mf, m, l, oT);
    if (n != 0) { for (int st = 1; st < 4; ++st) attn_step<64, 160>(qf, kl, vl, w + 2 * st, w + 2 * st + 1, mfi, m, l, oT); }
    else { for (int st = 1; st < 4; ++st) attn_step<64, 160>(qf, kl, vl, w + 2 * st, w + 2 * st + 1, mf, m, l, oT); }
    attn_step<64, 160>(qf, kl, vl, w + 8, w + 9, mf, m, l, oT);
    const float inv = 1.0f / l;
    bf16_t* op = oA + ((size_t)g * T + tq) * 256 + h * 64 + 4 * kq;
#pragma unroll
    for (int dt = 0; dt < 4; ++dt) { u32x2 wv; wv.x = pk2(oT[dt][0] * inv, oT[dt][1] * inv); wv.y = pk2(oT[dt][2] * inv, oT[dt][3] * inv); *(u32x2*)(op + 16 * dt) = wv; }
    if (kq == 0) lseA[((size_t)g * T + tq) * 4 + h] = (m + __builtin_amdgcn_logf(l)) * LN2F;
}
__device__ __forceinline__ void attnB_fetch(int u, int tid, u32x4 (&pfc)[8], float& tabv, const bf16_t* __restrict__ hq, const float* __restrict__ relb) {
    asm volatile("" : "+v"(tid));
    const int kvh = u & 1, n = (u >> 1) & 31, b = u >> 6, tb = b * SEQ;
    const bf16_t* kcol = hq + hq_off64(44 + kvh, 0); const bf16_t* vcol = hq + hq_off64(46 + kvh, 0);
#pragma unroll
    for (int i = 0; i < 8; ++i) { const int idx = tid + NTHREADS_ * i, isv = idx >> 11, i2 = idx & 2047, row = i2 >> 3, ch = i2 & 7, pos = (n - 1) * 128 + row;
        pfc[i] = (pos >= 0) ? *(const u32x4*)((isv ? vcol : kcol) + (size_t)(tb + pos) * 64 + ch * 8) : (u32x4){0u, 0u, 0u, 0u}; }
    { const int hd = tid >> 7, off = tid & 127; tabv = relb[kBucket[0][off] * 20 + 12 + kvh * 4 + hd] * LOG2E; }
}
__device__ __forceinline__ void attnB_compute(int u, int tid, LAS unsigned char* lds, const bf16_t* __restrict__ hq, const float* __restrict__ sinks, bf16_t* __restrict__ yb) {
    asm volatile("" : "+v"(tid));
    const int kvh = u & 1, n = (u >> 1) & 31, b = u >> 6, tb = b * SEQ;
    LAS unsigned char* kl = lds; LAS unsigned char* vl = lds + ATT_KV64; LAS float* tab = (LAS float*)(lds + 2 * ATT_KV64);
    const int w = tid >> 6, lane = tid & 63, r16 = lane & 15, kq = lane >> 4, kmin = (n == 0) ? 128 : 0;
    for (int i = 0; i < 4; ++i) {
        const int task = w + 8 * i, hd = task >> 3, sub = task & 7, head = kvh * 4 + hd, qi = 16 * sub + r16;
        const size_t tq = (size_t)(tb + n * 128 + qi);
        pg8::bf16x8 qf[2];
#pragma unroll
        for (int s = 0; s < 2; ++s) qf[s] = *(const pg8::bf16x8*)(hq + hq_off64(36 + head, tq) + 32 * s + 8 * kq);
        float m = sinks[head] * LOG2E, l = 1.0f; f32x4 oT[4];
#pragma unroll
        for (int dt = 0; dt < 4; ++dt) oT[dt] = (f32x4){0.f, 0.f, 0.f, 0.f};
        LAS float* tb_h = tab + hd * 128;
        auto mf = [&](int tile, int kr, float s) -> float { const int kk = 16 * tile + kr, off = qi + 128 - kk; const bool ok = (off >= 0) && (off <= 127) && (kk >= kmin);
            const int oc = off < 0 ? 0 : (off > 127 ? 127 : off); return ok ? s + tb_h[oc] : -1e30f; };
        auto mfi = [&](int tile, int kr, float s) -> float { return s + tb_h[qi + 128 - 16 * tile - kr]; };
        attn_step<64, 160>(qf, kl, vl, sub, sub + 1, mf, m, l, oT);
        if (n != 0) { for (int st = 1; st < 4; ++st) attn_step<64, 160>(qf, kl, vl, sub + 2 * st, sub + 2 * st + 1, mfi, m, l, oT); }
        else { for (int st = 1; st < 4; ++st) attn_step<64, 160>(qf, kl, vl, sub + 2 * st, sub + 2 * st + 1, mf, m, l, oT); }
        attn_step<64, 160>(qf, kl, vl, sub + 8, sub + 9, mf, m, l, oT);
        const float inv = 1.0f / l;
        bf16_t* op = yb + tq * 512 + head * 64 + 4 * kq;
#pragma unroll
        for (int dt = 0; dt < 4; ++dt) { u32x2 wv; wv.x = pk2(oT[dt][0] * inv, oT[dt][1] * inv); wv.y = pk2(oT[dt][2] * inv, oT[dt][3] * inv); *(u32x2*)(op + 16 * dt) = wv; }
    }
}
__device__ __forceinline__ void attnAB_phase(LAS unsigned char* lds, const bf16_t* __restrict__ hq, const float* __restrict__ relb, const float* __restrict__ sinks, bf16_t* __restrict__ oA, float* __restrict__ lseA, bf16_t* __restrict__ yb) {
    int tid = threadIdx.x; asm volatile("" : "+v"(tid));
    u32x4 pfc[8]; float tabv = 0.f;
    int u = blockIdx.x;
    if (u < 3072) attnA_fetch(u, tid, pfc, tabv, hq, relb);
    for (; u < 3072; u += gridDim.x) {
        attnAB_store(tid, pfc, tabv, lds, 129);
        __syncthreads();
        const int un = u + gridDim.x;
        if (un < 3072) attnA_fetch(un, tid, pfc, tabv, hq, relb); else if ((int)blockIdx.x < 512) attnB_fetch((int)blockIdx.x, tid, pfc, tabv, hq, relb);
        attnA_compute(u, tid, lds, hq, oA, lseA);
        __syncthreads();
    }
    u = blockIdx.x;
    if (3072 <= (int)blockIdx.x && u < 512) attnB_fetch(u, tid, pfc, tabv, hq, relb);
    for (; u < 512; u += gridDim.x) {
        attnAB_store(tid, pfc, tabv, lds, 512);
        __syncthreads();
        const int un = u + gridDim.x;
        if (un < 512) attnB_fetch(un, tid, pfc, tabv, hq, relb);
        attnB_compute(u, tid, lds, hq, sinks, yb);
        __syncthreads();
    }
}
__device__ __forceinline__ void attnC_unit(int u, LAS unsigned char* lds, const bf16_t* __restrict__ hq, const bf16_t* __restrict__ kvm, bf16_t* __restrict__ yc) {
    int tid = threadIdx.x; asm volatile("" : "+v"(tid));
    const int qc = u & 7, head = (u >> 3) & 3, b = u >> 5, tb = b * SEQ;
    constexpr int CP = 272, IMG = 256 * CP;
    LAS unsigned char* kl = lds; LAS unsigned char* vl = lds + IMG;
    for (int idx = tid; idx < 8192; idx += NTHREADS_) { const int isv = idx >> 12, i2 = idx & 4095, row = i2 >> 4, ch = i2 & 15;
        lds_put16((isv ? vl : kl) + row * CP + ch * 16, kvm + (size_t)(b * MEMLEN + row) * 1024 + isv * 512 + head * 128 + ch * 8); }
    __syncthreads();
    const int w = tid >> 6, lane = tid & 63, r16 = lane & 15, kq = lane >> 4;
    auto mf = [&](int, int, float s) -> float { return s; };
    for (int qt = 0; qt < 4; ++qt) {
        const size_t tq = (size_t)(tb + qc * 512 + qt * 128 + 16 * w + r16);
        pg8::bf16x8 qf[4];
#pragma unroll
        for (int s = 0; s < 4; ++s) qf[s] = *(const pg8::bf16x8*)(hq + hq_offc(head, tq) + 32 * s + 8 * kq);
        float m = ATT_M0, l = 0.f; f32x4 oT[8];
#pragma unroll
        for (int dt = 0; dt < 8; ++dt) oT[dt] = (f32x4){0.f, 0.f, 0.f, 0.f};
        for (int st = 0; st < 8; ++st) attn_step<128, CP>(qf, kl, vl, 2 * st, 2 * st + 1, mf, m, l, oT);
        const float inv = 1.0f / l;
        bf16_t* op = yc + tq * 512 + head * 128 + 4 * kq;
#pragma unroll
        for (int dt = 0; dt < 8; ++dt) { u32x2 wv; wv.x = pk2(oT[dt][0] * inv, oT[dt][1] * inv); wv.y = pk2(oT[dt][2] * inv, oT[dt][3] * inv); *(u32x2*)(op + 16 * dt) = wv; }
    }
    __syncthreads();
}

#define CE_DESC(a, b) do { const unsigned _mx = (a) > (b) ? (a) : (b), _mn = (a) > (b) ? (b) : (a); (a) = _mx; (b) = _mn; } while (0)
__device__ __forceinline__ void sort16_desc(unsigned (&v)[16]) {
    CE_DESC(v[0], v[13]); CE_DESC(v[1], v[12]); CE_DESC(v[2], v[15]); CE_DESC(v[3], v[14]); CE_DESC(v[4], v[8]); CE_DESC(v[5], v[6]); CE_DESC(v[7], v[11]); CE_DESC(v[9], v[10]);
    CE_DESC(v[0], v[5]); CE_DESC(v[1], v[7]); CE_DESC(v[2], v[9]); CE_DESC(v[3], v[4]); CE_DESC(v[6], v[13]); CE_DESC(v[8], v[14]); CE_DESC(v[10], v[15]); CE_DESC(v[11], v[12]);
    CE_DESC(v[0], v[1]); CE_DESC(v[2], v[3]); CE_DESC(v[4], v[5]); CE_DESC(v[6], v[8]); CE_DESC(v[7], v[9]); CE_DESC(v[10], v[11]); CE_DESC(v[12], v[13]); CE_DESC(v[14], v[15]);
    CE_DESC(v[0], v[2]); CE_DESC(v[1], v[3]); CE_DESC(v[4], v[10]); CE_DESC(v[5], v[11]); CE_DESC(v[6], v[7]); CE_DESC(v[8], v[9]); CE_DESC(v[12], v[14]); CE_DESC(v[13], v[15]);
    CE_DESC(v[1], v[2]); CE_DESC(v[3], v[12]); CE_DESC(v[4], v[6]); CE_DESC(v[5], v[7]); CE_DESC(v[8], v[10]); CE_DESC(v[9], v[11]); CE_DESC(v[13], v[14]);
    CE_DESC(v[1], v[4]); CE_DESC(v[2], v[6]); CE_DESC(v[5], v[8]); CE_DESC(v[7], v[10]); CE_DESC(v[9], v[13]); CE_DESC(v[11], v[14]);
    CE_DESC(v[2], v[4]); CE_DESC(v[3], v[6]); CE_DESC(v[9], v[12]); CE_DESC(v[11], v[13]);
    CE_DESC(v[3], v[5]); CE_DESC(v[6], v[8]); CE_DESC(v[7], v[9]); CE_DESC(v[10], v[12]);
    CE_DESC(v[3], v[4]); CE_DESC(v[5], v[6]); CE_DESC(v[7], v[8]); CE_DESC(v[9], v[10]); CE_DESC(v[11], v[12]);
    CE_DESC(v[6], v[7]); CE_DESC(v[8], v[9]);
}
__device__ __forceinline__ void bitonic_merge16_desc(unsigned (&v)[16]) {
#pragma unroll
    for (int j = 8; j > 0; j >>= 1)
#pragma unroll
        for (int i = 0; i < 16; ++i) { const int p = i ^ j; if (p > i) CE_DESC(v[i], v[p]); }
}
__device__ __forceinline__ void top16_merge(unsigned (&a)[16], const unsigned (&b)[16]) {
#pragma unroll
    for (int i = 0; i < 16; ++i) a[i] = a[i] > b[15 - i] ? a[i] : b[15 - i];
    bitonic_merge16_desc(a);
}
__device__ __forceinline__ unsigned f2key(float f) { const unsigned u = __float_as_uint(f); return u ^ ((unsigned)((int)u >> 31) | 0x80000000u); }
__device__ __forceinline__ float key2f(unsigned k) { return __uint_as_float((k & 0x80000000u) ? (k ^ 0x80000000u) : ~k); }

constexpr int TK_KIMG = 128 * 144;
__device__ __forceinline__ void topk_unit(int u, LAS unsigned char* lds, const bf16_t* __restrict__ qb, const bf16_t* __restrict__ subk, unsigned short* __restrict__ eidx, float* __restrict__ gate) {
    int tid = threadIdx.x; asm volatile("" : "+v"(tid));
    const int h = u & 7, tile = u >> 3;
    typedef float f32x16 __attribute__((ext_vector_type(16)));
    for (int idx = tid; idx < 2048; idx += NTHREADS_) { const int row = idx >> 3, ch = idx & 7;
        *(LAS u32x4*)(lds + row * 144 + ch * 16) = *(const u32x4*)(subk + ((size_t)(h * 256 + row)) * 64 + ch * 8); }
    __syncthreads();
    const int w = tid >> 6, lane = tid & 63, r32 = lane & 31, hh = lane >> 5;
    const size_t tok = (size_t)tile * 256 + w * 32 + r32;
    unsigned top[2][16];
#pragma unroll
    for (int c = 0; c < 2; ++c) {
        pg8::bf16x8 qf[4];
#pragma unroll
        for (int s = 0; s < 4; ++s) qf[s] = *(const pg8::bf16x8*)(qb + tok * D + h * 128 + c * 64 + 16 * s + 8 * hh);
        unsigned key[4][16];
#pragma unroll
        for (int kt = 0; kt < 4; ++kt) { f32x16 acc;
#pragma unroll
            for (int i = 0; i < 16; ++i) acc[i] = 0.f;
#pragma unroll
            for (int s = 0; s < 4; ++s) { const pg8::bf16x8 a = *(const LAS pg8::bf16x8*)(lds + c * TK_KIMG + (32 * kt + r32) * 144 + (16 * s + 8 * hh) * 2);
                acc = __builtin_amdgcn_mfma_f32_32x32x16_bf16(a, qf[s], acc, 0, 0, 0); }
            const unsigned lowb = 127u - 4u * hh - 32u * kt;
#pragma unroll
            for (int i = 0; i < 16; ++i) key[kt][i] = (f2key(acc[i]) & 0xFFFFFF80u) | (lowb - (unsigned)((i & 3) + 8 * (i >> 2)));
            sort16_desc(key[kt]); }
        top16_merge(key[0], key[1]); top16_merge(key[2], key[3]); top16_merge(key[0], key[2]);
        unsigned other[16];
#pragma unroll
        for (int i = 0; i < 16; ++i) other[i] = (unsigned)__shfl_xor((int)key[0][i], 32, 64);
        top16_merge(key[0], other);
#pragma unroll
        for (int i = 0; i < 16; ++i) top[c][i] = key[0][i];
    }
    float v0[16], v1[16];
#pragma unroll
    for (int i = 0; i < 16; ++i) { v0[i] = key2f(top[0][i] & 0xFFFFFF80u); v1[i] = key2f(top[1][i] & 0xFFFFFF80u); }
    unsigned cand[4][16];
#pragma unroll
    for (int q = 0; q < 4; ++q)
#pragma unroll
        for (int i = 0; i < 16; ++i) cand[q][i] = 0u;
#define CAND_(q, e, i, j) cand[q][e] = (f2key(v0[i] + v1[j]) & 0xFFFFFF00u) | (unsigned)(255 - ((i) * 16 + (j)))
    CAND_(0, 0, 0, 0);
    CAND_(0, 1, 0, 1);
    CAND_(0, 2, 0, 2);
    CAND_(0, 3, 0, 3);
    CAND_(0, 4, 0, 4);
    CAND_(0, 5, 0, 5);
    CAND_(0, 6, 0, 6);
    CAND_(0, 7, 0, 7);
    CAND_(0, 8, 0, 8);
    CAND_(0, 9, 0, 9);
    CAND_(0, 10, 0, 10);
    CAND_(0, 11, 0, 11);
    CAND_(0, 12, 0, 12);
    CAND_(0, 13, 0, 13);
    CAND_(0, 14, 0, 14);
    CAND_(0, 15, 0, 15);
    CAND_(1, 0, 1, 0);
    CAND_(1, 1, 1, 1);
    CAND_(1, 2, 1, 2);
    CAND_(1, 3, 1, 3);
    CAND_(1, 4, 1, 4);
    CAND_(1, 5, 1, 5);
    CAND_(1, 6, 1, 6);
    CAND_(1, 7, 1, 7);
    CAND_(1, 8, 2, 0);
    CAND_(1, 9, 2, 1);
    CAND_(1, 10, 2, 2);
    CAND_(1, 11, 2, 3);
    CAND_(1, 12, 2, 4);
    CAND_(1, 13, 3, 0);
    CAND_(1, 14, 3, 1);
    CAND_(1, 15, 3, 2);
    CAND_(2, 0, 3, 3);
    CAND_(2, 1, 4, 0);
    CAND_(2, 2, 4, 1);
    CAND_(2, 3, 4, 2);
    CAND_(2, 4, 5, 0);
    CAND_(2, 5, 5, 1);
    CAND_(2, 6, 6, 0);
    CAND_(2, 7, 6, 1);
    CAND_(2, 8, 7, 0);
    CAND_(2, 9, 7, 1);
    CAND_(2, 10, 8, 0);
    CAND_(2, 11, 9, 0);
    CAND_(2, 12, 10, 0);
    CAND_(2, 13, 11, 0);
    CAND_(2, 14, 12, 0);
    CAND_(2, 15, 13, 0);
    CAND_(3, 0, 14, 0);
    CAND_(3, 1, 15, 0);
#undef CAND_
#pragma unroll
    for (int q = 0; q < 4; ++q) sort16_desc(cand[q]);
    top16_merge(cand[0], cand[1]); top16_merge(cand[2], cand[3]); top16_merge(cand[0], cand[2]);
    float ev[16]; const float vmax = key2f(cand[0][0] & 0xFFFFFF00u); float esum = 0.f;
#pragma unroll
    for (int k = 0; k < 16; ++k) { ev[k] = __builtin_amdgcn_exp2f((key2f(cand[0][k] & 0xFFFFFF00u) - vmax) * LOG2E); esum += ev[k]; }
    const float einv = 1.0f / esum;
    LAS unsigned char* st = lds + 2 * TK_KIMG + (w * 64 + lane) * 32;
#pragma unroll
    for (int g4 = 0; g4 < 4; ++g4) { unsigned d0 = 0u, d1 = 0u;
#pragma unroll
        for (int e = 0; e < 4; ++e) { d0 |= (127u - (top[0][4 * g4 + e] & 127u)) << (8 * e); d1 |= (127u - (top[1][4 * g4 + e] & 127u)) << (8 * e); }
        *(LAS unsigned*)(st + 4 * g4) = d0; *(LAS unsigned*)(st + 16 + 4 * g4) = d1; }
    int eo[16];
#pragma unroll
    for (int k = 0; k < 16; ++k) { const unsigned code = 255u - (cand[0][k] & 255u); eo[k] = (int)st[code >> 4] * 128 + (int)st[16 + (code & 15u)]; }
    if (hh == 0) {
        u32x4 o0, o1;
        o0.x = (unsigned)eo[0] | ((unsigned)eo[1] << 16); o0.y = (unsigned)eo[2] | ((unsigned)eo[3] << 16); o0.z = (unsigned)eo[4] | ((unsigned)eo[5] << 16); o0.w = (unsigned)eo[6] | ((unsigned)eo[7] << 16);
        o1.x = (unsigned)eo[8] | ((unsigned)eo[9] << 16); o1.y = (unsigned)eo[10] | ((unsigned)eo[11] << 16); o1.z = (unsigned)eo[12] | ((unsigned)eo[13] << 16); o1.w = (unsigned)eo[14] | ((unsigned)eo[15] << 16);
        *(u32x4*)(eidx + tok * 128 + h * 16) = o0; *(u32x4*)(eidx + tok * 128 + h * 16 + 8) = o1;
    } else {
#pragma unroll
        for (int k4 = 0; k4 < 4; ++k4) { f32x4 o; o[0] = ev[4 * k4] * einv; o[1] = ev[4 * k4 + 1] * einv; o[2] = ev[4 * k4 + 2] * einv; o[3] = ev[4 * k4 + 3] * einv;
            *(f32x4*)(gate + tok * 128 + h * 16 + 4 * k4) = o; }
    }
    __syncthreads();
}

__device__ __forceinline__ float fp8dot16(const u32x4 w, const f32x2 (&xp)[8]) {
    f32x2 a0 = __builtin_amdgcn_cvt_pk_f32_fp8((int)w.x, false) * xp[0];
    a0 = __builtin_elementwise_fma(__builtin_amdgcn_cvt_pk_f32_fp8((int)w.x, true), xp[1], a0);
    a0 = __builtin_elementwise_fma(__builtin_amdgcn_cvt_pk_f32_fp8((int)w.y, false), xp[2], a0); a0 = __builtin_elementwise_fma(__builtin_amdgcn_cvt_pk_f32_fp8((int)w.y, true), xp[3], a0);
    a0 = __builtin_elementwise_fma(__builtin_amdgcn_cvt_pk_f32_fp8((int)w.z, false), xp[4], a0); a0 = __builtin_elementwise_fma(__builtin_amdgcn_cvt_pk_f32_fp8((int)w.z, true), xp[5], a0);
    a0 = __builtin_elementwise_fma(__builtin_amdgcn_cvt_pk_f32_fp8((int)w.w, false), xp[6], a0); a0 = __builtin_elementwise_fma(__builtin_amdgcn_cvt_pk_f32_fp8((int)w.w, true), xp[7], a0);
    return a0.x + a0.y;
}
typedef int i32x4 __attribute__((ext_vector_type(4)));
#define PEER_EIDX16(dst, t_) do { const unsigned short* ep_ = eidx + (size_t)(t_) * 128 + 16 * grp; const u32x4 e0_ = *(const u32x4*)ep_, e1_ = *(const u32x4*)(ep_ + 8); \
        dst[0] = (int)(e0_.x & 0xffffu); dst[1] = (int)(e0_.x >> 16); dst[2] = (int)(e0_.y & 0xffffu); dst[3] = (int)(e0_.y >> 16); dst[4] = (int)(e0_.z & 0xffffu); dst[5] = (int)(e0_.z >> 16); dst[6] = (int)(e0_.w & 0xffffu); dst[7] = (int)(e0_.w >> 16); \
        dst[8] = (int)(e1_.x & 0xffffu); dst[9] = (int)(e1_.x >> 16); dst[10] = (int)(e1_.y & 0xffffu); dst[11] = (int)(e1_.y >> 16); dst[12] = (int)(e1_.z & 0xffffu); dst[13] = (int)(e1_.z >> 16); dst[14] = (int)(e1_.w & 0xffffu); dst[15] = (int)(e1_.w >> 16); } while (0)
#define PEER_GATHER16(BUF, base, ev) _Pragma("unroll") for (int i_ = 0; i_ < 16; ++i_) BUF[i_] = *(const u32x4*)((base) + (unsigned)(((unsigned)(ev)[i_] << 10) + (unsigned)colbase))
template <int CTRL> __device__ __forceinline__ float xsel_addf_dpp(float keep_lo, float keep_hi, bool hi) { const float send = hi ? keep_lo : keep_hi, keep = hi ? keep_hi : keep_lo;
    return keep + __uint_as_float(__builtin_amdgcn_update_dpp(0u, __float_as_uint(send), CTRL, 0xf, 0xf, false)); }
__device__ __forceinline__ float swap32_add(float lo, float hi) { typedef unsigned u2_ __attribute__((ext_vector_type(2))); const u2_ r = __builtin_amdgcn_permlane32_swap(__float_as_uint(lo), __float_as_uint(hi), false, false); return __uint_as_float(r.x) + __uint_as_float(r.y); }
__device__ __forceinline__ float swap16_add(float lo, float hi) { typedef unsigned u2_ __attribute__((ext_vector_type(2))); const u2_ r = __builtin_amdgcn_permlane16_swap(__float_as_uint(lo), __float_as_uint(hi), false, false); return __uint_as_float(r.x) + __uint_as_float(r.y); }
#define PEER_GATHER4(R, o, base, E, p) _Pragma("unroll") for (int j_ = 0; j_ < 4; ++j_) R[(o) + j_] = *(const u32x4*)((base) + (unsigned)(((unsigned)(E)[4 * (p) + j_] << 10) + (unsigned)colbase))
__device__ __forceinline__ void peerU_phase(int slice, int tok0, int tok1, const bf16_t* __restrict__ x1b,
                                            const unsigned short* __restrict__ eidx, const unsigned char* __restrict__ ub8, bf16_t* __restrict__ hp) {
    int tid = threadIdx.x; asm volatile("" : "+v"(tid));
    const int wave = tid >> 6, lane = tid & 63, sub = lane & 7, grp = lane >> 3, colbase = 128 * slice + 16 * sub;
    if (tok0 + wave >= tok1) return;
    const bool l0 = lane & 1, l1 = lane & 2, l2 = lane & 4;
    const int tfirst = tok0 + wave, tlast = tfirst + ((tok1 - 1 - tfirst) >> 3) * 8;
    const bf16_t* xl = x1b + colbase;
    const int hoff = 16 * grp + ((lane & 4) ? 8 : 0) + ((lane & 2) ? 4 : 0) + ((lane & 1) ? 2 : 0);
#define TOKC(i) ((tfirst + 8 * (i)) <= tlast ? (tfirst + 8 * (i)) : tlast)
    u32x4 R[32]; int EA[16], EB[16]; u32x4 xrA0, xrA1, xrB0, xrB1;
    { const int t0 = TOKC(0), t1 = TOKC(1);
      PEER_EIDX16(EA, t0); PEER_EIDX16(EB, t1);
      xrA0 = *(const u32x4*)(xl + (size_t)t0 * D); xrA1 = *(const u32x4*)(xl + (size_t)t0 * D + 8); xrB0 = *(const u32x4*)(xl + (size_t)t1 * D); xrB1 = *(const u32x4*)(xl + (size_t)t1 * D + 8);
#pragma unroll
      for (int p = 0; p < 4; ++p) { PEER_GATHER4(R, 4 * p, ub8, EA, p); }
#pragma unroll
      for (int p = 0; p < 4; ++p) { PEER_GATHER4(R, 16 + 4 * p, ub8, EB, p); }
      const int t2 = TOKC(2), t3 = TOKC(3); PEER_EIDX16(EA, t2); PEER_EIDX16(EB, t3); }
    for (int i = 0;; i += 2) {
#define PEER_U_TOKEN(RO, E, xr0, xr1, ti, tnext2, tnext4) do { \
        f32x2 xp[8]; \
        xp[0] = (f32x2){bflo(xr0.x), bfhi(xr0.x)}; xp[1] = (f32x2){bflo(xr0.y), bfhi(xr0.y)}; xp[2] = (f32x2){bflo(xr0.z), bfhi(xr0.z)}; xp[3] = (f32x2){bflo(xr0.w), bfhi(xr0.w)}; \
        xp[4] = (f32x2){bflo(xr1.x), bfhi(xr1.x)}; xp[5] = (f32x2){bflo(xr1.y), bfhi(xr1.y)}; xp[6] = (f32x2){bflo(xr1.z), bfhi(xr1.z)}; xp[7] = (f32x2){bflo(xr1.w), bfhi(xr1.w)}; \
        xr0 = *(const u32x4*)(xl + (size_t)(tnext2) * D); xr1 = *(const u32x4*)(xl + (size_t)(tnext2) * D + 8);        \
        float pd[16]; \
        _Pragma("unroll") for (int p = 0; p < 4; ++p) { \
            _Pragma("unroll") for (int j = 0; j < 4; ++j) pd[4 * p + j] = fp8dot16(R[(RO) + 4 * p + j], xp); \
            PEER_GATHER4(R, (RO) + 4 * p, ub8, E, p); } \
        PEER_EIDX16(E, tnext4); \
        float q8[8]; \
        _Pragma("unroll") for (int k = 0; k < 8; ++k) q8[k] = xsel_addf_dpp<0x141>(pd[k], pd[k + 8], l2);            \
        const float r0 = xsel_addf_dpp<0x4E>(q8[0], q8[4], l1), r1 = xsel_addf_dpp<0x4E>(q8[1], q8[5], l1), r2 = xsel_addf_dpp<0x4E>(q8[2], q8[6], l1), r3 = xsel_addf_dpp<0x4E>(q8[3], q8[7], l1);     \
        f32x2 o; o.x = xsel_addf_dpp<0xB1>(r0, r2, l0); o.y = xsel_addf_dpp<0xB1>(r1, r3, l0);                       \
        if ((tfirst + 8 * (ti)) <= tlast) *(unsigned*)(hp + ((size_t)slice * T + (size_t)(tfirst + 8 * (ti))) * 128 + hoff) = pk2(o.x, o.y); } while (0)
        { const int tn2 = TOKC(i + 2), tn4 = TOKC(i + 4); PEER_U_TOKEN(0, EA, xrA0, xrA1, i, tn2, tn4); }
        { const int tn2 = TOKC(i + 3), tn4 = TOKC(i + 5); PEER_U_TOKEN(16, EB, xrB0, xrB1, i + 1, tn2, tn4); }
        if (tfirst + 8 * (i + 2) > tlast) break;
    }
#undef PEER_U_TOKEN
#undef TOKC
}
#ifdef PROBE_EXP
__device__ __forceinline__ void probe_gather(int slice, int tok0, int tok1, const unsigned short* __restrict__ eidx, const unsigned char* __restrict__ ub8, float* __restrict__ dummy) {
    int tid = threadIdx.x; asm volatile("" : "+v"(tid));
    const int wave = tid >> 6, lane = tid & 63, sub = lane & 7, grp = lane >> 3, colbase = 128 * slice + 16 * sub;
    if (tok0 + wave >= tok1) return;
    const unsigned char* ubl = ub8;
    const int tlast = tok0 + wave + ((tok1 - 1 - tok0 - wave) >> 3) * 8;
    int EA[16], EB[16]; u32x4 UA[16], UB[16];
    int ta = tok0 + wave, tb = ta + 8 <= tlast ? ta + 8 : tlast;
    PEER_EIDX16(EA, ta); PEER_EIDX16(EB, tb);
    PEER_GATHER16(UA, ubl, EA);
    unsigned accx = 0u;
    for (;;) {
        PEER_GATHER16(UB, ubl, EB);
        const int ta2 = ta + 16 <= tlast ? ta + 16 : tlast; PEER_EIDX16(EA, ta2);
#pragma unroll
        for (int i = 0; i < 16; ++i) accx ^= UA[i].x ^ UA[i].y ^ UA[i].z ^ UA[i].w;
        PEER_GATHER16(UA, ubl, EA);
        const int tb2 = ta + 24 <= tlast ? ta + 24 : tlast; PEER_EIDX16(EB, tb2);
#pragma unroll
        for (int i = 0; i < 16; ++i) accx ^= UB[i].x ^ UB[i].y ^ UB[i].z ^ UB[i].w;
        if (ta + 16 > tlast) break;
        ta = ta2; tb = tb2;
    }
    dummy[(size_t)blockIdx.x * 512 + tid] = __uint_as_float(accx & 0x3fffffffu);
}
#endif

#if defined(PROBE_EXP) && PROBE_EXP >= 10 && PROBE_EXP < 20
__device__ __forceinline__ void probe_valu(float* __restrict__ dummy) {
    int tid = threadIdx.x; asm volatile("" : "+v"(tid));
    unsigned w[8]; f32x2 a[8];
#pragma unroll
    for (int i = 0; i < 8; ++i) { w[i] = (unsigned)tid * 2654435761u + i * 40503u; a[i] = (f32x2){(float)i, 1.0f}; }
    for (int it = 0; it < 2048; ++it) {
#pragma unroll
        for (int r = 0; r < 4; ++r)
#pragma unroll
            for (int i = 0; i < 8; ++i) {
#if PROBE_EXP == 10
                asm volatile("v_cvt_pk_f32_fp8_e32 %0, %1" : "=v"(a[i]) : "v"(w[i]));
#elif PROBE_EXP == 11
                asm volatile("v_pk_fma_f32 %0, %1, %1, %0" : "+v"(a[i]) : "v"(a[(i + 1) & 7]));
#elif PROBE_EXP == 12
                asm volatile("v_cvt_f32_ubyte0_e32 %0, %1" : "=v"(a[i].x) : "v"(w[i]));
#elif PROBE_EXP == 13
                asm volatile("v_dot4_i32_i8 %0, %1, %1, %0" : "+v"(w[i]) : "v"(w[(i + 1) & 7]));
#elif PROBE_EXP == 14
                asm volatile("v_fma_f32 %0, %1, %1, %0" : "+v"(a[i].x) : "v"(a[(i + 1) & 7].y));
#elif PROBE_EXP == 15
                asm volatile("v_dot2_f32_bf16 %0, %1, %1, %0" : "+v"(a[i].x) : "v"(w[i]));
#endif
            }
    }
    float s = 0.f;
#pragma unroll
    for (int i = 0; i < 8; ++i) s += a[i].x + a[i].y + __uint_as_float(w[i] & 0x3fffffffu);
    dummy[(size_t)blockIdx.x * 512 + tid] = s;
}
#endif
__device__ __forceinline__ void peerR_phase(const bf16_t* __restrict__ hp, const unsigned short* __restrict__ eidx, const float* __restrict__ gate, const float* __restrict__ usc, const float* __restrict__ vsc, bf16_t* __restrict__ cb) {
    for (size_t i = (size_t)blockIdx.x * 512 + threadIdx.x; i < (size_t)T * 32; i += (size_t)gridDim.x * 512) {
        f32x4 h = (f32x4){0.f, 0.f, 0.f, 0.f};
#pragma unroll
        for (int j = 0; j < 8; ++j) { const u32x2 w = *(const u32x2*)(hp + (size_t)j * T * 128 + 4 * i); h += (f32x4){bflo(w.x), bfhi(w.x), bflo(w.y), bfhi(w.y)}; }
        const u32x2 ew = *(const u32x2*)(eidx + 4 * i); const int e[4] = {(int)(ew.x & 0xffffu), (int)(ew.x >> 16), (int)(ew.y & 0xffffu), (int)(ew.y >> 16)};
        const f32x4 gt = *(const f32x4*)(gate + 4 * i); float c[4];
#pragma unroll
        for (int j = 0; j < 4; ++j) { const float hh = h[j] * usc[e[j]]; const pg8::f32x2 ge = pg8::gelu_pk((pg8::f32x2){hh, hh}); c[j] = gt[j] * ge.x * vsc[e[j]]; }
        u32x2 cw; cw.x = pk2(c[0], c[1]); cw.y = pk2(c[2], c[3]); *(u32x2*)(cb + 4 * i) = cw; }
}
__device__ __forceinline__ void peerV_phase(int slice, int tok0, int tok1, const bf16_t* __restrict__ cb, const unsigned short* __restrict__ eidx, const unsigned char* __restrict__ vb8, bf16_t* __restrict__ yp) {
    int tid = threadIdx.x; asm volatile("" : "+v"(tid));
    const int wave = tid >> 6, lane = tid & 63, sub = lane & 7, grp = lane >> 3, colbase = 128 * slice + 16 * sub;
    if (tok0 + wave >= tok1) return;
    const bool l3 = lane & 8, l4 = lane & 16, l5 = lane & 32;
    const int tfirst = tok0 + wave, tlast = tfirst + ((tok1 - 1 - tfirst) >> 3) * 8;
    const bf16_t* cl = cb + 16 * grp;
    const int yoff = colbase + ((lane & 32) ? 8 : 0) + ((lane & 16) ? 4 : 0) + ((lane & 8) ? 2 : 0);
#define TOKC(i) ((tfirst + 8 * (i)) <= tlast ? (tfirst + 8 * (i)) : tlast)
#define PEER_C16(dst, t_) do { const bf16_t* cp_ = cl + (size_t)(t_) * 128; dst[0] = *(const u32x4*)cp_; dst[1] = *(const u32x4*)(cp_ + 8); } while (0)
    u32x4 R[32]; int EA[16], EB[16]; u32x4 cA[2], cB[2];
    { const int t0 = TOKC(0), t1 = TOKC(1);
      PEER_EIDX16(EA, t0); PEER_EIDX16(EB, t1); PEER_C16(cA, t0); PEER_C16(cB, t1);
#pragma unroll
      for (int p = 0; p < 4; ++p) { PEER_GATHER4(R, 4 * p, vb8, EA, p); }
#pragma unroll
      for (int p = 0; p < 4; ++p) { PEER_GATHER4(R, 16 + 4 * p, vb8, EB, p); }
      const int t2 = TOKC(2), t3 = TOKC(3); PEER_EIDX16(EA, t2); PEER_EIDX16(EB, t3); }
    for (int i = 0;; i += 2) {
#define PEER_V_TOKEN(RO, E, cc, ti, tnext2, tnext4) do { \
        const u32x4 c0_ = cc[0], c1_ = cc[1]; \
        const float cv[16] = {bflo(c0_.x), bfhi(c0_.x), bflo(c0_.y), bfhi(c0_.y), bflo(c0_.z), bfhi(c0_.z), bflo(c0_.w), bfhi(c0_.w), bflo(c1_.x), bfhi(c1_.x), bflo(c1_.y), bfhi(c1_.y), bflo(c1_.z), bfhi(c1_.z), bflo(c1_.w), bfhi(c1_.w)}; \
        PEER_C16(cc, tnext2);                                        \
        f32x2 acc[8]; \
        _Pragma("unroll") for (int k = 0; k < 8; ++k) acc[k] = (f32x2){0.f, 0.f}; \
        _Pragma("unroll") for (int p = 0; p < 4; ++p) { \
            _Pragma("unroll") for (int j = 0; j < 4; ++j) { const u32x4 w = R[(RO) + 4 * p + j]; const f32x2 c2v = (f32x2){cv[4 * p + j], cv[4 * p + j]}; \
                acc[0] = __builtin_elementwise_fma(__builtin_amdgcn_cvt_pk_f32_fp8((int)w.x, false), c2v, acc[0]); acc[1] = __builtin_elementwise_fma(__builtin_amdgcn_cvt_pk_f32_fp8((int)w.x, true), c2v, acc[1]); \
                acc[2] = __builtin_elementwise_fma(__builtin_amdgcn_cvt_pk_f32_fp8((int)w.y, false), c2v, acc[2]); acc[3] = __builtin_elementwise_fma(__builtin_amdgcn_cvt_pk_f32_fp8((int)w.y, true), c2v, acc[3]); \
                acc[4] = __builtin_elementwise_fma(__builtin_amdgcn_cvt_pk_f32_fp8((int)w.z, false), c2v, acc[4]); acc[5] = __builtin_elementwise_fma(__builtin_amdgcn_cvt_pk_f32_fp8((int)w.z, true), c2v, acc[5]); \
                acc[6] = __builtin_elementwise_fma(__builtin_amdgcn_cvt_pk_f32_fp8((int)w.w, false), c2v, acc[6]); acc[7] = __builtin_elementwise_fma(__builtin_amdgcn_cvt_pk_f32_fp8((int)w.w, true), c2v, acc[7]); } \
            PEER_GATHER4(R, (RO) + 4 * p, vb8, E, p); } \
        PEER_EIDX16(E, tnext4); \
        const float a[16] = {acc[0].x, acc[0].y, acc[1].x, acc[1].y, acc[2].x, acc[2].y, acc[3].x, acc[3].y, acc[4].x, acc[4].y, acc[5].x, acc[5].y, acc[6].x, acc[6].y, acc[7].x, acc[7].y}; \
        float q8[8]; \
        _Pragma("unroll") for (int k = 0; k < 8; ++k) q8[k] = swap32_add(a[k], a[k + 8]); \
        const float r0 = swap16_add(q8[0], q8[4]), r1 = swap16_add(q8[1], q8[5]), r2 = swap16_add(q8[2], q8[6]), r3 = swap16_add(q8[3], q8[7]); \
        f32x2 o; o.x = xsel_addf_dpp<0x128>(r0, r2, l3); o.y = xsel_addf_dpp<0x128>(r1, r3, l3);               \
        if ((tfirst + 8 * (ti)) <= tlast) *(unsigned*)(yp + (size_t)(tfirst + 8 * (ti)) * D + yoff) = pk2(o.x, o.y); } while (0)
        { const int tn2 = TOKC(i + 2), tn4 = TOKC(i + 4); PEER_V_TOKEN(0, EA, cA, i, tn2, tn4); }
        { const int tn2 = TOKC(i + 3), tn4 = TOKC(i + 5); PEER_V_TOKEN(16, EB, cB, i + 1, tn2, tn4); }
        if (tfirst + 8 * (i + 2) > tlast) break;
    }
#undef PEER_V_TOKEN
#undef PEER_C16
#undef TOKC
}
template <int NT>
__device__ __forceinline__ void peerL_token(size_t t0, size_t tstride, const bf16_t* __restrict__ z, const float* __restrict__ stats, const float* g1, const float* b1, const bf16_t* __restrict__ yp, const float* g2, const float* b2, float* __restrict__ out) {
    const int lane = threadIdx.x & 63;
    u32x4 zw[NT][2], yw[NT][2]; float mean1[NT], rstd1[NT];
#pragma unroll
    for (int k = 0; k < NT; ++k) { const size_t t = t0 + k * tstride;
#pragma unroll
        for (int hlf = 0; hlf < 2; ++hlf) { const int c = 16 * lane + 8 * hlf; zw[k][hlf] = *(const u32x4*)(z + t * D + c); yw[k][hlf] = *(const u32x4*)(yp + t * D + c); }
        const float mu = stats[t * 2] * (1.f / D), var = stats[t * 2 + 1] * (1.f / D) - mu * mu; mean1[k] = mu; rstd1[k] = rsqrtf(var + LN_EPS); }
#pragma unroll
    for (int k = 0; k < NT; ++k) { const size_t t = t0 + k * tstride;
        float y[16]; float s = 0.f;
#pragma unroll
        for (int hlf = 0; hlf < 2; ++hlf) { const int c = 16 * lane + 8 * hlf; const u32x4 zq = zw[k][hlf], yq = yw[k][hlf];
            const float zz[8] = {bflo(zq.x), bfhi(zq.x), bflo(zq.y), bfhi(zq.y), bflo(zq.z), bfhi(zq.z), bflo(zq.w), bfhi(zq.w)}, yy[8] = {bflo(yq.x), bfhi(yq.x), bflo(yq.y), bfhi(yq.y), bflo(yq.z), bfhi(yq.z), bflo(yq.w), bfhi(yq.w)};
            const f32x4 ga = *(const f32x4*)(g1 + c), gb = *(const f32x4*)(g1 + c + 4), ba = *(const f32x4*)(b1 + c), bb = *(const f32x4*)(b1 + c + 4);
#pragma unroll
            for (int j = 0; j < 8; ++j) { const float gg = j < 4 ? ga[j & 3] : gb[j & 3], bq = j < 4 ? ba[j & 3] : bb[j & 3]; const float v = ALPHA * ((zz[j] - mean1[k]) * rstd1[k] * gg + bq) + yy[j]; y[8 * hlf + j] = v; s += v; } }
        const float mean2 = wave_sum(s) * (1.f / D); float ss = 0.f;
#pragma unroll
        for (int i = 0; i < 16; ++i) { const float dlt = y[i] - mean2; ss += dlt * dlt; }
        const float rstd2 = rsqrtf(wave_sum(ss) * (1.f / D) + LN_EPS);
#pragma unroll
        for (int q = 0; q < 4; ++q) { const int c = 16 * lane + 4 * q; const f32x4 gg = *(const f32x4*)(g2 + c), bb = *(const f32x4*)(b2 + c); f32x4 o;
#pragma unroll
            for (int j = 0; j < 4; ++j) o[j] = (y[4 * q + j] - mean2) * rstd2 * gg[j] + bb[j];
            *(f32x4*)(out + t * D + c) = o; } }
}

constexpr int NTHREADS = 512, NWAVES = 8;
constexpr int LDS_BYTES = 147456;
constexpr int LDS_MISC = 131072;
constexpr int LDS_XB = LDS_BYTES - 16;
constexpr size_t CTL_ZERO_BYTES = 16384;

struct Params {
    const float *x, *mem, *relb, *w_in, *b_gate, *w_memkv, *sinks, *w_a, *w_b, *w_c, *w_out, *ln1g, *ln1b, *w_q, *subk, *pu, *pv, *ln2g, *ln2b;
    float* out; char* ws; int lo, hi;
};

__device__ __forceinline__ void g_cvt(const float* __restrict__ src, bf16_t* __restrict__ dst, size_t n8) {
    for (size_t i = (size_t)blockIdx.x * NTHREADS + threadIdx.x; i < n8; i += (size_t)gridDim.x * NTHREADS) {
        const f32x4 a = ((const f32x4*)src)[2 * i], b = ((const f32x4*)src)[2 * i + 1];
        u32x4 w; w.x = pk2(a[0], a[1]); w.y = pk2(a[2], a[3]); w.z = pk2(b[0], b[1]); w.w = pk2(b[2], b[3]);
        ((u32x4*)dst)[i] = w; }
}


__device__ __forceinline__ void g_cvt8(const float* __restrict__ src, unsigned char* __restrict__ dst, size_t n16, float sc) {
    for (size_t i = (size_t)blockIdx.x * NTHREADS + threadIdx.x; i < n16; i += (size_t)gridDim.x * NTHREADS) {
        const f32x4 a = ((const f32x4*)src)[4 * i], b = ((const f32x4*)src)[4 * i + 1], c = ((const f32x4*)src)[4 * i + 2], d = ((const f32x4*)src)[4 * i + 3];
        u32x4 w; int t;
        t = 0; t = __builtin_amdgcn_cvt_pk_fp8_f32(a[0] * sc, a[1] * sc, t, false); t = __builtin_amdgcn_cvt_pk_fp8_f32(a[2] * sc, a[3] * sc, t, true); w.x = (unsigned)t;
        t = 0; t = __builtin_amdgcn_cvt_pk_fp8_f32(b[0] * sc, b[1] * sc, t, false); t = __builtin_amdgcn_cvt_pk_fp8_f32(b[2] * sc, b[3] * sc, t, true); w.y = (unsigned)t;
        t = 0; t = __builtin_amdgcn_cvt_pk_fp8_f32(c[0] * sc, c[1] * sc, t, false); t = __builtin_amdgcn_cvt_pk_fp8_f32(c[2] * sc, c[3] * sc, t, true); w.z = (unsigned)t;
        t = 0; t = __builtin_amdgcn_cvt_pk_fp8_f32(d[0] * sc, d[1] * sc, t, false); t = __builtin_amdgcn_cvt_pk_fp8_f32(d[2] * sc, d[3] * sc, t, true); w.w = (unsigned)t;
        ((u32x4*)dst)[i] = w; }
}

template <bool FP8>
__device__ __forceinline__ void transpose_tile_wave(const float* __restrict__ src, int K, int N, void* __restrict__ dstv, int tn, int tk, LAS float* tile, float sc) {
    const int lane = threadIdx.x & 63, n0 = tn * 64, k0 = tk * 64, rq = lane >> 4, c4 = (lane & 15) * 4;
    f32x4 v[16];
#pragma unroll
    for (int i = 0; i < 16; ++i) v[i] = *(const f32x4*)(src + (size_t)(k0 + 4 * i + rq) * N + n0 + c4);
#pragma unroll
    for (int i = 0; i < 16; ++i) *(LAS f32x4*)(tile + (4 * i + rq) * 68 + c4) = v[i];
    asm volatile("s_waitcnt lgkmcnt(0)" ::: "memory");
    float y[64];
#pragma unroll
    for (int k = 0; k < 64; ++k) y[k] = tile[k * 68 + lane];
    if constexpr (FP8) { unsigned char* dst = (unsigned char*)dstv + (size_t)(n0 + lane) * K + k0;
#pragma unroll
        for (int q = 0; q < 4; ++q) { u32x4 w; int t;
#pragma unroll
            for (int d = 0; d < 4; ++d) { t = 0; t = __builtin_amdgcn_cvt_pk_fp8_f32(y[16 * q + 4 * d] * sc, y[16 * q + 4 * d + 1] * sc, t, false); t = __builtin_amdgcn_cvt_pk_fp8_f32(y[16 * q + 4 * d + 2] * sc, y[16 * q + 4 * d + 3] * sc, t, true); w[d] = (unsigned)t; }
            *(u32x4*)(dst + 16 * q) = w; } }
    else { bf16_t* dst = (bf16_t*)dstv + (size_t)(n0 + lane) * K + k0;
#pragma unroll
        for (int q = 0; q < 8; ++q) { u32x4 w; w.x = pk2(y[8 * q], y[8 * q + 1]); w.y = pk2(y[8 * q + 2], y[8 * q + 3]); w.z = pk2(y[8 * q + 4], y[8 * q + 5]); w.w = pk2(y[8 * q + 6], y[8 * q + 7]); *(u32x4*)(dst + 8 * q) = w; } }
    asm volatile("s_waitcnt lgkmcnt(0)" ::: "memory");
}
#define W_ws (p.ws)
#define W_dout ((char*)p.out)
#define W_wmemkv_t ((bf16_t*)(W_ws + WS_WMEMKV))
#define W_wA_t ((bf16_t*)(W_ws + WS_WA))
#define W_wB_t ((bf16_t*)(W_ws + WS_WB))
#define W_wC_t ((bf16_t*)(W_ws + WS_WC))
#define W_wout_t ((bf16_t*)(W_ws + WS_WOUT))
#define W_wq_t ((bf16_t*)(W_ws + WS_WQ))
#define W_subkb ((bf16_t*)(W_ws + WS_SUBK))
#define W_memb ((bf16_t*)(W_ws + WS_MEMB))
#define W_kvm ((bf16_t*)(W_ws + WS_KVM))
#define W_stats ((float*)(W_ws + WS_STATS))
#define W_lseA ((float*)(W_ws + WS_LSE))
#define W_hq ((bf16_t*)(W_ws + WS_HQ))
#define W_gates ((bf16_t*)(W_ws + WS_GATES))
#define W_xb ((bf16_t*)(W_ws + WS_XB))
#define W_mf ((float*)(W_ws + WS_MF))
#define W_mb ((bf16_t*)(W_ws + WS_MB))
#define W_z ((bf16_t*)(W_ws + WS_Z))
#define W_x1b ((bf16_t*)(W_ws + WS_X1B))
#define W_qb ((bf16_t*)(W_ws + WS_Q))
#define W_eidx ((unsigned short*)(W_ws + WS_EIDX))
#define W_gate ((float*)(W_ws + WS_GATE))
#define W_ub8 ((unsigned char*)(W_ws + WS_UB))
#define W_vb8 ((unsigned char*)(W_ws + WS_UB + 16 * MiB))
#define W_usc ((float*)(W_ws + WS_UB + 32 * MiB))
#define W_vsc (W_usc + NEXP)
#define W_w_in_t ((bf16_t*)(W_dout + DO_WINT))
#define W_oA ((bf16_t*)(W_dout + DO_OA))
#define W_yb ((bf16_t*)(W_dout + DO_YB))
#define W_yc ((bf16_t*)(W_dout + DO_YC))
#define W_ya ((bf16_t*)(W_dout + DO_YA))
#define W_x8 ((unsigned char*)W_dout)
#define W_hp ((bf16_t*)(W_ws + 120 * MiB))
#define W_cbuf ((bf16_t*)(W_ws + 24 * MiB))
#define W_yp W_hp
__global__ void __launch_bounds__(NTHREADS, 2) mk_fwd(Params p) {
    extern __shared__ __attribute__((aligned(16))) unsigned char lds[];
#define LAUNDER_TID int tid = threadIdx.x; asm volatile("" : "+v"(tid)); const int wave = tid >> 6; const int gw = blockIdx.x * NWAVES + wave, nw = gridDim.x * NWAVES; (void)wave; (void)gw; (void)nw;
    if (threadIdx.x == 0) *(uint4*)(lds + LDS_XB) = make_uint4(0u, 0u, 0u, 0u);
    __syncthreads();
    XcdBarrier bar = xcd_barrier_post((unsigned*)(W_ws + WS_CTL), (volatile LAS unsigned*)(lds + LDS_XB));
#define PH(k) (p.lo <= (k) && (k) < p.hi)
#define SEAM(k) do { if (PH(k) && PH((k) + 1)) xcd_barrier(bar); } while (0)

    if (PH(0)) { LAUNDER_TID
        g_cvt8(p.x, (unsigned char*)W_xb, (size_t)T * D / 16, 1.0f);
        g_cvt(p.mem, W_memb, (size_t)BATCH * MEMLEN * D / 8);
        g_cvt(p.subk, W_subkb, (size_t)8 * 2 * 128 * 64 / 8);
        for (size_t i = (size_t)blockIdx.x * NTHREADS + tid; i < (size_t)T * 2; i += (size_t)gridDim.x * NTHREADS) W_stats[i] = 0.f;
        LAS float* tile = (LAS float*)((LAS unsigned char*)lds + wave * (64 * 68 * 4));
        for (int u = gw; u < 2752; u += nw) {
            if (u < 1664) transpose_tile_wave<true>(p.w_in, D, INW, W_w_in_t, u % 104, u / 104, tile, 32.0f);
            else if (u < 1920) { const int v = u - 1664; transpose_tile_wave<false>(p.w_memkv, D, 1024, W_wmemkv_t, v & 15, v >> 4, tile, 1.f); }
            else if (u < 1984) { const int v = u - 1920; transpose_tile_wave<false>(p.w_a, 256, 1024, W_wA_t, v & 15, v >> 4, tile, 1.f); }
            else if (u < 2112) { const int v = u - 1984; transpose_tile_wave<false>(p.w_b, 512, 1024, W_wB_t, v & 15, v >> 4, tile, 1.f); }
            else if (u < 2240) { const int v = u - 2112; transpose_tile_wave<false>(p.w_c, 512, 1024, W_wC_t, v & 15, v >> 4, tile, 1.f); }
            else if (u < 2496) { const int v = u - 2240; transpose_tile_wave<false>(p.w_out, D, 1024, W_wout_t, v & 15, v >> 4, tile, 1.f); }
            else { const int v = u - 2496; transpose_tile_wave<false>(p.w_q, D, 1024, W_wq_t, v & 15, v >> 4, tile, 1.f); }
        }
    }
    SEAM(0);
    if (PH(1)) {
        { pg8::Gemm g; g.A = W_memb; g.Bt = W_wmemkv_t; g.M = BATCH * MEMLEN; g.N = 1024; g.K = D; EpiPlain E; E.O = W_kvm; E.ldc = 1024;
          pg8::StaticOrder S; S.init(g.M, g.N, (int)gridDim.x, (int)blockIdx.x); pg8::gemm_phase<EpiPlain, pg8::StaticOrder, false>((PG8_LAS unsigned char*)lds, g, S, E, nullptr); }
        __syncthreads();
        { pg8::Gemm g; g.A = W_xb; g.Bt = W_w_in_t; g.M = T; g.N = INW; g.K = D / 2; EpiIn E; E.hq = W_hq; E.gates = W_gates; E.bgate = p.b_gate;
          pg8::StaticOrder S; S.init(g.M, g.N, (int)gridDim.x, (int)blockIdx.x); pg8::gemm_phase<EpiIn, pg8::StaticOrder, false, true>((PG8_LAS unsigned char*)lds, g, S, E, nullptr); }
    }
    SEAM(1);
    if (PH(2)) { LAUNDER_TID
        LAS unsigned char* L = (LAS unsigned char*)lds;
        attnAB_phase(L, W_hq, p.relb, p.sinks, W_oA, W_lseA, W_yb);
        for (int u = blockIdx.x; u < 256; u += gridDim.x) attnC_unit(u, L, W_hq, W_kvm, W_yc);
        for (int row = gw; row < NEXP / 2; row += nw) cvt_rows_fp8(p.pu, p.pv, W_ub8, W_vb8, W_usc, W_vsc, row, row + NEXP / 2);
    }
    SEAM(2);
    if (PH(3)) { LAUNDER_TID for (size_t i = (size_t)blockIdx.x * NTHREADS + tid; i < (size_t)T * 32; i += (size_t)gridDim.x * NTHREADS) t_mix(i, W_oA, W_lseA, W_ya); }
    SEAM(3);
    if (PH(4)) {
        pg8::MergeArgs g; g.A[0] = W_ya; g.A[1] = W_yb; g.A[2] = W_yc; g.Bt[0] = W_wA_t; g.Bt[1] = W_wB_t; g.Bt[2] = W_wC_t; g.K[0] = 256; g.K[1] = 512; g.K[2] = 512; g.gates = W_gates; g.mb = W_mb;
        pg8::StaticOrder S; S.init(T, D, (int)gridDim.x, (int)blockIdx.x); pg8::gemm_phase_merge<pg8::StaticOrder>((PG8_LAS unsigned char*)lds, g, S);
    }
    SEAM(4);
    if (PH(5)) {
        pg8::Gemm g; g.A = W_mb; g.Bt = W_wout_t; g.M = T; g.N = D; g.K = D; EpiOut E; E.x = p.x; E.z = W_z; E.stats = W_stats;
        pg8::StaticOrder S; S.init(g.M, g.N, (int)gridDim.x, (int)blockIdx.x); pg8::gemm_phase<EpiOut, pg8::StaticOrder, false>((PG8_LAS unsigned char*)lds, g, S, E, nullptr);
    }
    SEAM(5);
    if (PH(6)) { LAUNDER_TID for (size_t i = (size_t)blockIdx.x * NTHREADS + tid; i < (size_t)T * 128; i += (size_t)gridDim.x * NTHREADS) t_ln1(i, W_z, W_stats, p.ln1g, p.ln1b, W_x1b); }
    SEAM(6);
    if (PH(7)) {
        pg8::Gemm g; g.A = W_x1b; g.Bt = W_wq_t; g.M = T; g.N = D; g.K = D; EpiPlain E; E.O = W_qb; E.ldc = 1024;
        pg8::StaticOrder S; S.init(g.M, g.N, (int)gridDim.x, (int)blockIdx.x); pg8::gemm_phase<EpiPlain, pg8::StaticOrder, false>((PG8_LAS unsigned char*)lds, g, S, E, nullptr);
    }
    SEAM(7);
    if (PH(8)) { for (int u = blockIdx.x; u < (T / 256) * 8; u += gridDim.x) topk_unit(u, (LAS unsigned char*)lds, W_qb, W_subkb, W_eidx, W_gate); }
    SEAM(8);
    if (PH(9)) { const int ngrp = (int)(gridDim.x >> 3), tpc = ((T + ngrp - 1) / ngrp + 7) & ~7, sl_tok0 = (int)(blockIdx.x >> 3) * tpc, sl_tok1 = ((int)(blockIdx.x >> 3) < ngrp) ? (sl_tok0 + tpc < T ? sl_tok0 + tpc : T) : 0; peerU_phase((int)(blockIdx.x & 7), sl_tok0, sl_tok1, W_x1b, W_eidx, W_ub8, W_hp); }
    SEAM(9);
    if (PH(10)) { peerR_phase(W_hp, W_eidx, W_gate, W_usc, W_vsc, W_cbuf); }
    SEAM(10);
    if (PH(11)) { const int ngrp = (int)(gridDim.x >> 3), tpc = ((T + ngrp - 1) / ngrp + 7) & ~7, sl_tok0 = (int)(blockIdx.x >> 3) * tpc, sl_tok1 = ((int)(blockIdx.x >> 3) < ngrp) ? (sl_tok0 + tpc < T ? sl_tok0 + tpc : T) : 0; peerV_phase((int)(blockIdx.x & 7), sl_tok0, sl_tok1, W_cbuf, W_eidx, W_vb8, W_yp); }
    SEAM(11);
#ifdef PROBE_EXP
    if (PH(13)) { const int ngrp = (int)(gridDim.x >> 3), tpc = ((T + ngrp - 1) / ngrp + 7) & ~7, sl_tok0 = (int)(blockIdx.x >> 3) * tpc, sl_tok1 = ((int)(blockIdx.x >> 3) < ngrp) ? (sl_tok0 + tpc < T ? sl_tok0 + tpc : T) : 0;
        const int sl = (PROBE_EXP == 0) ? (int)(blockIdx.x & 7) : (int)((blockIdx.x + (blockIdx.x >> 3)) & 7);
#if PROBE_EXP == 20
        for (int rep = 0; rep < 20; ++rep) xcd_barrier(bar); (void)sl; (void)sl_tok0; (void)sl_tok1; }
#elif PROBE_EXP >= 10
        probe_valu((float*)(W_ws + 24 * MiB)); (void)sl; (void)sl_tok0; (void)sl_tok1; }
#else
        probe_gather(sl, sl_tok0, sl_tok1, W_eidx, W_ub8, (float*)(W_ws + 24 * MiB)); }
#endif
#endif
    if (PH(12)) { LAUNDER_TID int t = gw; for (; t + 3 * nw < T; t += 4 * nw) peerL_token<4>((size_t)t, (size_t)nw, W_z, W_stats, p.ln1g, p.ln1b, W_yp, p.ln2g, p.ln2b, p.out);
        for (; t < T; t += nw) peerL_token<1>((size_t)t, (size_t)nw, W_z, W_stats, p.ln1g, p.ln1b, W_yp, p.ln2g, p.ln2b, p.out); }
}

#ifndef MK_CUTS
#define MK_CUTS 0
#endif
extern "C" void kernel_launch(void* const* d_in, const int* in_sizes, int n_in, void* d_out, int out_size, void* d_ws, size_t ws_size, hipStream_t stream) {
    if (n_in != 19 || in_sizes[0] != T * D || out_size != T * D || ws_size < WS_END) { fprintf(stderr, "kernel_launch: unexpected shapes / workspace (%d inputs, ws %zu)\n", n_in, ws_size); return; }
    static int grid = 0;
    if (!grid) {
        int dev = 0, cus = 0, per_cu = 0;
        if (hipGetDevice(&dev) != hipSuccess || hipDeviceGetAttribute(&cus, hipDeviceAttributeMultiprocessorCount, dev) != hipSuccess) { fprintf(stderr, "kernel_launch: device query failed\n"); return; }
        if (hipFuncSetAttribute((const void*)mk_fwd, hipFuncAttributeMaxDynamicSharedMemorySize, LDS_BYTES) != hipSuccess) { fprintf(stderr, "kernel_launch: hipFuncSetAttribute failed\n"); return; }
        if (hipOccupancyMaxActiveBlocksPerMultiprocessor(&per_cu, (const void*)mk_fwd, NTHREADS, LDS_BYTES) != hipSuccess || per_cu < 1) { fprintf(stderr, "kernel_launch: occupancy query says %d\n", per_cu); return; }
        grid = cus;
    }
    Params p{};
    p.x = (const float*)d_in[0]; p.mem = (const float*)d_in[1]; p.relb = (const float*)d_in[2]; p.w_in = (const float*)d_in[3]; p.b_gate = (const float*)d_in[4]; p.w_memkv = (const float*)d_in[5];
    p.sinks = (const float*)d_in[6]; p.w_a = (const float*)d_in[7]; p.w_b = (const float*)d_in[8]; p.w_c = (const float*)d_in[9]; p.w_out = (const float*)d_in[10]; p.ln1g = (const float*)d_in[11];
    p.ln1b = (const float*)d_in[12]; p.w_q = (const float*)d_in[13]; p.subk = (const float*)d_in[14]; p.pu = (const float*)d_in[15]; p.pv = (const float*)d_in[16]; p.ln2g = (const float*)d_in[17];
    p.ln2b = (const float*)d_in[18]; p.out = (float*)d_out; p.ws = (char*)d_ws;
    if (hipMemsetAsync((char*)d_ws + WS_CTL, 0, CTL_ZERO_BYTES, stream) != hipSuccess) { fprintf(stderr, "kernel_launch: memset failed\n"); return; }
#if MK_CUTS
    for (int k = 0; k < 13; ++k) { p.lo = k; p.hi = k + 1; hipLaunchKernelGGL(mk_fwd, dim3(grid), dim3(NTHREADS), LDS_BYTES, stream, p); }
#else
#ifdef PROBE_SPLITK
    p.lo = 0; p.hi = PROBE_SPLITK + 1; hipLaunchKernelGGL(mk_fwd, dim3(grid), dim3(NTHREADS), LDS_BYTES, stream, p);
#ifndef PROBE_SPLITK_BASE
    (void)hipMemsetAsync((char*)d_ws + WS_CTL, 0, CTL_ZERO_BYTES, stream);
    p.lo = PROBE_SPLITK; p.hi = PROBE_SPLITK + 1; hipLaunchKernelGGL(mk_fwd, dim3(grid), dim3(NTHREADS), LDS_BYTES, stream, p);
#endif
    (void)hipMemsetAsync((char*)d_ws + WS_CTL, 0, CTL_ZERO_BYTES, stream);
    p.lo = PROBE_SPLITK + 1; p.hi = 13; hipLaunchKernelGGL(mk_fwd, dim3(grid), dim3(NTHREADS), LDS_BYTES, stream, p);
#else
    p.lo = 0; p.hi = 13; hipLaunchKernelGGL(mk_fwd, dim3(grid), dim3(NTHREADS), LDS_BYTES, stream, p);
#endif
#endif
#ifdef PROBE_EXP
    (void)hipMemsetAsync((char*)d_ws + WS_CTL, 0, CTL_ZERO_BYTES, stream);
    p.lo = 13; p.hi = 14; hipLaunchKernelGGL(mk_fwd, dim3(grid), dim3(NTHREADS), LDS_BYTES, stream, p);
#endif
#ifdef PROBE_RELAUNCH
    p.lo = PROBE_RELAUNCH; p.hi = PROBE_RELAUNCH + 1; hipLaunchKernelGGL(mk_fwd, dim3(grid), dim3(NTHREADS), LDS_BYTES, stream, p);
#endif
}
```

```cpp
#include <hip/hip_runtime.h>
#include <cstdio>
#include <cstdint>
namespace pg8 {
#define PG8_LAS __attribute__((address_space(3)))
typedef unsigned short bf16_t;
typedef short bf16x8 __attribute__((ext_vector_type(8)));
typedef float f32x4 __attribute__((ext_vector_type(4)));
typedef unsigned u32x4 __attribute__((ext_vector_type(4)));
constexpr int BM = 256, BK = 64, HALF = 128, HTB = HALF * BK * 2  , STAGE_BYTES = 8 * HTB, NXCD = 8, WGM = 8;

__host__ __device__ __forceinline__ int lds_byte(int r, int c) { const int st = (r >> 4) * 2 + (c >> 5), rr = r & 15, cc = c & 31, ob = rr * 64 + cc * 2; return st * 1024 + (ob ^ (((ob >> 9) & 1) << 5)); }
__host__ __device__ __forceinline__ void stage_rc(int b, int& R, int& C) { const int st = b / 1024, sb = b % 1024, swz = sb ^ (((sb >> 9) & 1) << 5); R = (st >> 1) * 16 + swz / 64; C = (st & 1) * 32 + (swz % 64) / 2; }
__host__ __device__ __forceinline__ int perm32(int rho) { const int n = rho >> 4, i = rho & 15; return 8 * (i >> 2) + 4 * n + (i & 3); }

struct Unit { int pm, pn; };
struct Gemm { const bf16_t* A; const bf16_t* Bt; int M, N, K; };

struct StaticOrder {
    int nM, nN, nwg, G, c;
    __host__ __device__ void init(int M, int N, int G_, int c_) { nM = M / BM; nN = N / BM; nwg = nM * nN; G = G_; c = c_; }
    __host__ __device__ bool next(int i, Unit& u) const {
        const long L = (long)i * G + c; if (L >= nwg) return false;
        int wgid = (int)L; { const int q = nwg / NXCD, r = nwg % NXCD, xcd = wgid % NXCD, off = wgid / NXCD; wgid = (xcd < r ? xcd * (q + 1) : r * (q + 1) + (xcd - r) * q) + off; }
        const int nig = WGM * nN, gid = wgid / nig, fm = gid * WGM, gsz = (nM - fm) < WGM ? (nM - fm) : WGM;
        u.pm = fm + ((wgid % nig) % gsz); u.pn = (wgid % nig) / gsz; return true;
    }
    __device__ __forceinline__ void a_ready(const Unit&) const {}
    __device__ __forceinline__ void done(const Unit&) const {}
};
__device__ __forceinline__ unsigned cvt_pk_bf16(float lo, float hi) { unsigned r; asm volatile("v_cvt_pk_bf16_f32 %0, %1, %2" : "=v"(r) : "v"(lo), "v"(hi)); return r; }
typedef float f32x2 __attribute__((ext_vector_type(2)));
__device__ __forceinline__ f32x2 gelu_pk(f32x2 v) {
    const f32x2 av = __builtin_elementwise_abs(v), d = av * 0.2316418882f + 1.0f;
    f32x2 t; t.x = __builtin_amdgcn_rcpf(d.x); t.y = __builtin_amdgcn_rcpf(d.y);
    f32x2 q = t * 0.5307027145f + (-0.7265760135f); q = q * t + 0.7107068705f; q = q * t + (-0.142248368f); q = q * t + 0.127414796f; q = q * t;
    const f32x2 s = (v * v) * (-0.72134752044f);
    f32x2 e; e.x = __builtin_amdgcn_exp2f(s.x); e.y = __builtin_amdgcn_exp2f(s.y);
    const f32x2 m = v * (q * e), r = v - m;
    f32x2 o; o.x = v.x < 0.f ? m.x : r.x; o.y = v.y < 0.f ? m.y : r.y; return o;
}
template <class Epi, class Sched, bool STAMP = false, bool FP8 = false, int XSCALE = 127>
__device__ __forceinline__ void gemm_phase(PG8_LAS unsigned char* lds, const Gemm g, const Sched& S, const Epi& E, unsigned long long* stamps) {
    int tid_l = threadIdx.x; asm volatile("" : "+v"(tid_l));
    const int tid = tid_l, wid = __builtin_amdgcn_readfirstlane(tid >> 6), lane = tid & 63, wr = wid >> 2, wc = wid & 3, fr = lane & 15, fq = lane >> 4;
    const int K = g.K, nt = K / BK;
    int ts_lo = 0, ts_hi = 0, nts = 0; const unsigned long long rt_entry = STAMP ? (unsigned long long)wall_clock64() : 0ull;
#define PG8_STAMP() do { if (STAMP && wid == 0 && nts < 64) { const unsigned long long _c = (unsigned long long)clock64(); \
        ts_lo = (lane == nts) ? (int)(unsigned)_c : ts_lo; ts_hi = (lane == nts) ? (int)(unsigned)(_c >> 32) : ts_hi; ++nts; } } while (0)
    PG8_STAMP();
    unsigned voffA[2], voffB[2];
#pragma unroll
    for (int i = 0; i < 2; ++i) { int R, C; stage_rc(tid * 16 + i * 8192, R, C); const int Rb = Epi::PERM ? ((R & ~31) + perm32(R & 31)) : R;
        voffA[i] = (unsigned)(R * K + C) * 2u; voffB[i] = (unsigned)(Rb * K + C) * 2u; }
    const size_t kstep = (size_t)(BK * 2);
    const size_t hstep = (size_t)HALF * K * 2;
    const size_t tstep = 2 * hstep;
    const unsigned ldsw = (unsigned)wid * 1024u;
    const int aoff = lds_byte(wr * 64 + fr, fq * 8), boff = lds_byte(wc * 32 + fr, fq * 8);
#define PG8_SA(b, h) (((b) * 2 + (h)) * HTB)
#define PG8_SB(b, h) ((4 + (b) * 2 + (h)) * HTB)
#define PG8_STAGE(bufoff, gbase, voff) do { _Pragma("unroll") for (int _i = 0; _i < 2; ++_i) \
        __builtin_amdgcn_global_load_lds((const unsigned*)((const char*)(gbase) + (voff)[_i]), (PG8_LAS unsigned*)(lds + (bufoff) + ldsw + _i * 8192), 16, 0, 0); } while (0)
#define PG8_LDA(dst, b, h) do { if constexpr (FP8) { _Pragma("unroll") for (int m = 0; m < 4; ++m) dst##8[m] = __builtin_shufflevector(*(const PG8_LAS i32x4_*)(lds + PG8_SA(b, h) + aoff + m * 2048), *(const PG8_LAS i32x4_*)(lds + PG8_SA(b, h) + aoff + m * 2048 + 1024), 0, 1, 2, 3, 4, 5, 6, 7); } \
        else { _Pragma("unroll") for (int m = 0; m < 4; ++m) _Pragma("unroll") for (int k = 0; k < 2; ++k) dst[m][k] = *(const PG8_LAS bf16x8*)(lds + PG8_SA(b, h) + aoff + m * 2048 + k * 1024); } } while (0)
#define PG8_LDB(dst, b, h) do { if constexpr (FP8) { _Pragma("unroll") for (int n = 0; n < 2; ++n) dst##8[n] = __builtin_shufflevector(*(const PG8_LAS i32x4_*)(lds + PG8_SB(b, h) + boff + n * 2048), *(const PG8_LAS i32x4_*)(lds + PG8_SB(b, h) + boff + n * 2048 + 1024), 0, 1, 2, 3, 4, 5, 6, 7); } \
        else { _Pragma("unroll") for (int n = 0; n < 2; ++n) _Pragma("unroll") for (int k = 0; k < 2; ++k) dst[n][k] = *(const PG8_LAS bf16x8*)(lds + PG8_SB(b, h) + boff + n * 2048 + k * 1024); } } while (0)
#define PG8_MMA(ai, bj, At, Bt) do { __builtin_amdgcn_s_setprio(1); _Pragma("unroll") for (int m = 0; m < 4; ++m) _Pragma("unroll") for (int n = 0; n < 2; ++n) { \
        if constexpr (FP8) asm volatile("v_mfma_scale_f32_16x16x128_f8f6f4 %0, %1, %2, %0, %3, %4 op_sel_hi:[0,0,0]" : "+v"(acc[ai][bj][m][n]) : "v"(Bt##8[n]), "v"(At##8[m]), "v"(scale_w), "v"(scale_x));        \
        else { _Pragma("unroll") for (int k = 0; k < 2; ++k) acc[ai][bj][m][n] = __builtin_amdgcn_mfma_f32_16x16x32_bf16(Bt[n][k], At[m][k], acc[ai][bj][m][n], 0, 0, 0); } } \
        __builtin_amdgcn_s_setprio(0); } while (0)
#define PG8_WAIT_V(n) asm volatile("s_waitcnt vmcnt(" #n ")" ::: "memory")
#define PG8_WAIT_L(n) asm volatile("s_waitcnt lgkmcnt(" #n ")" ::: "memory")
#define PG8_BAR __builtin_amdgcn_s_barrier()
#define PG8_SCHED __builtin_amdgcn_sched_barrier(0)
    Unit cur, nxt; int ui = 0;
    if (!S.next(0, cur)) return;
    f32x4 acc[2][2][4][2];
#pragma unroll
    for (int a = 0; a < 2; ++a)
#pragma unroll
        for (int b = 0; b < 2; ++b)
#pragma unroll
            for (int m = 0; m < 4; ++m)
#pragma unroll
                for (int n = 0; n < 2; ++n) acc[a][b][m][n] = (f32x4){0.f, 0.f, 0.f, 0.f};
    typedef int i32x4_ __attribute__((ext_vector_type(4))); typedef int i32x8_ __attribute__((ext_vector_type(8)));
    int scale_w = 122, scale_x = XSCALE; asm volatile("" : "+v"(scale_w), "+v"(scale_x));
    bf16x8 At[4][2], B0[2][2], B1[2][2]; i32x8_ At8[4], B08[2], B18[2];
    const char* cA = (const char*)g.A + (size_t)cur.pm * tstep; const char* cB = (const char*)g.Bt + (size_t)cur.pn * tstep;
    S.a_ready(cur);
    PG8_STAGE(PG8_SB(0, 0), cB, voffB); PG8_STAGE(PG8_SA(0, 0), cA, voffA); PG8_STAGE(PG8_SB(0, 1), cB + hstep, voffB); PG8_STAGE(PG8_SA(0, 1), cA + hstep, voffA);
    if (wr == 1) PG8_BAR;
    PG8_WAIT_V(4); PG8_BAR;
    PG8_STAGE(PG8_SB(1, 0), cB + kstep, voffB); PG8_STAGE(PG8_SA(1, 0), cA + kstep, voffA); PG8_STAGE(PG8_SB(1, 1), cB + hstep + kstep, voffB);
    PG8_WAIT_V(6); PG8_BAR;
    PG8_STAMP();
    for (;;) {
        const bool has_next = S.next(ui + 1, nxt);
        const char* nA = has_next ? (const char*)g.A + (size_t)nxt.pm * tstep : cA; const char* nB = has_next ? (const char*)g.Bt + (size_t)nxt.pn * tstep : cB;
        for (int t = 0; t < nt; t += 2) {
            const bool last = (t == nt - 2);
            const char* a1 = cA + (size_t)(t + 1) * kstep;
            const char* a2 = last ? nA : cA + (size_t)(t + 2) * kstep; const char* b2 = last ? nB : cB + (size_t)(t + 2) * kstep;
            const char* a3 = a2 + kstep; const char* b3 = b2 + kstep;
            if (last && has_next) S.a_ready(nxt);
            PG8_LDB(B0, 0, 0); PG8_SCHED; PG8_LDA(At, 0, 0); PG8_STAGE(PG8_SA(1, 1), a1 + hstep, voffA);
            PG8_WAIT_L(8); PG8_BAR; PG8_WAIT_L(0); PG8_MMA(0, 0, At, B0); PG8_BAR; PG8_SCHED;
            PG8_LDB(B1, 0, 1); PG8_STAGE(PG8_SB(0, 0), b2, voffB);
            PG8_BAR; PG8_WAIT_L(0); PG8_MMA(0, 1, At, B1); PG8_BAR;
            PG8_LDA(At, 0, 1); PG8_STAGE(PG8_SA(0, 0), a2, voffA);
            PG8_BAR; PG8_WAIT_L(0); PG8_MMA(1, 0, At, B0); PG8_BAR; PG8_SCHED;
            PG8_STAGE(PG8_SB(0, 1), b2 + hstep, voffB);
            PG8_WAIT_V(6); PG8_BAR; PG8_MMA(1, 1, At, B1); PG8_BAR;
            PG8_LDB(B0, 1, 0); PG8_SCHED; PG8_LDA(At, 1, 0); PG8_STAGE(PG8_SA(0, 1), a2 + hstep, voffA);
            PG8_WAIT_L(8); PG8_BAR; PG8_WAIT_L(0); PG8_MMA(0, 0, At, B0); PG8_BAR; PG8_SCHED;
            PG8_LDB(B1, 1, 1); PG8_STAGE(PG8_SB(1, 0), b3, voffB);
            PG8_BAR; PG8_WAIT_L(0); PG8_MMA(0, 1, At, B1); PG8_BAR;
            PG8_LDA(At, 1, 1); PG8_STAGE(PG8_SA(1, 0), a3, voffA);
            PG8_BAR; PG8_WAIT_L(0); PG8_MMA(1, 0, At, B0); PG8_BAR; PG8_SCHED;
            PG8_STAGE(PG8_SB(1, 1), b3 + hstep, voffB);
            PG8_WAIT_V(6); PG8_BAR; PG8_MMA(1, 1, At, B1); PG8_BAR;
        }
        PG8_STAMP();
        if constexpr (FP8) { asm volatile("s_nop 15\n\ts_nop 15" ::: "memory");
#pragma unroll
            for (int a = 0; a < 2; ++a)
#pragma unroll
                for (int b = 0; b < 2; ++b)
#pragma unroll
                    for (int m = 0; m < 4; ++m)
#pragma unroll
                        for (int n = 0; n < 2; ++n) asm volatile("" : "+v"(acc[a][b][m][n])); }
        if constexpr (!Epi::AFTER_DRAIN) { E(acc, cur, wr, wc, fr, fq); S.done(cur); }
        PG8_STAMP();
        if (!has_next) break;
#pragma unroll
        for (int a = 0; a < 2; ++a)
#pragma unroll
            for (int b = 0; b < 2; ++b)
#pragma unroll
                for (int m = 0; m < 4; ++m)
#pragma unroll
                    for (int n = 0; n < 2; ++n) acc[a][b][m][n] = (f32x4){0.f, 0.f, 0.f, 0.f};
        cur = nxt; cA = nA; cB = nB; ++ui;
    }
    PG8_WAIT_V(0);
    if (wr == 0) PG8_BAR;
    PG8_BAR;
    if constexpr (Epi::AFTER_DRAIN) { E.fused(acc, cur, wr, wc, fr, fq, lds, wid, lane); S.done(cur); }
    PG8_STAMP();
    if (STAMP && wid == 0) { stamps[lane] = lane < nts ? (((unsigned long long)(unsigned)ts_hi << 32) | (unsigned)ts_lo) : 0ull;
        if (lane == 62) stamps[62] = rt_entry; if (lane == 63) stamps[63] = (unsigned long long)wall_clock64(); }
#undef PG8_STAMP
#undef PG8_SA
#undef PG8_SB
#undef PG8_STAGE
#undef PG8_LDA
#undef PG8_LDB
#undef PG8_MMA
#undef PG8_WAIT_V
#undef PG8_WAIT_L
#undef PG8_BAR
#undef PG8_SCHED
}
}

namespace pg8 {
struct MergeArgs { const bf16_t* A[3]; const bf16_t* Bt[3]; int K[3]; const bf16_t* gates; unsigned char* mb; };
template <class Sched>
__device__ __forceinline__ void gemm_phase_merge(PG8_LAS unsigned char* lds, const MergeArgs g, const Sched& S) {
    int tid_l = threadIdx.x; asm volatile("" : "+v"(tid_l));
    const int tid = tid_l, wid = __builtin_amdgcn_readfirstlane(tid >> 6), lane = tid & 63, wr = wid >> 2, wc = wid & 3, fr = lane & 15, fq = lane >> 4;
    unsigned R2A[2], R2B[2], C2[2];
#pragma unroll
    for (int i = 0; i < 2; ++i) { int R, C; stage_rc(tid * 16 + i * 8192, R, C); const int Rb = (R & ~31) + perm32(R & 31); R2A[i] = (unsigned)R * 2u; R2B[i] = (unsigned)Rb * 2u; C2[i] = (unsigned)C * 2u; }
    const size_t kstep = (size_t)(BK * 2);
    const unsigned ldsw = (unsigned)wid * 1024u;
    const int aoff = lds_byte(wr * 64 + fr, fq * 8), boff = lds_byte(wc * 32 + fr, fq * 8);
#define PG8_SA(b, h) (((b) * 2 + (h)) * HTB)
#define PG8_SB(b, h) ((4 + (b) * 2 + (h)) * HTB)
#define PG8_STAGEK(bufoff, gbase, R2, KK) do { _Pragma("unroll") for (int _i = 0; _i < 2; ++_i) \
        __builtin_amdgcn_global_load_lds((const unsigned*)((const char*)(gbase) + (R2)[_i] * (unsigned)(KK) + C2[_i]), (PG8_LAS unsigned*)(lds + (bufoff) + ldsw + _i * 8192), 16, 0, 0); } while (0)
#define PG8_LDA(dst, b, h) do { _Pragma("unroll") for (int m = 0; m < 4; ++m) _Pragma("unroll") for (int k = 0; k < 2; ++k) dst[m][k] = *(const PG8_LAS bf16x8*)(lds + PG8_SA(b, h) + aoff + m * 2048 + k * 1024); } while (0)
#define PG8_LDB(dst, b, h) do { _Pragma("unroll") for (int n = 0; n < 2; ++n) _Pragma("unroll") for (int k = 0; k < 2; ++k) dst[n][k] = *(const PG8_LAS bf16x8*)(lds + PG8_SB(b, h) + boff + n * 2048 + k * 1024); } while (0)
#define PG8_MMA(ai, bj, At, Bt) do { __builtin_amdgcn_s_setprio(1); _Pragma("unroll") for (int m = 0; m < 4; ++m) _Pragma("unroll") for (int n = 0; n < 2; ++n) _Pragma("unroll") for (int k = 0; k < 2; ++k) \
        acc[ai][bj][m][n] = __builtin_amdgcn_mfma_f32_16x16x32_bf16(Bt[n][k], At[m][k], acc[ai][bj][m][n], 0, 0, 0); __builtin_amdgcn_s_setprio(0); } while (0)
#define PG8_WAIT_V(n) asm volatile("s_waitcnt vmcnt(" #n ")" ::: "memory")
#define PG8_WAIT_L(n) asm volatile("s_waitcnt lgkmcnt(" #n ")" ::: "memory")
#define PG8_BAR __builtin_amdgcn_s_barrier()
#define PG8_SCHED __builtin_amdgcn_sched_barrier(0)
    Unit cur, nxt; int ui = 0, seg = 0;
    if (!S.next(0, cur)) return;
    f32x4 acc[2][2][4][2];
#pragma unroll
    for (int a = 0; a < 2; ++a)
#pragma unroll
        for (int b = 0; b < 2; ++b)
#pragma unroll
            for (int m = 0; m < 4; ++m)
#pragma unroll
                for (int n = 0; n < 2; ++n) acc[a][b][m][n] = (f32x4){0.f, 0.f, 0.f, 0.f};
    bf16x8 At[4][2], B0[2][2], B1[2][2];
    int Kc = g.K[0];
    const char* cA = (const char*)g.A[0] + (size_t)cur.pm * 512 * Kc; const char* cB = (const char*)g.Bt[0] + (size_t)cur.pn * 512 * Kc;
    {   const size_t hs = (size_t)256 * Kc;
        PG8_STAGEK(PG8_SB(0, 0), cB, R2B, Kc); PG8_STAGEK(PG8_SA(0, 0), cA, R2A, Kc); PG8_STAGEK(PG8_SB(0, 1), cB + hs, R2B, Kc); PG8_STAGEK(PG8_SA(0, 1), cA + hs, R2A, Kc);
        if (wr == 1) PG8_BAR;
        PG8_WAIT_V(4); PG8_BAR;
        PG8_STAGEK(PG8_SB(1, 0), cB + kstep, R2B, Kc); PG8_STAGEK(PG8_SA(1, 0), cA + kstep, R2A, Kc); PG8_STAGEK(PG8_SB(1, 1), cB + hs + kstep, R2B, Kc);
        PG8_WAIT_V(6); PG8_BAR; }
    for (;;) {
        bool has_next_tile = false; int nseg = seg + 1; Unit nu = cur;
        if (nseg == 3) { nseg = 0; has_next_tile = S.next(ui + 1, nxt); nu = nxt; }
        const bool more = (seg < 2) || has_next_tile;
        const int Kn = more ? (nseg == 0 ? g.K[0] : (nseg == 1 ? g.K[1] : g.K[2])) : Kc;
        const bf16_t* gA = nseg == 0 ? g.A[0] : (nseg == 1 ? g.A[1] : g.A[2]); const bf16_t* gB = nseg == 0 ? g.Bt[0] : (nseg == 1 ? g.Bt[1] : g.Bt[2]);
        const char* nA = more ? (const char*)gA + (size_t)nu.pm * 512 * Kn : cA; const char* nB = more ? (const char*)gB + (size_t)nu.pn * 512 * Kn : cB;
        const int nt = Kc / BK; const size_t hsc = (size_t)256 * Kc, hsn = (size_t)256 * Kn;
        for (int t = 0; t < nt; t += 2) {
            const bool last = (t == nt - 2);
            const char* a1 = cA + (size_t)(t + 1) * kstep;
            const char* a2 = last ? nA : cA + (size_t)(t + 2) * kstep; const char* b2 = last ? nB : cB + (size_t)(t + 2) * kstep;
            const char* a3 = a2 + kstep; const char* b3 = b2 + kstep;
            const int K2 = last ? Kn : Kc; const size_t hs2 = last ? hsn : hsc;
            PG8_LDB(B0, 0, 0); PG8_SCHED; PG8_LDA(At, 0, 0); PG8_STAGEK(PG8_SA(1, 1), a1 + hsc, R2A, Kc);
            PG8_WAIT_L(8); PG8_BAR; PG8_WAIT_L(0); PG8_MMA(0, 0, At, B0); PG8_BAR; PG8_SCHED;
            PG8_LDB(B1, 0, 1); PG8_STAGEK(PG8_SB(0, 0), b2, R2B, K2);
            PG8_BAR; PG8_WAIT_L(0); PG8_MMA(0, 1, At, B1); PG8_BAR;
            PG8_LDA(At, 0, 1); PG8_STAGEK(PG8_SA(0, 0), a2, R2A, K2);
            PG8_BAR; PG8_WAIT_L(0); PG8_MMA(1, 0, At, B0); PG8_BAR; PG8_SCHED;
            PG8_STAGEK(PG8_SB(0, 1), b2 + hs2, R2B, K2);
            PG8_WAIT_V(6); PG8_BAR; PG8_MMA(1, 1, At, B1); PG8_BAR;
            PG8_LDB(B0, 1, 0); PG8_SCHED; PG8_LDA(At, 1, 0); PG8_STAGEK(PG8_SA(0, 1), a2 + hs2, R2A, K2);
            PG8_WAIT_L(8); PG8_BAR; PG8_WAIT_L(0); PG8_MMA(0, 0, At, B0); PG8_BAR; PG8_SCHED;
            PG8_LDB(B1, 1, 1); PG8_STAGEK(PG8_SB(1, 0), b3, R2B, K2);
            PG8_BAR; PG8_WAIT_L(0); PG8_MMA(0, 1, At, B1); PG8_BAR;
            PG8_LDA(At, 1, 1); PG8_STAGEK(PG8_SA(1, 0), a3, R2A, K2);
            PG8_BAR; PG8_WAIT_L(0); PG8_MMA(1, 0, At, B0); PG8_BAR; PG8_SCHED;
            PG8_STAGEK(PG8_SB(1, 1), b3 + hs2, R2B, K2);
            PG8_WAIT_V(6); PG8_BAR; PG8_MMA(1, 1, At, B1); PG8_BAR;
        }
        {   const int row0 = cur.pm * 256 + wr * 64 + fr, col0 = cur.pn * 256 + wc * 32 + 8 * fq;
            const bf16_t* gb_s = g.gates + ((size_t)(seg * 128 + cur.pm) * 4 + cur.pn) * 65536 + (size_t)tid * 8;
            const bf16_t* gb_n = gb_s + (size_t)128 * 4 * 65536;
            u32x4 GS[2][4], GN[2][4];
#define MRG_LOAD(buf, bt) do { _Pragma("unroll") for (int c = 0; c < 4; ++c) { GS[buf][c] = *(const u32x4*)(gb_s + (size_t)(((bt) * 4 + c) * 512) * 8); \
                GN[buf][c] = (seg < 2) ? *(const u32x4*)(gb_n + (size_t)(((bt) * 4 + c) * 512) * 8) : (u32x4){0x3f803f80u, 0x3f803f80u, 0x3f803f80u, 0x3f803f80u}; } } while (0)
#define MRG_APPLY(buf, bt) do { _Pragma("unroll") for (int c = 0; c < 4; ++c) { const int idx = (bt) * 4 + c, ai = idx >> 3, m = (idx >> 1) & 3, bj = idx & 1; \
                const u32x4 gs = GS[buf][c], gn = GN[buf][c]; \
                float f[8] = {__uint_as_float(gs.x << 16), __uint_as_float(gs.x & 0xffff0000u), __uint_as_float(gs.y << 16), __uint_as_float(gs.y & 0xffff0000u), \
                              __uint_as_float(gs.z << 16), __uint_as_float(gs.z & 0xffff0000u), __uint_as_float(gs.w << 16), __uint_as_float(gs.w & 0xffff0000u)}; \
                const float d[8] = {__uint_as_float(gn.x << 16), __uint_as_float(gn.x & 0xffff0000u), __uint_as_float(gn.y << 16), __uint_as_float(gn.y & 0xffff0000u), \
                                    __uint_as_float(gn.z << 16), __uint_as_float(gn.z & 0xffff0000u), __uint_as_float(gn.w << 16), __uint_as_float(gn.w & 0xffff0000u)}; \
                _Pragma("unroll") for (int j = 0; j < 8; ++j) f[j] = f[j] * __builtin_amdgcn_rcpf(fmaxf(d[j], 1e-20f)); \
                f32x4 v0 = acc[ai][bj][m][0], v1 = acc[ai][bj][m][1]; \
                v0[0] *= f[0]; v0[1] *= f[1]; v0[2] *= f[2]; v0[3] *= f[3]; v1[0] *= f[4]; v1[1] *= f[5]; v1[2] *= f[6]; v1[3] *= f[7]; \
                if (seg < 2) { acc[ai][bj][m][0] = v0; acc[ai][bj][m][1] = v1; } \
                else { typedef unsigned u32x2_ __attribute__((ext_vector_type(2))); u32x2_ w; int t8 = 0; t8 = __builtin_amdgcn_cvt_pk_fp8_f32(v0[0] * 16.f, v0[1] * 16.f, t8, false); t8 = __builtin_amdgcn_cvt_pk_fp8_f32(v0[2] * 16.f, v0[3] * 16.f, t8, true); w.x = (unsigned)t8; \
                    t8 = 0; t8 = __builtin_amdgcn_cvt_pk_fp8_f32(v1[0] * 16.f, v1[1] * 16.f, t8, false); t8 = __builtin_amdgcn_cvt_pk_fp8_f32(v1[2] * 16.f, v1[3] * 16.f, t8, true); w.y = (unsigned)t8; \
                    *(u32x2_*)(g.mb + (size_t)(row0 + ai * 128 + m * 16) * 1024 + col0 + bj * 128) = w;        \
                    acc[ai][bj][m][0] = (f32x4){0.f, 0.f, 0.f, 0.f}; acc[ai][bj][m][1] = (f32x4){0.f, 0.f, 0.f, 0.f}; } } } while (0)
            MRG_LOAD(0, 0);
#pragma unroll
            for (int bt = 0; bt < 4; bt += 2) {
                MRG_LOAD(1, bt + 1); asm volatile("" ::: "memory"); MRG_APPLY(0, bt);
                if (bt + 2 < 4) { MRG_LOAD(0, bt + 2); } asm volatile("" ::: "memory"); MRG_APPLY(1, bt + 1); }
#undef MRG_LOAD
#undef MRG_APPLY
        }
        if (!more) break;
        if (nseg == 0) { cur = nxt; ++ui; }
        seg = nseg; Kc = Kn; cA = nA; cB = nB;
    }
    PG8_WAIT_V(0);
    if (wr == 0) PG8_BAR;
    PG8_BAR;
#undef PG8_SA
#undef PG8_SB
#undef PG8_STAGEK
#undef PG8_LDA
#undef PG8_LDB
#undef PG8_MMA
#undef PG8_WAIT_V
#undef PG8_WAIT_L
#undef PG8_BAR
#undef PG8_SCHED
}
}
#define XB_TMO      128
#define XB_XCNT(j)  (256  + 64 * (j))
#define XB_XSUB(j)  (1280 + 64 * (j))
#define XB_XGEN(j)  (2304 + 64 * (j))
#define XB_TOP      3328
#define XB_TOPGEN   3392
#define XCD_BAR_WORDS 3456
#define XB_SPIN_CAP (1u << 18)
#define LAS __attribute__((address_space(3)))

__device__ __forceinline__ unsigned xb_ld(unsigned* p)              { return __hip_atomic_load(p, __ATOMIC_RELAXED, __HIP_MEMORY_SCOPE_AGENT); }
__device__ __forceinline__ unsigned xb_add(unsigned* p, unsigned v) { return __hip_atomic_fetch_add(p, v, __ATOMIC_RELAXED, __HIP_MEMORY_SCOPE_AGENT); }
__device__ __forceinline__ unsigned xb_xcc_id() { return (unsigned)__builtin_amdgcn_s_getreg((3 << 11) | 20) & 0xFu; }
#define XB_SPIN(cond, bar) do { unsigned _sp = 0; while (cond) { __builtin_amdgcn_s_sleep(1); \
    if ((++_sp & 255u) == 0u) { if (xb_ld(&(bar)[XB_TMO])) break; if (_sp > XB_SPIN_CAP) { atomicAdd(&(bar)[XB_TMO], 1u); break; } } } } while (0)

struct XcdBarrier {
    unsigned* bar; unsigned x;
    volatile LAS unsigned* st;
};

__device__ __forceinline__ XcdBarrier xcd_barrier_post(unsigned* bar, volatile LAS unsigned* st) {
    XcdBarrier b; b.bar = bar; b.x = xb_xcc_id(); b.st = st;
    if (threadIdx.x == 0) (void)xb_add(&bar[XB_XCNT(b.x)], 1u);
    return b;
}
__device__ __forceinline__ void xcd_barrier_complete(unsigned* bar, unsigned x, unsigned& nloc, unsigned& nx) {
    const unsigned G = gridDim.x * gridDim.y * gridDim.z;
    unsigned sum, cnt, mine, sp = 0u;
    for (;;) {
        sum = 0u; cnt = 0u; mine = 0u;
#pragma unroll
        for (unsigned j = 0; j < 16; ++j) { const unsigned c = xb_ld(&bar[XB_XCNT(j)]); sum += c; cnt += (c > 0u) ? 1u : 0u; mine = (j == x) ? c : mine; }
        if (sum == G) break;
        __builtin_amdgcn_s_sleep(1);
        if ((++sp & 255u) == 0u) { if (xb_ld(&bar[XB_TMO])) break; if (sp > XB_SPIN_CAP) { atomicAdd(&bar[XB_TMO], 1u); break; } }
    }
    nloc = mine > 0u ? mine : 1u; nx = cnt > 0u ? cnt : 1u;
}

__device__ __forceinline__ void xcd_barrier(const XcdBarrier& b) {
    asm volatile("s_waitcnt vmcnt(0)" ::: "memory");
    __syncthreads();
    if (threadIdx.x == 0) {
        unsigned* bar = b.bar;
        __builtin_amdgcn_s_waitcnt(0);
        unsigned nloc = b.st[0], nx = b.st[1];
        if (nloc == 0u) { xcd_barrier_complete(bar, b.x, nloc, nx); b.st[0] = nloc; b.st[1] = nx; }
        const unsigned old = xb_add(&bar[XB_XSUB(b.x)], 1u);
        const unsigned gen = old / nloc;
        if (old + 1u == (gen + 1u) * nloc) {
            __builtin_amdgcn_fence(__ATOMIC_RELEASE, "agent");
            asm volatile("s_waitcnt vmcnt(0)" ::: "memory");
            const unsigned og = xb_add(&bar[XB_TOP], 1u);
            const unsigned tg = og / nx;
            if (og + 1u == (tg + 1u) * nx) xb_add(&bar[XB_TOPGEN], 1u);
            else XB_SPIN(xb_ld(&bar[XB_TOPGEN]) == tg, bar);
            __builtin_amdgcn_fence(__ATOMIC_ACQUIRE, "agent");
            xb_add(&bar[XB_XGEN(b.x)], 1u);
            asm volatile("s_waitcnt vmcnt(0)" ::: "memory");
        } else {
            XB_SPIN(xb_ld(&bar[XB_XGEN(b.x)]) == gen, bar);
            __builtin_amdgcn_fence(__ATOMIC_ACQUIRE, "agent");
            asm volatile("s_waitcnt vmcnt(0)" ::: "memory");
        }
    }
    __syncthreads();
}


typedef unsigned short bf16_t;
typedef float f32x4 __attribute__((ext_vector_type(4)));
typedef unsigned u32x4 __attribute__((ext_vector_type(4)));
typedef unsigned u32x2 __attribute__((ext_vector_type(2)));
typedef __bf16 bf16x2_t __attribute__((ext_vector_type(2)));
constexpr int D = 1024, BATCH = 8, SEQ = 4096, T = BATCH * SEQ, MEMLEN = 256;
constexpr int HQW = 3584, GW = 3072, INW = 6656, NEXP = 16384;
constexpr int C_AQ = 0, C_AK = 768, C_AV = 1536, C_BQ = 2304, C_BK = 2816, C_BV = 2944, C_CQ = 3072;
constexpr float ALPHA = 1.189207115002721f, LOG2E = 1.4426950408889634f, LN2F = 0.6931471805599453f, LN_EPS = 1e-5f, NEGBIG = -1e30f;
constexpr size_t MiB = 1u << 20;
#ifndef DBG_CHECK
#define DBG_CHECK 0
#endif
#ifndef DBG_DROP
#define DBG_DROP 0
#endif
constexpr size_t WS_CTL = 0, WS_WMEMKV = 1 * MiB, WS_WA = 3 * MiB, WS_WB = WS_WA + MiB / 2, WS_WC = WS_WB + MiB, WS_WOUT = WS_WC + MiB, WS_WQ = WS_WOUT + 2 * MiB,
                 WS_SUBK = WS_WQ + 2 * MiB, WS_MEMB = 10 * MiB, WS_KVM = 14 * MiB, WS_STATS = 18 * MiB, WS_LSE = 19 * MiB;
constexpr size_t WS_RA = 24 * MiB, WS_RB = 248 * MiB, WS_RC = 440 * MiB, WS_END = 504 * MiB;
constexpr size_t WS_HQ = WS_RA, WS_GATES = WS_RB, WS_XB = WS_RC;
constexpr size_t WS_MF = WS_RA, WS_MB = WS_RA + 128 * MiB;
constexpr size_t WS_Z = WS_RB, WS_X1B = WS_RB + 128 * MiB;
constexpr size_t WS_Q = WS_RA, WS_EIDX = WS_RA + 88 * MiB - 24 * MiB, WS_GATE = WS_EIDX + 16 * MiB;
constexpr size_t WS_UB = WS_RC, WS_VB = WS_RC + 32 * MiB;
constexpr size_t DO_WINT = 0;
constexpr size_t DO_OA = 0, DO_YB = 48 * MiB, DO_YC = 80 * MiB, DO_YA = 112 * MiB;

__device__ __forceinline__ size_t hq_off64(int slot, size_t tok) { return ((size_t)slot * T + tok) * 64; }
__device__ __forceinline__ size_t hq_offc(int head, size_t tok) { return (size_t)48 * T * 64 + ((size_t)head * T + tok) * 128; }
__device__ const unsigned char kBucket[3][132] = {
{0,1,2,3,4,5,6,7,8,9,10,11,12,13,14,15,16,16,16,16,16,16,17,17,17,17,17,17,17,17,18,18,18,18,18,18,18,18,18,18,19,19,19,19,19,19,19,19,19,19,19,19,19,19,20,20,20,20,20,20,20,20,20,20,20,20,20,20,20,20,20,20,20,21,21,21,21,21,21,21,21,21,21,21,21,21,21,21,21,21,21,21,21,21,21,21,21,21,21,22,22,22,22,22,22,22,22,22,22,22,22,22,22,22,22,22,22,22,22,22,22,22,22,22,22,22,22,22,22,22,22,22},
{0,4,8,12,16,16,17,17,18,18,19,19,19,19,20,20,20,20,20,21,21,21,21,21,21,22,22,22,22,22,22,22,22,22,23,23,23,23,23,23,23,23,23,23,23,23,24,24,24,24,24,24,24,24,24,24,24,24,24,24,24,24,25,25,25,25,25,25,25,25,25,25,25,25,25,25,25,25,25,25,25,25,25,26,26,26,26,26,26,26,26,26,26,26,26,26,26,26,26,26,26,26,26,26,26,26,26,26,26,26,26,26,26,27,27,27,27,27,27,27,27,27,27,27,27,27,27,27,27,27,27,27},
{0,16,18,19,20,21,21,22,22,23,23,23,24,24,24,24,25,25,25,25,25,26,26,26,26,26,26,26,26,27,27,27,27,27,27,27,27,27,27,28,28,28,28,28,28,28,28,28,28,28,28,28,29,29,29,29,29,29,29,29,29,29,29,29,29,29,29,29,29,29,30,30,30,30,30,30,30,30,30,30,30,30,30,30,30,30,30,30,30,30,30,30,30,30,30,31,31,31,31,31,31,31,31,31,31,31,31,31,31,31,31,31,31,31,31,31,31,31,31,31,31,31,31,31,31,31,31,31,31,31,31,31}};

__device__ __forceinline__ bf16_t f2bf(float x) { unsigned u = __float_as_uint(x); u += 0x7fffu + ((u >> 16) & 1u); return (bf16_t)(u >> 16); }
__device__ __forceinline__ float bf2f(bf16_t h) { return __uint_as_float((unsigned)h << 16); }
__device__ __forceinline__ float bflo(unsigned w) { return __uint_as_float(w << 16); }
__device__ __forceinline__ float bfhi(unsigned w) { return __uint_as_float(w & 0xffff0000u); }
__device__ __forceinline__ unsigned pk2(float lo, float hi) { bf16x2_t v; v.x = (__bf16)lo; v.y = (__bf16)hi; return __builtin_bit_cast(unsigned, v); }
__device__ __forceinline__ float dot2bf(unsigned a, unsigned b, float acc) { return __builtin_amdgcn_fdot2_f32_bf16(__builtin_bit_cast(bf16x2_t, a), __builtin_bit_cast(bf16x2_t, b), acc, false); }
__device__ __forceinline__ float wave_sum(float v) { for (int o = 32; o >= 1; o >>= 1) v += __shfl_xor(v, o, 64); return v; }
__device__ __forceinline__ float wave_max(float v) { for (int o = 32; o >= 1; o >>= 1) v = fmaxf(v, __shfl_xor(v, o, 64)); return v; }

struct EpiIn {
    static constexpr bool PERM = true, AFTER_DRAIN = false;
    bf16_t* hq; bf16_t* gates; const float* bgate;
    __device__ __forceinline__ void operator()(const pg8::f32x4 (&acc)[2][2][4][2], const pg8::Unit& u, int wr, int wc, int fr, int fq) const {
        const int row0 = u.pm * 256 + wr * 64 + fr;
        if (u.pn < 14) {
            const float sc = (u.pn < 3 || u.pn == 9 || u.pn == 10) ? 0.125f * LOG2E : ((u.pn >= 12) ? 0.08838834764831845f * LOG2E : 1.0f);
            const int col0 = u.pn * 256 + wc * 32 + 8 * fq;
#pragma unroll
            for (int ai = 0; ai < 2; ++ai)
#pragma unroll
                for (int m = 0; m < 4; ++m) { const size_t tok = (size_t)(row0 + ai * 128 + m * 16);
#pragma unroll
                    for (int bj = 0; bj < 2; ++bj) { const pg8::f32x4 v0 = acc[ai][bj][m][0] * sc, v1 = acc[ai][bj][m][1] * sc; const int col = col0 + bj * 128;
                        u32x4 w; w.x = pk2(v0[0], v0[1]); w.y = pk2(v0[2], v0[3]); w.z = pk2(v1[0], v1[1]); w.w = pk2(v1[2], v1[3]);
                        bf16_t* dst = (col < 3072) ? hq + hq_off64(col >> 6, tok) + (col & 63) : hq + hq_offc((col - 3072) >> 7, tok) + ((col - 3072) & 127);
                        *(u32x4*)dst = w; } }
        } else {
            const int gi = u.pn - 14, s = gi >> 2, pn = gi & 3, col0 = gi * 256 + wc * 32 + 8 * fq, tid = (wr * 4 + wc) * 64 + fq * 16 + fr;
            bf16_t* blk = gates + ((size_t)(s * 128 + u.pm) * 4 + pn) * 65536 + (size_t)tid * 8;
            pg8::f32x4 bv[2][2];
#pragma unroll
            for (int bj = 0; bj < 2; ++bj)
#pragma unroll
                for (int n = 0; n < 2; ++n) bv[bj][n] = *(const pg8::f32x4*)(bgate + col0 + bj * 128 + 4 * n);
#pragma unroll
            for (int ai = 0; ai < 2; ++ai)
#pragma unroll
                for (int m = 0; m < 4; ++m) {
#pragma unroll
                    for (int bj = 0; bj < 2; ++bj) { pg8::f32x4 v0 = acc[ai][bj][m][0] + bv[bj][0], v1 = acc[ai][bj][m][1] + bv[bj][1];
#pragma unroll
                        for (int j = 0; j < 4; ++j) { v0[j] = __builtin_amdgcn_rcpf(1.0f + __builtin_amdgcn_exp2f(-LOG2E * v0[j])); v1[j] = __builtin_amdgcn_rcpf(1.0f + __builtin_amdgcn_exp2f(-LOG2E * v1[j])); }
                        u32x4 w; w.x = pk2(v0[0], v0[1]); w.y = pk2(v0[2], v0[3]); w.z = pk2(v1[0], v1[1]); w.w = pk2(v1[2], v1[3]);
                        *(u32x4*)(blk + (size_t)(((ai * 4 + m) * 2 + bj) * 512) * 8) = w; } }
        }
    }
};
struct EpiPlain {
    static constexpr bool PERM = true, AFTER_DRAIN = false;
    bf16_t* O; int ldc;
    __device__ __forceinline__ void operator()(const pg8::f32x4 (&acc)[2][2][4][2], const pg8::Unit& u, int wr, int wc, int fr, int fq) const {
        const int row0 = u.pm * 256 + wr * 64 + fr, col0 = u.pn * 256 + wc * 32 + 8 * fq;
#pragma unroll
        for (int ai = 0; ai < 2; ++ai)
#pragma unroll
            for (int m = 0; m < 4; ++m) { bf16_t* rowp = O + (size_t)(row0 + ai * 128 + m * 16) * ldc + col0;
#pragma unroll
                for (int bj = 0; bj < 2; ++bj) { const pg8::f32x4 v0 = acc[ai][bj][m][0], v1 = acc[ai][bj][m][1];
                    u32x4 w; w.x = pk2(v0[0], v0[1]); w.y = pk2(v0[2], v0[3]); w.z = pk2(v1[0], v1[1]); w.w = pk2(v1[2], v1[3]);
                    *(u32x4*)(rowp + bj * 128) = w; } }
    }
};
struct EpiOut {
    static constexpr bool PERM = true, AFTER_DRAIN = false;
    const float* x; bf16_t* z; float* stats;
    __device__ __forceinline__ void operator()(const pg8::f32x4 (&acc)[2][2][4][2], const pg8::Unit& u, int wr, int wc, int fr, int fq) const {
        const int row0 = u.pm * 256 + wr * 64 + fr, col0 = u.pn * 256 + wc * 32 + 8 * fq;
#pragma unroll
        for (int ai = 0; ai < 2; ++ai)
#pragma unroll
            for (int m = 0; m < 4; ++m) { const size_t row = (size_t)(row0 + ai * 128 + m * 16); float s = 0.f, ss = 0.f;
#pragma unroll
                for (int bj = 0; bj < 2; ++bj) { const size_t o = row * D + col0 + bj * 128;
                    pg8::f32x4 v0 = *(const pg8::f32x4*)(x + o) * ALPHA + acc[ai][bj][m][0], v1 = *(const pg8::f32x4*)(x + o + 4) * ALPHA + acc[ai][bj][m][1];
                    { u32x4 w; w.x = pk2(v0[0], v0[1]); w.y = pk2(v0[2], v0[3]); w.z = pk2(v1[0], v1[1]); w.w = pk2(v1[2], v1[3]); *(u32x4*)(z + o) = w; }
#pragma unroll
                    for (int j = 0; j < 4; ++j) { s += v0[j] + v1[j]; ss += v0[j] * v0[j] + v1[j] * v1[j]; } }
                s += __shfl_xor(s, 16, 64); ss += __shfl_xor(ss, 16, 64); s += __shfl_xor(s, 32, 64); ss += __shfl_xor(ss, 32, 64);
                if (fq == 0) { atomicAdd(stats + row * 2, s); atomicAdd(stats + row * 2 + 1, ss); } }
    }
};

__device__ __forceinline__ void t_mix(size_t i, const bf16_t* __restrict__ oA, const float* __restrict__ lseA, bf16_t* __restrict__ ya) {
    const size_t t = i >> 5; const int col = (int)(i & 31) * 8, h = col >> 6; const size_t e = t * 256 + col;
    const float l0 = lseA[((size_t)0 * T + t) * 4 + h], l1 = lseA[((size_t)1 * T + t) * 4 + h], l2 = lseA[((size_t)2 * T + t) * 4 + h];
    const u32x4 a = *(const u32x4*)(oA + e), b = *(const u32x4*)(oA + (size_t)T * 256 + e), c = *(const u32x4*)(oA + (size_t)2 * T * 256 + e);
    const float mx = fmaxf(l0, fmaxf(l1, l2)), e0 = __expf(l0 - mx), e1 = __expf(l1 - mx), e2 = __expf(l2 - mx), inv = 1.f / (e0 + e1 + e2), w0 = e0 * inv, w1 = e1 * inv, w2 = e2 * inv;
    u32x4 o;
    o.x = pk2(w0 * bflo(a.x) + w1 * bflo(b.x) + w2 * bflo(c.x), w0 * bfhi(a.x) + w1 * bfhi(b.x) + w2 * bfhi(c.x)); o.y = pk2(w0 * bflo(a.y) + w1 * bflo(b.y) + w2 * bflo(c.y), w0 * bfhi(a.y) + w1 * bfhi(b.y) + w2 * bfhi(c.y));
    o.z = pk2(w0 * bflo(a.z) + w1 * bflo(b.z) + w2 * bflo(c.z), w0 * bfhi(a.z) + w1 * bfhi(b.z) + w2 * bfhi(c.z)); o.w = pk2(w0 * bflo(a.w) + w1 * bflo(b.w) + w2 * bflo(c.w), w0 * bfhi(a.w) + w1 * bfhi(b.w) + w2 * bfhi(c.w));
    *(u32x4*)(ya + e) = o;
}
template <int NT>
__device__ __forceinline__ void t_res_ln1(size_t t0, size_t tstride, const float* __restrict__ x, const bf16_t* __restrict__ mo, const float* g, const float* b, bf16_t* __restrict__ x1b) {
    const int lane = threadIdx.x & 63, c = 16 * lane;
    f32x4 xv[NT][4]; u32x4 mv[NT][2];
#pragma unroll
    for (int k = 0; k < NT; ++k) { const size_t t = t0 + k * tstride;
#pragma unroll
        for (int q = 0; q < 4; ++q) xv[k][q] = *(const f32x4*)(x + t * D + c + 4 * q);
        mv[k][0] = *(const u32x4*)(mo + t * D + c); mv[k][1] = *(const u32x4*)(mo + t * D + c + 8); }
    f32x4 gg[4], bb[4];
#pragma unroll
    for (int q = 0; q < 4; ++q) { gg[q] = *(const f32x4*)(g + c + 4 * q); bb[q] = *(const f32x4*)(b + c + 4 * q); }
#pragma unroll
    for (int k = 0; k < NT; ++k) { const size_t t = t0 + k * tstride;
        const float mm[16] = {bflo(mv[k][0].x), bfhi(mv[k][0].x), bflo(mv[k][0].y), bfhi(mv[k][0].y), bflo(mv[k][0].z), bfhi(mv[k][0].z), bflo(mv[k][0].w), bfhi(mv[k][0].w),
                              bflo(mv[k][1].x), bfhi(mv[k][1].x), bflo(mv[k][1].y), bfhi(mv[k][1].y), bflo(mv[k][1].z), bfhi(mv[k][1].z), bflo(mv[k][1].w), bfhi(mv[k][1].w)};
        float zz[16]; float s = 0.f;
#pragma unroll
        for (int i = 0; i < 16; ++i) { zz[i] = ALPHA * xv[k][i >> 2][i & 3] + mm[i]; s += zz[i]; }
        const float mean = wave_sum(s) * (1.f / D); float ss = 0.f;
#pragma unroll
        for (int i = 0; i < 16; ++i) { const float d = zz[i] - mean; ss += d * d; }
        const float rstd = rsqrtf(wave_sum(ss) * (1.f / D) + LN_EPS);
        float y[16];
#pragma unroll
        for (int i = 0; i < 16; ++i) y[i] = (zz[i] - mean) * rstd * gg[i >> 2][i & 3] + bb[i >> 2][i & 3];
        u32x4 w0, w1; w0.x = pk2(y[0], y[1]); w0.y = pk2(y[2], y[3]); w0.z = pk2(y[4], y[5]); w0.w = pk2(y[6], y[7]); w1.x = pk2(y[8], y[9]); w1.y = pk2(y[10], y[11]); w1.z = pk2(y[12], y[13]); w1.w = pk2(y[14], y[15]);
        *(u32x4*)(x1b + t * D + c) = w0; *(u32x4*)(x1b + t * D + c + 8) = w1; }
}
typedef float f32x2 __attribute__((ext_vector_type(2)));
__device__ __forceinline__ void cvt_row_fp8_finish(const f32x4 a, const f32x4 b, const f32x4 c, const f32x4 d, unsigned char* __restrict__ dst, float* __restrict__ inv_scale, int row, int lane) {
    float mx = 0.f;
#pragma unroll
    for (int j = 0; j < 4; ++j) mx = fmaxf(mx, fmaxf(fmaxf(fabsf(a[j]), fabsf(b[j])), fmaxf(fabsf(c[j]), fabsf(d[j]))));
    mx = wave_max(mx);
    const unsigned E = (__float_as_uint(mx) >> 23) & 255u;
    const float sc = (E == 0u || E > 250u) ? 1.0f : __uint_as_float((260u - E) << 23), isc = (E == 0u || E > 250u) ? 1.0f : __uint_as_float((E - 6u) << 23);
    u32x4 w; int t;
    t = 0; t = __builtin_amdgcn_cvt_pk_fp8_f32(a[0] * sc, a[1] * sc, t, false); t = __builtin_amdgcn_cvt_pk_fp8_f32(a[2] * sc, a[3] * sc, t, true); w.x = (unsigned)t;
    t = 0; t = __builtin_amdgcn_cvt_pk_fp8_f32(b[0] * sc, b[1] * sc, t, false); t = __builtin_amdgcn_cvt_pk_fp8_f32(b[2] * sc, b[3] * sc, t, true); w.y = (unsigned)t;
    t = 0; t = __builtin_amdgcn_cvt_pk_fp8_f32(c[0] * sc, c[1] * sc, t, false); t = __builtin_amdgcn_cvt_pk_fp8_f32(c[2] * sc, c[3] * sc, t, true); w.z = (unsigned)t;
    t = 0; t = __builtin_amdgcn_cvt_pk_fp8_f32(d[0] * sc, d[1] * sc, t, false); t = __builtin_amdgcn_cvt_pk_fp8_f32(d[2] * sc, d[3] * sc, t, true); w.w = (unsigned)t;
    *(u32x4*)(dst + (size_t)row * D + 16 * lane) = w;
    if (lane == 0) inv_scale[row] = isc;
}
__device__ __forceinline__ void cvt_rows_fp8(const float* __restrict__ pu, const float* __restrict__ pv, unsigned char* __restrict__ ub8, unsigned char* __restrict__ vb8, float* __restrict__ usc, float* __restrict__ vsc, int r0, int r1) {
    const int lane = threadIdx.x & 63;
    const float* s0 = pu + (size_t)r0 * D + 16 * lane; const float* s1 = pv + (size_t)r0 * D + 16 * lane; const float* s2 = pu + (size_t)r1 * D + 16 * lane; const float* s3 = pv + (size_t)r1 * D + 16 * lane;
    f32x4 q[4][4];
#pragma unroll
    for (int j = 0; j < 4; ++j) { q[0][j] = ((const f32x4*)s0)[j]; q[1][j] = ((const f32x4*)s1)[j]; q[2][j] = ((const f32x4*)s2)[j]; q[3][j] = ((const f32x4*)s3)[j]; }
    cvt_row_fp8_finish(q[0][0], q[0][1], q[0][2], q[0][3], ub8, usc, r0, lane); cvt_row_fp8_finish(q[1][0], q[1][1], q[1][2], q[1][3], vb8, vsc, r0, lane);
    cvt_row_fp8_finish(q[2][0], q[2][1], q[2][2], q[2][3], ub8, usc, r1, lane); cvt_row_fp8_finish(q[3][0], q[3][1], q[3][2], q[3][3], vb8, vsc, r1, lane);
}
__device__ __forceinline__ float xsel_add(float keep_lo, float keep_hi, bool hi, int mask) {
    const float send = hi ? keep_lo : keep_hi, keep = hi ? keep_hi : keep_lo; return keep + __shfl_xor(send, mask, 64);
}

typedef short s16x4 __attribute__((ext_vector_type(4)));
constexpr int NTHREADS_ = 512;
#define ATT_M0 (-30000.0f)
__device__ __forceinline__ float red_max_16_32(float x) { typedef unsigned u2_ __attribute__((ext_vector_type(2)));
    u2_ r = __builtin_amdgcn_permlane16_swap(__float_as_uint(x), __float_as_uint(x), false, false); x = fmaxf(__uint_as_float(r.x), __uint_as_float(r.y));
    r = __builtin_amdgcn_permlane32_swap(__float_as_uint(x), __float_as_uint(x), false, false); return fmaxf(__uint_as_float(r.x), __uint_as_float(r.y)); }
__device__ __forceinline__ float red_sum_16_32(float x) { typedef unsigned u2_ __attribute__((ext_vector_type(2)));
    u2_ r = __builtin_amdgcn_permlane16_swap(__float_as_uint(x), __float_as_uint(x), false, false); x = __uint_as_float(r.x) + __uint_as_float(r.y);
    r = __builtin_amdgcn_permlane32_swap(__float_as_uint(x), __float_as_uint(x), false, false); return __uint_as_float(r.x) + __uint_as_float(r.y); }
template <int DH, int PITCH, class MaskF>
__device__ __forceinline__ void attn_step(const pg8::bf16x8 (&qf)[DH / 32], LAS unsigned char* kl, LAS unsigned char* vl, int t0, int t1, const MaskF& mf, float& m, float& l, f32x4 (&oT)[DH / 16]) {
    const int lane = threadIdx.x & 63, r16 = lane & 15, kq = lane >> 4;
    f32x4 s0 = {0.f, 0.f, 0.f, 0.f}, s1 = {0.f, 0.f, 0.f, 0.f};
    LAS unsigned char* ka0 = kl + (16 * t0 + r16) * PITCH + 16 * kq; LAS unsigned char* ka1 = kl + (16 * t1 + r16) * PITCH + 16 * kq;
#pragma unroll
    for (int s = 0; s < DH / 32; ++s) { const pg8::bf16x8 a0 = *(const LAS pg8::bf16x8*)(ka0 + 64 * s), a1 = *(const LAS pg8::bf16x8*)(ka1 + 64 * s);
        s0 = __builtin_amdgcn_mfma_f32_16x16x32_bf16(a0, qf[s], s0, 0, 0, 0); s1 = __builtin_amdgcn_mfma_f32_16x16x32_bf16(a1, qf[s], s1, 0, 0, 0); }
    float mx = -1e30f;
#pragma unroll
    for (int j = 0; j < 4; ++j) { s0[j] = mf(t0, 4 * kq + j, s0[j]); s1[j] = mf(t1, 4 * kq + j, s1[j]); mx = fmaxf(mx, fmaxf(s0[j], s1[j])); }
    mx = red_max_16_32(mx);
    const float mn = fmaxf(m, mx), sc = __builtin_amdgcn_exp2f(m - mn);
    float rs = 0.f;
#pragma unroll
    for (int j = 0; j < 4; ++j) { s0[j] = __builtin_amdgcn_exp2f(s0[j] - mn); s1[j] = __builtin_amdgcn_exp2f(s1[j] - mn); rs += s0[j] + s1[j]; }
    rs = red_sum_16_32(rs);
    l = l * sc + rs; m = mn;
    u32x4 pw; pw.x = pk2(s0[0], s0[1]); pw.y = pk2(s0[2], s0[3]); pw.z = pk2(s1[0], s1[1]); pw.w = pk2(s1[2], s1[3]);
    const pg8::bf16x8 pb = __builtin_bit_cast(pg8::bf16x8, pw);
    const int q = r16 >> 2, p = r16 & 3;
    LAS unsigned char* va0 = vl + (16 * t0 + 4 * kq + q) * PITCH + 8 * p; LAS unsigned char* va1 = vl + (16 * t1 + 4 * kq + q) * PITCH + 8 * p;
#pragma unroll
    for (int dt = 0; dt < DH / 16; ++dt) {
        const s16x4 lo = __builtin_amdgcn_ds_read_tr16_b64_v4i16((LAS s16x4*)(va0 + 32 * dt)), hi = __builtin_amdgcn_ds_read_tr16_b64_v4i16((LAS s16x4*)(va1 + 32 * dt));
        const pg8::bf16x8 va = __builtin_shufflevector(lo, hi, 0, 1, 2, 3, 4, 5, 6, 7);
        oT[dt] = oT[dt] * sc; oT[dt] = __builtin_amdgcn_mfma_f32_16x16x32_bf16(va, pb, oT[dt], 0, 0, 0); }
}
__device__ __forceinline__ void lds_put16(LAS unsigned char* dst, const bf16_t* src) { *(LAS u32x4*)dst = src ? *(const u32x4*)src : (u32x4){0u, 0u, 0u, 0u}; }

constexpr int ATT_KV64 = 272 * 160;
__device__ __forceinline__ void attnA_fetch(int u, int tid, u32x4 (&pfc)[8], float& tabv, const bf16_t* __restrict__ hq, const float* __restrict__ relb) {
    asm volatile("" : "+v"(tid));
    const int h = u & 3, rn = (u >> 2) & 31, b = (u >> 7) & 7, g = u >> 10;
    const int r = (g == 0) ? 1 : (g == 1 ? 4 : 16), nblk = 32 / r, rho = rn / nblk, n = rn % nblk, tb = b * SEQ;
    const bf16_t* kcol = hq + hq_off64(12 + g * 4 + h, 0); const bf16_t* vcol = hq + hq_off64(24 + g * 4 + h, 0);
#pragma unroll
    for (int i = 0; i < 8; ++i) { const int idx = tid + NTHREADS_ * i, isv = idx >> 11, i2 = idx & 2047, row = i2 >> 3, ch = i2 & 7, pos = (n - 1) * 128 + row;
        pfc[i] = (pos >= 0) ? *(const u32x4*)((isv ? vcol : kcol) + (size_t)(tb + rho + r * pos) * 64 + ch * 8) : (u32x4){0u, 0u, 0u, 0u}; }
    tabv = (tid < 129) ? relb[kBucket[g][tid] * 20 + g * 4 + h] * LOG2E : 0.f;
}
__device__ __forceinline__ void attnAB_store(int tid, const u32x4 (&pfc)[8], float tabv, LAS unsigned char* lds, int ntab) {
    asm volatile("" : "+v"(tid));
    LAS unsigned char* kl = lds; LAS unsigned char* vl = lds + ATT_KV64; LAS float* tab = (LAS float*)(lds + 2 * ATT_KV64);
#pragma unroll
    for (int i = 0; i < 8; ++i) { const int idx = tid + NTHREADS_ * i, isv = idx >> 11, i2 = idx & 2047, row = i2 >> 3, ch = i2 & 7; *(LAS u32x4*)((isv ? vl : kl) + row * 160 + ch * 16) = pfc[i]; }
    if (tid < 320) { const int isv = tid >= 160, i2 = isv ? tid - 160 : tid; *(LAS u32x4*)((isv ? vl : kl) + 256 * 160 + i2 * 16) = (u32x4){0u, 0u, 0u, 0u}; }
    if (tid < ntab) tab[tid] = tabv;
}
__device__ __forceinline__ void attnA_compute(int u, int tid, LAS unsigned char* lds, const bf16_t* __restrict__ hq, bf16_t* __restrict__ oA, float* __restrict__ lseA) {
    asm volatile("" : "+v"(tid));
    const int h = u & 3, rn = (u >> 2) & 31, b = (u >> 7) & 7, g = u >> 10;
    const int r = (g == 0) ? 1 : (g == 1 ? 4 : 16), nblk = 32 / r, rho = rn / nblk, n = rn % nblk, tb = b * SEQ;
    LAS unsigned char* kl = lds; LAS unsigned char* vl = lds + ATT_KV64; LAS float* tab = (LAS float*)(lds + 2 * ATT_KV64);
    const int w = tid >> 6, lane = tid & 63, r16 = lane & 15, kq = lane >> 4, qi = 16 * w + r16, kmin = (n == 0) ? 128 : 0;
    const size_t tq = (size_t)(tb + rho + r * (n * 128 + qi));
    pg8::bf16x8 qf[2];
#pragma unroll
    for (int s = 0; s < 2; ++s) qf[s] = *(const pg8::bf16x8*)(hq + hq_off64(g * 4 + h, tq) + 32 * s + 8 * kq);
    float m = ATT_M0, l = 0.f; f32x4 oT[4];
#pragma unroll
    for (int dt = 0; dt < 4; ++dt) oT[dt] = (f32x4){0.f, 0.f, 0.f, 0.f};
    auto mf = [&](int tile, int kr, float s) -> float { const int kk = 16 * tile + kr, off = qi + 128 - kk; const bool ok = (off >= 0) && (off <= 128) && (kk >= kmin);
        const int oc = off < 0 ? 0 : (off > 128 ? 128 : off); return ok ? s + tab[oc] : -1e30f; };
    auto mfi = [&](int tile, int kr, float s) -> float { return s + tab[qi + 128 - 16 * tile - kr]; };
    attn_step<64, 160>(qf, kl, vl, w, w + 1, mf, m, l, oT);
    if (n != 0) { for (int st = 1; st < 4; ++st) attn_step<64, 160>(qf, kl, vl, w + 2 * st, w + 2 * st + 1, mfi, m, l, oT); }
    else { for (int st = 1; st < 4; ++st) attn_step<64, 160>(qf, kl, vl, w + 2 * st, w + 2 * st + 1, mf, m, l, oT); }
    attn_step<64, 160>(qf, kl, vl, w + 8, w + 9, mf, m, l, oT);
    const float inv = 1.0f / l;
    bf16_t* op = oA + ((size_t)g * T + tq) * 256 + h * 64 + 4 * kq;
#pragma unroll
    for (int dt = 0; dt < 4; ++dt) { u32x2 wv; wv.x = pk2(oT[dt][0] * inv, oT[dt][1] * inv); wv.y = pk2(oT[dt][2] * inv, oT[dt][3] * inv); *(u32x2*)(op + 16 * dt) = wv; }
    if (kq == 0) lseA[((size_t)g * T + tq) * 4 + h] = (m + __builtin_amdgcn_logf(l)) * LN2F;
}
__device__ __forceinline__ void attnB_fetch(int u, int tid, u32x4 (&pfc)[8], float& tabv, const bf16_t* __restrict__ hq, const float* __restrict__ relb) {
    asm volatile("" : "+v"(tid));
    const int kvh = u & 1, n = (u >> 1) & 31, b = u >> 6, tb = b * SEQ;
    const bf16_t* kcol = hq + hq_off64(44 + kvh, 0); const bf16_t* vcol = hq + hq_off64(46 + kvh, 0);
#pragma unroll
    for (int i = 0; i < 8; ++i) { const int idx = tid + NTHREADS_ * i, isv = idx >> 11, i2 = idx & 2047, row = i2 >> 3, ch = i2 & 7, pos = (n - 1) * 128 + row;
        pfc[i] = (pos >= 0) ? *(const u32x4*)((isv ? vcol : kcol) + (size_t)(tb + pos) * 64 + ch * 8) : (u32x4){0u, 0u, 0u, 0u}; }
    { const int hd = tid >> 7, off = tid & 127; tabv = relb[kBucket[0][off] * 20 + 12 + kvh * 4 + hd] * LOG2E; }
}
__device__ __forceinline__ void attnB_compute(int u, int tid, LAS unsigned char* lds, const bf16_t* __restrict__ hq, const float* __restrict__ sinks, bf16_t* __restrict__ yb) {
    asm volatile("" : "+v"(tid));
    const int kvh = u & 1, n = (u >> 1) & 31, b = u >> 6, tb = b * SEQ;
    LAS unsigned char* kl = lds; LAS unsigned char* vl = lds + ATT_KV64; LAS float* tab = (LAS float*)(lds + 2 * ATT_KV64);
    const int w = tid >> 6, lane = tid & 63, r16 = lane & 15, kq = lane >> 4, kmin = (n == 0) ? 128 : 0;
    for (int i = 0; i < 4; ++i) {
        const int task = w + 8 * i, hd = task >> 3, sub = task & 7, head = kvh * 4 + hd, qi = 16 * sub + r16;
        const size_t tq = (size_t)(tb + n * 128 + qi);
        pg8::bf16x8 qf[2];
#pragma unroll
        for (int s = 0; s < 2; ++s) qf[s] = *(const pg8::bf16x8*)(hq + hq_off64(36 + head, tq) + 32 * s + 8 * kq);
        float m = sinks[head] * LOG2E, l = 1.0f; f32x4 oT[4];
#pragma unroll
        for (int dt = 0; dt < 4; ++dt) oT[dt] = (f32x4){0.f, 0.f, 0.f, 0.f};
        LAS float* tb_h = tab + hd * 128;
        auto mf = [&](int tile, int kr, float s) -> float { const int kk = 16 * tile + kr, off = qi + 128 - kk; const bool ok = (off >= 0) && (off <= 127) && (kk >= kmin);
            const int oc = off < 0 ? 0 : (off > 127 ? 127 : off); return ok ? s + tb_h[oc] : -1e30f; };
        auto mfi = [&](int tile, int kr, float s) -> float { return s + tb_h[qi + 128 - 16 * tile - kr]; };
        attn_step<64, 160>(qf, kl, vl, sub, sub + 1, mf, m, l, oT);
        if (n != 0) { for (int st = 1; st < 4; ++st) attn_step<64, 160>(qf, kl, vl, sub + 2 * st, sub + 2 * st + 1, mfi, m, l, oT); }
        else { for (int st = 1; st < 4; ++st) attn_step<64, 160>(qf, kl, vl, sub + 2 * st, sub + 2 * st + 1, mf, m, l, oT); }
        attn_step<64, 160>(qf, kl, vl, sub + 8, sub + 9, mf, m, l, oT);
        const float inv = 1.0f / l;
        bf16_t* op = yb + tq * 512 + head * 64 + 4 * kq;
#pragma unroll
        for (int dt = 0; dt < 4; ++dt) { u32x2 wv; wv.x = pk2(oT[dt][0] * inv, oT[dt][1] * inv); wv.y = pk2(oT[dt][2] * inv, oT[dt][3] * inv); *(u32x2*)(op + 16 * dt) = wv; }
    }
}
__device__ __forceinline__ void attnAB_phase(LAS unsigned char* lds, const bf16_t* __restrict__ hq, const float* __restrict__ relb, const float* __restrict__ sinks, bf16_t* __restrict__ oA, float* __restrict__ lseA, bf16_t* __restrict__ yb) {
    int tid = threadIdx.x; asm volatile("" : "+v"(tid));
    u32x4 pfc[8]; float tabv = 0.f;
    int u = blockIdx.x;
    if (u < 3072) attnA_fetch(u, tid, pfc, tabv, hq, relb);
    for (; u < 3072; u += gridDim.x) {
        attnAB_store(tid, pfc, tabv, lds, 129);
        __syncthreads();
        const int un = u + gridDim.x;
        if (un < 3072) attnA_fetch(un, tid, pfc, tabv, hq, relb); else if ((int)blockIdx.x < 512) attnB_fetch((int)blockIdx.x, tid, pfc, tabv, hq, relb);
        attnA_compute(u, tid, lds, hq, oA, lseA);
        __syncthreads();
    }
    u = blockIdx.x;
    if (3072 <= (int)blockIdx.x && u < 512) attnB_fetch(u, tid, pfc, tabv, hq, relb);
    for (; u < 512; u += gridDim.x) {
        attnAB_store(tid, pfc, tabv, lds, 512);
        __syncthreads();
        const int un = u + gridDim.x;
        if (un < 512) attnB_fetch(un, tid, pfc, tabv, hq, relb);
        attnB_compute(u, tid, lds, hq, sinks, yb);
        __syncthreads();
    }
}
__device__ __forceinline__ void attnC_unit(int u, LAS unsigned char* lds, const bf16_t* __restrict__ hq, const bf16_t* __restrict__ kvm, bf16_t* __restrict__ yc) {
    int tid = threadIdx.x; asm volatile("" : "+v"(tid));
    const int qc = u & 7, head = (u >> 3) & 3, b = u >> 5, tb = b * SEQ;
    constexpr int CP = 272, IMG = 256 * CP;
    LAS unsigned char* kl = lds; LAS unsigned char* vl = lds + IMG;
    for (int idx = tid; idx < 8192; idx += NTHREADS_) { const int isv = idx >> 12, i2 = idx & 4095, row = i2 >> 4, ch = i2 & 15;
        lds_put16((isv ? vl : kl) + row * CP + ch * 16, kvm + (size_t)(b * MEMLEN + row) * 1024 + isv * 512 + head * 128 + ch * 8); }
    __syncthreads();
    const int w = tid >> 6, lane = tid & 63, r16 = lane & 15, kq = lane >> 4;
    auto mf = [&](int, int, float s) -> float { return s; };
    for (int qt = 0; qt < 4; ++qt) {
        const size_t tq = (size_t)(tb + qc * 512 + qt * 128 + 16 * w + r16);
        pg8::bf16x8 qf[4];
#pragma unroll
        for (int s = 0; s < 4; ++s) qf[s] = *(const pg8::bf16x8*)(hq + hq_offc(head, tq) + 32 * s + 8 * kq);
        float m = ATT_M0, l = 0.f; f32x4 oT[8];
#pragma unroll
        for (int dt = 0; dt < 8; ++dt) oT[dt] = (f32x4){0.f, 0.f, 0.f, 0.f};
        for (int st = 0; st < 8; ++st) attn_step<128, CP>(qf, kl, vl, 2 * st, 2 * st + 1, mf, m, l, oT);
        const float inv = 1.0f / l;
        bf16_t* op = yc + tq * 512 + head * 128 + 4 * kq;
#pragma unroll
        for (int dt = 0; dt < 8; ++dt) { u32x2 wv; wv.x = pk2(oT[dt][0] * inv, oT[dt][1] * inv); wv.y = pk2(oT[dt][2] * inv, oT[dt][3] * inv); *(u32x2*)(op + 16 * dt) = wv; }
    }
    __syncthreads();
}

#define CE_DESC(a, b) do { const unsigned _mx = (a) > (b) ? (a) : (b), _mn = (a) > (b) ? (b) : (a); (a) = _mx; (b) = _mn; } while (0)
__device__ __forceinline__ void sort16_desc(unsigned (&v)[16]) {
    CE_DESC(v[0], v[13]); CE_DESC(v[1], v[12]); CE_DESC(v[2], v[15]); CE_DESC(v[3], v[14]); CE_DESC(v[4], v[8]); CE_DESC(v[5], v[6]); CE_DESC(v[7], v[11]); CE_DESC(v[9], v[10]);
    CE_DESC(v[0], v[5]); CE_DESC(v[1], v[7]); CE_DESC(v[2], v[9]); CE_DESC(v[3], v[4]); CE_DESC(v[6], v[13]); CE_DESC(v[8], v[14]); CE_DESC(v[10], v[15]); CE_DESC(v[11], v[12]);
    CE_DESC(v[0], v[1]); CE_DESC(v[2], v[3]); CE_DESC(v[4], v[5]); CE_DESC(v[6], v[8]); CE_DESC(v[7], v[9]); CE_DESC(v[10], v[11]); CE_DESC(v[12], v[13]); CE_DESC(v[14], v[15]);
    CE_DESC(v[0], v[2]); CE_DESC(v[1], v[3]); CE_DESC(v[4], v[10]); CE_DESC(v[5], v[11]); CE_DESC(v[6], v[7]); CE_DESC(v[8], v[9]); CE_DESC(v[12], v[14]); CE_DESC(v[13], v[15]);
    CE_DESC(v[1], v[2]); CE_DESC(v[3], v[12]); CE_DESC(v[4], v[6]); CE_DESC(v[5], v[7]); CE_DESC(v[8], v[10]); CE_DESC(v[9], v[11]); CE_DESC(v[13], v[14]);
    CE_DESC(v[1], v[4]); CE_DESC(v[2], v[6]); CE_DESC(v[5], v[8]); CE_DESC(v[7], v[10]); CE_DESC(v[9], v[13]); CE_DESC(v[11], v[14]);
    CE_DESC(v[2], v[4]); CE_DESC(v[3], v[6]); CE_DESC(v[9], v[12]); CE_DESC(v[11], v[13]);
    CE_DESC(v[3], v[5]); CE_DESC(v[6], v[8]); CE_DESC(v[7], v[9]); CE_DESC(v[10], v[12]);
    CE_DESC(v[3], v[4]); CE_DESC(v[5], v[6]); CE_DESC(v[7], v[8]); CE_DESC(v[9], v[10]); CE_DESC(v[11], v[12]);
    CE_DESC(v[6], v[7]); CE_DESC(v[8], v[9]);
}
__device__ __forceinline__ void bitonic_merge16_desc(unsigned (&v)[16]) {
#pragma unroll
    for (int j = 8; j > 0; j >>= 1)
#pragma unroll
        for (int i = 0; i < 16; ++i) { const int p = i ^ j; if (p > i) CE_DESC(v[i], v[p]); }
}
__device__ __forceinline__ void top16_merge(unsigned (&a)[16], const unsigned (&b)[16]) {
#pragma unroll
    for (int i = 0; i < 16; ++i) a[i] = a[i] > b[15 - i] ? a[i] : b[15 - i];
    bitonic_merge16_desc(a);
}
__device__ __forceinline__ unsigned f2key(float f) { const unsigned u = __float_as_uint(f); return u ^ ((unsigned)((int)u >> 31) | 0x80000000u); }
__device__ __forceinline__ float key2f(unsigned k) { return __uint_as_float((k & 0x80000000u) ? (k ^ 0x80000000u) : ~k); }

constexpr int TK_KIMG = 128 * 144;
__device__ __forceinline__ void topk_unit(int u, LAS unsigned char* lds, const bf16_t* __restrict__ qb, const bf16_t* __restrict__ subk, unsigned short* __restrict__ eidx, float* __restrict__ gate) {
    int tid = threadIdx.x; asm volatile("" : "+v"(tid));
    const int h = u & 7, tile = u >> 3;
    typedef float f32x16 __attribute__((ext_vector_type(16)));
    for (int idx = tid; idx < 2048; idx += NTHREADS_) { const int row = idx >> 3, ch = idx & 7;
        *(LAS u32x4*)(lds + row * 144 + ch * 16) = *(const u32x4*)(subk + ((size_t)(h * 256 + row)) * 64 + ch * 8); }
    __syncthreads();
    const int w = tid >> 6, lane = tid & 63, r32 = lane & 31, hh = lane >> 5;
    const size_t tok = (size_t)tile * 256 + w * 32 + r32;
    unsigned top[2][16];
#pragma unroll
    for (int c = 0; c < 2; ++c) {
        pg8::bf16x8 qf[4];
#pragma unroll
        for (int s = 0; s < 4; ++s) qf[s] = *(const pg8::bf16x8*)(qb + tok * D + h * 128 + c * 64 + 16 * s + 8 * hh);
        unsigned key[4][16];
#pragma unroll
        for (int kt = 0; kt < 4; ++kt) { f32x16 acc;
#pragma unroll
            for (int i = 0; i < 16; ++i) acc[i] = 0.f;
#pragma unroll
            for (int s = 0; s < 4; ++s) { const pg8::bf16x8 a = *(const LAS pg8::bf16x8*)(lds + c * TK_KIMG + (32 * kt + r32) * 144 + (16 * s + 8 * hh) * 2);
                acc = __builtin_amdgcn_mfma_f32_32x32x16_bf16(a, qf[s], acc, 0, 0, 0); }
            const unsigned lowb = 127u - 4u * hh - 32u * kt;
#pragma unroll
            for (int i = 0; i < 16; ++i) key[kt][i] = (f2key(acc[i]) & 0xFFFFFF80u) | (lowb - (unsigned)((i & 3) + 8 * (i >> 2)));
            sort16_desc(key[kt]); }
        top16_merge(key[0], key[1]); top16_merge(key[2], key[3]); top16_merge(key[0], key[2]);
        unsigned other[16];
#pragma unroll
        for (int i = 0; i < 16; ++i) other[i] = (unsigned)__shfl_xor((int)key[0][i], 32, 64);
        top16_merge(key[0], other);
#pragma unroll
        for (int i = 0; i < 16; ++i) top[c][i] = key[0][i];
    }
    float v0[16], v1[16];
#pragma unroll
    for (int i = 0; i < 16; ++i) { v0[i] = key2f(top[0][i] & 0xFFFFFF80u); v1[i] = key2f(top[1][i] & 0xFFFFFF80u); }
    unsigned cand[4][16];
#pragma unroll
    for (int q = 0; q < 4; ++q)
#pragma unroll
        for (int i = 0; i < 16; ++i) cand[q][i] = 0u;
#define CAND_(q, e, i, j) cand[q][e] = (f2key(v0[i] + v1[j]) & 0xFFFFFF00u) | (unsigned)(255 - ((i) * 16 + (j)))
    CAND_(0, 0, 0, 0);
    CAND_(0, 1, 0, 1);
    CAND_(0, 2, 0, 2);
    CAND_(0, 3, 0, 3);
    CAND_(0, 4, 0, 4);
    CAND_(0, 5, 0, 5);
    CAND_(0, 6, 0, 6);
    CAND_(0, 7, 0, 7);
    CAND_(0, 8, 0, 8);
    CAND_(0, 9, 0, 9);
    CAND_(0, 10, 0, 10);
    CAND_(0, 11, 0, 11);
    CAND_(0, 12, 0, 12);
    CAND_(0, 13, 0, 13);
    CAND_(0, 14, 0, 14);
    CAND_(0, 15, 0, 15);
    CAND_(1, 0, 1, 0);
    CAND_(1, 1, 1, 1);
    CAND_(1, 2, 1, 2);
    CAND_(1, 3, 1, 3);
    CAND_(1, 4, 1, 4);
    CAND_(1, 5, 1, 5);
    CAND_(1, 6, 1, 6);
    CAND_(1, 7, 1, 7);
    CAND_(1, 8, 2, 0);
    CAND_(1, 9, 2, 1);
    CAND_(1, 10, 2, 2);
    CAND_(1, 11, 2, 3);
    CAND_(1, 12, 2, 4);
    CAND_(1, 13, 3, 0);
    CAND_(1, 14, 3, 1);
    CAND_(1, 15, 3, 2);
    CAND_(2, 0, 3, 3);
    CAND_(2, 1, 4, 0);
    CAND_(2, 2, 4, 1);
    CAND_(2, 3, 4, 2);
    CAND_(2, 4, 5, 0);
    CAND_(2, 5, 5, 1);
    CAND_(2, 6, 6, 0);
    CAND_(2, 7, 6, 1);
    CAND_(2, 8, 7, 0);
    CAND_(2, 9, 7, 1);
    CAND_(2, 10, 8, 0);
    CAND_(2, 11, 9, 0);
    CAND_(2, 12, 10, 0);
    CAND_(2, 13, 11, 0);
    CAND_(2, 14, 12, 0);
    CAND_(2, 15, 13, 0);
    CAND_(3, 0, 14, 0);
    CAND_(3, 1, 15, 0);
#undef CAND_
#pragma unroll
    for (int q = 0; q < 4; ++q) sort16_desc(cand[q]);
    top16_merge(cand[0], cand[1]); top16_merge(cand[2], cand[3]); top16_merge(cand[0], cand[2]);
    float ev[16]; const float vmax = key2f(cand[0][0] & 0xFFFFFF00u); float esum = 0.f;
#pragma unroll
    for (int k = 0; k < 16; ++k) { ev[k] = __builtin_amdgcn_exp2f((key2f(cand[0][k] & 0xFFFFFF00u) - vmax) * LOG2E); esum += ev[k]; }
    const float einv = 1.0f / esum;
    LAS unsigned char* st = lds + 2 * TK_KIMG + (w * 64 + lane) * 32;
#pragma unroll
    for (int g4 = 0; g4 < 4; ++g4) { unsigned d0 = 0u, d1 = 0u;
#pragma unroll
        for (int e = 0; e < 4; ++e) { d0 |= (127u - (top[0][4 * g4 + e] & 127u)) << (8 * e); d1 |= (127u - (top[1][4 * g4 + e] & 127u)) << (8 * e); }
        *(LAS unsigned*)(st + 4 * g4) = d0; *(LAS unsigned*)(st + 16 + 4 * g4) = d1; }
    int eo[16];
#pragma unroll
    for (int k = 0; k < 16; ++k) { const unsigned code = 255u - (cand[0][k] & 255u); eo[k] = (int)st[code >> 4] * 128 + (int)st[16 + (code & 15u)]; }
    if (hh == 0) {
        u32x4 o0, o1;
        o0.x = (unsigned)eo[0] | ((unsigned)eo[1] << 16); o0.y = (unsigned)eo[2] | ((unsigned)eo[3] << 16); o0.z = (unsigned)eo[4] | ((unsigned)eo[5] << 16); o0.w = (unsigned)eo[6] | ((unsigned)eo[7] << 16);
        o1.x = (unsigned)eo[8] | ((unsigned)eo[9] << 16); o1.y = (unsigned)eo[10] | ((unsigned)eo[11] << 16); o1.z = (unsigned)eo[12] | ((unsigned)eo[13] << 16); o1.w = (unsigned)eo[14] | ((unsigned)eo[15] << 16);
        *(u32x4*)(eidx + tok * 128 + h * 16) = o0; *(u32x4*)(eidx + tok * 128 + h * 16 + 8) = o1;
    } else {
#pragma unroll
        for (int k4 = 0; k4 < 4; ++k4) { f32x4 o; o[0] = ev[4 * k4] * einv; o[1] = ev[4 * k4 + 1] * einv; o[2] = ev[4 * k4 + 2] * einv; o[3] = ev[4 * k4 + 3] * einv;
            *(f32x4*)(gate + tok * 128 + h * 16 + 4 * k4) = o; }
    }
    __syncthreads();
}

__device__ __forceinline__ float fp8dot16(const u32x4 w, const f32x2 (&xp)[8]) {
    f32x2 a0 = __builtin_amdgcn_cvt_pk_f32_fp8((int)w.x, false) * xp[0];
    a0 = __builtin_elementwise_fma(__builtin_amdgcn_cvt_pk_f32_fp8((int)w.x, true), xp[1], a0);
    a0 = __builtin_elementwise_fma(__builtin_amdgcn_cvt_pk_f32_fp8((int)w.y, false), xp[2], a0); a0 = __builtin_elementwise_fma(__builtin_amdgcn_cvt_pk_f32_fp8((int)w.y, true), xp[3], a0);
    a0 = __builtin_elementwise_fma(__builtin_amdgcn_cvt_pk_f32_fp8((int)w.z, false), xp[4], a0); a0 = __builtin_elementwise_fma(__builtin_amdgcn_cvt_pk_f32_fp8((int)w.z, true), xp[5], a0);
    a0 = __builtin_elementwise_fma(__builtin_amdgcn_cvt_pk_f32_fp8((int)w.w, false), xp[6], a0); a0 = __builtin_elementwise_fma(__builtin_amdgcn_cvt_pk_f32_fp8((int)w.w, true), xp[7], a0);
    return a0.x + a0.y;
}
typedef int i32x4 __attribute__((ext_vector_type(4)));
#define PEER_EIDX16(dst, t_) do { const unsigned short* ep_ = eidx + (size_t)(t_) * 128 + 16 * grp; const u32x4 e0_ = *(const u32x4*)ep_, e1_ = *(const u32x4*)(ep_ + 8); \
        dst[0] = (int)(e0_.x & 0xffffu); dst[1] = (int)(e0_.x >> 16); dst[2] = (int)(e0_.y & 0xffffu); dst[3] = (int)(e0_.y >> 16); dst[4] = (int)(e0_.z & 0xffffu); dst[5] = (int)(e0_.z >> 16); dst[6] = (int)(e0_.w & 0xffffu); dst[7] = (int)(e0_.w >> 16); \
        dst[8] = (int)(e1_.x & 0xffffu); dst[9] = (int)(e1_.x >> 16); dst[10] = (int)(e1_.y & 0xffffu); dst[11] = (int)(e1_.y >> 16); dst[12] = (int)(e1_.z & 0xffffu); dst[13] = (int)(e1_.z >> 16); dst[14] = (int)(e1_.w & 0xffffu); dst[15] = (int)(e1_.w >> 16); } while (0)
#define PEER_GATHER16(BUF, base, ev) _Pragma("unroll") for (int i_ = 0; i_ < 16; ++i_) BUF[i_] = *(const u32x4*)((base) + (unsigned)(((unsigned)(ev)[i_] << 10) + (unsigned)colbase))
template <int CTRL> __device__ __forceinline__ float xsel_addf_dpp(float keep_lo, float keep_hi, bool hi) { const float send = hi ? keep_lo : keep_hi, keep = hi ? keep_hi : keep_lo;
    return keep + __uint_as_float(__builtin_amdgcn_update_dpp(0u, __float_as_uint(send), CTRL, 0xf, 0xf, false)); }
__device__ __forceinline__ float swap32_add(float lo, float hi) { typedef unsigned u2_ __attribute__((ext_vector_type(2))); const u2_ r = __builtin_amdgcn_permlane32_swap(__float_as_uint(lo), __float_as_uint(hi), false, false); return __uint_as_float(r.x) + __uint_as_float(r.y); }
__device__ __forceinline__ float swap16_add(float lo, float hi) { typedef unsigned u2_ __attribute__((ext_vector_type(2))); const u2_ r = __builtin_amdgcn_permlane16_swap(__float_as_uint(lo), __float_as_uint(hi), false, false); return __uint_as_float(r.x) + __uint_as_float(r.y); }
#define PEER_GATHER4(R, o, base, E, p) _Pragma("unroll") for (int j_ = 0; j_ < 4; ++j_) R[(o) + j_] = *(const u32x4*)((base) + (unsigned)(((unsigned)(E)[4 * (p) + j_] << 10) + (unsigned)colbase))
__device__ __forceinline__ void peerU_phase(int slice, int tok0, int tok1, const bf16_t* __restrict__ x1b,
                                            const unsigned short* __restrict__ eidx, const unsigned char* __restrict__ ub8, bf16_t* __restrict__ hp) {
    int tid = threadIdx.x; asm volatile("" : "+v"(tid));
    const int wave = tid >> 6, lane = tid & 63, sub = lane & 7, grp = lane >> 3, colbase = 128 * slice + 16 * sub;
    if (tok0 + wave >= tok1) return;
    const bool l0 = lane & 1, l1 = lane & 2, l2 = lane & 4;
    const int tfirst = tok0 + wave, tlast = tfirst + ((tok1 - 1 - tfirst) >> 3) * 8;
    const bf16_t* xl = x1b + colbase;
    const int hoff = 16 * grp + ((lane & 4) ? 8 : 0) + ((lane & 2) ? 4 : 0) + ((lane & 1) ? 2 : 0);
#define TOKC(i) ((tfirst + 8 * (i)) <= tlast ? (tfirst + 8 * (i)) : tlast)
    u32x4 R[32]; int EA[16], EB[16]; u32x4 xrA0, xrA1, xrB0, xrB1;
    { const int t0 = TOKC(0), t1 = TOKC(1);
      PEER_EIDX16(EA, t0); PEER_EIDX16(EB, t1);
      xrA0 = *(const u32x4*)(xl + (size_t)t0 * D); xrA1 = *(const u32x4*)(xl + (size_t)t0 * D + 8); xrB0 = *(const u32x4*)(xl + (size_t)t1 * D); xrB1 = *(const u32x4*)(xl + (size_t)t1 * D + 8);
#pragma unroll
      for (int p = 0; p < 4; ++p) { PEER_GATHER4(R, 4 * p, ub8, EA, p); }
#pragma unroll
      for (int p = 0; p < 4; ++p) { PEER_GATHER4(R, 16 + 4 * p, ub8, EB, p); }
      const int t2 = TOKC(2), t3 = TOKC(3); PEER_EIDX16(EA, t2); PEER_EIDX16(EB, t3); }
    for (int i = 0;; i += 2) {
#define PEER_U_TOKEN(RO, E, xr0, xr1, ti, tnext2, tnext4) do { \
        f32x2 xp[8]; \
        xp[0] = (f32x2){bflo(xr0.x), bfhi(xr0.x)}; xp[1] = (f32x2){bflo(xr0.y), bfhi(xr0.y)}; xp[2] = (f32x2){bflo(xr0.z), bfhi(xr0.z)}; xp[3] = (f32x2){bflo(xr0.w), bfhi(xr0.w)}; \
        xp[4] = (f32x2){bflo(xr1.x), bfhi(xr1.x)}; xp[5] = (f32x2){bflo(xr1.y), bfhi(xr1.y)}; xp[6] = (f32x2){bflo(xr1.z), bfhi(xr1.z)}; xp[7] = (f32x2){bflo(xr1.w), bfhi(xr1.w)}; \
        xr0 = *(const u32x4*)(xl + (size_t)(tnext2) * D); xr1 = *(const u32x4*)(xl + (size_t)(tnext2) * D + 8);        \
        float pd[16]; \
        _Pragma("unroll") for (int p = 0; p < 4; ++p) { \
            _Pragma("unroll") for (int j = 0; j < 4; ++j) pd[4 * p + j] = fp8dot16(R[(RO) + 4 * p + j], xp); \
            PEER_GATHER4(R, (RO) + 4 * p, ub8, E, p); } \
        PEER_EIDX16(E, tnext4); \
        float q8[8]; \
        _Pragma("unroll") for (int k = 0; k < 8; ++k) q8[k] = xsel_addf_dpp<0x141>(pd[k], pd[k + 8], l2);            \
        const float r0 = xsel_addf_dpp<0x4E>(q8[0], q8[4], l1), r1 = xsel_addf_dpp<0x4E>(q8[1], q8[5], l1), r2 = xsel_addf_dpp<0x4E>(q8[2], q8[6], l1), r3 = xsel_addf_dpp<0x4E>(q8[3], q8[7], l1);     \
        f32x2 o; o.x = xsel_addf_dpp<0xB1>(r0, r2, l0); o.y = xsel_addf_dpp<0xB1>(r1, r3, l0);                       \
        if ((tfirst + 8 * (ti)) <= tlast) *(unsigned*)(hp + ((size_t)slice * T + (size_t)(tfirst + 8 * (ti))) * 128 + hoff) = pk2(o.x, o.y); } while (0)
        { const int tn2 = TOKC(i + 2), tn4 = TOKC(i + 4); PEER_U_TOKEN(0, EA, xrA0, xrA1, i, tn2, tn4); }
        { const int tn2 = TOKC(i + 3), tn4 = TOKC(i + 5); PEER_U_TOKEN(16, EB, xrB0, xrB1, i + 1, tn2, tn4); }
        if (tfirst + 8 * (i + 2) > tlast) break;
    }
#undef PEER_U_TOKEN
#undef TOKC
}
#ifdef PROBE_EXP
__device__ __forceinline__ void probe_gather(int slice, int tok0, int tok1, const unsigned short* __restrict__ eidx, const unsigned char* __restrict__ ub8, float* __restrict__ dummy) {
    int tid = threadIdx.x; asm volatile("" : "+v"(tid));
    const int wave = tid >> 6, lane = tid & 63, sub = lane & 7, grp = lane >> 3, colbase = 128 * slice + 16 * sub;
    if (tok0 + wave >= tok1) return;
    const unsigned char* ubl = ub8;
    const int tlast = tok0 + wave + ((tok1 - 1 - tok0 - wave) >> 3) * 8;
    int EA[16], EB[16]; u32x4 UA[16], UB[16];
    int ta = tok0 + wave, tb = ta + 8 <= tlast ? ta + 8 : tlast;
    PEER_EIDX16(EA, ta); PEER_EIDX16(EB, tb);
    PEER_GATHER16(UA, ubl, EA);
    unsigned accx = 0u;
    for (;;) {
        PEER_GATHER16(UB, ubl, EB);
        const int ta2 = ta + 16 <= tlast ? ta + 16 : tlast; PEER_EIDX16(EA, ta2);
#pragma unroll
        for (int i = 0; i < 16; ++i) accx ^= UA[i].x ^ UA[i].y ^ UA[i].z ^ UA[i].w;
        PEER_GATHER16(UA, ubl, EA);
        const int tb2 = ta + 24 <= tlast ? ta + 24 : tlast; PEER_EIDX16(EB, tb2);
#pragma unroll
        for (int i = 0; i < 16; ++i) accx ^= UB[i].x ^ UB[i].y ^ UB[i].z ^ UB[i].w;
        if (ta + 16 > tlast) break;
        ta = ta2; tb = tb2;
    }
    dummy[(size_t)blockIdx.x * 512 + tid] = __uint_as_float(accx & 0x3fffffffu);
}
#endif

#if defined(PROBE_EXP) && PROBE_EXP >= 10 && PROBE_EXP < 20
__device__ __forceinline__ void probe_valu(float* __restrict__ dummy) {
    int tid = threadIdx.x; asm volatile("" : "+v"(tid));
    unsigned w[8]; f32x2 a[8];
#pragma unroll
    for (int i = 0; i < 8; ++i) { w[i] = (unsigned)tid * 2654435761u + i * 40503u; a[i] = (f32x2){(float)i, 1.0f}; }
    for (int it = 0; it < 2048; ++it) {
#pragma unroll
        for (int r = 0; r < 4; ++r)
#pragma unroll
            for (int i = 0; i < 8; ++i) {
#if PROBE_EXP == 10
                asm volatile("v_cvt_pk_f32_fp8_e32 %0, %1" : "=v"(a[i]) : "v"(w[i]));
#elif PROBE_EXP == 11
                asm volatile("v_pk_fma_f32 %0, %1, %1, %0" : "+v"(a[i]) : "v"(a[(i + 1) & 7]));
#elif PROBE_EXP == 12
                asm volatile("v_cvt_f32_ubyte0_e32 %0, %1" : "=v"(a[i].x) : "v"(w[i]));
#elif PROBE_EXP == 13
                asm volatile("v_dot4_i32_i8 %0, %1, %1, %0" : "+v"(w[i]) : "v"(w[(i + 1) & 7]));
#elif PROBE_EXP == 14
                asm volatile("v_fma_f32 %0, %1, %1, %0" : "+v"(a[i].x) : "v"(a[(i + 1) & 7].y));
#elif PROBE_EXP == 15
                asm volatile("v_dot2_f32_bf16 %0, %1, %1, %0" : "+v"(a[i].x) : "v"(w[i]));
#endif
            }
    }
    float s = 0.f;
#pragma unroll
    for (int i = 0; i < 8; ++i) s += a[i].x + a[i].y + __uint_as_float(w[i] & 0x3fffffffu);
    dummy[(size_t)blockIdx.x * 512 + tid] = s;
}
#endif
__device__ __forceinline__ void peerR_phase(const bf16_t* __restrict__ hp, const unsigned short* __restrict__ eidx, const float* __restrict__ gate, const float* __restrict__ usc, const float* __restrict__ vsc, bf16_t* __restrict__ cb) {
    for (size_t i = (size_t)blockIdx.x * 512 + threadIdx.x; i < (size_t)T * 32; i += (size_t)gridDim.x * 512) {
        f32x4 h = (f32x4){0.f, 0.f, 0.f, 0.f};
#pragma unroll
        for (int j = 0; j < 8; ++j) { const u32x2 w = *(const u32x2*)(hp + (size_t)j * T * 128 + 4 * i); h += (f32x4){bflo(w.x), bfhi(w.x), bflo(w.y), bfhi(w.y)}; }
        const u32x2 ew = *(const u32x2*)(eidx + 4 * i); const int e[4] = {(int)(ew.x & 0xffffu), (int)(ew.x >> 16), (int)(ew.y & 0xffffu), (int)(ew.y >> 16)};
        const f32x4 gt = *(const f32x4*)(gate + 4 * i); float c[4];
#pragma unroll
        for (int j = 0; j < 4; ++j) { const float hh = h[j] * usc[e[j]]; const pg8::f32x2 ge = pg8::gelu_pk((pg8::f32x2){hh, hh}); c[j] = gt[j] * ge.x * vsc[e[j]]; }
        u32x2 cw; cw.x = pk2(c[0], c[1]); cw.y = pk2(c[2], c[3]); *(u32x2*)(cb + 4 * i) = cw; }
}
__device__ __forceinline__ void peerV_phase(int slice, int tok0, int tok1, const bf16_t* __restrict__ cb, const unsigned short* __restrict__ eidx, const unsigned char* __restrict__ vb8, bf16_t* __restrict__ yp) {
    int tid = threadIdx.x; asm volatile("" : "+v"(tid));
    const int wave = tid >> 6, lane = tid & 63, sub = lane & 7, grp = lane >> 3, colbase = 128 * slice + 16 * sub;
    if (tok0 + wave >= tok1) return;
    const bool l3 = lane & 8, l4 = lane & 16, l5 = lane & 32;
    const int tfirst = tok0 + wave, tlast = tfirst + ((tok1 - 1 - tfirst) >> 3) * 8;
    const bf16_t* cl = cb + 16 * grp;
    const int yoff = colbase + ((lane & 32) ? 8 : 0) + ((lane & 16) ? 4 : 0) + ((lane & 8) ? 2 : 0);
#define TOKC(i) ((tfirst + 8 * (i)) <= tlast ? (tfirst + 8 * (i)) : tlast)
#define PEER_C16(dst, t_) do { const bf16_t* cp_ = cl + (size_t)(t_) * 128; dst[0] = *(const u32x4*)cp_; dst[1] = *(const u32x4*)(cp_ + 8); } while (0)
    u32x4 R[32]; int EA[16], EB[16]; u32x4 cA[2], cB[2];
    { const int t0 = TOKC(0), t1 = TOKC(1);
      PEER_EIDX16(EA, t0); PEER_EIDX16(EB, t1); PEER_C16(cA, t0); PEER_C16(cB, t1);
#pragma unroll
      for (int p = 0; p < 4; ++p) { PEER_GATHER4(R, 4 * p, vb8, EA, p); }
#pragma unroll
      for (int p = 0; p < 4; ++p) { PEER_GATHER4(R, 16 + 4 * p, vb8, EB, p); }
      const int t2 = TOKC(2), t3 = TOKC(3); PEER_EIDX16(EA, t2); PEER_EIDX16(EB, t3); }
    for (int i = 0;; i += 2) {
#define PEER_V_TOKEN(RO, E, cc, ti, tnext2, tnext4) do { \
        const u32x4 c0_ = cc[0], c1_ = cc[1]; \
        const float cv[16] = {bflo(c0_.x), bfhi(c0_.x), bflo(c0_.y), bfhi(c0_.y), bflo(c0_.z), bfhi(c0_.z), bflo(c0_.w), bfhi(c0_.w), bflo(c1_.x), bfhi(c1_.x), bflo(c1_.y), bfhi(c1_.y), bflo(c1_.z), bfhi(c1_.z), bflo(c1_.w), bfhi(c1_.w)}; \
        PEER_C16(cc, tnext2);                                        \
        f32x2 acc[8]; \
        _Pragma("unroll") for (int k = 0; k < 8; ++k) acc[k] = (f32x2){0.f, 0.f}; \
        _Pragma("unroll") for (int p = 0; p < 4; ++p) { \
            _Pragma("unroll") for (int j = 0; j < 4; ++j) { const u32x4 w = R[(RO) + 4 * p + j]; const f32x2 c2v = (f32x2){cv[4 * p + j], cv[4 * p + j]}; \
                acc[0] = __builtin_elementwise_fma(__builtin_amdgcn_cvt_pk_f32_fp8((int)w.x, false), c2v, acc[0]); acc[1] = __builtin_elementwise_fma(__builtin_amdgcn_cvt_pk_f32_fp8((int)w.x, true), c2v, acc[1]); \
                acc[2] = __builtin_elementwise_fma(__builtin_amdgcn_cvt_pk_f32_fp8((int)w.y, false), c2v, acc[2]); acc[3] = __builtin_elementwise_fma(__builtin_amdgcn_cvt_pk_f32_fp8((int)w.y, true), c2v, acc[3]); \
                acc[4] = __builtin_elementwise_fma(__builtin_amdgcn_cvt_pk_f32_fp8((int)w.z, false), c2v, acc[4]); acc[5] = __builtin_elementwise_fma(__builtin_amdgcn_cvt_pk_f32_fp8((int)w.z, true), c2v, acc[5]); \
                acc[6] = __builtin_elementwise_fma(__builtin_amdgcn_cvt_pk_f32_fp8((int)w.w, false), c2v, acc[6]); acc[7] = __builtin_elementwise_fma(__builtin_amdgcn_cvt_pk_f32_fp8((int)w.w, true), c2v, acc[7]); } \
            PEER_GATHER4(R, (RO) + 4 * p, vb8, E, p); } \
        PEER_EIDX16(E, tnext4); \
        const float a[16] = {acc[0].x, acc[0].y, acc[1].x, acc[1].y, acc[2].x, acc[2].y, acc[3].x, acc[3].y, acc[4].x, acc[4].y, acc[5].x, acc[5].y, acc[6].x, acc[6].y, acc[7].x, acc[7].y}; \
        float q8[8]; \
        _Pragma("unroll") for (int k = 0; k < 8; ++k) q8[k] = swap32_add(a[k], a[k + 8]); \
        const float r0 = swap16_add(q8[0], q8[4]), r1 = swap16_add(q8[1], q8[5]), r2 = swap16_add(q8[2], q8[6]), r3 = swap16_add(q8[3], q8[7]); \
        f32x2 o; o.x = xsel_addf_dpp<0x128>(r0, r2, l3); o.y = xsel_addf_dpp<0x128>(r1, r3, l3);               \
        if ((tfirst + 8 * (ti)) <= tlast) *(unsigned*)(yp + (size_t)(tfirst + 8 * (ti)) * D + yoff) = pk2(o.x, o.y); } while (0)
        { const int tn2 = TOKC(i + 2), tn4 = TOKC(i + 4); PEER_V_TOKEN(0, EA, cA, i, tn2, tn4); }
        { const int tn2 = TOKC(i + 3), tn4 = TOKC(i + 5); PEER_V_TOKEN(16, EB, cB, i + 1, tn2, tn4); }
        if (tfirst + 8 * (i + 2) > tlast) break;
    }
#undef PEER_V_TOKEN
#undef PEER_C16
#undef TOKC
}
template <int NT>
__device__ __forceinline__ void peerL_token(size_t t0, size_t tstride, const bf16_t* __restrict__ x1b, const bf16_t* __restrict__ yp, const float* g2, const float* b2, float* __restrict__ out) {
    const int lane = threadIdx.x & 63;
    u32x4 xw[NT][2], yw[NT][2];
#pragma unroll
    for (int k = 0; k < NT; ++k) { const size_t t = t0 + k * tstride;
#pragma unroll
        for (int hlf = 0; hlf < 2; ++hlf) { const int c = 16 * lane + 8 * hlf; xw[k][hlf] = *(const u32x4*)(x1b + t * D + c); yw[k][hlf] = *(const u32x4*)(yp + t * D + c); } }
#pragma unroll
    for (int k = 0; k < NT; ++k) { const size_t t = t0 + k * tstride;
        float y[16]; float s = 0.f;
#pragma unroll
        for (int hlf = 0; hlf < 2; ++hlf) { const u32x4 xq = xw[k][hlf], yq = yw[k][hlf];
            const float xx[8] = {bflo(xq.x), bfhi(xq.x), bflo(xq.y), bfhi(xq.y), bflo(xq.z), bfhi(xq.z), bflo(xq.w), bfhi(xq.w)}, yy[8] = {bflo(yq.x), bfhi(yq.x), bflo(yq.y), bfhi(yq.y), bflo(yq.z), bfhi(yq.z), bflo(yq.w), bfhi(yq.w)};
#pragma unroll
            for (int j = 0; j < 8; ++j) { const float v = ALPHA * xx[j] + yy[j]; y[8 * hlf + j] = v; s += v; } }
        const float mean2 = wave_sum(s) * (1.f / D); float ss = 0.f;
#pragma unroll
        for (int i = 0; i < 16; ++i) { const float dlt = y[i] - mean2; ss += dlt * dlt; }
        const float rstd2 = rsqrtf(wave_sum(ss) * (1.f / D) + LN_EPS);
#pragma unroll
        for (int q = 0; q < 4; ++q) { const int c = 16 * lane + 4 * q; const f32x4 gg = *(const f32x4*)(g2 + c), bb = *(const f32x4*)(b2 + c); f32x4 o;
#pragma unroll
            for (int j = 0; j < 4; ++j) o[j] = (y[4 * q + j] - mean2) * rstd2 * gg[j] + bb[j];
            *(f32x4*)(out + t * D + c) = o; } }
}

constexpr int NTHREADS = 512, NWAVES = 8;
constexpr int LDS_BYTES = 147456;
constexpr int LDS_MISC = 131072;
constexpr int LDS_XB = LDS_BYTES - 16;
constexpr size_t CTL_ZERO_BYTES = 16384;

struct Params {
    const float *x, *mem, *relb, *w_in, *b_gate, *w_memkv, *sinks, *w_a, *w_b, *w_c, *w_out, *ln1g, *ln1b, *w_q, *subk, *pu, *pv, *ln2g, *ln2b;
    float* out; char* ws; int lo, hi;
};

__device__ __forceinline__ void g_cvt(const float* __restrict__ src, bf16_t* __restrict__ dst, size_t n8) {
    for (size_t i = (size_t)blockIdx.x * NTHREADS + threadIdx.x; i < n8; i += (size_t)gridDim.x * NTHREADS) {
        const f32x4 a = ((const f32x4*)src)[2 * i], b = ((const f32x4*)src)[2 * i + 1];
        u32x4 w; w.x = pk2(a[0], a[1]); w.y = pk2(a[2], a[3]); w.z = pk2(b[0], b[1]); w.w = pk2(b[2], b[3]);
        ((u32x4*)dst)[i] = w; }
}


__device__ __forceinline__ void g_cvt8(const float* __restrict__ src, unsigned char* __restrict__ dst, size_t n16, float sc) {
    for (size_t i = (size_t)blockIdx.x * NTHREADS + threadIdx.x; i < n16; i += (size_t)gridDim.x * NTHREADS) {
        const f32x4 a = ((const f32x4*)src)[4 * i], b = ((const f32x4*)src)[4 * i + 1], c = ((const f32x4*)src)[4 * i + 2], d = ((const f32x4*)src)[4 * i + 3];
        u32x4 w; int t;
        t = 0; t = __builtin_amdgcn_cvt_pk_fp8_f32(a[0] * sc, a[1] * sc, t, false); t = __builtin_amdgcn_cvt_pk_fp8_f32(a[2] * sc, a[3] * sc, t, true); w.x = (unsigned)t;
        t = 0; t = __builtin_amdgcn_cvt_pk_fp8_f32(b[0] * sc, b[1] * sc, t, false); t = __builtin_amdgcn_cvt_pk_fp8_f32(b[2] * sc, b[3] * sc, t, true); w.y = (unsigned)t;
        t = 0; t = __builtin_amdgcn_cvt_pk_fp8_f32(c[0] * sc, c[1] * sc, t, false); t = __builtin_amdgcn_cvt_pk_fp8_f32(c[2] * sc, c[3] * sc, t, true); w.z = (unsigned)t;
        t = 0; t = __builtin_amdgcn_cvt_pk_fp8_f32(d[0] * sc, d[1] * sc, t, false); t = __builtin_amdgcn_cvt_pk_fp8_f32(d[2] * sc, d[3] * sc, t, true); w.w = (unsigned)t;
        ((u32x4*)dst)[i] = w; }
}

template <bool FP8>
__device__ __forceinline__ void transpose_tile_wave(const float* __restrict__ src, int K, int N, void* __restrict__ dstv, int tn, int tk, LAS float* tile, float sc) {
    const int lane = threadIdx.x & 63, n0 = tn * 64, k0 = tk * 64, rq = lane >> 4, c4 = (lane & 15) * 4;
    f32x4 v[16];
#pragma unroll
    for (int i = 0; i < 16; ++i) v[i] = *(const f32x4*)(src + (size_t)(k0 + 4 * i + rq) * N + n0 + c4);
#pragma unroll
    for (int i = 0; i < 16; ++i) *(LAS f32x4*)(tile + (4 * i + rq) * 68 + c4) = v[i];
    asm volatile("s_waitcnt lgkmcnt(0)" ::: "memory");
    float y[64];
#pragma unroll
    for (int k = 0; k < 64; ++k) y[k] = tile[k * 68 + lane];
    if constexpr (FP8) { unsigned char* dst = (unsigned char*)dstv + (size_t)(n0 + lane) * K + k0;
#pragma unroll
        for (int q = 0; q < 4; ++q) { u32x4 w; int t;
#pragma unroll
            for (int d = 0; d < 4; ++d) { t = 0; t = __builtin_amdgcn_cvt_pk_fp8_f32(y[16 * q + 4 * d] * sc, y[16 * q + 4 * d + 1] * sc, t, false); t = __builtin_amdgcn_cvt_pk_fp8_f32(y[16 * q + 4 * d + 2] * sc, y[16 * q + 4 * d + 3] * sc, t, true); w[d] = (unsigned)t; }
            *(u32x4*)(dst + 16 * q) = w; } }
    else { bf16_t* dst = (bf16_t*)dstv + (size_t)(n0 + lane) * K + k0;
#pragma unroll
        for (int q = 0; q < 8; ++q) { u32x4 w; w.x = pk2(y[8 * q], y[8 * q + 1]); w.y = pk2(y[8 * q + 2], y[8 * q + 3]); w.z = pk2(y[8 * q + 4], y[8 * q + 5]); w.w = pk2(y[8 * q + 6], y[8 * q + 7]); *(u32x4*)(dst + 8 * q) = w; } }
    asm volatile("s_waitcnt lgkmcnt(0)" ::: "memory");
}
#define W_ws (p.ws)
#define W_dout ((char*)p.out)
#define W_wmemkv_t ((bf16_t*)(W_ws + WS_WMEMKV))
#define W_wA_t ((bf16_t*)(W_ws + WS_WA))
#define W_wB_t ((bf16_t*)(W_ws + WS_WB))
#define W_wC_t ((bf16_t*)(W_ws + WS_WC))
#define W_wout_t ((bf16_t*)(W_ws + WS_WOUT))
#define W_wq_t ((bf16_t*)(W_ws + WS_WQ))
#define W_subkb ((bf16_t*)(W_ws + WS_SUBK))
#define W_memb ((bf16_t*)(W_ws + WS_MEMB))
#define W_kvm ((bf16_t*)(W_ws + WS_KVM))
#define W_stats ((float*)(W_ws + WS_STATS))
#define W_lseA ((float*)(W_ws + WS_LSE))
#define W_hq ((bf16_t*)(W_ws + WS_HQ))
#define W_gates ((bf16_t*)(W_ws + WS_GATES))
#define W_xb ((bf16_t*)(W_ws + WS_XB))
#define W_mf ((float*)(W_ws + WS_MF))
#define W_mb ((unsigned char*)(W_ws + WS_MB))
#define W_z ((bf16_t*)(W_ws + WS_Z))
#define W_x1b ((bf16_t*)(W_ws + WS_X1B))
#define W_qb ((bf16_t*)(W_ws + WS_Q))
#define W_eidx ((unsigned short*)(W_ws + WS_EIDX))
#define W_gate ((float*)(W_ws + WS_GATE))
#define W_ub8 ((unsigned char*)(W_ws + WS_UB))
#define W_vb8 ((unsigned char*)(W_ws + WS_UB + 16 * MiB))
#define W_usc ((float*)(W_ws + WS_UB + 32 * MiB))
#define W_vsc (W_usc + NEXP)
#define W_w_in_t ((bf16_t*)(W_dout + DO_WINT))
#define W_oA ((bf16_t*)(W_dout + DO_OA))
#define W_yb ((bf16_t*)(W_dout + DO_YB))
#define W_yc ((bf16_t*)(W_dout + DO_YC))
#define W_ya ((bf16_t*)(W_dout + DO_YA))
#define W_x8 ((unsigned char*)W_dout)
#define W_hp ((bf16_t*)(W_ws + 120 * MiB))
#define W_cbuf ((bf16_t*)(W_ws + 24 * MiB))
#define W_yp W_hp
__global__ void __launch_bounds__(NTHREADS, 2) mk_fwd(Params p) {
    extern __shared__ __attribute__((aligned(16))) unsigned char lds[];
#define LAUNDER_TID int tid = threadIdx.x; asm volatile("" : "+v"(tid)); const int wave = tid >> 6; const int gw = blockIdx.x * NWAVES + wave, nw = gridDim.x * NWAVES; (void)wave; (void)gw; (void)nw;
    if (threadIdx.x == 0) *(uint4*)(lds + LDS_XB) = make_uint4(0u, 0u, 0u, 0u);
    __syncthreads();
    XcdBarrier bar = xcd_barrier_post((unsigned*)(W_ws + WS_CTL), (volatile LAS unsigned*)(lds + LDS_XB));
#define PH(k) (p.lo <= (k) && (k) < p.hi)
#define SEAM(k) do { if (PH(k) && PH((k) + 1)) xcd_barrier(bar); } while (0)

    if (PH(0)) { LAUNDER_TID
        g_cvt8(p.x, (unsigned char*)W_xb, (size_t)T * D / 16, 1.0f);
        g_cvt(p.mem, W_memb, (size_t)BATCH * MEMLEN * D / 8);
        g_cvt(p.subk, W_subkb, (size_t)8 * 2 * 128 * 64 / 8);
        LAS float* tile = (LAS float*)((LAS unsigned char*)lds + wave * (64 * 68 * 4));
        for (int u = gw; u < 2752; u += nw) {
            if (u < 1664) transpose_tile_wave<true>(p.w_in, D, INW, W_w_in_t, u % 104, u / 104, tile, 32.0f);
            else if (u < 1920) { const int v = u - 1664; transpose_tile_wave<false>(p.w_memkv, D, 1024, W_wmemkv_t, v & 15, v >> 4, tile, 1.f); }
            else if (u < 1984) { const int v = u - 1920; transpose_tile_wave<false>(p.w_a, 256, 1024, W_wA_t, v & 15, v >> 4, tile, 1.f); }
            else if (u < 2112) { const int v = u - 1984; transpose_tile_wave<false>(p.w_b, 512, 1024, W_wB_t, v & 15, v >> 4, tile, 1.f); }
            else if (u < 2240) { const int v = u - 2112; transpose_tile_wave<false>(p.w_c, 512, 1024, W_wC_t, v & 15, v >> 4, tile, 1.f); }
            else if (u < 2496) { const int v = u - 2240; transpose_tile_wave<true>(p.w_out, D, 1024, W_wout_t, v & 15, v >> 4, tile, 32.0f); }
            else { const int v = u - 2496; transpose_tile_wave<false>(p.w_q, D, 1024, W_wq_t, v & 15, v >> 4, tile, 1.f); }
        }
    }
    SEAM(0);
    if (PH(1)) {
        { pg8::Gemm g; g.A = W_memb; g.Bt = W_wmemkv_t; g.M = BATCH * MEMLEN; g.N = 1024; g.K = D; EpiPlain E; E.O = W_kvm; E.ldc = 1024;
          pg8::StaticOrder S; S.init(g.M, g.N, (int)gridDim.x, (int)blockIdx.x); pg8::gemm_phase<EpiPlain, pg8::StaticOrder, false>((PG8_LAS unsigned char*)lds, g, S, E, nullptr); }
        __syncthreads();
        { pg8::Gemm g; g.A = W_xb; g.Bt = W_w_in_t; g.M = T; g.N = INW; g.K = D / 2; EpiIn E; E.hq = W_hq; E.gates = W_gates; E.bgate = p.b_gate;
          pg8::StaticOrder S; S.init(g.M, g.N, (int)gridDim.x, (int)blockIdx.x); pg8::gemm_phase<EpiIn, pg8::StaticOrder, false, true>((PG8_LAS unsigned char*)lds, g, S, E, nullptr); }
    }
    SEAM(1);
    if (PH(2)) { LAUNDER_TID
        LAS unsigned char* L = (LAS unsigned char*)lds;
        attnAB_phase(L, W_hq, p.relb, p.sinks, W_oA, W_lseA, W_yb);
        for (int u = blockIdx.x; u < 256; u += gridDim.x) attnC_unit(u, L, W_hq, W_kvm, W_yc);
        for (int row = gw; row < NEXP / 2; row += nw) cvt_rows_fp8(p.pu, p.pv, W_ub8, W_vb8, W_usc, W_vsc, row, row + NEXP / 2);
    }
    SEAM(2);
    if (PH(3)) { LAUNDER_TID for (size_t i = (size_t)blockIdx.x * NTHREADS + tid; i < (size_t)T * 32; i += (size_t)gridDim.x * NTHREADS) t_mix(i, W_oA, W_lseA, W_ya); }
    SEAM(3);
    if (PH(4)) {
        pg8::MergeArgs g; g.A[0] = W_ya; g.A[1] = W_yb; g.A[2] = W_yc; g.Bt[0] = W_wA_t; g.Bt[1] = W_wB_t; g.Bt[2] = W_wC_t; g.K[0] = 256; g.K[1] = 512; g.K[2] = 512; g.gates = W_gates; g.mb = W_mb;
        pg8::StaticOrder S; S.init(T, D, (int)gridDim.x, (int)blockIdx.x); pg8::gemm_phase_merge<pg8::StaticOrder>((PG8_LAS unsigned char*)lds, g, S);
    }
    SEAM(4);
    if (PH(5)) {
        pg8::Gemm g; g.A = (const bf16_t*)W_mb; g.Bt = W_wout_t; g.M = T; g.N = D; g.K = D / 2; EpiPlain E; E.O = W_z; E.ldc = 1024;
        pg8::StaticOrder S; S.init(g.M, g.N, (int)gridDim.x, (int)blockIdx.x); pg8::gemm_phase<EpiPlain, pg8::StaticOrder, false, true, 123>((PG8_LAS unsigned char*)lds, g, S, E, nullptr);
    }
    SEAM(5);
    if (PH(6)) { LAUNDER_TID int t = gw; for (; t + 3 * nw < T; t += 4 * nw) t_res_ln1<4>((size_t)t, (size_t)nw, p.x, W_z, p.ln1g, p.ln1b, W_x1b);
        for (; t < T; t += nw) t_res_ln1<1>((size_t)t, (size_t)nw, p.x, W_z, p.ln1g, p.ln1b, W_x1b); }
    SEAM(6);
    if (PH(7)) {
        pg8::Gemm g; g.A = W_x1b; g.Bt = W_wq_t; g.M = T; g.N = D; g.K = D; EpiPlain E; E.O = W_qb; E.ldc = 1024;
        pg8::StaticOrder S; S.init(g.M, g.N, (int)gridDim.x, (int)blockIdx.x); pg8::gemm_phase<EpiPlain, pg8::StaticOrder, false>((PG8_LAS unsigned char*)lds, g, S, E, nullptr);
    }
    SEAM(7);
    if (PH(8)) { for (int u = blockIdx.x; u < (T / 256) * 8; u += gridDim.x) topk_unit(u, (LAS unsigned char*)lds, W_qb, W_subkb, W_eidx, W_gate); }
    SEAM(8);
    if (PH(9)) { const int ngrp = (int)(gridDim.x >> 3), tpc = ((T + ngrp - 1) / ngrp + 7) & ~7, sl_tok0 = (int)(blockIdx.x >> 3) * tpc, sl_tok1 = ((int)(blockIdx.x >> 3) < ngrp) ? (sl_tok0 + tpc < T ? sl_tok0 + tpc : T) : 0; peerU_phase((int)(blockIdx.x & 7), sl_tok0, sl_tok1, W_x1b, W_eidx, W_ub8, W_hp); }
    SEAM(9);
    if (PH(10)) { peerR_phase(W_hp, W_eidx, W_gate, W_usc, W_vsc, W_cbuf); }
    SEAM(10);
    if (PH(11)) { const int ngrp = (int)(gridDim.x >> 3), tpc = ((T + ngrp - 1) / ngrp + 7) & ~7, sl_tok0 = (int)(blockIdx.x >> 3) * tpc, sl_tok1 = ((int)(blockIdx.x >> 3) < ngrp) ? (sl_tok0 + tpc < T ? sl_tok0 + tpc : T) : 0; peerV_phase((int)(blockIdx.x & 7), sl_tok0, sl_tok1, W_cbuf, W_eidx, W_vb8, W_yp); }
    SEAM(11);
#ifdef PROBE_EXP
    if (PH(13)) { const int ngrp = (int)(gridDim.x >> 3), tpc = ((T + ngrp - 1) / ngrp + 7) & ~7, sl_tok0 = (int)(blockIdx.x >> 3) * tpc, sl_tok1 = ((int)(blockIdx.x >> 3) < ngrp) ? (sl_tok0 + tpc < T ? sl_tok0 + tpc : T) : 0;
        const int sl = (PROBE_EXP == 0) ? (int)(blockIdx.x & 7) : (int)((blockIdx.x + (blockIdx.x >> 3)) & 7);
#if PROBE_EXP == 20
        for (int rep = 0; rep < 20; ++rep) xcd_barrier(bar); (void)sl; (void)sl_tok0; (void)sl_tok1; }
#elif PROBE_EXP >= 10
        probe_valu((float*)(W_ws + 24 * MiB)); (void)sl; (void)sl_tok0; (void)sl_tok1; }
#else
        probe_gather(sl, sl_tok0, sl_tok1, W_eidx, W_ub8, (float*)(W_ws + 24 * MiB)); }
#endif
#endif
    if (PH(12)) { LAUNDER_TID int t = gw; for (; t + 3 * nw < T; t += 4 * nw) peerL_token<4>((size_t)t, (size_t)nw, W_x1b, W_yp, p.ln2g, p.ln2b, p.out);
        for (; t < T; t += nw) peerL_token<1>((size_t)t, (size_t)nw, W_x1b, W_yp, p.ln2g, p.ln2b, p.out); }
}

#ifndef MK_CUTS
#define MK_CUTS 0
#endif
extern "C" void kernel_launch(void* const* d_in, const int* in_sizes, int n_in, void* d_out, int out_size, void* d_ws, size_t ws_size, hipStream_t stream) {
    if (n_in != 19 || in_sizes[0] != T * D || out_size != T * D || ws_size < WS_END) { fprintf(stderr, "kernel_launch: unexpected shapes / workspace (%d inputs, ws %zu)\n", n_in, ws_size); return; }
    static int grid = 0;
    if (!grid) {
        int dev = 0, cus = 0, per_cu = 0;
        if (hipGetDevice(&dev) != hipSuccess || hipDeviceGetAttribute(&cus, hipDeviceAttributeMultiprocessorCount, dev) != hipSuccess) { fprintf(stderr, "kernel_launch: device query failed\n"); return; }
        if (hipFuncSetAttribute((const void*)mk_fwd, hipFuncAttributeMaxDynamicSharedMemorySize, LDS_BYTES) != hipSuccess) { fprintf(stderr, "kernel_launch: hipFuncSetAttribute failed\n"); return; }
        if (hipOccupancyMaxActiveBlocksPerMultiprocessor(&per_cu, (const void*)mk_fwd, NTHREADS, LDS_BYTES) != hipSuccess || per_cu < 1) { fprintf(stderr, "kernel_launch: occupancy query says %d\n", per_cu); return; }
        grid = cus;
    }
    Params p{};
    p.x = (const float*)d_in[0]; p.mem = (const float*)d_in[1]; p.relb = (const float*)d_in[2]; p.w_in = (const float*)d_in[3]; p.b_gate = (const float*)d_in[4]; p.w_memkv = (const float*)d_in[5];
    p.sinks = (const float*)d_in[6]; p.w_a = (const float*)d_in[7]; p.w_b = (const float*)d_in[8]; p.w_c = (const float*)d_in[9]; p.w_out = (const float*)d_in[10]; p.ln1g = (const float*)d_in[11];
    p.ln1b = (const float*)d_in[12]; p.w_q = (const float*)d_in[13]; p.subk = (const float*)d_in[14]; p.pu = (const float*)d_in[15]; p.pv = (const float*)d_in[16]; p.ln2g = (const float*)d_in[17];
    p.ln2b = (const float*)d_in[18]; p.out = (float*)d_out; p.ws = (char*)d_ws;
    if (hipMemsetAsync((char*)d_ws + WS_CTL, 0, CTL_ZERO_BYTES, stream) != hipSuccess) { fprintf(stderr, "kernel_launch: memset failed\n"); return; }
#if MK_CUTS
    for (int k = 0; k < 13; ++k) { p.lo = k; p.hi = k + 1; hipLaunchKernelGGL(mk_fwd, dim3(grid), dim3(NTHREADS), LDS_BYTES, stream, p); }
#else
#ifdef PROBE_SPLITK
    p.lo = 0; p.hi = PROBE_SPLITK + 1; hipLaunchKernelGGL(mk_fwd, dim3(grid), dim3(NTHREADS), LDS_BYTES, stream, p);
#ifndef PROBE_SPLITK_BASE
    (void)hipMemsetAsync((char*)d_ws + WS_CTL, 0, CTL_ZERO_BYTES, stream);
    p.lo = PROBE_SPLITK; p.hi = PROBE_SPLITK + 1; hipLaunchKernelGGL(mk_fwd, dim3(grid), dim3(NTHREADS), LDS_BYTES, stream, p);
#endif
    (void)hipMemsetAsync((char*)d_ws + WS_CTL, 0, CTL_ZERO_BYTES, stream);
    p.lo = PROBE_SPLITK + 1; p.hi = 13; hipLaunchKernelGGL(mk_fwd, dim3(grid), dim3(NTHREADS), LDS_BYTES, stream, p);
#else
    p.lo = 0; p.hi = 13; hipLaunchKernelGGL(mk_fwd, dim3(grid), dim3(NTHREADS), LDS_BYTES, stream, p);
#endif
#endif
#ifdef PROBE_EXP
    (void)hipMemsetAsync((char*)d_ws + WS_CTL, 0, CTL_ZERO_BYTES, stream);
    p.lo = 13; p.hi = 14; hipLaunchKernelGGL(mk_fwd, dim3(grid), dim3(NTHREADS), LDS_BYTES, stream, p);
#endif
#ifdef PROBE_RELAUNCH
    p.lo = PROBE_RELAUNCH; p.hi = PROBE_RELAUNCH + 1; hipLaunchKernelGGL(mk_fwd, dim3(grid), dim3(NTHREADS), LDS_BYTES, stream, p);
#endif
}
```

```cpp
#include <hip/hip_runtime.h>
#include <cstdio>
#include <cstdint>
namespace pg8 {
#define PG8_LAS __attribute__((address_space(3)))
typedef unsigned short bf16_t;
typedef short bf16x8 __attribute__((ext_vector_type(8)));
typedef float f32x4 __attribute__((ext_vector_type(4)));
typedef unsigned u32x4 __attribute__((ext_vector_type(4)));
constexpr int BM = 256, BK = 64, HALF = 128, HTB = HALF * BK * 2  , STAGE_BYTES = 8 * HTB, NXCD = 8, WGM = 8;

__host__ __device__ __forceinline__ int lds_byte(int r, int c) { const int st = (r >> 4) * 2 + (c >> 5), rr = r & 15, cc = c & 31, ob = rr * 64 + cc * 2; return st * 1024 + (ob ^ (((ob >> 9) & 1) << 5)); }
__host__ __device__ __forceinline__ void stage_rc(int b, int& R, int& C) { const int st = b / 1024, sb = b % 1024, swz = sb ^ (((sb >> 9) & 1) << 5); R = (st >> 1) * 16 + swz / 64; C = (st & 1) * 32 + (swz % 64) / 2; }
__host__ __device__ __forceinline__ int perm32(int rho) { const int n = rho >> 4, i = rho & 15; return 8 * (i >> 2) + 4 * n + (i & 3); }

struct Unit { int pm, pn; };
struct Gemm { const bf16_t* A; const bf16_t* Bt; int M, N, K; };

struct StaticOrder {
    int nM, nN, nwg, G, c;
    __host__ __device__ void init(int M, int N, int G_, int c_) { nM = M / BM; nN = N / BM; nwg = nM * nN; G = G_; c = c_; }
    __host__ __device__ bool next(int i, Unit& u) const {
        const long L = (long)i * G + c; if (L >= nwg) return false;
        int wgid = (int)L; { const int q = nwg / NXCD, r = nwg % NXCD, xcd = wgid % NXCD, off = wgid / NXCD; wgid = (xcd < r ? xcd * (q + 1) : r * (q + 1) + (xcd - r) * q) + off; }
        const int nig = WGM * nN, gid = wgid / nig, fm = gid * WGM, gsz = (nM - fm) < WGM ? (nM - fm) : WGM;
        u.pm = fm + ((wgid % nig) % gsz); u.pn = (wgid % nig) / gsz; return true;
    }
    __device__ __forceinline__ void a_ready(const Unit&) const {}
    __device__ __forceinline__ void done(const Unit&) const {}
};
__device__ __forceinline__ unsigned cvt_pk_bf16(float lo, float hi) { unsigned r; asm volatile("v_cvt_pk_bf16_f32 %0, %1, %2" : "=v"(r) : "v"(lo), "v"(hi)); return r; }
typedef float f32x2 __attribute__((ext_vector_type(2)));
__device__ __forceinline__ f32x2 gelu_pk(f32x2 v) {
    const f32x2 av = __builtin_elementwise_abs(v), d = av * 0.2316418882f + 1.0f;
    f32x2 t; t.x = __builtin_amdgcn_rcpf(d.x); t.y = __builtin_amdgcn_rcpf(d.y);
    f32x2 q = t * 0.5307027145f + (-0.7265760135f); q = q * t + 0.7107068705f; q = q * t + (-0.142248368f); q = q * t + 0.127414796f; q = q * t;
    const f32x2 s = (v * v) * (-0.72134752044f);
    f32x2 e; e.x = __builtin_amdgcn_exp2f(s.x); e.y = __builtin_amdgcn_exp2f(s.y);
    const f32x2 m = v * (q * e), r = v - m;
    f32x2 o; o.x = v.x < 0.f ? m.x : r.x; o.y = v.y < 0.f ? m.y : r.y; return o;
}
template <class Epi, class Sched, bool STAMP = false, bool FP8 = false, int XSCALE = 127>
__device__ __forceinline__ void gemm_phase(PG8_LAS unsigned char* lds, const Gemm g, const Sched& S, const Epi& E, unsigned long long* stamps) {
    int tid_l = threadIdx.x; asm volatile("" : "+v"(tid_l));
    const int tid = tid_l, wid = __builtin_amdgcn_readfirstlane(tid >> 6), lane = tid & 63, wr = wid >> 2, wc = wid & 3, fr = lane & 15, fq = lane >> 4;
    const int K = g.K, nt = K / BK;
    int ts_lo = 0, ts_hi = 0, nts = 0; const unsigned long long rt_entry = STAMP ? (unsigned long long)wall_clock64() : 0ull;
#define PG8_STAMP() do { if (STAMP && wid == 0 && nts < 64) { const unsigned long long _c = (unsigned long long)clock64(); \
        ts_lo = (lane == nts) ? (int)(unsigned)_c : ts_lo; ts_hi = (lane == nts) ? (int)(unsigned)(_c >> 32) : ts_hi; ++nts; } } while (0)
    PG8_STAMP();
    unsigned voffA[2], voffB[2];
#pragma unroll
    for (int i = 0; i < 2; ++i) { int R, C; stage_rc(tid * 16 + i * 8192, R, C); const int Rb = Epi::PERM ? ((R & ~31) + perm32(R & 31)) : R;
        voffA[i] = (unsigned)(R * K + C) * 2u; voffB[i] = (unsigned)(Rb * K + C) * 2u; }
    const size_t kstep = (size_t)(BK * 2);
    const size_t hstep = (size_t)HALF * K * 2;
    const size_t tstep = 2 * hstep;
    const unsigned ldsw = (unsigned)wid * 1024u;
    const int aoff = lds_byte(wr * 64 + fr, fq * 8), boff = lds_byte(wc * 32 + fr, fq * 8);
#define PG8_SA(b, h) (((b) * 2 + (h)) * HTB)
#define PG8_SB(b, h) ((4 + (b) * 2 + (h)) * HTB)
#define PG8_STAGE(bufoff, gbase, voff) do { _Pragma("unroll") for (int _i = 0; _i < 2; ++_i) \
        __builtin_amdgcn_global_load_lds((const unsigned*)((const char*)(gbase) + (voff)[_i]), (PG8_LAS unsigned*)(lds + (bufoff) + ldsw + _i * 8192), 16, 0, 0); } while (0)
#define PG8_LDA(dst, b, h) do { if constexpr (FP8) { _Pragma("unroll") for (int m = 0; m < 4; ++m) dst##8[m] = __builtin_shufflevector(*(const PG8_LAS i32x4_*)(lds + PG8_SA(b, h) + aoff + m * 2048), *(const PG8_LAS i32x4_*)(lds + PG8_SA(b, h) + aoff + m * 2048 + 1024), 0, 1, 2, 3, 4, 5, 6, 7); } \
        else { _Pragma("unroll") for (int m = 0; m < 4; ++m) _Pragma("unroll") for (int k = 0; k < 2; ++k) dst[m][k] = *(const PG8_LAS bf16x8*)(lds + PG8_SA(b, h) + aoff + m * 2048 + k * 1024); } } while (0)
#define PG8_LDB(dst, b, h) do { if constexpr (FP8) { _Pragma("unroll") for (int n = 0; n < 2; ++n) dst##8[n] = __builtin_shufflevector(*(const PG8_LAS i32x4_*)(lds + PG8_SB(b, h) + boff + n * 2048), *(const PG8_LAS i32x4_*)(lds + PG8_SB(b, h) + boff + n * 2048 + 1024), 0, 1, 2, 3, 4, 5, 6, 7); } \
        else { _Pragma("unroll") for (int n = 0; n < 2; ++n) _Pragma("unroll") for (int k = 0; k < 2; ++k) dst[n][k] = *(const PG8_LAS bf16x8*)(lds + PG8_SB(b, h) + boff + n * 2048 + k * 1024); } } while (0)
#define PG8_MMA(ai, bj, At, Bt) do { __builtin_amdgcn_s_setprio(1); _Pragma("unroll") for (int m = 0; m < 4; ++m) _Pragma("unroll") for (int n = 0; n < 2; ++n) { \
        if constexpr (FP8) asm volatile("v_mfma_scale_f32_16x16x128_f8f6f4 %0, %1, %2, %0, %3, %4 op_sel_hi:[0,0,0]" : "+v"(acc[ai][bj][m][n]) : "v"(Bt##8[n]), "v"(At##8[m]), "v"(scale_w), "v"(scale_x));        \
        else { _Pragma("unroll") for (int k = 0; k < 2; ++k) acc[ai][bj][m][n] = __builtin_amdgcn_mfma_f32_16x16x32_bf16(Bt[n][k], At[m][k], acc[ai][bj][m][n], 0, 0, 0); } } \
        __builtin_amdgcn_s_setprio(0); } while (0)
#define PG8_WAIT_V(n) asm volatile("s_waitcnt vmcnt(" #n ")" ::: "memory")
#define PG8_WAIT_L(n) asm volatile("s_waitcnt lgkmcnt(" #n ")" ::: "memory")
#define PG8_BAR __builtin_amdgcn_s_barrier()
#define PG8_SCHED __builtin_amdgcn_sched_barrier(0)
    Unit cur, nxt; int ui = 0;
    if (!S.next(0, cur)) return;
    f32x4 acc[2][2][4][2];
#pragma unroll
    for (int a = 0; a < 2; ++a)
#pragma unroll
        for (int b = 0; b < 2; ++b)
#pragma unroll
            for (int m = 0; m < 4; ++m)
#pragma unroll
                for (int n = 0; n < 2; ++n) acc[a][b][m][n] = (f32x4){0.f, 0.f, 0.f, 0.f};
    typedef int i32x4_ __attribute__((ext_vector_type(4))); typedef int i32x8_ __attribute__((ext_vector_type(8)));
    int scale_w = 122, scale_x = XSCALE; asm volatile("" : "+v"(scale_w), "+v"(scale_x));
    bf16x8 At[4][2], B0[2][2], B1[2][2]; i32x8_ At8[4], B08[2], B18[2];
    const char* cA = (const char*)g.A + (size_t)cur.pm * tstep; const char* cB = (const char*)g.Bt + (size_t)cur.pn * tstep;
    S.a_ready(cur);
    PG8_STAGE(PG8_SB(0, 0), cB, voffB); PG8_STAGE(PG8_SA(0, 0), cA, voffA); PG8_STAGE(PG8_SB(0, 1), cB + hstep, voffB); PG8_STAGE(PG8_SA(0, 1), cA + hstep, voffA);
    if (wr == 1) PG8_BAR;
    PG8_WAIT_V(4); PG8_BAR;
    PG8_STAGE(PG8_SB(1, 0), cB + kstep, voffB); PG8_STAGE(PG8_SA(1, 0), cA + kstep, voffA); PG8_STAGE(PG8_SB(1, 1), cB + hstep + kstep, voffB);
    PG8_WAIT_V(6); PG8_BAR;
    PG8_STAMP();
    for (;;) {
        const bool has_next = S.next(ui + 1, nxt);
        const char* nA = has_next ? (const char*)g.A + (size_t)nxt.pm * tstep : cA; const char* nB = has_next ? (const char*)g.Bt + (size_t)nxt.pn * tstep : cB;
        for (int t = 0; t < nt; t += 2) {
            const bool last = (t == nt - 2);
            const char* a1 = cA + (size_t)(t + 1) * kstep;
            const char* a2 = last ? nA : cA + (size_t)(t + 2) * kstep; const char* b2 = last ? nB : cB + (size_t)(t + 2) * kstep;
            const char* a3 = a2 + kstep; const char* b3 = b2 + kstep;
            if (last && has_next) S.a_ready(nxt);
            PG8_LDB(B0, 0, 0); PG8_SCHED; PG8_LDA(At, 0, 0); PG8_STAGE(PG8_SA(1, 1), a1 + hstep, voffA);
            PG8_WAIT_L(8); PG8_BAR; PG8_WAIT_L(0); PG8_MMA(0, 0, At, B0); PG8_BAR; PG8_SCHED;
            PG8_LDB(B1, 0, 1); PG8_STAGE(PG8_SB(0, 0), b2, voffB);
            PG8_BAR; PG8_WAIT_L(0); PG8_MMA(0, 1, At, B1); PG8_BAR;
            PG8_LDA(At, 0, 1); PG8_STAGE(PG8_SA(0, 0), a2, voffA);
            PG8_BAR; PG8_WAIT_L(0); PG8_MMA(1, 0, At, B0); PG8_BAR; PG8_SCHED;
            PG8_STAGE(PG8_SB(0, 1), b2 + hstep, voffB);
            PG8_WAIT_V(6); PG8_BAR; PG8_MMA(1, 1, At, B1); PG8_BAR;
            PG8_LDB(B0, 1, 0); PG8_SCHED; PG8_LDA(At, 1, 0); PG8_STAGE(PG8_SA(0, 1), a2 + hstep, voffA);
            PG8_WAIT_L(8); PG8_BAR; PG8_WAIT_L(0); PG8_MMA(0, 0, At, B0); PG8_BAR; PG8_SCHED;
            PG8_LDB(B1, 1, 1); PG8_STAGE(PG8_SB(1, 0), b3, voffB);
            PG8_BAR; PG8_WAIT_L(0); PG8_MMA(0, 1, At, B1); PG8_BAR;
            PG8_LDA(At, 1, 1); PG8_STAGE(PG8_SA(1, 0), a3, voffA);
            PG8_BAR; PG8_WAIT_L(0); PG8_MMA(1, 0, At, B0); PG8_BAR; PG8_SCHED;
            PG8_STAGE(PG8_SB(1, 1), b3 + hstep, voffB);
            PG8_WAIT_V(6); PG8_BAR; PG8_MMA(1, 1, At, B1); PG8_BAR;
        }
        PG8_STAMP();
        if constexpr (FP8) { asm volatile("s_nop 15\n\ts_nop 15" ::: "memory");
#pragma unroll
            for (int a = 0; a < 2; ++a)
#pragma unroll
                for (int b = 0; b < 2; ++b)
#pragma unroll
                    for (int m = 0; m < 4; ++m)
#pragma unroll
                        for (int n = 0; n < 2; ++n) asm volatile("" : "+v"(acc[a][b][m][n])); }
        if constexpr (!Epi::AFTER_DRAIN) { E(acc, cur, wr, wc, fr, fq); S.done(cur); }
        PG8_STAMP();
        if (!has_next) break;
#pragma unroll
        for (int a = 0; a < 2; ++a)
#pragma unroll
            for (int b = 0; b < 2; ++b)
#pragma unroll
                for (int m = 0; m < 4; ++m)
#pragma unroll
                    for (int n = 0; n < 2; ++n) acc[a][b][m][n] = (f32x4){0.f, 0.f, 0.f, 0.f};
        cur = nxt; cA = nA; cB = nB; ++ui;
    }
    PG8_WAIT_V(0);
    if (wr == 0) PG8_BAR;
    PG8_BAR;
    if constexpr (Epi::AFTER_DRAIN) { E.fused(acc, cur, wr, wc, fr, fq, lds, wid, lane); S.done(cur); }
    PG8_STAMP();
    if (STAMP && wid == 0) { stamps[lane] = lane < nts ? (((unsigned long long)(unsigned)ts_hi << 32) | (unsigned)ts_lo) : 0ull;
        if (lane == 62) stamps[62] = rt_entry; if (lane == 63) stamps[63] = (unsigned long long)wall_clock64(); }
#undef PG8_STAMP
#undef PG8_SA
#undef PG8_SB
#undef PG8_STAGE
#undef PG8_LDA
#undef PG8_LDB
#undef PG8_MMA
#undef PG8_WAIT_V
#undef PG8_WAIT_L
#undef PG8_BAR
#undef PG8_SCHED
}
}

namespace pg8 {
struct MergeArgs { const bf16_t* A[3]; const bf16_t* Bt[3]; int K[3]; const bf16_t* gates; unsigned char* mb; };
template <class Sched, bool FP8 = false>
__device__ __forceinline__ void gemm_phase_merge(PG8_LAS unsigned char* lds, const MergeArgs g, const Sched& S) {
    int tid_l = threadIdx.x; asm volatile("" : "+v"(tid_l));
    const int tid = tid_l, wid = __builtin_amdgcn_readfirstlane(tid >> 6), lane = tid & 63, wr = wid >> 2, wc = wid & 3, fr = lane & 15, fq = lane >> 4;
    unsigned R2A[2], R2B[2], C2[2];
#pragma unroll
    for (int i = 0; i < 2; ++i) { int R, C; stage_rc(tid * 16 + i * 8192, R, C); const int Rb = (R & ~31) + perm32(R & 31); R2A[i] = (unsigned)R * 2u; R2B[i] = (unsigned)Rb * 2u; C2[i] = (unsigned)C * 2u; }
    const size_t kstep = (size_t)(BK * 2);
    const unsigned ldsw = (unsigned)wid * 1024u;
    const int aoff = lds_byte(wr * 64 + fr, fq * 8), boff = lds_byte(wc * 32 + fr, fq * 8);
#define PG8_SA(b, h) (((b) * 2 + (h)) * HTB)
#define PG8_SB(b, h) ((4 + (b) * 2 + (h)) * HTB)
#define PG8_STAGEK(bufoff, gbase, R2, KK) do { _Pragma("unroll") for (int _i = 0; _i < 2; ++_i) \
        __builtin_amdgcn_global_load_lds((const unsigned*)((const char*)(gbase) + (R2)[_i] * (unsigned)(KK) + C2[_i]), (PG8_LAS unsigned*)(lds + (bufoff) + ldsw + _i * 8192), 16, 0, 0); } while (0)
#define PG8_LDA(dst, b, h) do { if constexpr (FP8) { _Pragma("unroll") for (int m = 0; m < 4; ++m) dst##8[m] = __builtin_shufflevector(*(const PG8_LAS i32x4_*)(lds + PG8_SA(b, h) + aoff + m * 2048), *(const PG8_LAS i32x4_*)(lds + PG8_SA(b, h) + aoff + m * 2048 + 1024), 0, 1, 2, 3, 4, 5, 6, 7); } \
        else { _Pragma("unroll") for (int m = 0; m < 4; ++m) _Pragma("unroll") for (int k = 0; k < 2; ++k) dst[m][k] = *(const PG8_LAS bf16x8*)(lds + PG8_SA(b, h) + aoff + m * 2048 + k * 1024); } } while (0)
#define PG8_LDB(dst, b, h) do { if constexpr (FP8) { _Pragma("unroll") for (int n = 0; n < 2; ++n) dst##8[n] = __builtin_shufflevector(*(const PG8_LAS i32x4_*)(lds + PG8_SB(b, h) + boff + n * 2048), *(const PG8_LAS i32x4_*)(lds + PG8_SB(b, h) + boff + n * 2048 + 1024), 0, 1, 2, 3, 4, 5, 6, 7); } \
        else { _Pragma("unroll") for (int n = 0; n < 2; ++n) _Pragma("unroll") for (int k = 0; k < 2; ++k) dst[n][k] = *(const PG8_LAS bf16x8*)(lds + PG8_SB(b, h) + boff + n * 2048 + k * 1024); } } while (0)
#define PG8_MMA(ai, bj, At, Bt) do { __builtin_amdgcn_s_setprio(1); _Pragma("unroll") for (int m = 0; m < 4; ++m) _Pragma("unroll") for (int n = 0; n < 2; ++n) { \
        if constexpr (FP8) asm volatile("v_mfma_scale_f32_16x16x128_f8f6f4 %0, %1, %2, %0, %3, %4 op_sel_hi:[0,0,0]" : "+v"(acc[ai][bj][m][n]) : "v"(Bt##8[n]), "v"(At##8[m]), "v"(scale_w), "v"(scale_x)); \
        else { _Pragma("unroll") for (int k = 0; k < 2; ++k) acc[ai][bj][m][n] = __builtin_amdgcn_mfma_f32_16x16x32_bf16(Bt[n][k], At[m][k], acc[ai][bj][m][n], 0, 0, 0); } } \
        __builtin_amdgcn_s_setprio(0); } while (0)
#define PG8_WAIT_V(n) asm volatile("s_waitcnt vmcnt(" #n ")" ::: "memory")
#define PG8_WAIT_L(n) asm volatile("s_waitcnt lgkmcnt(" #n ")" ::: "memory")
#define PG8_BAR __builtin_amdgcn_s_barrier()
#define PG8_SCHED __builtin_amdgcn_sched_barrier(0)
    Unit cur, nxt; int ui = 0, seg = 0;
    if (!S.next(0, cur)) return;
    f32x4 acc[2][2][4][2];
#pragma unroll
    for (int a = 0; a < 2; ++a)
#pragma unroll
        for (int b = 0; b < 2; ++b)
#pragma unroll
            for (int m = 0; m < 4; ++m)
#pragma unroll
                for (int n = 0; n < 2; ++n) acc[a][b][m][n] = (f32x4){0.f, 0.f, 0.f, 0.f};
    typedef int i32x4_ __attribute__((ext_vector_type(4))); typedef int i32x8_ __attribute__((ext_vector_type(8)));
    int scale_w = 122, scale_x = 123; asm volatile("" : "+v"(scale_w), "+v"(scale_x));
    bf16x8 At[4][2], B0[2][2], B1[2][2]; i32x8_ At8[4], B08[2], B18[2];
    int Kc = g.K[0];
    const char* cA = (const char*)g.A[0] + (size_t)cur.pm * 512 * Kc; const char* cB = (const char*)g.Bt[0] + (size_t)cur.pn * 512 * Kc;
    {   const size_t hs = (size_t)256 * Kc;
        PG8_STAGEK(PG8_SB(0, 0), cB, R2B, Kc); PG8_STAGEK(PG8_SA(0, 0), cA, R2A, Kc); PG8_STAGEK(PG8_SB(0, 1), cB + hs, R2B, Kc); PG8_STAGEK(PG8_SA(0, 1), cA + hs, R2A, Kc);
        if (wr == 1) PG8_BAR;
        PG8_WAIT_V(4); PG8_BAR;
        PG8_STAGEK(PG8_SB(1, 0), cB + kstep, R2B, Kc); PG8_STAGEK(PG8_SA(1, 0), cA + kstep, R2A, Kc); PG8_STAGEK(PG8_SB(1, 1), cB + hs + kstep, R2B, Kc);
        PG8_WAIT_V(6); PG8_BAR; }
    for (;;) {
        bool has_next_tile = false; int nseg = seg + 1; Unit nu = cur;
        if (nseg == 3) { nseg = 0; has_next_tile = S.next(ui + 1, nxt); nu = nxt; }
        const bool more = (seg < 2) || has_next_tile;
        const int Kn = more ? (nseg == 0 ? g.K[0] : (nseg == 1 ? g.K[1] : g.K[2])) : Kc;
        const bf16_t* gA = nseg == 0 ? g.A[0] : (nseg == 1 ? g.A[1] : g.A[2]); const bf16_t* gB = nseg == 0 ? g.Bt[0] : (nseg == 1 ? g.Bt[1] : g.Bt[2]);
        const char* nA = more ? (const char*)gA + (size_t)nu.pm * 512 * Kn : cA; const char* nB = more ? (const char*)gB + (size_t)nu.pn * 512 * Kn : cB;
        const int nt = Kc / BK; const size_t hsc = (size_t)256 * Kc, hsn = (size_t)256 * Kn;
        for (int t = 0; t < nt; t += 2) {
            const bool last = (t == nt - 2);
            const char* a1 = cA + (size_t)(t + 1) * kstep;
            const char* a2 = last ? nA : cA + (size_t)(t + 2) * kstep; const char* b2 = last ? nB : cB + (size_t)(t + 2) * kstep;
            const char* a3 = a2 + kstep; const char* b3 = b2 + kstep;
            const int K2 = last ? Kn : Kc; const size_t hs2 = last ? hsn : hsc;
            PG8_LDB(B0, 0, 0); PG8_SCHED; PG8_LDA(At, 0, 0); PG8_STAGEK(PG8_SA(1, 1), a1 + hsc, R2A, Kc);
            PG8_WAIT_L(8); PG8_BAR; PG8_WAIT_L(0); PG8_MMA(0, 0, At, B0); PG8_BAR; PG8_SCHED;
            PG8_LDB(B1, 0, 1); PG8_STAGEK(PG8_SB(0, 0), b2, R2B, K2);
            PG8_BAR; PG8_WAIT_L(0); PG8_MMA(0, 1, At, B1); PG8_BAR;
            PG8_LDA(At, 0, 1); PG8_STAGEK(PG8_SA(0, 0), a2, R2A, K2);
            PG8_BAR; PG8_WAIT_L(0); PG8_MMA(1, 0, At, B0); PG8_BAR; PG8_SCHED;
            PG8_STAGEK(PG8_SB(0, 1), b2 + hs2, R2B, K2);
            PG8_WAIT_V(6); PG8_BAR; PG8_MMA(1, 1, At, B1); PG8_BAR;
            PG8_LDB(B0, 1, 0); PG8_SCHED; PG8_LDA(At, 1, 0); PG8_STAGEK(PG8_SA(0, 1), a2 + hs2, R2A, K2);
            PG8_WAIT_L(8); PG8_BAR; PG8_WAIT_L(0); PG8_MMA(0, 0, At, B0); PG8_BAR; PG8_SCHED;
            PG8_LDB(B1, 1, 1); PG8_STAGEK(PG8_SB(1, 0), b3, R2B, K2);
            PG8_BAR; PG8_WAIT_L(0); PG8_MMA(0, 1, At, B1); PG8_BAR;
            PG8_LDA(At, 1, 1); PG8_STAGEK(PG8_SA(1, 0), a3, R2A, K2);
            PG8_BAR; PG8_WAIT_L(0); PG8_MMA(1, 0, At, B0); PG8_BAR; PG8_SCHED;
            PG8_STAGEK(PG8_SB(1, 1), b3 + hs2, R2B, K2);
            PG8_WAIT_V(6); PG8_BAR; PG8_MMA(1, 1, At, B1); PG8_BAR;
        }
        if constexpr (FP8) { asm volatile("s_nop 15\n\ts_nop 15" ::: "memory");
#pragma unroll
            for (int a = 0; a < 2; ++a)
#pragma unroll
                for (int b = 0; b < 2; ++b)
#pragma unroll
                    for (int mm = 0; mm < 4; ++mm)
#pragma unroll
                        for (int n = 0; n < 2; ++n) asm volatile("" : "+v"(acc[a][b][mm][n])); }
        {   const int row0 = cur.pm * 256 + wr * 64 + fr, col0 = cur.pn * 256 + wc * 32 + 8 * fq;
            const bf16_t* gb_s = g.gates + ((size_t)(seg * 128 + cur.pm) * 4 + cur.pn) * 65536 + (size_t)tid * 8;
            const bf16_t* gb_n = gb_s + (size_t)128 * 4 * 65536;
            u32x4 GS[2][4], GN[2][4];
#define MRG_LOAD(buf, bt) do { _Pragma("unroll") for (int c = 0; c < 4; ++c) { GS[buf][c] = *(const u32x4*)(gb_s + (size_t)(((bt) * 4 + c) * 512) * 8); \
                GN[buf][c] = (seg < 2) ? *(const u32x4*)(gb_n + (size_t)(((bt) * 4 + c) * 512) * 8) : (u32x4){0x3f803f80u, 0x3f803f80u, 0x3f803f80u, 0x3f803f80u}; } } while (0)
#define MRG_APPLY(buf, bt) do { _Pragma("unroll") for (int c = 0; c < 4; ++c) { const int idx = (bt) * 4 + c, ai = idx >> 3, m = (idx >> 1) & 3, bj = idx & 1; \
                const u32x4 gs = GS[buf][c], gn = GN[buf][c]; \
                float f[8] = {__uint_as_float(gs.x << 16), __uint_as_float(gs.x & 0xffff0000u), __uint_as_float(gs.y << 16), __uint_as_float(gs.y & 0xffff0000u), \
                              __uint_as_float(gs.z << 16), __uint_as_float(gs.z & 0xffff0000u), __uint_as_float(gs.w << 16), __uint_as_float(gs.w & 0xffff0000u)}; \
                const float d[8] = {__uint_as_float(gn.x << 16), __uint_as_float(gn.x & 0xffff0000u), __uint_as_float(gn.y << 16), __uint_as_float(gn.y & 0xffff0000u), \
                                    __uint_as_float(gn.z << 16), __uint_as_float(gn.z & 0xffff0000u), __uint_as_float(gn.w << 16), __uint_as_float(gn.w & 0xffff0000u)}; \
                _Pragma("unroll") for (int j = 0; j < 8; ++j) f[j] = f[j] * __builtin_amdgcn_rcpf(fmaxf(d[j], 1e-20f)); \
                f32x4 v0 = acc[ai][bj][m][0], v1 = acc[ai][bj][m][1]; \
                v0[0] *= f[0]; v0[1] *= f[1]; v0[2] *= f[2]; v0[3] *= f[3]; v1[0] *= f[4]; v1[1] *= f[5]; v1[2] *= f[6]; v1[3] *= f[7]; \
                if (seg < 2) { acc[ai][bj][m][0] = v0; acc[ai][bj][m][1] = v1; } \
                else { typedef unsigned u32x2_ __attribute__((ext_vector_type(2))); u32x2_ w; int t8 = 0; t8 = __builtin_amdgcn_cvt_pk_fp8_f32(v0[0] * 16.f, v0[1] * 16.f, t8, false); t8 = __builtin_amdgcn_cvt_pk_fp8_f32(v0[2] * 16.f, v0[3] * 16.f, t8, true); w.x = (unsigned)t8; \
                    t8 = 0; t8 = __builtin_amdgcn_cvt_pk_fp8_f32(v1[0] * 16.f, v1[1] * 16.f, t8, false); t8 = __builtin_amdgcn_cvt_pk_fp8_f32(v1[2] * 16.f, v1[3] * 16.f, t8, true); w.y = (unsigned)t8; \
                    *(u32x2_*)(g.mb + (size_t)(row0 + ai * 128 + m * 16) * 1024 + col0 + bj * 128) = w;        \
                    acc[ai][bj][m][0] = (f32x4){0.f, 0.f, 0.f, 0.f}; acc[ai][bj][m][1] = (f32x4){0.f, 0.f, 0.f, 0.f}; } } } while (0)
            MRG_LOAD(0, 0);
#pragma unroll
            for (int bt = 0; bt < 4; bt += 2) {
                MRG_LOAD(1, bt + 1); asm volatile("" ::: "memory"); MRG_APPLY(0, bt);
                if (bt + 2 < 4) { MRG_LOAD(0, bt + 2); } asm volatile("" ::: "memory"); MRG_APPLY(1, bt + 1); }
#undef MRG_LOAD
#undef MRG_APPLY
        }
        if (!more) break;
        if (nseg == 0) { cur = nxt; ++ui; }
        seg = nseg; Kc = Kn; cA = nA; cB = nB;
    }
    PG8_WAIT_V(0);
    if (wr == 0) PG8_BAR;
    PG8_BAR;
#undef PG8_SA
#undef PG8_SB
#undef PG8_STAGEK
#undef PG8_LDA
#undef PG8_LDB
#undef PG8_MMA
#undef PG8_WAIT_V
#undef PG8_WAIT_L
#undef PG8_BAR
#undef PG8_SCHED
}
}
#define XB_TMO      128
#define XB_XCNT(j)  (256  + 64 * (j))
#define XB_XSUB(j)  (1280 + 64 * (j))
#define XB_XGEN(j)  (2304 + 64 * (j))
#define XB_TOP      3328
#define XB_TOPGEN   3392
#define XCD_BAR_WORDS 3456
#define XB_SPIN_CAP (1u << 18)
#define LAS __attribute__((address_space(3)))

__device__ __forceinline__ unsigned xb_ld(unsigned* p)              { return __hip_atomic_load(p, __ATOMIC_RELAXED, __HIP_MEMORY_SCOPE_AGENT); }
__device__ __forceinline__ unsigned xb_add(unsigned* p, unsigned v) { return __hip_atomic_fetch_add(p, v, __ATOMIC_RELAXED, __HIP_MEMORY_SCOPE_AGENT); }
__device__ __forceinline__ unsigned xb_xcc_id() { return (unsigned)__builtin_amdgcn_s_getreg((3 << 11) | 20) & 0xFu; }
#define XB_SPIN(cond, bar) do { unsigned _sp = 0; while (cond) { __builtin_amdgcn_s_sleep(1); \
    if ((++_sp & 255u) == 0u) { if (xb_ld(&(bar)[XB_TMO])) break; if (_sp > XB_SPIN_CAP) { atomicAdd(&(bar)[XB_TMO], 1u); break; } } } } while (0)

struct XcdBarrier {
    unsigned* bar; unsigned x;
    volatile LAS unsigned* st;
};

__device__ __forceinline__ XcdBarrier xcd_barrier_post(unsigned* bar, volatile LAS unsigned* st) {
    XcdBarrier b; b.bar = bar; b.x = xb_xcc_id(); b.st = st;
    if (threadIdx.x == 0) (void)xb_add(&bar[XB_XCNT(b.x)], 1u);
    return b;
}
__device__ __forceinline__ void xcd_barrier_complete(unsigned* bar, unsigned x, unsigned& nloc, unsigned& nx) {
    const unsigned G = gridDim.x * gridDim.y * gridDim.z;
    unsigned sum, cnt, mine, sp = 0u;
    for (;;) {
        sum = 0u; cnt = 0u; mine = 0u;
#pragma unroll
        for (unsigned j = 0; j < 16; ++j) { const unsigned c = xb_ld(&bar[XB_XCNT(j)]); sum += c; cnt += (c > 0u) ? 1u : 0u; mine = (j == x) ? c : mine; }
        if (sum == G) break;
        __builtin_amdgcn_s_sleep(1);
        if ((++sp & 255u) == 0u) { if (xb_ld(&bar[XB_TMO])) break; if (sp > XB_SPIN_CAP) { atomicAdd(&bar[XB_TMO], 1u); break; } }
    }
    nloc = mine > 0u ? mine : 1u; nx = cnt > 0u ? cnt : 1u;
}

__device__ __forceinline__ void xcd_barrier(const XcdBarrier& b) {
    asm volatile("s_waitcnt vmcnt(0)" ::: "memory");
    __syncthreads();
    if (threadIdx.x == 0) {
        unsigned* bar = b.bar;
        __builtin_amdgcn_s_waitcnt(0);
        unsigned nloc = b.st[0], nx = b.st[1];
        if (nloc == 0u) { xcd_barrier_complete(bar, b.x, nloc, nx); b.st[0] = nloc; b.st[1] = nx; }
        const unsigned old = xb_add(&bar[XB_XSUB(b.x)], 1u);
        const unsigned gen = old / nloc;
        if (old + 1u == (gen + 1u) * nloc) {
            __builtin_amdgcn_fence(__ATOMIC_RELEASE, "agent");
            asm volatile("s_waitcnt vmcnt(0)" ::: "memory");
            const unsigned og = xb_add(&bar[XB_TOP], 1u);
            const unsigned tg = og / nx;
            if (og + 1u == (tg + 1u) * nx) xb_add(&bar[XB_TOPGEN], 1u);
            else XB_SPIN(xb_ld(&bar[XB_TOPGEN]) == tg, bar);
            __builtin_amdgcn_fence(__ATOMIC_ACQUIRE, "agent");
            xb_add(&bar[XB_XGEN(b.x)], 1u);
            asm volatile("s_waitcnt vmcnt(0)" ::: "memory");
        } else {
            XB_SPIN(xb_ld(&bar[XB_XGEN(b.x)]) == gen, bar);
            __builtin_amdgcn_fence(__ATOMIC_ACQUIRE, "agent");
            asm volatile("s_waitcnt vmcnt(0)" ::: "memory");
        }
    }
    __syncthreads();
}


typedef unsigned short bf16_t;
typedef float f32x4 __attribute__((ext_vector_type(4)));
typedef unsigned u32x4 __attribute__((ext_vector_type(4)));
typedef unsigned u32x2 __attribute__((ext_vector_type(2)));
typedef __bf16 bf16x2_t __attribute__((ext_vector_type(2)));
constexpr int D = 1024, BATCH = 8, SEQ = 4096, T = BATCH * SEQ, MEMLEN = 256;
constexpr int HQW = 3584, GW = 3072, INW = 6656, NEXP = 16384;
constexpr int C_AQ = 0, C_AK = 768, C_AV = 1536, C_BQ = 2304, C_BK = 2816, C_BV = 2944, C_CQ = 3072;
constexpr float ALPHA = 1.189207115002721f, LOG2E = 1.4426950408889634f, LN2F = 0.6931471805599453f, LN_EPS = 1e-5f, NEGBIG = -1e30f;
constexpr size_t MiB = 1u << 20;
#ifndef DBG_CHECK
#define DBG_CHECK 0
#endif
#ifndef DBG_DROP
#define DBG_DROP 0
#endif
constexpr size_t WS_CTL = 0, WS_WMEMKV = 1 * MiB, WS_WA = 3 * MiB, WS_WB = WS_WA + MiB / 2, WS_WC = WS_WB + MiB, WS_WOUT = WS_WC + MiB, WS_WQ = WS_WOUT + 2 * MiB,
                 WS_SUBK = WS_WQ + 2 * MiB, WS_MEMB = 10 * MiB, WS_KVM = 14 * MiB, WS_STATS = 18 * MiB, WS_LSE = 19 * MiB;
constexpr size_t WS_RA = 24 * MiB, WS_RB = 248 * MiB, WS_RC = 440 * MiB, WS_END = 504 * MiB;
constexpr size_t WS_HQ = WS_RA, WS_GATES = WS_RB, WS_XB = WS_RC;
constexpr size_t WS_MF = WS_RA, WS_MB = WS_RA + 128 * MiB;
constexpr size_t WS_Z = WS_RB, WS_X1B = WS_RB + 128 * MiB;
constexpr size_t WS_Q = WS_RA, WS_EIDX = WS_RA + 88 * MiB - 24 * MiB, WS_GATE = WS_EIDX + 16 * MiB;
constexpr size_t WS_UB = WS_RC, WS_VB = WS_RC + 32 * MiB;
constexpr size_t DO_WINT = 0;
constexpr size_t DO_OA = 0, DO_YB = 48 * MiB, DO_YC = 80 * MiB, DO_YA = 112 * MiB;

__device__ __forceinline__ size_t hq_off64(int slot, size_t tok) { return ((size_t)slot * T + tok) * 64; }
__device__ __forceinline__ size_t hq_offc(int head, size_t tok) { return (size_t)48 * T * 64 + ((size_t)head * T + tok) * 128; }
__device__ const unsigned char kBucket[3][132] = {
{0,1,2,3,4,5,6,7,8,9,10,11,12,13,14,15,16,16,16,16,16,16,17,17,17,17,17,17,17,17,18,18,18,18,18,18,18,18,18,18,19,19,19,19,19,19,19,19,19,19,19,19,19,19,20,20,20,20,20,20,20,20,20,20,20,20,20,20,20,20,20,20,20,21,21,21,21,21,21,21,21,21,21,21,21,21,21,21,21,21,21,21,21,21,21,21,21,21,21,22,22,22,22,22,22,22,22,22,22,22,22,22,22,22,22,22,22,22,22,22,22,22,22,22,22,22,22,22,22,22,22,22},
{0,4,8,12,16,16,17,17,18,18,19,19,19,19,20,20,20,20,20,21,21,21,21,21,21,22,22,22,22,22,22,22,22,22,23,23,23,23,23,23,23,23,23,23,23,23,24,24,24,24,24,24,24,24,24,24,24,24,24,24,24,24,25,25,25,25,25,25,25,25,25,25,25,25,25,25,25,25,25,25,25,25,25,26,26,26,26,26,26,26,26,26,26,26,26,26,26,26,26,26,26,26,26,26,26,26,26,26,26,26,26,26,26,27,27,27,27,27,27,27,27,27,27,27,27,27,27,27,27,27,27,27},
{0,16,18,19,20,21,21,22,22,23,23,23,24,24,24,24,25,25,25,25,25,26,26,26,26,26,26,26,26,27,27,27,27,27,27,27,27,27,27,28,28,28,28,28,28,28,28,28,28,28,28,28,29,29,29,29,29,29,29,29,29,29,29,29,29,29,29,29,29,29,30,30,30,30,30,30,30,30,30,30,30,30,30,30,30,30,30,30,30,30,30,30,30,30,30,31,31,31,31,31,31,31,31,31,31,31,31,31,31,31,31,31,31,31,31,31,31,31,31,31,31,31,31,31,31,31,31,31,31,31,31,31}};

__device__ __forceinline__ bf16_t f2bf(float x) { unsigned u = __float_as_uint(x); u += 0x7fffu + ((u >> 16) & 1u); return (bf16_t)(u >> 16); }
__device__ __forceinline__ float bf2f(bf16_t h) { return __uint_as_float((unsigned)h << 16); }
__device__ __forceinline__ float bflo(unsigned w) { return __uint_as_float(w << 16); }
__device__ __forceinline__ float bfhi(unsigned w) { return __uint_as_float(w & 0xffff0000u); }
__device__ __forceinline__ unsigned pk2(float lo, float hi) { bf16x2_t v; v.x = (__bf16)lo; v.y = (__bf16)hi; return __builtin_bit_cast(unsigned, v); }
__device__ __forceinline__ float dot2bf(unsigned a, unsigned b, float acc) { return __builtin_amdgcn_fdot2_f32_bf16(__builtin_bit_cast(bf16x2_t, a), __builtin_bit_cast(bf16x2_t, b), acc, false); }
__device__ __forceinline__ float wave_sum(float v) { for (int o = 32; o >= 1; o >>= 1) v += __shfl_xor(v, o, 64); return v; }
__device__ __forceinline__ float wave_max(float v) { for (int o = 32; o >= 1; o >>= 1) v = fmaxf(v, __shfl_xor(v, o, 64)); return v; }

struct EpiIn {
    static constexpr bool PERM = true, AFTER_DRAIN = false;
    bf16_t* hq; bf16_t* gates; const float* bgate;
    __device__ __forceinline__ void operator()(const pg8::f32x4 (&acc)[2][2][4][2], const pg8::Unit& u, int wr, int wc, int fr, int fq) const {
        const int row0 = u.pm * 256 + wr * 64 + fr;
        if (u.pn < 14) {
            const float sc = (u.pn < 3 || u.pn == 9 || u.pn == 10) ? 0.125f * LOG2E : ((u.pn >= 12) ? 0.08838834764831845f * LOG2E : 1.0f);
            const int col0 = u.pn * 256 + wc * 32 + 8 * fq;
#pragma unroll
            for (int ai = 0; ai < 2; ++ai)
#pragma unroll
                for (int m = 0; m < 4; ++m) { const size_t tok = (size_t)(row0 + ai * 128 + m * 16);
#pragma unroll
                    for (int bj = 0; bj < 2; ++bj) { const pg8::f32x4 v0 = acc[ai][bj][m][0] * sc, v1 = acc[ai][bj][m][1] * sc; const int col = col0 + bj * 128;
                        u32x4 w; w.x = pk2(v0[0], v0[1]); w.y = pk2(v0[2], v0[3]); w.z = pk2(v1[0], v1[1]); w.w = pk2(v1[2], v1[3]);
                        bf16_t* dst = (col < 3072) ? hq + hq_off64(col >> 6, tok) + (col & 63) : hq + hq_offc((col - 3072) >> 7, tok) + ((col - 3072) & 127);
                        *(u32x4*)dst = w; } }
        } else {
            const int gi = u.pn - 14, s = gi >> 2, pn = gi & 3, col0 = gi * 256 + wc * 32 + 8 * fq, tid = (wr * 4 + wc) * 64 + fq * 16 + fr;
            bf16_t* blk = gates + ((size_t)(s * 128 + u.pm) * 4 + pn) * 65536 + (size_t)tid * 8;
            pg8::f32x4 bv[2][2];
#pragma unroll
            for (int bj = 0; bj < 2; ++bj)
#pragma unroll
                for (int n = 0; n < 2; ++n) bv[bj][n] = *(const pg8::f32x4*)(bgate + col0 + bj * 128 + 4 * n);
#pragma unroll
            for (int ai = 0; ai < 2; ++ai)
#pragma unroll
                for (int m = 0; m < 4; ++m) {
#pragma unroll
                    for (int bj = 0; bj < 2; ++bj) { pg8::f32x4 v0 = acc[ai][bj][m][0] + bv[bj][0], v1 = acc[ai][bj][m][1] + bv[bj][1];
#pragma unroll
                        for (int j = 0; j < 4; ++j) { v0[j] = __builtin_amdgcn_rcpf(1.0f + __builtin_amdgcn_exp2f(-LOG2E * v0[j])); v1[j] = __builtin_amdgcn_rcpf(1.0f + __builtin_amdgcn_exp2f(-LOG2E * v1[j])); }
                        u32x4 w; w.x = pk2(v0[0], v0[1]); w.y = pk2(v0[2], v0[3]); w.z = pk2(v1[0], v1[1]); w.w = pk2(v1[2], v1[3]);
                        *(u32x4*)(blk + (size_t)(((ai * 4 + m) * 2 + bj) * 512) * 8) = w; } }
        }
    }
};
struct EpiPlain {
    static constexpr bool PERM = true, AFTER_DRAIN = false;
    bf16_t* O; int ldc;
    __device__ __forceinline__ void operator()(const pg8::f32x4 (&acc)[2][2][4][2], const pg8::Unit& u, int wr, int wc, int fr, int fq) const {
        const int row0 = u.pm * 256 + wr * 64 + fr, col0 = u.pn * 256 + wc * 32 + 8 * fq;
#pragma unroll
        for (int ai = 0; ai < 2; ++ai)
#pragma unroll
            for (int m = 0; m < 4; ++m) { bf16_t* rowp = O + (size_t)(row0 + ai * 128 + m * 16) * ldc + col0;
#pragma unroll
                for (int bj = 0; bj < 2; ++bj) { const pg8::f32x4 v0 = acc[ai][bj][m][0], v1 = acc[ai][bj][m][1];
                    u32x4 w; w.x = pk2(v0[0], v0[1]); w.y = pk2(v0[2], v0[3]); w.z = pk2(v1[0], v1[1]); w.w = pk2(v1[2], v1[3]);
                    *(u32x4*)(rowp + bj * 128) = w; } }
    }
};
struct EpiOut {
    static constexpr bool PERM = true, AFTER_DRAIN = false;
    const float* x; bf16_t* z; float* stats;
    __device__ __forceinline__ void operator()(const pg8::f32x4 (&acc)[2][2][4][2], const pg8::Unit& u, int wr, int wc, int fr, int fq) const {
        const int row0 = u.pm * 256 + wr * 64 + fr, col0 = u.pn * 256 + wc * 32 + 8 * fq;
#pragma unroll
        for (int ai = 0; ai < 2; ++ai)
#pragma unroll
            for (int m = 0; m < 4; ++m) { const size_t row = (size_t)(row0 + ai * 128 + m * 16); float s = 0.f, ss = 0.f;
#pragma unroll
                for (int bj = 0; bj < 2; ++bj) { const size_t o = row * D + col0 + bj * 128;
                    pg8::f32x4 v0 = *(const pg8::f32x4*)(x + o) * ALPHA + acc[ai][bj][m][0], v1 = *(const pg8::f32x4*)(x + o + 4) * ALPHA + acc[ai][bj][m][1];
                    { u32x4 w; w.x = pk2(v0[0], v0[1]); w.y = pk2(v0[2], v0[3]); w.z = pk2(v1[0], v1[1]); w.w = pk2(v1[2], v1[3]); *(u32x4*)(z + o) = w; }
#pragma unroll
                    for (int j = 0; j < 4; ++j) { s += v0[j] + v1[j]; ss += v0[j] * v0[j] + v1[j] * v1[j]; } }
                s += __shfl_xor(s, 16, 64); ss += __shfl_xor(ss, 16, 64); s += __shfl_xor(s, 32, 64); ss += __shfl_xor(ss, 32, 64);
                if (fq == 0) { atomicAdd(stats + row * 2, s); atomicAdd(stats + row * 2 + 1, ss); } }
    }
};

__device__ __forceinline__ void t_mix(size_t i, const bf16_t* __restrict__ oA, const float* __restrict__ lseA, bf16_t* __restrict__ ya) {
    const size_t t = i >> 5; const int col = (int)(i & 31) * 8, h = col >> 6; const size_t e = t * 256 + col;
    const float l0 = lseA[((size_t)0 * T + t) * 4 + h], l1 = lseA[((size_t)1 * T + t) * 4 + h], l2 = lseA[((size_t)2 * T + t) * 4 + h];
    const u32x4 a = *(const u32x4*)(oA + e), b = *(const u32x4*)(oA + (size_t)T * 256 + e), c = *(const u32x4*)(oA + (size_t)2 * T * 256 + e);
    const float mx = fmaxf(l0, fmaxf(l1, l2)), e0 = __expf(l0 - mx), e1 = __expf(l1 - mx), e2 = __expf(l2 - mx), inv = 1.f / (e0 + e1 + e2); float w0 = e0 * inv, w1 = e1 * inv, w2 = e2 * inv;
    w0 *= 16.f; w1 *= 16.f; w2 *= 16.f;
    u32x2 o; int t8 = 0;
    t8 = __builtin_amdgcn_cvt_pk_fp8_f32(w0 * bflo(a.x) + w1 * bflo(b.x) + w2 * bflo(c.x), w0 * bfhi(a.x) + w1 * bfhi(b.x) + w2 * bfhi(c.x), t8, false); t8 = __builtin_amdgcn_cvt_pk_fp8_f32(w0 * bflo(a.y) + w1 * bflo(b.y) + w2 * bflo(c.y), w0 * bfhi(a.y) + w1 * bfhi(b.y) + w2 * bfhi(c.y), t8, true); o.x = (unsigned)t8;
    t8 = 0; t8 = __builtin_amdgcn_cvt_pk_fp8_f32(w0 * bflo(a.z) + w1 * bflo(b.z) + w2 * bflo(c.z), w0 * bfhi(a.z) + w1 * bfhi(b.z) + w2 * bfhi(c.z), t8, false); t8 = __builtin_amdgcn_cvt_pk_fp8_f32(w0 * bflo(a.w) + w1 * bflo(b.w) + w2 * bflo(c.w), w0 * bfhi(a.w) + w1 * bfhi(b.w) + w2 * bfhi(c.w), t8, true); o.y = (unsigned)t8;
    *(u32x2*)((unsigned char*)ya + e) = o;
}
template <int NT>
__device__ __forceinline__ void t_res_ln1(size_t t0, size_t tstride, const float* __restrict__ x, const bf16_t* __restrict__ mo, const float* g, const float* b, bf16_t* __restrict__ x1b) {
    const int lane = threadIdx.x & 63, c = 16 * lane;
    f32x4 xv[NT][4]; u32x4 mv[NT][2];
#pragma unroll
    for (int k = 0; k < NT; ++k) { const size_t t = t0 + k * tstride;
#pragma unroll
        for (int q = 0; q < 4; ++q) xv[k][q] = *(const f32x4*)(x + t * D + c + 4 * q);
        mv[k][0] = *(const u32x4*)(mo + t * D + c); mv[k][1] = *(const u32x4*)(mo + t * D + c + 8); }
    f32x4 gg[4], bb[4];
#pragma unroll
    for (int q = 0; q < 4; ++q) { gg[q] = *(const f32x4*)(g + c + 4 * q); bb[q] = *(const f32x4*)(b + c + 4 * q); }
#pragma unroll
    for (int k = 0; k < NT; ++k) { const size_t t = t0 + k * tstride;
        const float mm[16] = {bflo(mv[k][0].x), bfhi(mv[k][0].x), bflo(mv[k][0].y), bfhi(mv[k][0].y), bflo(mv[k][0].z), bfhi(mv[k][0].z), bflo(mv[k][0].w), bfhi(mv[k][0].w),
                              bflo(mv[k][1].x), bfhi(mv[k][1].x), bflo(mv[k][1].y), bfhi(mv[k][1].y), bflo(mv[k][1].z), bfhi(mv[k][1].z), bflo(mv[k][1].w), bfhi(mv[k][1].w)};
        float zz[16]; float s = 0.f;
#pragma unroll
        for (int i = 0; i < 16; ++i) { zz[i] = ALPHA * xv[k][i >> 2][i & 3] + mm[i]; s += zz[i]; }
        const float mean = wave_sum(s) * (1.f / D); float ss = 0.f;
#pragma unroll
        for (int i = 0; i < 16; ++i) { const float d = zz[i] - mean; ss += d * d; }
        const float rstd = rsqrtf(wave_sum(ss) * (1.f / D) + LN_EPS);
        float y[16];
#pragma unroll
        for (int i = 0; i < 16; ++i) y[i] = (zz[i] - mean) * rstd * gg[i >> 2][i & 3] + bb[i >> 2][i & 3];
        u32x4 w0, w1; w0.x = pk2(y[0], y[1]); w0.y = pk2(y[2], y[3]); w0.z = pk2(y[4], y[5]); w0.w = pk2(y[6], y[7]); w1.x = pk2(y[8], y[9]); w1.y = pk2(y[10], y[11]); w1.z = pk2(y[12], y[13]); w1.w = pk2(y[14], y[15]);
        *(u32x4*)(x1b + t * D + c) = w0; *(u32x4*)(x1b + t * D + c + 8) = w1; }
}
typedef float f32x2 __attribute__((ext_vector_type(2)));
__device__ __forceinline__ void cvt_row_fp8_finish(const f32x4 a, const f32x4 b, const f32x4 c, const f32x4 d, unsigned char* __restrict__ dst, float* __restrict__ inv_scale, int row, int lane) {
    float mx = 0.f;
#pragma unroll
    for (int j = 0; j < 4; ++j) mx = fmaxf(mx, fmaxf(fmaxf(fabsf(a[j]), fabsf(b[j])), fmaxf(fabsf(c[j]), fabsf(d[j]))));
    mx = wave_max(mx);
    const unsigned E = (__float_as_uint(mx) >> 23) & 255u;
    const float sc = (E == 0u || E > 250u) ? 1.0f : __uint_as_float((260u - E) << 23), isc = (E == 0u || E > 250u) ? 1.0f : __uint_as_float((E - 6u) << 23);
    u32x4 w; int t;
    t = 0; t = __builtin_amdgcn_cvt_pk_fp8_f32(a[0] * sc, a[1] * sc, t, false); t = __builtin_amdgcn_cvt_pk_fp8_f32(a[2] * sc, a[3] * sc, t, true); w.x = (unsigned)t;
    t = 0; t = __builtin_amdgcn_cvt_pk_fp8_f32(b[0] * sc, b[1] * sc, t, false); t = __builtin_amdgcn_cvt_pk_fp8_f32(b[2] * sc, b[3] * sc, t, true); w.y = (unsigned)t;
    t = 0; t = __builtin_amdgcn_cvt_pk_fp8_f32(c[0] * sc, c[1] * sc, t, false); t = __builtin_amdgcn_cvt_pk_fp8_f32(c[2] * sc, c[3] * sc, t, true); w.z = (unsigned)t;
    t = 0; t = __builtin_amdgcn_cvt_pk_fp8_f32(d[0] * sc, d[1] * sc, t, false); t = __builtin_amdgcn_cvt_pk_fp8_f32(d[2] * sc, d[3] * sc, t, true); w.w = (unsigned)t;
    *(u32x4*)(dst + (size_t)row * D + 16 * lane) = w;
    if (lane == 0) inv_scale[row] = isc;
}
__device__ __forceinline__ void cvt_rows_fp8(const float* __restrict__ pu, const float* __restrict__ pv, unsigned char* __restrict__ ub8, unsigned char* __restrict__ vb8, float* __restrict__ usc, float* __restrict__ vsc, int r0, int r1) {
    const int lane = threadIdx.x & 63;
    const float* s0 = pu + (size_t)r0 * D + 16 * lane; const float* s1 = pv + (size_t)r0 * D + 16 * lane; const float* s2 = pu + (size_t)r1 * D + 16 * lane; const float* s3 = pv + (size_t)r1 * D + 16 * lane;
    f32x4 q[4][4];
#pragma unroll
    for (int j = 0; j < 4; ++j) { q[0][j] = ((const f32x4*)s0)[j]; q[1][j] = ((const f32x4*)s1)[j]; q[2][j] = ((const f32x4*)s2)[j]; q[3][j] = ((const f32x4*)s3)[j]; }
    cvt_row_fp8_finish(q[0][0], q[0][1], q[0][2], q[0][3], ub8, usc, r0, lane); cvt_row_fp8_finish(q[1][0], q[1][1], q[1][2], q[1][3], vb8, vsc, r0, lane);
    cvt_row_fp8_finish(q[2][0], q[2][1], q[2][2], q[2][3], ub8, usc, r1, lane); cvt_row_fp8_finish(q[3][0], q[3][1], q[3][2], q[3][3], vb8, vsc, r1, lane);
}
__device__ __forceinline__ float xsel_add(float keep_lo, float keep_hi, bool hi, int mask) {
    const float send = hi ? keep_lo : keep_hi, keep = hi ? keep_hi : keep_lo; return keep + __shfl_xor(send, mask, 64);
}

typedef short s16x4 __attribute__((ext_vector_type(4)));
constexpr int NTHREADS_ = 512;
#define ATT_M0 (-30000.0f)
__device__ __forceinline__ float red_max_16_32(float x) { typedef unsigned u2_ __attribute__((ext_vector_type(2)));
    u2_ r = __builtin_amdgcn_permlane16_swap(__float_as_uint(x), __float_as_uint(x), false, false); x = fmaxf(__uint_as_float(r.x), __uint_as_float(r.y));
    r = __builtin_amdgcn_permlane32_swap(__float_as_uint(x), __float_as_uint(x), false, false); return fmaxf(__uint_as_float(r.x), __uint_as_float(r.y)); }
__device__ __forceinline__ float red_sum_16_32(float x) { typedef unsigned u2_ __attribute__((ext_vector_type(2)));
    u2_ r = __builtin_amdgcn_permlane16_swap(__float_as_uint(x), __float_as_uint(x), false, false); x = __uint_as_float(r.x) + __uint_as_float(r.y);
    r = __builtin_amdgcn_permlane32_swap(__float_as_uint(x), __float_as_uint(x), false, false); return __uint_as_float(r.x) + __uint_as_float(r.y); }
template <int DH, int PITCH, class MaskF>
__device__ __forceinline__ void attn_step(const pg8::bf16x8 (&qf)[DH / 32], LAS unsigned char* kl, LAS unsigned char* vl, int t0, int t1, const MaskF& mf, float& m, float& l, f32x4 (&oT)[DH / 16]) {
    const int lane = threadIdx.x & 63, r16 = lane & 15, kq = lane >> 4;
    f32x4 s0 = {0.f, 0.f, 0.f, 0.f}, s1 = {0.f, 0.f, 0.f, 0.f};
    LAS unsigned char* ka0 = kl + (16 * t0 + r16) * PITCH + 16 * kq; LAS unsigned char* ka1 = kl + (16 * t1 + r16) * PITCH + 16 * kq;
#pragma unroll
    for (int s = 0; s < DH / 32; ++s) { const pg8::bf16x8 a0 = *(const LAS pg8::bf16x8*)(ka0 + 64 * s), a1 = *(const LAS pg8::bf16x8*)(ka1 + 64 * s);
        s0 = __builtin_amdgcn_mfma_f32_16x16x32_bf16(a0, qf[s], s0, 0, 0, 0); s1 = __builtin_amdgcn_mfma_f32_16x16x32_bf16(a1, qf[s], s1, 0, 0, 0); }
    float mx = -1e30f;
#pragma unroll
    for (int j = 0; j < 4; ++j) { s0[j] = mf(t0, 4 * kq + j, s0[j]); s1[j] = mf(t1, 4 * kq + j, s1[j]); mx = fmaxf(mx, fmaxf(s0[j], s1[j])); }
    mx = red_max_16_32(mx);
    const float mn = fmaxf(m, mx), sc = __builtin_amdgcn_exp2f(m - mn);
    float rs = 0.f;
#pragma unroll
    for (int j = 0; j < 4; ++j) { s0[j] = __builtin_amdgcn_exp2f(s0[j] - mn); s1[j] = __builtin_amdgcn_exp2f(s1[j] - mn); rs += s0[j] + s1[j]; }
    rs = red_sum_16_32(rs);
    l = l * sc + rs; m = mn;
    u32x4 pw; pw.x = pk2(s0[0], s0[1]); pw.y = pk2(s0[2], s0[3]); pw.z = pk2(s1[0], s1[1]); pw.w = pk2(s1[2], s1[3]);
    const pg8::bf16x8 pb = __builtin_bit_cast(pg8::bf16x8, pw);
    const int q = r16 >> 2, p = r16 & 3;
    LAS unsigned char* va0 = vl + (16 * t0 + 4 * kq + q) * PITCH + 8 * p; LAS unsigned char* va1 = vl + (16 * t1 + 4 * kq + q) * PITCH + 8 * p;
#pragma unroll
    for (int dt = 0; dt < DH / 16; ++dt) {
        const s16x4 lo = __builtin_amdgcn_ds_read_tr16_b64_v4i16((LAS s16x4*)(va0 + 32 * dt)), hi = __builtin_amdgcn_ds_read_tr16_b64_v4i16((LAS s16x4*)(va1 + 32 * dt));
        const pg8::bf16x8 va = __builtin_shufflevector(lo, hi, 0, 1, 2, 3, 4, 5, 6, 7);
        oT[dt] = oT[dt] * sc; oT[dt] = __builtin_amdgcn_mfma_f32_16x16x32_bf16(va, pb, oT[dt], 0, 0, 0); }
}
__device__ __forceinline__ void lds_put16(LAS unsigned char* dst, const bf16_t* src) { *(LAS u32x4*)dst = src ? *(const u32x4*)src : (u32x4){0u, 0u, 0u, 0u}; }

constexpr int ATT_KV64 = 272 * 160;
__device__ __forceinline__ void attnA_fetch(int u, int tid, u32x4 (&pfc)[8], float& tabv, const bf16_t* __restrict__ hq, const float* __restrict__ relb) {
    asm volatile("" : "+v"(tid));
    const int h = u & 3, rn = (u >> 2) & 31, b = (u >> 7) & 7, g = u >> 10;
    const int r = (g == 0) ? 1 : (g == 1 ? 4 : 16), nblk = 32 / r, rho = rn / nblk, n = rn % nblk, tb = b * SEQ;
    const bf16_t* kcol = hq + hq_off64(12 + g * 4 + h, 0); const bf16_t* vcol = hq + hq_off64(24 + g * 4 + h, 0);
#pragma unroll
    for (int i = 0; i < 8; ++i) { const int idx = tid + NTHREADS_ * i, isv = idx >> 11, i2 = idx & 2047, row = i2 >> 3, ch = i2 & 7, pos = (n - 1) * 128 + row;
        pfc[i] = (pos >= 0) ? *(const u32x4*)((isv ? vcol : kcol) + (size_t)(tb + rho + r * pos) * 64 + ch * 8) : (u32x4){0u, 0u, 0u, 0u}; }
    tabv = (tid < 129) ? relb[kBucket[g][tid] * 20 + g * 4 + h] * LOG2E : 0.f;
}
__device__ __forceinline__ void attnAB_store(int tid, const u32x4 (&pfc)[8], float tabv, LAS unsigned char* lds, int ntab) {
    asm volatile("" : "+v"(tid));
    LAS unsigned char* kl = lds; LAS unsigned char* vl = lds + ATT_KV64; LAS float* tab = (LAS float*)(lds + 2 * ATT_KV64);
#pragma unroll
    for (int i = 0; i < 8; ++i) { const int idx = tid + NTHREADS_ * i, isv = idx >> 11, i2 = idx & 2047, row = i2 >> 3, ch = i2 & 7; *(LAS u32x4*)((isv ? vl : kl) + row * 160 + ch * 16) = pfc[i]; }
    if (tid < 320) { const int isv = tid >= 160, i2 = isv ? tid - 160 : tid; *(LAS u32x4*)((isv ? vl : kl) + 256 * 160 + i2 * 16) = (u32x4){0u, 0u, 0u, 0u}; }
    if (tid < ntab) tab[tid] = tabv;
}
__device__ __forceinline__ void attnA_compute(int u, int tid, LAS unsigned char* lds, const bf16_t* __restrict__ hq, bf16_t* __restrict__ oA, float* __restrict__ lseA) {
    asm volatile("" : "+v"(tid));
    const int h = u & 3, rn = (u >> 2) & 31, b = (u >> 7) & 7, g = u >> 10;
    const int r = (g == 0) ? 1 : (g == 1 ? 4 : 16), nblk = 32 / r, rho = rn / nblk, n = rn % nblk, tb = b * SEQ;
    LAS unsigned char* kl = lds; LAS unsigned char* vl = lds + ATT_KV64; LAS float* tab = (LAS float*)(lds + 2 * ATT_KV64);
    const int w = tid >> 6, lane = tid & 63, r16 = lane & 15, kq = lane >> 4, qi = 16 * w + r16, kmin = (n == 0) ? 128 : 0;
    const size_t tq = (size_t)(tb + rho + r * (n * 128 + qi));
    pg8::bf16x8 qf[2];
#pragma unroll
    for (int s = 0; s < 2; ++s) qf[s] = *(const pg8::bf16x8*)(hq + hq_off64(g * 4 + h, tq) + 32 * s + 8 * kq);
    float m = ATT_M0, l = 0.f; f32x4 oT[4];
#pragma unroll
    for (int dt = 0; dt < 4; ++dt) oT[dt] = (f32x4){0.f, 0.f, 0.f, 0.f};
    auto mf = [&](int tile, int kr, float s) -> float { const int kk = 16 * tile + kr, off = qi + 128 - kk; const bool ok = (off >= 0) && (off <= 128) && (kk >= kmin);
        const int oc = off < 0 ? 0 : (off > 128 ? 128 : off); return ok ? s + tab[oc] : -1e30f; };
    auto mfi = [&](int tile, int kr, float s) -> float { return s + tab[qi + 128 - 16 * tile - kr]; };
    attn_step<64, 160>(qf, kl, vl, w, w + 1, mf, m, l, oT);
    if (n != 0) { for (int st = 1; st < 4; ++st) attn_step<64, 160>(qf, kl, vl, w + 2 * st, w + 2 * st + 1, mfi, m, l, oT); }
    else { for (int st = 1; st < 4; ++st) attn_step<64, 160>(qf, kl, vl, w + 2 * st, w + 2 * st + 1, mf, m, l, oT); }
    attn_step<64, 160>(qf, kl, vl, w + 8, w + 9, mf, m, l, oT);
    const float inv = 1.0f / l;
    bf16_t* op = oA + ((size_t)g * T + tq) * 256 + h * 64 + 4 * kq;
#pragma unroll
    for (int dt = 0; dt < 4; ++dt) { u32x2 wv; wv.x = pk2(oT[dt][0] * inv, oT[dt][1] * inv); wv.y = pk2(oT[dt][2] * inv, oT[dt][3] * inv); *(u32x2*)(op + 16 * dt) = wv; }
    if (kq == 0) lseA[((size_t)g * T + tq) * 4 + h] = (m + __builtin_amdgcn_logf(l)) * LN2F;
}
__device__ __forceinline__ void attnB_fetch(int u, int tid, u32x4 (&pfc)[8], float& tabv, const bf16_t* __restrict__ hq, const float* __restrict__ relb) {
    asm volatile("" : "+v"(tid));
    const int kvh = u & 1, n = (u >> 1) & 31, b = u >> 6, tb = b * SEQ;
    const bf16_t* kcol = hq + hq_off64(44 + kvh, 0); const bf16_t* vcol = hq + hq_off64(46 + kvh, 0);
#pragma unroll
    for (int i = 0; i < 8; ++i) { const int idx = tid + NTHREADS_ * i, isv = idx >> 11, i2 = idx & 2047, row = i2 >> 3, ch = i2 & 7, pos = (n - 1) * 128 + row;
        pfc[i] = (pos >= 0) ? *(const u32x4*)((isv ? vcol : kcol) + (size_t)(tb + pos) * 64 + ch * 8) : (u32x4){0u, 0u, 0u, 0u}; }
    { const int hd = tid >> 7, off = tid & 127; tabv = relb[kBucket[0][off] * 20 + 12 + kvh * 4 + hd] * LOG2E; }
}
__device__ __forceinline__ void attnB_compute(int u, int tid, LAS unsigned char* lds, const bf16_t* __restrict__ hq, const float* __restrict__ sinks, bf16_t* __restrict__ yb) {
    asm volatile("" : "+v"(tid));
    const int kvh = u & 1, n = (u >> 1) & 31, b = u >> 6, tb = b * SEQ;
    LAS unsigned char* kl = lds; LAS unsigned char* vl = lds + ATT_KV64; LAS float* tab = (LAS float*)(lds + 2 * ATT_KV64);
    const int w = tid >> 6, lane = tid & 63, r16 = lane & 15, kq = lane >> 4, kmin = (n == 0) ? 128 : 0;
    for (int i = 0; i < 4; ++i) {
        const int task = w + 8 * i, hd = task >> 3, sub = task & 7, head = kvh * 4 + hd, qi = 16 * sub + r16;
        const size_t tq = (size_t)(tb + n * 128 + qi);
        pg8::bf16x8 qf[2];
#pragma unroll
        for (int s = 0; s < 2; ++s) qf[s] = *(const pg8::bf16x8*)(hq + hq_off64(36 + head, tq) + 32 * s + 8 * kq);
        float m = sinks[head] * LOG2E, l = 1.0f; f32x4 oT[4];
#pragma unroll
        for (int dt = 0; dt < 4; ++dt) oT[dt] = (f32x4){0.f, 0.f, 0.f, 0.f};
        LAS float* tb_h = tab + hd * 128;
        auto mf = [&](int tile, int kr, float s) -> float { const int kk = 16 * tile + kr, off = qi + 128 - kk; const bool ok = (off >= 0) && (off <= 127) && (kk >= kmin);
            const int oc = off < 0 ? 0 : (off > 127 ? 127 : off); return ok ? s + tb_h[oc] : -1e30f; };
        auto mfi = [&](int tile, int kr, float s) -> float { return s + tb_h[qi + 128 - 16 * tile - kr]; };
        attn_step<64, 160>(qf, kl, vl, sub, sub + 1, mf, m, l, oT);
        if (n != 0) { for (int st = 1; st < 4; ++st) attn_step<64, 160>(qf, kl, vl, sub + 2 * st, sub + 2 * st + 1, mfi, m, l, oT); }
        else { for (int st = 1; st < 4; ++st) attn_step<64, 160>(qf, kl, vl, sub + 2 * st, sub + 2 * st + 1, mf, m, l, oT); }
        attn_step<64, 160>(qf, kl, vl, sub + 8, sub + 9, mf, m, l, oT);
        const float inv = 1.0f / l;
        const float inv16 = inv * 16.f; unsigned char* op = (unsigned char*)yb + tq * 512 + head * 64 + 4 * kq;
#pragma unroll
        for (int dt = 0; dt < 4; ++dt) { int t8 = 0; t8 = __builtin_amdgcn_cvt_pk_fp8_f32(oT[dt][0] * inv16, oT[dt][1] * inv16, t8, false); t8 = __builtin_amdgcn_cvt_pk_fp8_f32(oT[dt][2] * inv16, oT[dt][3] * inv16, t8, true); *(unsigned*)(op + 16 * dt) = (unsigned)t8; }
    }
}
__device__ __forceinline__ void attnAB_phase(LAS unsigned char* lds, const bf16_t* __restrict__ hq, const float* __restrict__ relb, const float* __restrict__ sinks, bf16_t* __restrict__ oA, float* __restrict__ lseA, bf16_t* __restrict__ yb) {
    int tid = threadIdx.x; asm volatile("" : "+v"(tid));
    u32x4 pfc[8]; float tabv = 0.f;
    int u = blockIdx.x;
    if (u < 3072) attnA_fetch(u, tid, pfc, tabv, hq, relb);
    for (; u < 3072; u += gridDim.x) {
        attnAB_store(tid, pfc, tabv, lds, 129);
        __syncthreads();
        const int un = u + gridDim.x;
        if (un < 3072) attnA_fetch(un, tid, pfc, tabv, hq, relb); else if ((int)blockIdx.x < 512) attnB_fetch((int)blockIdx.x, tid, pfc, tabv, hq, relb);
        attnA_compute(u, tid, lds, hq, oA, lseA);
        __syncthreads();
    }
    u = blockIdx.x;
    if (3072 <= (int)blockIdx.x && u < 512) attnB_fetch(u, tid, pfc, tabv, hq, relb);
    for (; u < 512; u += gridDim.x) {
        attnAB_store(tid, pfc, tabv, lds, 512);
        __syncthreads();
        const int un = u + gridDim.x;
        if (un < 512) attnB_fetch(un, tid, pfc, tabv, hq, relb);
        attnB_compute(u, tid, lds, hq, sinks, yb);
        __syncthreads();
    }
}
__device__ __forceinline__ void attnC_unit(int u, LAS unsigned char* lds, const bf16_t* __restrict__ hq, const bf16_t* __restrict__ kvm, bf16_t* __restrict__ yc) {
    int tid = threadIdx.x; asm volatile("" : "+v"(tid));
    const int qc = u & 7, head = (u >> 3) & 3, b = u >> 5, tb = b * SEQ;
    constexpr int CP = 272, IMG = 256 * CP;
    LAS unsigned char* kl = lds; LAS unsigned char* vl = lds + IMG;
    for (int idx = tid; idx < 8192; idx += NTHREADS_) { const int isv = idx >> 12, i2 = idx & 4095, row = i2 >> 4, ch = i2 & 15;
        lds_put16((isv ? vl : kl) + row * CP + ch * 16, kvm + (size_t)(b * MEMLEN + row) * 1024 + isv * 512 + head * 128 + ch * 8); }
    __syncthreads();
    const int w = tid >> 6, lane = tid & 63, r16 = lane & 15, kq = lane >> 4;
    auto mf = [&](int, int, float s) -> float { return s; };
    for (int qt = 0; qt < 4; ++qt) {
        const size_t tq = (size_t)(tb + qc * 512 + qt * 128 + 16 * w + r16);
        pg8::bf16x8 qf[4];
#pragma unroll
        for (int s = 0; s < 4; ++s) qf[s] = *(const pg8::bf16x8*)(hq + hq_offc(head, tq) + 32 * s + 8 * kq);
        float m = ATT_M0, l = 0.f; f32x4 oT[8];
#pragma unroll
        for (int dt = 0; dt < 8; ++dt) oT[dt] = (f32x4){0.f, 0.f, 0.f, 0.f};
        for (int st = 0; st < 8; ++st) attn_step<128, CP>(qf, kl, vl, 2 * st, 2 * st + 1, mf, m, l, oT);
        const float inv = 1.0f / l;
        const float inv16 = inv * 16.f; unsigned char* op = (unsigned char*)yc + tq * 512 + head * 128 + 4 * kq;
#pragma unroll
        for (int dt = 0; dt < 8; ++dt) { int t8 = 0; t8 = __builtin_amdgcn_cvt_pk_fp8_f32(oT[dt][0] * inv16, oT[dt][1] * inv16, t8, false); t8 = __builtin_amdgcn_cvt_pk_fp8_f32(oT[dt][2] * inv16, oT[dt][3] * inv16, t8, true); *(unsigned*)(op + 16 * dt) = (unsigned)t8; }
    }
    __syncthreads();
}

#define CE_DESC(a, b) do { const unsigned _mx = (a) > (b) ? (a) : (b), _mn = (a) > (b) ? (b) : (a); (a) = _mx; (b) = _mn; } while (0)
__device__ __forceinline__ void sort16_desc(unsigned (&v)[16]) {
    CE_DESC(v[0], v[13]); CE_DESC(v[1], v[12]); CE_DESC(v[2], v[15]); CE_DESC(v[3], v[14]); CE_DESC(v[4], v[8]); CE_DESC(v[5], v[6]); CE_DESC(v[7], v[11]); CE_DESC(v[9], v[10]);
    CE_DESC(v[0], v[5]); CE_DESC(v[1], v[7]); CE_DESC(v[2], v[9]); CE_DESC(v[3], v[4]); CE_DESC(v[6], v[13]); CE_DESC(v[8], v[14]); CE_DESC(v[10], v[15]); CE_DESC(v[11], v[12]);
    CE_DESC(v[0], v[1]); CE_DESC(v[2], v[3]); CE_DESC(v[4], v[5]); CE_DESC(v[6], v[8]); CE_DESC(v[7], v[9]); CE_DESC(v[10], v[11]); CE_DESC(v[12], v[13]); CE_DESC(v[14], v[15]);
    CE_DESC(v[0], v[2]); CE_DESC(v[1], v[3]); CE_DESC(v[4], v[10]); CE_DESC(v[5], v[11]); CE_DESC(v[6], v[7]); CE_DESC(v[8], v[9]); CE_DESC(v[12], v[14]); CE_DESC(v[13], v[15]);
    CE_DESC(v[1], v[2]); CE_DESC(v[3], v[12]); CE_DESC(v[4], v[6]); CE_DESC(v[5], v[7]); CE_DESC(v[8], v[10]); CE_DESC(v[9], v[11]); CE_DESC(v[13], v[14]);
    CE_DESC(v[1], v[4]); CE_DESC(v[2], v[6]); CE_DESC(v[5], v[8]); CE_DESC(v[7], v[10]); CE_DESC(v[9], v[13]); CE_DESC(v[11], v[14]);
    CE_DESC(v[2], v[4]); CE_DESC(v[3], v[6]); CE_DESC(v[9], v[12]); CE_DESC(v[11], v[13]);
    CE_DESC(v[3], v[5]); CE_DESC(v[6], v[8]); CE_DESC(v[7], v[9]); CE_DESC(v[10], v[12]);
    CE_DESC(v[3], v[4]); CE_DESC(v[5], v[6]); CE_DESC(v[7], v[8]); CE_DESC(v[9], v[10]); CE_DESC(v[11], v[12]);
    CE_DESC(v[6], v[7]); CE_DESC(v[8], v[9]);
}
__device__ __forceinline__ void bitonic_merge16_desc(unsigned (&v)[16]) {
#pragma unroll
    for (int j = 8; j > 0; j >>= 1)
#pragma unroll
        for (int i = 0; i < 16; ++i) { const int p = i ^ j; if (p > i) CE_DESC(v[i], v[p]); }
}
__device__ __forceinline__ void top16_merge(unsigned (&a)[16], const unsigned (&b)[16]) {
#pragma unroll
    for (int i = 0; i < 16; ++i) a[i] = a[i] > b[15 - i] ? a[i] : b[15 - i];
    bitonic_merge16_desc(a);
}
__device__ __forceinline__ unsigned f2key(float f) { const unsigned u = __float_as_uint(f); return u ^ ((unsigned)((int)u >> 31) | 0x80000000u); }
__device__ __forceinline__ float key2f(unsigned k) { return __uint_as_float((k & 0x80000000u) ? (k ^ 0x80000000u) : ~k); }

constexpr int TK_KIMG = 128 * 144;
__device__ __forceinline__ void topk_unit(int u, LAS unsigned char* lds, const bf16_t* __restrict__ qb, const bf16_t* __restrict__ subk, unsigned short* __restrict__ eidx, float* __restrict__ gate) {
    int tid = threadIdx.x; asm volatile("" : "+v"(tid));
    const int h = u & 7, tile = u >> 3;
    typedef float f32x16 __attribute__((ext_vector_type(16)));
    for (int idx = tid; idx < 2048; idx += NTHREADS_) { const int row = idx >> 3, ch = idx & 7;
        *(LAS u32x4*)(lds + row * 144 + ch * 16) = *(const u32x4*)(subk + ((size_t)(h * 256 + row)) * 64 + ch * 8); }
    __syncthreads();
    const int w = tid >> 6, lane = tid & 63, r32 = lane & 31, hh = lane >> 5;
    const size_t tok = (size_t)tile * 256 + w * 32 + r32;
    unsigned top[2][16];
#pragma unroll
    for (int c = 0; c < 2; ++c) {
        pg8::bf16x8 qf[4];
#pragma unroll
        for (int s = 0; s < 4; ++s) qf[s] = *(const pg8::bf16x8*)(qb + tok * D + h * 128 + c * 64 + 16 * s + 8 * hh);
        unsigned key[4][16];
#pragma unroll
        for (int kt = 0; kt < 4; ++kt) { f32x16 acc;
#pragma unroll
            for (int i = 0; i < 16; ++i) acc[i] = 0.f;
#pragma unroll
            for (int s = 0; s < 4; ++s) { const pg8::bf16x8 a = *(const LAS pg8::bf16x8*)(lds + c * TK_KIMG + (32 * kt + r32) * 144 + (16 * s + 8 * hh) * 2);
                acc = __builtin_amdgcn_mfma_f32_32x32x16_bf16(a, qf[s], acc, 0, 0, 0); }
            const unsigned lowb = 127u - 4u * hh - 32u * kt;
#pragma unroll
            for (int i = 0; i < 16; ++i) key[kt][i] = (f2key(acc[i]) & 0xFFFFFF80u) | (lowb - (unsigned)((i & 3) + 8 * (i >> 2)));
            sort16_desc(key[kt]); }
        top16_merge(key[0], key[1]); top16_merge(key[2], key[3]); top16_merge(key[0], key[2]);
        unsigned other[16];
#pragma unroll
        for (int i = 0; i < 16; ++i) other[i] = (unsigned)__shfl_xor((int)key[0][i], 32, 64);
        top16_merge(key[0], other);
#pragma unroll
        for (int i = 0; i < 16; ++i) top[c][i] = key[0][i];
    }
    float v0[16], v1[16];
#pragma unroll
    for (int i = 0; i < 16; ++i) { v0[i] = key2f(top[0][i] & 0xFFFFFF80u); v1[i] = key2f(top[1][i] & 0xFFFFFF80u); }
    unsigned cand[4][16];
#pragma unroll
    for (int q = 0; q < 4; ++q)
#pragma unroll
        for (int i = 0; i < 16; ++i) cand[q][i] = 0u;
#define CAND_(q, e, i, j) cand[q][e] = (f2key(v0[i] + v1[j]) & 0xFFFFFF00u) | (unsigned)(255 - ((i) * 16 + (j)))
    CAND_(0, 0, 0, 0);
    CAND_(0, 1, 0, 1);
    CAND_(0, 2, 0, 2);
    CAND_(0, 3, 0, 3);
    CAND_(0, 4, 0, 4);
    CAND_(0, 5, 0, 5);
    CAND_(0, 6, 0, 6);
    CAND_(0, 7, 0, 7);
    CAND_(0, 8, 0, 8);
    CAND_(0, 9, 0, 9);
    CAND_(0, 10, 0, 10);
    CAND_(0, 11, 0, 11);
    CAND_(0, 12, 0, 12);
    CAND_(0, 13, 0, 13);
    CAND_(0, 14, 0, 14);
    CAND_(0, 15, 0, 15);
    CAND_(1, 0, 1, 0);
    CAND_(1, 1, 1, 1);
    CAND_(1, 2, 1, 2);
    CAND_(1, 3, 1, 3);
    CAND_(1, 4, 1, 4);
    CAND_(1, 5, 1, 5);
    CAND_(1, 6, 1, 6);
    CAND_(1, 7, 1, 7);
    CAND_(1, 8, 2, 0);
    CAND_(1, 9, 2, 1);
    CAND_(1, 10, 2, 2);
    CAND_(1, 11, 2, 3);
    CAND_(1, 12, 2, 4);
    CAND_(1, 13, 3, 0);
    CAND_(1, 14, 3, 1);
    CAND_(1, 15, 3, 2);
    CAND_(2, 0, 3, 3);
    CAND_(2, 1, 4, 0);
    CAND_(2, 2, 4, 1);
    CAND_(2, 3, 4, 2);
    CAND_(2, 4, 5, 0);
    CAND_(2, 5, 5, 1);
    CAND_(2, 6, 6, 0);
    CAND_(2, 7, 6, 1);
    CAND_(2, 8, 7, 0);
    CAND_(2, 9, 7, 1);
    CAND_(2, 10, 8, 0);
    CAND_(2, 11, 9, 0);
    CAND_(2, 12, 10, 0);
    CAND_(2, 13, 11, 0);
    CAND_(2, 14, 12, 0);
    CAND_(2, 15, 13, 0);
    CAND_(3, 0, 14, 0);
    CAND_(3, 1, 15, 0);
#undef CAND_
#pragma unroll
    for (int q = 0; q < 4; ++q) sort16_desc(cand[q]);
    top16_merge(cand[0], cand[1]); top16_merge(cand[2], cand[3]); top16_merge(cand[0], cand[2]);
    float ev[16]; const float vmax = key2f(cand[0][0] & 0xFFFFFF00u); float esum = 0.f;
#pragma unroll
    for (int k = 0; k < 16; ++k) { ev[k] = __builtin_amdgcn_exp2f((key2f(cand[0][k] & 0xFFFFFF00u) - vmax) * LOG2E); esum += ev[k]; }
    const float einv = 1.0f / esum;
    LAS unsigned char* st = lds + 2 * TK_KIMG + (w * 64 + lane) * 32;
#pragma unroll
    for (int g4 = 0; g4 < 4; ++g4) { unsigned d0 = 0u, d1 = 0u;
#pragma unroll
        for (int e = 0; e < 4; ++e) { d0 |= (127u - (top[0][4 * g4 + e] & 127u)) << (8 * e); d1 |= (127u - (top[1][4 * g4 + e] & 127u)) << (8 * e); }
        *(LAS unsigned*)(st + 4 * g4) = d0; *(LAS unsigned*)(st + 16 + 4 * g4) = d1; }
    int eo[16];
#pragma unroll
    for (int k = 0; k < 16; ++k) { const unsigned code = 255u - (cand[0][k] & 255u); eo[k] = (int)st[code >> 4] * 128 + (int)st[16 + (code & 15u)]; }
    if (hh == 0) {
        u32x4 o0, o1;
        o0.x = (unsigned)eo[0] | ((unsigned)eo[1] << 16); o0.y = (unsigned)eo[2] | ((unsigned)eo[3] << 16); o0.z = (unsigned)eo[4] | ((unsigned)eo[5] << 16); o0.w = (unsigned)eo[6] | ((unsigned)eo[7] << 16);
        o1.x = (unsigned)eo[8] | ((unsigned)eo[9] << 16); o1.y = (unsigned)eo[10] | ((unsigned)eo[11] << 16); o1.z = (unsigned)eo[12] | ((unsigned)eo[13] << 16); o1.w = (unsigned)eo[14] | ((unsigned)eo[15] << 16);
        *(u32x4*)(eidx + tok * 128 + h * 16) = o0; *(u32x4*)(eidx + tok * 128 + h * 16 + 8) = o1;
    } else {
#pragma unroll
        for (int k4 = 0; k4 < 4; ++k4) { f32x4 o; o[0] = ev[4 * k4] * einv; o[1] = ev[4 * k4 + 1] * einv; o[2] = ev[4 * k4 + 2] * einv; o[3] = ev[4 * k4 + 3] * einv;
            *(f32x4*)(gate + tok * 128 + h * 16 + 4 * k4) = o; }
    }
    __syncthreads();
}

__device__ __forceinline__ float fp8dot16(const u32x4 w, const f32x2 (&xp)[8]) {
    f32x2 a0 = __builtin_amdgcn_cvt_pk_f32_fp8((int)w.x, false) * xp[0];
    a0 = __builtin_elementwise_fma(__builtin_amdgcn_cvt_pk_f32_fp8((int)w.x, true), xp[1], a0);
    a0 = __builtin_elementwise_fma(__builtin_amdgcn_cvt_pk_f32_fp8((int)w.y, false), xp[2], a0); a0 = __builtin_elementwise_fma(__builtin_amdgcn_cvt_pk_f32_fp8((int)w.y, true), xp[3], a0);
    a0 = __builtin_elementwise_fma(__builtin_amdgcn_cvt_pk_f32_fp8((int)w.z, false), xp[4], a0); a0 = __builtin_elementwise_fma(__builtin_amdgcn_cvt_pk_f32_fp8((int)w.z, true), xp[5], a0);
    a0 = __builtin_elementwise_fma(__builtin_amdgcn_cvt_pk_f32_fp8((int)w.w, false), xp[6], a0); a0 = __builtin_elementwise_fma(__builtin_amdgcn_cvt_pk_f32_fp8((int)w.w, true), xp[7], a0);
    return a0.x + a0.y;
}
typedef int i32x4 __attribute__((ext_vector_type(4)));
#define PEER_EIDX16(dst, t_) do { const unsigned short* ep_ = eidx + (size_t)(t_) * 128 + 16 * grp; const u32x4 e0_ = *(const u32x4*)ep_, e1_ = *(const u32x4*)(ep_ + 8); \
        dst[0] = (int)(e0_.x & 0xffffu); dst[1] = (int)(e0_.x >> 16); dst[2] = (int)(e0_.y & 0xffffu); dst[3] = (int)(e0_.y >> 16); dst[4] = (int)(e0_.z & 0xffffu); dst[5] = (int)(e0_.z >> 16); dst[6] = (int)(e0_.w & 0xffffu); dst[7] = (int)(e0_.w >> 16); \
        dst[8] = (int)(e1_.x & 0xffffu); dst[9] = (int)(e1_.x >> 16); dst[10] = (int)(e1_.y & 0xffffu); dst[11] = (int)(e1_.y >> 16); dst[12] = (int)(e1_.z & 0xffffu); dst[13] = (int)(e1_.z >> 16); dst[14] = (int)(e1_.w & 0xffffu); dst[15] = (int)(e1_.w >> 16); } while (0)
#define PEER_GATHER16(BUF, base, ev) _Pragma("unroll") for (int i_ = 0; i_ < 16; ++i_) BUF[i_] = *(const u32x4*)((base) + (unsigned)(((unsigned)(ev)[i_] << 10) + (unsigned)colbase))
template <int CTRL> __device__ __forceinline__ float xsel_addf_dpp(float keep_lo, float keep_hi, bool hi) { const float send = hi ? keep_lo : keep_hi, keep = hi ? keep_hi : keep_lo;
    return keep + __uint_as_float(__builtin_amdgcn_update_dpp(0u, __float_as_uint(send), CTRL, 0xf, 0xf, false)); }
__device__ __forceinline__ float swap32_add(float lo, float hi) { typedef unsigned u2_ __attribute__((ext_vector_type(2))); const u2_ r = __builtin_amdgcn_permlane32_swap(__float_as_uint(lo), __float_as_uint(hi), false, false); return __uint_as_float(r.x) + __uint_as_float(r.y); }
__device__ __forceinline__ float swap16_add(float lo, float hi) { typedef unsigned u2_ __attribute__((ext_vector_type(2))); const u2_ r = __builtin_amdgcn_permlane16_swap(__float_as_uint(lo), __float_as_uint(hi), false, false); return __uint_as_float(r.x) + __uint_as_float(r.y); }
#define PEER_GATHER4(R, o, base, E, p) _Pragma("unroll") for (int j_ = 0; j_ < 4; ++j_) R[(o) + j_] = *(const u32x4*)((base) + (unsigned)(((unsigned)(E)[4 * (p) + j_] << 10) + (unsigned)colbase))
__device__ __forceinline__ void peerU_phase(int slice, int tok0, int tok1, const bf16_t* __restrict__ x1b,
                                            const unsigned short* __restrict__ eidx, const unsigned char* __restrict__ ub8, bf16_t* __restrict__ hp) {
    int tid = threadIdx.x; asm volatile("" : "+v"(tid));
    const int wave = tid >> 6, lane = tid & 63, sub = lane & 7, grp = lane >> 3, colbase = 128 * slice + 16 * sub;
    if (tok0 + wave >= tok1) return;
    const bool l0 = lane & 1, l1 = lane & 2, l2 = lane & 4;
    const int tfirst = tok0 + wave, tlast = tfirst + ((tok1 - 1 - tfirst) >> 3) * 8;
    const bf16_t* xl = x1b + colbase;
    const int hoff = 16 * grp + ((lane & 4) ? 8 : 0) + ((lane & 2) ? 4 : 0) + ((lane & 1) ? 2 : 0);
#define TOKC(i) ((tfirst + 8 * (i)) <= tlast ? (tfirst + 8 * (i)) : tlast)
    u32x4 R[32]; int EA[16], EB[16]; u32x4 xrA0, xrA1, xrB0, xrB1;
    { const int t0 = TOKC(0), t1 = TOKC(1);
      PEER_EIDX16(EA, t0); PEER_EIDX16(EB, t1);
      xrA0 = *(const u32x4*)(xl + (size_t)t0 * D); xrA1 = *(const u32x4*)(xl + (size_t)t0 * D + 8); xrB0 = *(const u32x4*)(xl + (size_t)t1 * D); xrB1 = *(const u32x4*)(xl + (size_t)t1 * D + 8);
#pragma unroll
      for (int p = 0; p < 4; ++p) { PEER_GATHER4(R, 4 * p, ub8, EA, p); }
#pragma unroll
      for (int p = 0; p < 4; ++p) { PEER_GATHER4(R, 16 + 4 * p, ub8, EB, p); }
      const int t2 = TOKC(2), t3 = TOKC(3); PEER_EIDX16(EA, t2); PEER_EIDX16(EB, t3); }
    for (int i = 0;; i += 2) {
#define PEER_U_TOKEN(RO, E, xr0, xr1, ti, tnext2, tnext4) do { \
        f32x2 xp[8]; \
        xp[0] = (f32x2){bflo(xr0.x), bfhi(xr0.x)}; xp[1] = (f32x2){bflo(xr0.y), bfhi(xr0.y)}; xp[2] = (f32x2){bflo(xr0.z), bfhi(xr0.z)}; xp[3] = (f32x2){bflo(xr0.w), bfhi(xr0.w)}; \
        xp[4] = (f32x2){bflo(xr1.x), bfhi(xr1.x)}; xp[5] = (f32x2){bflo(xr1.y), bfhi(xr1.y)}; xp[6] = (f32x2){bflo(xr1.z), bfhi(xr1.z)}; xp[7] = (f32x2){bflo(xr1.w), bfhi(xr1.w)}; \
        xr0 = *(const u32x4*)(xl + (size_t)(tnext2) * D); xr1 = *(const u32x4*)(xl + (size_t)(tnext2) * D + 8);        \
        float pd[16]; \
        _Pragma("unroll") for (int p = 0; p < 4; ++p) { \
            _Pragma("unroll") for (int j = 0; j < 4; ++j) pd[4 * p + j] = fp8dot16(R[(RO) + 4 * p + j], xp); \
            PEER_GATHER4(R, (RO) + 4 * p, ub8, E, p); } \
        PEER_EIDX16(E, tnext4); \
        float q8[8]; \
        _Pragma("unroll") for (int k = 0; k < 8; ++k) q8[k] = xsel_addf_dpp<0x141>(pd[k], pd[k + 8], l2);            \
        const float r0 = xsel_addf_dpp<0x4E>(q8[0], q8[4], l1), r1 = xsel_addf_dpp<0x4E>(q8[1], q8[5], l1), r2 = xsel_addf_dpp<0x4E>(q8[2], q8[6], l1), r3 = xsel_addf_dpp<0x4E>(q8[3], q8[7], l1);     \
        f32x2 o; o.x = xsel_addf_dpp<0xB1>(r0, r2, l0); o.y = xsel_addf_dpp<0xB1>(r1, r3, l0);                       \
        if ((tfirst + 8 * (ti)) <= tlast) *(unsigned*)(hp + ((size_t)slice * T + (size_t)(tfirst + 8 * (ti))) * 128 + hoff) = pk2(o.x, o.y); } while (0)
        { const int tn2 = TOKC(i + 2), tn4 = TOKC(i + 4); PEER_U_TOKEN(0, EA, xrA0, xrA1, i, tn2, tn4); }
        { const int tn2 = TOKC(i + 3), tn4 = TOKC(i + 5); PEER_U_TOKEN(16, EB, xrB0, xrB1, i + 1, tn2, tn4); }
        if (tfirst + 8 * (i + 2) > tlast) break;
    }
#undef PEER_U_TOKEN
#undef TOKC
}
#ifdef PROBE_EXP
__device__ __forceinline__ void probe_gather(int slice, int tok0, int tok1, const unsigned short* __restrict__ eidx, const unsigned char* __restrict__ ub8, float* __restrict__ dummy) {
    int tid = threadIdx.x; asm volatile("" : "+v"(tid));
    const int wave = tid >> 6, lane = tid & 63, sub = lane & 7, grp = lane >> 3, colbase = 128 * slice + 16 * sub;
    if (tok0 + wave >= tok1) return;
    const unsigned char* ubl = ub8;
    const int tlast = tok0 + wave + ((tok1 - 1 - tok0 - wave) >> 3) * 8;
    int EA[16], EB[16]; u32x4 UA[16], UB[16];
    int ta = tok0 + wave, tb = ta + 8 <= tlast ? ta + 8 : tlast;
    PEER_EIDX16(EA, ta); PEER_EIDX16(EB, tb);
    PEER_GATHER16(UA, ubl, EA);
    unsigned accx = 0u;
    for (;;) {
        PEER_GATHER16(UB, ubl, EB);
        const int ta2 = ta + 16 <= tlast ? ta + 16 : tlast; PEER_EIDX16(EA, ta2);
#pragma unroll
        for (int i = 0; i < 16; ++i) accx ^= UA[i].x ^ UA[i].y ^ UA[i].z ^ UA[i].w;
        PEER_GATHER16(UA, ubl, EA);
        const int tb2 = ta + 24 <= tlast ? ta + 24 : tlast; PEER_EIDX16(EB, tb2);
#pragma unroll
        for (int i = 0; i < 16; ++i) accx ^= UB[i].x ^ UB[i].y ^ UB[i].z ^ UB[i].w;
        if (ta + 16 > tlast) break;
        ta = ta2; tb = tb2;
    }
    dummy[(size_t)blockIdx.x * 512 + tid] = __uint_as_float(accx & 0x3fffffffu);
}
#endif

#if defined(PROBE_EXP) && PROBE_EXP >= 10 && PROBE_EXP < 20
__device__ __forceinline__ void probe_valu(float* __restrict__ dummy) {
    int tid = threadIdx.x; asm volatile("" : "+v"(tid));
    unsigned w[8]; f32x2 a[8];
#pragma unroll
    for (int i = 0; i < 8; ++i) { w[i] = (unsigned)tid * 2654435761u + i * 40503u; a[i] = (f32x2){(float)i, 1.0f}; }
    for (int it = 0; it < 2048; ++it) {
#pragma unroll
        for (int r = 0; r < 4; ++r)
#pragma unroll
            for (int i = 0; i < 8; ++i) {
#if PROBE_EXP == 10
                asm volatile("v_cvt_pk_f32_fp8_e32 %0, %1" : "=v"(a[i]) : "v"(w[i]));
#elif PROBE_EXP == 11
                asm volatile("v_pk_fma_f32 %0, %1, %1, %0" : "+v"(a[i]) : "v"(a[(i + 1) & 7]));
#elif PROBE_EXP == 12
                asm volatile("v_cvt_f32_ubyte0_e32 %0, %1" : "=v"(a[i].x) : "v"(w[i]));
#elif PROBE_EXP == 13
                asm volatile("v_dot4_i32_i8 %0, %1, %1, %0" : "+v"(w[i]) : "v"(w[(i + 1) & 7]));
#elif PROBE_EXP == 14
                asm volatile("v_fma_f32 %0, %1, %1, %0" : "+v"(a[i].x) : "v"(a[(i + 1) & 7].y));
#elif PROBE_EXP == 15
                asm volatile("v_dot2_f32_bf16 %0, %1, %1, %0" : "+v"(a[i].x) : "v"(w[i]));
#endif
            }
    }
    float s = 0.f;
#pragma unroll
    for (int i = 0; i < 8; ++i) s += a[i].x + a[i].y + __uint_as_float(w[i] & 0x3fffffffu);
    dummy[(size_t)blockIdx.x * 512 + tid] = s;
}
#endif
__device__ __forceinline__ void peerR_phase(const bf16_t* __restrict__ hp, const unsigned short* __restrict__ eidx, const float* __restrict__ gate, const float* __restrict__ usc, const float* __restrict__ vsc, bf16_t* __restrict__ cb) {
    for (size_t i = (size_t)blockIdx.x * 512 + threadIdx.x; i < (size_t)T * 32; i += (size_t)gridDim.x * 512) {
        f32x4 h = (f32x4){0.f, 0.f, 0.f, 0.f};
#pragma unroll
        for (int j = 0; j < 8; ++j) { const u32x2 w = *(const u32x2*)(hp + (size_t)j * T * 128 + 4 * i); h += (f32x4){bflo(w.x), bfhi(w.x), bflo(w.y), bfhi(w.y)}; }
        const u32x2 ew = *(const u32x2*)(eidx + 4 * i); const int e[4] = {(int)(ew.x & 0xffffu), (int)(ew.x >> 16), (int)(ew.y & 0xffffu), (int)(ew.y >> 16)};
        const f32x4 gt = *(const f32x4*)(gate + 4 * i); float c[4];
#pragma unroll
        for (int j = 0; j < 4; ++j) { const float hh = h[j] * usc[e[j]]; const pg8::f32x2 ge = pg8::gelu_pk((pg8::f32x2){hh, hh}); c[j] = gt[j] * ge.x * vsc[e[j]]; }
        u32x2 cw; cw.x = pk2(c[0], c[1]); cw.y = pk2(c[2], c[3]); *(u32x2*)(cb + 4 * i) = cw; }
}
__device__ __forceinline__ void peerV_phase(int slice, int tok0, int tok1, const bf16_t* __restrict__ cb, const unsigned short* __restrict__ eidx, const unsigned char* __restrict__ vb8, bf16_t* __restrict__ yp) {
    int tid = threadIdx.x; asm volatile("" : "+v"(tid));
    const int wave = tid >> 6, lane = tid & 63, sub = lane & 7, grp = lane >> 3, colbase = 128 * slice + 16 * sub;
    if (tok0 + wave >= tok1) return;
    const bool l3 = lane & 8, l4 = lane & 16, l5 = lane & 32;
    const int tfirst = tok0 + wave, tlast = tfirst + ((tok1 - 1 - tfirst) >> 3) * 8;
    const bf16_t* cl = cb + 16 * grp;
    const int yoff = colbase + ((lane & 32) ? 8 : 0) + ((lane & 16) ? 4 : 0) + ((lane & 8) ? 2 : 0);
#define TOKC(i) ((tfirst + 8 * (i)) <= tlast ? (tfirst + 8 * (i)) : tlast)
#define PEER_C16(dst, t_) do { const bf16_t* cp_ = cl + (size_t)(t_) * 128; dst[0] = *(const u32x4*)cp_; dst[1] = *(const u32x4*)(cp_ + 8); } while (0)
    u32x4 R[32]; int EA[16], EB[16]; u32x4 cA[2], cB[2];
    { const int t0 = TOKC(0), t1 = TOKC(1);
      PEER_EIDX16(EA, t0); PEER_EIDX16(EB, t1); PEER_C16(cA, t0); PEER_C16(cB, t1);
#pragma unroll
      for (int p = 0; p < 4; ++p) { PEER_GATHER4(R, 4 * p, vb8, EA, p); }
#pragma unroll
      for (int p = 0; p < 4; ++p) { PEER_GATHER4(R, 16 + 4 * p, vb8, EB, p); }
      const int t2 = TOKC(2), t3 = TOKC(3); PEER_EIDX16(EA, t2); PEER_EIDX16(EB, t3); }
    for (int i = 0;; i += 2) {
#define PEER_V_TOKEN(RO, E, cc, ti, tnext2, tnext4) do { \
        const u32x4 c0_ = cc[0], c1_ = cc[1]; \
        const float cv[16] = {bflo(c0_.x), bfhi(c0_.x), bflo(c0_.y), bfhi(c0_.y), bflo(c0_.z), bfhi(c0_.z), bflo(c0_.w), bfhi(c0_.w), bflo(c1_.x), bfhi(c1_.x), bflo(c1_.y), bfhi(c1_.y), bflo(c1_.z), bfhi(c1_.z), bflo(c1_.w), bfhi(c1_.w)}; \
        PEER_C16(cc, tnext2);                                        \
        f32x2 acc[8]; \
        _Pragma("unroll") for (int k = 0; k < 8; ++k) acc[k] = (f32x2){0.f, 0.f}; \
        _Pragma("unroll") for (int p = 0; p < 4; ++p) { \
            _Pragma("unroll") for (int j = 0; j < 4; ++j) { const u32x4 w = R[(RO) + 4 * p + j]; const f32x2 c2v = (f32x2){cv[4 * p + j], cv[4 * p + j]}; \
                acc[0] = __builtin_elementwise_fma(__builtin_amdgcn_cvt_pk_f32_fp8((int)w.x, false), c2v, acc[0]); acc[1] = __builtin_elementwise_fma(__builtin_amdgcn_cvt_pk_f32_fp8((int)w.x, true), c2v, acc[1]); \
                acc[2] = __builtin_elementwise_fma(__builtin_amdgcn_cvt_pk_f32_fp8((int)w.y, false), c2v, acc[2]); acc[3] = __builtin_elementwise_fma(__builtin_amdgcn_cvt_pk_f32_fp8((int)w.y, true), c2v, acc[3]); \
                acc[4] = __builtin_elementwise_fma(__builtin_amdgcn_cvt_pk_f32_fp8((int)w.z, false), c2v, acc[4]); acc[5] = __builtin_elementwise_fma(__builtin_amdgcn_cvt_pk_f32_fp8((int)w.z, true), c2v, acc[5]); \
                acc[6] = __builtin_elementwise_fma(__builtin_amdgcn_cvt_pk_f32_fp8((int)w.w, false), c2v, acc[6]); acc[7] = __builtin_elementwise_fma(__builtin_amdgcn_cvt_pk_f32_fp8((int)w.w, true), c2v, acc[7]); } \
            PEER_GATHER4(R, (RO) + 4 * p, vb8, E, p); } \
        PEER_EIDX16(E, tnext4); \
        const float a[16] = {acc[0].x, acc[0].y, acc[1].x, acc[1].y, acc[2].x, acc[2].y, acc[3].x, acc[3].y, acc[4].x, acc[4].y, acc[5].x, acc[5].y, acc[6].x, acc[6].y, acc[7].x, acc[7].y}; \
        float q8[8]; \
        _Pragma("unroll") for (int k = 0; k < 8; ++k) q8[k] = swap32_add(a[k], a[k + 8]); \
        const float r0 = swap16_add(q8[0], q8[4]), r1 = swap16_add(q8[1], q8[5]), r2 = swap16_add(q8[2], q8[6]), r3 = swap16_add(q8[3], q8[7]); \
        f32x2 o; o.x = xsel_addf_dpp<0x128>(r0, r2, l3); o.y = xsel_addf_dpp<0x128>(r1, r3, l3);               \
        if ((tfirst + 8 * (ti)) <= tlast) *(unsigned*)(yp + (size_t)(tfirst + 8 * (ti)) * D + yoff) = pk2(o.x, o.y); } while (0)
        { const int tn2 = TOKC(i + 2), tn4 = TOKC(i + 4); PEER_V_TOKEN(0, EA, cA, i, tn2, tn4); }
        { const int tn2 = TOKC(i + 3), tn4 = TOKC(i + 5); PEER_V_TOKEN(16, EB, cB, i + 1, tn2, tn4); }
        if (tfirst + 8 * (i + 2) > tlast) break;
    }
#undef PEER_V_TOKEN
#undef PEER_C16
#undef TOKC
}
template <int NT>
__device__ __forceinline__ void peerL_token(size_t t0, size_t tstride, const bf16_t* __restrict__ x1b, const bf16_t* __restrict__ yp, const float* g2, const float* b2, float* __restrict__ out) {
    const int lane = threadIdx.x & 63;
    u32x4 xw[NT][2], yw[NT][2];
#pragma unroll
    for (int k = 0; k < NT; ++k) { const size_t t = t0 + k * tstride;
#pragma unroll
        for (int hlf = 0; hlf < 2; ++hlf) { const int c = 16 * lane + 8 * hlf; xw[k][hlf] = *(const u32x4*)(x1b + t * D + c); yw[k][hlf] = *(const u32x4*)(yp + t * D + c); } }
#pragma unroll
    for (int k = 0; k < NT; ++k) { const size_t t = t0 + k * tstride;
        float y[16]; float s = 0.f;
#pragma unroll
        for (int hlf = 0; hlf < 2; ++hlf) { const u32x4 xq = xw[k][hlf], yq = yw[k][hlf];
            const float xx[8] = {bflo(xq.x), bfhi(xq.x), bflo(xq.y), bfhi(xq.y), bflo(xq.z), bfhi(xq.z), bflo(xq.w), bfhi(xq.w)}, yy[8] = {bflo(yq.x), bfhi(yq.x), bflo(yq.y), bfhi(yq.y), bflo(yq.z), bfhi(yq.z), bflo(yq.w), bfhi(yq.w)};
#pragma unroll
            for (int j = 0; j < 8; ++j) { const float v = ALPHA * xx[j] + yy[j]; y[8 * hlf + j] = v; s += v; } }
        const float mean2 = wave_sum(s) * (1.f / D); float ss = 0.f;
#pragma unroll
        for (int i = 0; i < 16; ++i) { const float dlt = y[i] - mean2; ss += dlt * dlt; }
        const float rstd2 = rsqrtf(wave_sum(ss) * (1.f / D) + LN_EPS);
#pragma unroll
        for (int q = 0; q < 4; ++q) { const int c = 16 * lane + 4 * q; const f32x4 gg = *(const f32x4*)(g2 + c), bb = *(const f32x4*)(b2 + c); f32x4 o;
#pragma unroll
            for (int j = 0; j < 4; ++j) o[j] = (y[4 * q + j] - mean2) * rstd2 * gg[j] + bb[j];
            *(f32x4*)(out + t * D + c) = o; } }
}

constexpr int NTHREADS = 512, NWAVES = 8;
constexpr int LDS_BYTES = 147456;
constexpr int LDS_MISC = 131072;
constexpr int LDS_XB = LDS_BYTES - 16;
constexpr size_t CTL_ZERO_BYTES = 16384;

struct Params {
    const float *x, *mem, *relb, *w_in, *b_gate, *w_memkv, *sinks, *w_a, *w_b, *w_c, *w_out, *ln1g, *ln1b, *w_q, *subk, *pu, *pv, *ln2g, *ln2b;
    float* out; char* ws; int lo, hi;
};

__device__ __forceinline__ void g_cvt(const float* __restrict__ src, bf16_t* __restrict__ dst, size_t n8) {
    for (size_t i = (size_t)blockIdx.x * NTHREADS + threadIdx.x; i < n8; i += (size_t)gridDim.x * NTHREADS) {
        const f32x4 a = ((const f32x4*)src)[2 * i], b = ((const f32x4*)src)[2 * i + 1];
        u32x4 w; w.x = pk2(a[0], a[1]); w.y = pk2(a[2], a[3]); w.z = pk2(b[0], b[1]); w.w = pk2(b[2], b[3]);
        ((u32x4*)dst)[i] = w; }
}


__device__ __forceinline__ void g_cvt8(const float* __restrict__ src, unsigned char* __restrict__ dst, size_t n16, float sc) {
    for (size_t i = (size_t)blockIdx.x * NTHREADS + threadIdx.x; i < n16; i += (size_t)gridDim.x * NTHREADS) {
        const f32x4 a = ((const f32x4*)src)[4 * i], b = ((const f32x4*)src)[4 * i + 1], c = ((const f32x4*)src)[4 * i + 2], d = ((const f32x4*)src)[4 * i + 3];
        u32x4 w; int t;
        t = 0; t = __builtin_amdgcn_cvt_pk_fp8_f32(a[0] * sc, a[1] * sc, t, false); t = __builtin_amdgcn_cvt_pk_fp8_f32(a[2] * sc, a[3] * sc, t, true); w.x = (unsigned)t;
        t = 0; t = __builtin_amdgcn_cvt_pk_fp8_f32(b[0] * sc, b[1] * sc, t, false); t = __builtin_amdgcn_cvt_pk_fp8_f32(b[2] * sc, b[3] * sc, t, true); w.y = (unsigned)t;
        t = 0; t = __builtin_amdgcn_cvt_pk_fp8_f32(c[0] * sc, c[1] * sc, t, false); t = __builtin_amdgcn_cvt_pk_fp8_f32(c[2] * sc, c[3] * sc, t, true); w.z = (unsigned)t;
        t = 0; t = __builtin_amdgcn_cvt_pk_fp8_f32(d[0] * sc, d[1] * sc, t, false); t = __builtin_amdgcn_cvt_pk_fp8_f32(d[2] * sc, d[3] * sc, t, true); w.w = (unsigned)t;
        ((u32x4*)dst)[i] = w; }
}

template <bool FP8>
__device__ __forceinline__ void transpose_tile_wave(const float* __restrict__ src, int K, int N, void* __restrict__ dstv, int tn, int tk, LAS float* tile, float sc) {
    const int lane = threadIdx.x & 63, n0 = tn * 64, k0 = tk * 64, rq = lane >> 4, c4 = (lane & 15) * 4;
    f32x4 v[16];
#pragma unroll
    for (int i = 0; i < 16; ++i) v[i] = *(const f32x4*)(src + (size_t)(k0 + 4 * i + rq) * N + n0 + c4);
#pragma unroll
    for (int i = 0; i < 16; ++i) *(LAS f32x4*)(tile + (4 * i + rq) * 68 + c4) = v[i];
    asm volatile("s_waitcnt lgkmcnt(0)" ::: "memory");
    float y[64];
#pragma unroll
    for (int k = 0; k < 64; ++k) y[k] = tile[k * 68 + lane];
    if constexpr (FP8) { unsigned char* dst = (unsigned char*)dstv + (size_t)(n0 + lane) * K + k0;
#pragma unroll
        for (int q = 0; q < 4; ++q) { u32x4 w; int t;
#pragma unroll
            for (int d = 0; d < 4; ++d) { t = 0; t = __builtin_amdgcn_cvt_pk_fp8_f32(y[16 * q + 4 * d] * sc, y[16 * q + 4 * d + 1] * sc, t, false); t = __builtin_amdgcn_cvt_pk_fp8_f32(y[16 * q + 4 * d + 2] * sc, y[16 * q + 4 * d + 3] * sc, t, true); w[d] = (unsigned)t; }
            *(u32x4*)(dst + 16 * q) = w; } }
    else { bf16_t* dst = (bf16_t*)dstv + (size_t)(n0 + lane) * K + k0;
#pragma unroll
        for (int q = 0; q < 8; ++q) { u32x4 w; w.x = pk2(y[8 * q], y[8 * q + 1]); w.y = pk2(y[8 * q + 2], y[8 * q + 3]); w.z = pk2(y[8 * q + 4], y[8 * q + 5]); w.w = pk2(y[8 * q + 6], y[8 * q + 7]); *(u32x4*)(dst + 8 * q) = w; } }
    asm volatile("s_waitcnt lgkmcnt(0)" ::: "memory");
}
#define W_ws (p.ws)
#define W_dout ((char*)p.out)
#define W_wmemkv_t ((bf16_t*)(W_ws + WS_WMEMKV))
#define W_wA_t ((bf16_t*)(W_ws + WS_WA))
#define W_wB_t ((bf16_t*)(W_ws + WS_WB))
#define W_wC_t ((bf16_t*)(W_ws + WS_WC))
#define W_wout_t ((bf16_t*)(W_ws + WS_WOUT))
#define W_wq_t ((bf16_t*)(W_ws + WS_WQ))
#define W_subkb ((bf16_t*)(W_ws + WS_SUBK))
#define W_memb ((bf16_t*)(W_ws + WS_MEMB))
#define W_kvm ((bf16_t*)(W_ws + WS_KVM))
#define W_stats ((float*)(W_ws + WS_STATS))
#define W_lseA ((float*)(W_ws + WS_LSE))
#define W_hq ((bf16_t*)(W_ws + WS_HQ))
#define W_gates ((bf16_t*)(W_ws + WS_GATES))
#define W_xb ((bf16_t*)(W_ws + WS_XB))
#define W_mf ((float*)(W_ws + WS_MF))
#define W_mb ((unsigned char*)(W_ws + WS_MB))
#define W_z ((bf16_t*)(W_ws + WS_Z))
#define W_x1b ((bf16_t*)(W_ws + WS_X1B))
#define W_qb ((bf16_t*)(W_ws + WS_Q))
#define W_eidx ((unsigned short*)(W_ws + WS_EIDX))
#define W_gate ((float*)(W_ws + WS_GATE))
#define W_ub8 ((unsigned char*)(W_ws + WS_UB))
#define W_vb8 ((unsigned char*)(W_ws + WS_UB + 16 * MiB))
#define W_usc ((float*)(W_ws + WS_UB + 32 * MiB))
#define W_vsc (W_usc + NEXP)
#define W_w_in_t ((bf16_t*)(W_dout + DO_WINT))
#define W_oA ((bf16_t*)(W_dout + DO_OA))
#define W_yb ((bf16_t*)(W_dout + DO_YB))
#define W_yc ((bf16_t*)(W_dout + DO_YC))
#define W_ya ((bf16_t*)(W_dout + DO_YA))
#define W_x8 ((unsigned char*)W_dout)
#define W_hp ((bf16_t*)(W_ws + 120 * MiB))
#define W_cbuf ((bf16_t*)(W_ws + 24 * MiB))
#define W_yp W_hp
__global__ void __launch_bounds__(NTHREADS, 2) mk_fwd(Params p) {
    extern __shared__ __attribute__((aligned(16))) unsigned char lds[];
#define LAUNDER_TID int tid = threadIdx.x; asm volatile("" : "+v"(tid)); const int wave = tid >> 6; const int gw = blockIdx.x * NWAVES + wave, nw = gridDim.x * NWAVES; (void)wave; (void)gw; (void)nw;
    if (threadIdx.x == 0) *(uint4*)(lds + LDS_XB) = make_uint4(0u, 0u, 0u, 0u);
    __syncthreads();
    XcdBarrier bar = xcd_barrier_post((unsigned*)(W_ws + WS_CTL), (volatile LAS unsigned*)(lds + LDS_XB));
#define PH(k) (p.lo <= (k) && (k) < p.hi)
#define SEAM(k) do { if (PH(k) && PH((k) + 1)) xcd_barrier(bar); } while (0)

    if (PH(0)) { LAUNDER_TID
        g_cvt8(p.x, (unsigned char*)W_xb, (size_t)T * D / 16, 1.0f);
        g_cvt(p.mem, W_memb, (size_t)BATCH * MEMLEN * D / 8);
        g_cvt(p.subk, W_subkb, (size_t)8 * 2 * 128 * 64 / 8);
        LAS float* tile = (LAS float*)((LAS unsigned char*)lds + wave * (64 * 68 * 4));
        for (int u = gw; u < 2752; u += nw) {
            if (u < 1664) transpose_tile_wave<true>(p.w_in, D, INW, W_w_in_t, u % 104, u / 104, tile, 32.0f);
            else if (u < 1920) { const int v = u - 1664; transpose_tile_wave<false>(p.w_memkv, D, 1024, W_wmemkv_t, v & 15, v >> 4, tile, 1.f); }
            else if (u < 1984) { const int v = u - 1920; transpose_tile_wave<true>(p.w_a, 256, 1024, W_wA_t, v & 15, v >> 4, tile, 32.0f); }
            else if (u < 2112) { const int v = u - 1984; transpose_tile_wave<true>(p.w_b, 512, 1024, W_wB_t, v & 15, v >> 4, tile, 32.0f); }
            else if (u < 2240) { const int v = u - 2112; transpose_tile_wave<true>(p.w_c, 512, 1024, W_wC_t, v & 15, v >> 4, tile, 32.0f); }
            else if (u < 2496) { const int v = u - 2240; transpose_tile_wave<true>(p.w_out, D, 1024, W_wout_t, v & 15, v >> 4, tile, 32.0f); }
            else { const int v = u - 2496; transpose_tile_wave<false>(p.w_q, D, 1024, W_wq_t, v & 15, v >> 4, tile, 1.f); }
        }
    }
    SEAM(0);
    if (PH(1)) {
        { pg8::Gemm g; g.A = W_memb; g.Bt = W_wmemkv_t; g.M = BATCH * MEMLEN; g.N = 1024; g.K = D; EpiPlain E; E.O = W_kvm; E.ldc = 1024;
          pg8::StaticOrder S; S.init(g.M, g.N, (int)gridDim.x, (int)blockIdx.x); pg8::gemm_phase<EpiPlain, pg8::StaticOrder, false>((PG8_LAS unsigned char*)lds, g, S, E, nullptr); }
        __syncthreads();
        { pg8::Gemm g; g.A = W_xb; g.Bt = W_w_in_t; g.M = T; g.N = INW; g.K = D / 2; EpiIn E; E.hq = W_hq; E.gates = W_gates; E.bgate = p.b_gate;
          pg8::StaticOrder S; S.init(g.M, g.N, (int)gridDim.x, (int)blockIdx.x); pg8::gemm_phase<EpiIn, pg8::StaticOrder, false, true>((PG8_LAS unsigned char*)lds, g, S, E, nullptr); }
    }
    SEAM(1);
    if (PH(2)) { LAUNDER_TID
        LAS unsigned char* L = (LAS unsigned char*)lds;
        attnAB_phase(L, W_hq, p.relb, p.sinks, W_oA, W_lseA, W_yb);
        for (int u = blockIdx.x; u < 256; u += gridDim.x) attnC_unit(u, L, W_hq, W_kvm, W_yc);
        for (int row = gw; row < NEXP / 2; row += nw) cvt_rows_fp8(p.pu, p.pv, W_ub8, W_vb8, W_usc, W_vsc, row, row + NEXP / 2);
    }
    SEAM(2);
    if (PH(3)) { LAUNDER_TID for (size_t i = (size_t)blockIdx.x * NTHREADS + tid; i < (size_t)T * 32; i += (size_t)gridDim.x * NTHREADS) t_mix(i, W_oA, W_lseA, W_ya); }
    SEAM(3);
    if (PH(4)) {
        pg8::MergeArgs g; g.A[0] = W_ya; g.A[1] = W_yb; g.A[2] = W_yc; g.Bt[0] = W_wA_t; g.Bt[1] = W_wB_t; g.Bt[2] = W_wC_t; g.K[0] = 128; g.K[1] = 256; g.K[2] = 256; g.gates = W_gates; g.mb = W_mb;
        pg8::StaticOrder S; S.init(T, D, (int)gridDim.x, (int)blockIdx.x); pg8::gemm_phase_merge<pg8::StaticOrder, true>((PG8_LAS unsigned char*)lds, g, S);
    }
    SEAM(4);
    if (PH(5)) {
        pg8::Gemm g; g.A = (const bf16_t*)W_mb; g.Bt = W_wout_t; g.M = T; g.N = D; g.K = D / 2; EpiPlain E; E.O = W_z; E.ldc = 1024;
        pg8::StaticOrder S; S.init(g.M, g.N, (int)gridDim.x, (int)blockIdx.x); pg8::gemm_phase<EpiPlain, pg8::StaticOrder, false, true, 123>((PG8_LAS unsigned char*)lds, g, S, E, nullptr);
    }
    SEAM(5);
    if (PH(6)) { LAUNDER_TID int t = gw; for (; t + 3 * nw < T; t += 4 * nw) t_res_ln1<4>((size_t)t, (size_t)nw, p.x, W_z, p.ln1g, p.ln1b, W_x1b);
        for (; t < T; t += nw) t_res_ln1<1>((size_t)t, (size_t)nw, p.x, W_z, p.ln1g, p.ln1b, W_x1b); }
    SEAM(6);
    if (PH(7)) {
        pg8::Gemm g; g.A = W_x1b; g.Bt = W_wq_t; g.M = T; g.N = D; g.K = D; EpiPlain E; E.O = W_qb; E.ldc = 1024;
        pg8::StaticOrder S; S.init(g.M, g.N, (int)gridDim.x, (int)blockIdx.x); pg8::gemm_phase<EpiPlain, pg8::StaticOrder, false>((PG8_LAS unsigned char*)lds, g, S, E, nullptr);
    }
    SEAM(7);
    if (PH(8)) { for (int u = blockIdx.x; u < (T / 256) * 8; u += gridDim.x) topk_unit(u, (LAS unsigned char*)lds, W_qb, W_subkb, W_eidx, W_gate); }
    SEAM(8);
    if (PH(9)) { const int ngrp = (int)(gridDim.x >> 3), tpc = ((T + ngrp - 1) / ngrp + 7) & ~7, sl_tok0 = (int)(blockIdx.x >> 3) * tpc, sl_tok1 = ((int)(blockIdx.x >> 3) < ngrp) ? (sl_tok0 + tpc < T ? sl_tok0 + tpc : T) : 0; peerU_phase((int)(blockIdx.x & 7), sl_tok0, sl_tok1, W_x1b, W_eidx, W_ub8, W_hp); }
    SEAM(9);
    if (PH(10)) { peerR_phase(W_hp, W_eidx, W_gate, W_usc, W_vsc, W_cbuf); }
    SEAM(10);
    if (PH(11)) { const int ngrp = (int)(gridDim.x >> 3), tpc = ((T + ngrp - 1) / ngrp + 7) & ~7, sl_tok0 = (int)(blockIdx.x >> 3) * tpc, sl_tok1 = ((int)(blockIdx.x >> 3) < ngrp) ? (sl_tok0 + tpc < T ? sl_tok0 + tpc : T) : 0; peerV_phase((int)(blockIdx.x & 7), sl_tok0, sl_tok1, W_cbuf, W_eidx, W_vb8, W_yp); }
    SEAM(11);
#ifdef PROBE_EXP
    if (PH(13)) { const int ngrp = (int)(gridDim.x >> 3), tpc = ((T + ngrp - 1) / ngrp + 7) & ~7, sl_tok0 = (int)(blockIdx.x >> 3) * tpc, sl_tok1 = ((int)(blockIdx.x >> 3) < ngrp) ? (sl_tok0 + tpc < T ? sl_tok0 + tpc : T) : 0;
        const int sl = (PROBE_EXP == 0) ? (int)(blockIdx.x & 7) : (int)((blockIdx.x + (blockIdx.x >> 3)) & 7);
#if PROBE_EXP == 20
        for (int rep = 0; rep < 20; ++rep) xcd_barrier(bar); (void)sl; (void)sl_tok0; (void)sl_tok1; }
#elif PROBE_EXP >= 10
        probe_valu((float*)(W_ws + 24 * MiB)); (void)sl; (void)sl_tok0; (void)sl_tok1; }
#else
        probe_gather(sl, sl_tok0, sl_tok1, W_eidx, W_ub8, (float*)(W_ws + 24 * MiB)); }
#endif
#endif
    if (PH(12)) { LAUNDER_TID int t = gw; for (; t + 3 * nw < T; t += 4 * nw) peerL_token<4>((size_t)t, (size_t)nw, W_x1b, W_yp, p.ln2g, p.ln2b, p.out);
        for (; t < T; t += nw) peerL_token<1>((size_t)t, (size_t)nw, W_x1b, W_yp, p.ln2g, p.ln2b, p.out); }
}

#ifndef MK_CUTS
#define MK_CUTS 0
#endif
extern "C" void kernel_launch(void* const* d_in, const int* in_sizes, int n_in, void* d_out, int out_size, void* d_ws, size_t ws_size, hipStream_t stream) {
    if (n_in != 19 || in_sizes[0] != T * D || out_size != T * D || ws_size < WS_END) { fprintf(stderr, "kernel_launch: unexpected shapes / workspace (%d inputs, ws %zu)\n", n_in, ws_size); return; }
    static int grid = 0;
    if (!grid) {
        int dev = 0, cus = 0, per_cu = 0;
        if (hipGetDevice(&dev) != hipSuccess || hipDeviceGetAttribute(&cus, hipDeviceAttributeMultiprocessorCount, dev) != hipSuccess) { fprintf(stderr, "kernel_launch: device query failed\n"); return; }
        if (hipFuncSetAttribute((const void*)mk_fwd, hipFuncAttributeMaxDynamicSharedMemorySize, LDS_BYTES) != hipSuccess) { fprintf(stderr, "kernel_launch: hipFuncSetAttribute failed\n"); return; }
        if (hipOccupancyMaxActiveBlocksPerMultiprocessor(&per_cu, (const void*)mk_fwd, NTHREADS, LDS_BYTES) != hipSuccess || per_cu < 1) { fprintf(stderr, "kernel_launch: occupancy query says %d\n", per_cu); return; }
        grid = cus;
    }
    Params p{};
    p.x = (const float*)d_in[0]; p.mem = (const float*)d_in[1]; p.relb = (const float*)d_in[2]; p.w_in = (const float*)d_in[3]; p.b_gate = (const float*)d_in[4]; p.w_memkv = (const float*)d_in[5];
    p.sinks = (const float*)d_in[6]; p.w_a = (const float*)d_in[7]; p.w_b = (const float*)d_in[8]; p.w_c = (const float*)d_in[9]; p.w_out = (const float*)d_in[10]; p.ln1g = (const float*)d_in[11];
    p.ln1b = (const float*)d_in[12]; p.w_q = (const float*)d_in[13]; p.subk = (const float*)d_in[14]; p.pu = (const float*)d_in[15]; p.pv = (const float*)d_in[16]; p.ln2g = (const float*)d_in[17];
    p.ln2b = (const float*)d_in[18]; p.out = (float*)d_out; p.ws = (char*)d_ws;
    if (hipMemsetAsync((char*)d_ws + WS_CTL, 0, CTL_ZERO_BYTES, stream) != hipSuccess) { fprintf(stderr, "kernel_launch: memset failed\n"); return; }
#if MK_CUTS
    for (int k = 0; k < 13; ++k) { p.lo = k; p.hi = k + 1; hipLaunchKernelGGL(mk_fwd, dim3(grid), dim3(NTHREADS), LDS_BYTES, stream, p); }
#else
#ifdef PROBE_SPLITK
    p.lo = 0; p.hi = PROBE_SPLITK + 1; hipLaunchKernelGGL(mk_fwd, dim3(grid), dim3(NTHREADS), LDS_BYTES, stream, p);
#ifndef PROBE_SPLITK_BASE
    (void)hipMemsetAsync((char*)d_ws + WS_CTL, 0, CTL_ZERO_BYTES, stream);
    p.lo = PROBE_SPLITK; p.hi = PROBE_SPLITK + 1; hipLaunchKernelGGL(mk_fwd, dim3(grid), dim3(NTHREADS), LDS_BYTES, stream, p);
#endif
    (void)hipMemsetAsync((char*)d_ws + WS_CTL, 0, CTL_ZERO_BYTES, stream);
    p.lo = PROBE_SPLITK + 1; p.hi = 13; hipLaunchKernelGGL(mk_fwd, dim3(grid), dim3(NTHREADS), LDS_BYTES, stream, p);
#else
    p.lo = 0; p.hi = 13; hipLaunchKernelGGL(mk_fwd, dim3(grid), dim3(NTHREADS), LDS_BYTES, stream, p);
#endif
#endif
#ifdef PROBE_EXP
    (void)hipMemsetAsync((char*)d_ws + WS_CTL, 0, CTL_ZERO_BYTES, stream);
    p.lo = 13; p.hi = 14; hipLaunchKernelGGL(mk_fwd, dim3(grid), dim3(NTHREADS), LDS_BYTES, stream, p);
#endif
#ifdef PROBE_RELAUNCH
    p.lo = PROBE_RELAUNCH; p.hi = PROBE_RELAUNCH + 1; hipLaunchKernelGGL(mk_fwd, dim3(grid), dim3(NTHREADS), LDS_BYTES, stream, p);
#endif
}
```

```cpp
#include <hip/hip_runtime.h>
#include <cstdio>
#include <cstdint>
namespace pg8 {
#define PG8_LAS __attribute__((address_space(3)))
typedef unsigned short bf16_t;
typedef short bf16x8 __attribute__((ext_vector_type(8)));
typedef float f32x4 __attribute__((ext_vector_type(4)));
typedef unsigned u32x4 __attribute__((ext_vector_type(4)));
constexpr int BM = 256, BK = 64, HALF = 128, HTB = HALF * BK * 2  , STAGE_BYTES = 8 * HTB, NXCD = 8, WGM = 8;

__host__ __device__ __forceinline__ int lds_byte(int r, int c) { const int st = (r >> 4) * 2 + (c >> 5), rr = r & 15, cc = c & 31, ob = rr * 64 + cc * 2; return st * 1024 + (ob ^ (((ob >> 9) & 1) << 5)); }
__host__ __device__ __forceinline__ void stage_rc(int b, int& R, int& C) { const int st = b / 1024, sb = b % 1024, swz = sb ^ (((sb >> 9) & 1) << 5); R = (st >> 1) * 16 + swz / 64; C = (st & 1) * 32 + (swz % 64) / 2; }
__host__ __device__ __forceinline__ int perm32(int rho) { const int n = rho >> 4, i = rho & 15; return 8 * (i >> 2) + 4 * n + (i & 3); }

struct Unit { int pm, pn; };
struct Gemm { const bf16_t* A; const bf16_t* Bt; int M, N, K; };

struct StaticOrder {
    int nM, nN, nwg, G, c;
    __host__ __device__ void init(int M, int N, int G_, int c_) { nM = M / BM; nN = N / BM; nwg = nM * nN; G = G_; c = c_; }
    __host__ __device__ bool next(int i, Unit& u) const {
        const long L = (long)i * G + c; if (L >= nwg) return false;
        int wgid = (int)L; { const int q = nwg / NXCD, r = nwg % NXCD, xcd = wgid % NXCD, off = wgid / NXCD; wgid = (xcd < r ? xcd * (q + 1) : r * (q + 1) + (xcd - r) * q) + off; }
        const int nig = WGM * nN, gid = wgid / nig, fm = gid * WGM, gsz = (nM - fm) < WGM ? (nM - fm) : WGM;
        u.pm = fm + ((wgid % nig) % gsz); u.pn = (wgid % nig) / gsz; return true;
    }
    __device__ __forceinline__ void a_ready(const Unit&) const {}
    __device__ __forceinline__ void done(const Unit&) const {}
};
__device__ __forceinline__ unsigned cvt_pk_bf16(float lo, float hi) { unsigned r; asm volatile("v_cvt_pk_bf16_f32 %0, %1, %2" : "=v"(r) : "v"(lo), "v"(hi)); return r; }
typedef float f32x2 __attribute__((ext_vector_type(2)));
__device__ __forceinline__ f32x2 gelu_pk(f32x2 v) {
    const f32x2 av = __builtin_elementwise_abs(v), d = av * 0.2316418882f + 1.0f;
    f32x2 t; t.x = __builtin_amdgcn_rcpf(d.x); t.y = __builtin_amdgcn_rcpf(d.y);
    f32x2 q = t * 0.5307027145f + (-0.7265760135f); q = q * t + 0.7107068705f; q = q * t + (-0.142248368f); q = q * t + 0.127414796f; q = q * t;
    const f32x2 s = (v * v) * (-0.72134752044f);
    f32x2 e; e.x = __builtin_amdgcn_exp2f(s.x); e.y = __builtin_amdgcn_exp2f(s.y);
    const f32x2 m = v * (q * e), r = v - m;
    f32x2 o; o.x = v.x < 0.f ? m.x : r.x; o.y = v.y < 0.f ? m.y : r.y; return o;
}
template <class Epi, class Sched, bool STAMP = false, bool FP8 = false, int XSCALE = 127>
__device__ __forceinline__ void gemm_phase(PG8_LAS unsigned char* lds, const Gemm g, const Sched& S, const Epi& E, unsigned long long* stamps) {
    int tid_l = threadIdx.x; asm volatile("" : "+v"(tid_l));
    const int tid = tid_l, wid = __builtin_amdgcn_readfirstlane(tid >> 6), lane = tid & 63, wr = wid >> 2, wc = wid & 3, fr = lane & 15, fq = lane >> 4;
    const int K = g.K, nt = K / BK;
    int ts_lo = 0, ts_hi = 0, nts = 0; const unsigned long long rt_entry = STAMP ? (unsigned long long)wall_clock64() : 0ull;
#define PG8_STAMP() do { if (STAMP && wid == 0 && nts < 64) { const unsigned long long _c = (unsigned long long)clock64(); \
        ts_lo = (lane == nts) ? (int)(unsigned)_c : ts_lo; ts_hi = (lane == nts) ? (int)(unsigned)(_c >> 32) : ts_hi; ++nts; } } while (0)
    PG8_STAMP();
    unsigned voffA[2], voffB[2];
#pragma unroll
    for (int i = 0; i < 2; ++i) { int R, C; stage_rc(tid * 16 + i * 8192, R, C); const int Rb = Epi::PERM ? ((R & ~31) + perm32(R & 31)) : R;
        voffA[i] = (unsigned)(R * K + C) * 2u; voffB[i] = (unsigned)(Rb * K + C) * 2u; }
    const size_t kstep = (size_t)(BK * 2);
    const size_t hstep = (size_t)HALF * K * 2;
    const size_t tstep = 2 * hstep;
    const unsigned ldsw = (unsigned)wid * 1024u;
    const int aoff = lds_byte(wr * 64 + fr, fq * 8), boff = lds_byte(wc * 32 + fr, fq * 8);
#define PG8_SA(b, h) (((b) * 2 + (h)) * HTB)
#define PG8_SB(b, h) ((4 + (b) * 2 + (h)) * HTB)
#define PG8_STAGE(bufoff, gbase, voff) do { _Pragma("unroll") for (int _i = 0; _i < 2; ++_i) \
        __builtin_amdgcn_global_load_lds((const unsigned*)((const char*)(gbase) + (voff)[_i]), (PG8_LAS unsigned*)(lds + (bufoff) + ldsw + _i * 8192), 16, 0, 0); } while (0)
#define PG8_LDA(dst, b, h) do { if constexpr (FP8) { _Pragma("unroll") for (int m = 0; m < 4; ++m) dst##8[m] = __builtin_shufflevector(*(const PG8_LAS i32x4_*)(lds + PG8_SA(b, h) + aoff + m * 2048), *(const PG8_LAS i32x4_*)(lds + PG8_SA(b, h) + aoff + m * 2048 + 1024), 0, 1, 2, 3, 4, 5, 6, 7); } \
        else { _Pragma("unroll") for (int m = 0; m < 4; ++m) _Pragma("unroll") for (int k = 0; k < 2; ++k) dst[m][k] = *(const PG8_LAS bf16x8*)(lds + PG8_SA(b, h) + aoff + m * 2048 + k * 1024); } } while (0)
#define PG8_LDB(dst, b, h) do { if constexpr (FP8) { _Pragma("unroll") for (int n = 0; n < 2; ++n) dst##8[n] = __builtin_shufflevector(*(const PG8_LAS i32x4_*)(lds + PG8_SB(b, h) + boff + n * 2048), *(const PG8_LAS i32x4_*)(lds + PG8_SB(b, h) + boff + n * 2048 + 1024), 0, 1, 2, 3, 4, 5, 6, 7); } \
        else { _Pragma("unroll") for (int n = 0; n < 2; ++n) _Pragma("unroll") for (int k = 0; k < 2; ++k) dst[n][k] = *(const PG8_LAS bf16x8*)(lds + PG8_SB(b, h) + boff + n * 2048 + k * 1024); } } while (0)
#define PG8_MMA(ai, bj, At, Bt) do { __builtin_amdgcn_s_setprio(1); _Pragma("unroll") for (int m = 0; m < 4; ++m) _Pragma("unroll") for (int n = 0; n < 2; ++n) { \
        if constexpr (FP8) asm volatile("v_mfma_scale_f32_16x16x128_f8f6f4 %0, %1, %2, %0, %3, %4 op_sel_hi:[0,0,0]" : "+v"(acc[ai][bj][m][n]) : "v"(Bt##8[n]), "v"(At##8[m]), "v"(scale_w), "v"(scale_x));        \
        else { _Pragma("unroll") for (int k = 0; k < 2; ++k) acc[ai][bj][m][n] = __builtin_amdgcn_mfma_f32_16x16x32_bf16(Bt[n][k], At[m][k], acc[ai][bj][m][n], 0, 0, 0); } } \
        __builtin_amdgcn_s_setprio(0); } while (0)
#define PG8_WAIT_V(n) asm volatile("s_waitcnt vmcnt(" #n ")" ::: "memory")
#define PG8_WAIT_L(n) asm volatile("s_waitcnt lgkmcnt(" #n ")" ::: "memory")
#define PG8_BAR __builtin_amdgcn_s_barrier()
#define PG8_SCHED __builtin_amdgcn_sched_barrier(0)
    Unit cur, nxt; int ui = 0;
    if (!S.next(0, cur)) return;
    f32x4 acc[2][2][4][2];
#pragma unroll
    for (int a = 0; a < 2; ++a)
#pragma unroll
        for (int b = 0; b < 2; ++b)
#pragma unroll
            for (int m = 0; m < 4; ++m)
#pragma unroll
                for (int n = 0; n < 2; ++n) acc[a][b][m][n] = (f32x4){0.f, 0.f, 0.f, 0.f};
    typedef int i32x4_ __attribute__((ext_vector_type(4))); typedef int i32x8_ __attribute__((ext_vector_type(8)));
    int scale_w = 122, scale_x = XSCALE; asm volatile("" : "+v"(scale_w), "+v"(scale_x));
    bf16x8 At[4][2], B0[2][2], B1[2][2]; i32x8_ At8[4], B08[2], B18[2];
    const char* cA = (const char*)g.A + (size_t)cur.pm * tstep; const char* cB = (const char*)g.Bt + (size_t)cur.pn * tstep;
    S.a_ready(cur);
    PG8_STAGE(PG8_SB(0, 0), cB, voffB); PG8_STAGE(PG8_SA(0, 0), cA, voffA); PG8_STAGE(PG8_SB(0, 1), cB + hstep, voffB); PG8_STAGE(PG8_SA(0, 1), cA + hstep, voffA);
    if (wr == 1) PG8_BAR;
    PG8_WAIT_V(4); PG8_BAR;
    PG8_STAGE(PG8_SB(1, 0), cB + kstep, voffB); PG8_STAGE(PG8_SA(1, 0), cA + kstep, voffA); PG8_STAGE(PG8_SB(1, 1), cB + hstep + kstep, voffB);
    PG8_WAIT_V(6); PG8_BAR;
    PG8_STAMP();
    for (;;) {
        const bool has_next = S.next(ui + 1, nxt);
        const char* nA = has_next ? (const char*)g.A + (size_t)nxt.pm * tstep : cA; const char* nB = has_next ? (const char*)g.Bt + (size_t)nxt.pn * tstep : cB;
        for (int t = 0; t < nt; t += 2) {
            const bool last = (t == nt - 2);
            const char* a1 = cA + (size_t)(t + 1) * kstep;
            const char* a2 = last ? nA : cA + (size_t)(t + 2) * kstep; const char* b2 = last ? nB : cB + (size_t)(t + 2) * kstep;
            const char* a3 = a2 + kstep; const char* b3 = b2 + kstep;
            if (last && has_next) S.a_ready(nxt);
            PG8_LDB(B0, 0, 0); PG8_SCHED; PG8_LDA(At, 0, 0); PG8_STAGE(PG8_SA(1, 1), a1 + hstep, voffA);
            PG8_WAIT_L(8); PG8_BAR; PG8_WAIT_L(0); PG8_MMA(0, 0, At, B0); PG8_BAR; PG8_SCHED;
            PG8_LDB(B1, 0, 1); PG8_STAGE(PG8_SB(0, 0), b2, voffB);
            PG8_BAR; PG8_WAIT_L(0); PG8_MMA(0, 1, At, B1); PG8_BAR;
            PG8_LDA(At, 0, 1); PG8_STAGE(PG8_SA(0, 0), a2, voffA);
            PG8_BAR; PG8_WAIT_L(0); PG8_MMA(1, 0, At, B0); PG8_BAR; PG8_SCHED;
            PG8_STAGE(PG8_SB(0, 1), b2 + hstep, voffB);
            PG8_WAIT_V(6); PG8_BAR; PG8_MMA(1, 1, At, B1); PG8_BAR;
            PG8_LDB(B0, 1, 0); PG8_SCHED; PG8_LDA(At, 1, 0); PG8_STAGE(PG8_SA(0, 1), a2 + hstep, voffA);
            PG8_WAIT_L(8); PG8_BAR; PG8_WAIT_L(0); PG8_MMA(0, 0, At, B0); PG8_BAR; PG8_SCHED;
            PG8_LDB(B1, 1, 1); PG8_STAGE(PG8_SB(1, 0), b3, voffB);
            PG8_BAR; PG8_WAIT_L(0); PG8_MMA(0, 1, At, B1); PG8_BAR;
            PG8_LDA(At, 1, 1); PG8_STAGE(PG8_SA(1, 0), a3, voffA);
            PG8_BAR; PG8_WAIT_L(0); PG8_MMA(1, 0, At, B0); PG8_BAR; PG8_SCHED;
            PG8_STAGE(PG8_SB(1, 1), b3 + hstep, voffB);
            PG8_WAIT_V(6); PG8_BAR; PG8_MMA(1, 1, At, B1); PG8_BAR;
        }
        PG8_STAMP();
        if constexpr (FP8) { asm volatile("s_nop 15\n\ts_nop 15" ::: "memory");
#pragma unroll
            for (int a = 0; a < 2; ++a)
#pragma unroll
                for (int b = 0; b < 2; ++b)
#pragma unroll
                    for (int m = 0; m < 4; ++m)
#pragma unroll
                        for (int n = 0; n < 2; ++n) asm volatile("" : "+v"(acc[a][b][m][n])); }
        if constexpr (!Epi::AFTER_DRAIN) { E(acc, cur, wr, wc, fr, fq); S.done(cur); }
        PG8_STAMP();
        if (!has_next) break;
#pragma unroll
        for (int a = 0; a < 2; ++a)
#pragma unroll
            for (int b = 0; b < 2; ++b)
#pragma unroll
                for (int m = 0; m < 4; ++m)
#pragma unroll
                    for (int n = 0; n < 2; ++n) acc[a][b][m][n] = (f32x4){0.f, 0.f, 0.f, 0.f};
        cur = nxt; cA = nA; cB = nB; ++ui;
    }
    PG8_WAIT_V(0);
    if (wr == 0) PG8_BAR;
    PG8_BAR;
    if constexpr (Epi::AFTER_DRAIN) { E.fused(acc, cur, wr, wc, fr, fq, lds, wid, lane); S.done(cur); }
    PG8_STAMP();
    if (STAMP && wid == 0) { stamps[lane] = lane < nts ? (((unsigned long long)(unsigned)ts_hi << 32) | (unsigned)ts_lo) : 0ull;
        if (lane == 62) stamps[62] = rt_entry; if (lane == 63) stamps[63] = (unsigned long long)wall_clock64(); }
#undef PG8_STAMP
#undef PG8_SA
#undef PG8_SB
#undef PG8_STAGE
#undef PG8_LDA
#undef PG8_LDB
#undef PG8_MMA
#undef PG8_WAIT_V
#undef PG8_WAIT_L
#undef PG8_BAR
#undef PG8_SCHED
}
}

namespace pg8 {
struct MergeArgs { const bf16_t* A[3]; const bf16_t* Bt[3]; int K[3]; const bf16_t* gates; unsigned char* mb; };
template <class Sched, bool FP8 = false>
__device__ __forceinline__ void gemm_phase_merge(PG8_LAS unsigned char* lds, const MergeArgs g, const Sched& S) {
    int tid_l = threadIdx.x; asm volatile("" : "+v"(tid_l));
    const int tid = tid_l, wid = __builtin_amdgcn_readfirstlane(tid >> 6), lane = tid & 63, wr = wid >> 2, wc = wid & 3, fr = lane & 15, fq = lane >> 4;
    unsigned R2A[2], R2B[2], C2[2];
#pragma unroll
    for (int i = 0; i < 2; ++i) { int R, C; stage_rc(tid * 16 + i * 8192, R, C); const int Rb = (R & ~31) + perm32(R & 31); R2A[i] = (unsigned)R * 2u; R2B[i] = (unsigned)Rb * 2u; C2[i] = (unsigned)C * 2u; }
    const size_t kstep = (size_t)(BK * 2);
    const unsigned ldsw = (unsigned)wid * 1024u;
    const int aoff = lds_byte(wr * 64 + fr, fq * 8), boff = lds_byte(wc * 32 + fr, fq * 8);
#define PG8_SA(b, h) (((b) * 2 + (h)) * HTB)
#define PG8_SB(b, h) ((4 + (b) * 2 + (h)) * HTB)
#define PG8_STAGEK(bufoff, gbase, R2, KK) do { _Pragma("unroll") for (int _i = 0; _i < 2; ++_i) \
        __builtin_amdgcn_global_load_lds((const unsigned*)((const char*)(gbase) + (R2)[_i] * (unsigned)(KK) + C2[_i]), (PG8_LAS unsigned*)(lds + (bufoff) + ldsw + _i * 8192), 16, 0, 0); } while (0)
#define PG8_LDA(dst, b, h) do { if constexpr (FP8) { _Pragma("unroll") for (int m = 0; m < 4; ++m) dst##8[m] = __builtin_shufflevector(*(const PG8_LAS i32x4_*)(lds + PG8_SA(b, h) + aoff + m * 2048), *(const PG8_LAS i32x4_*)(lds + PG8_SA(b, h) + aoff + m * 2048 + 1024), 0, 1, 2, 3, 4, 5, 6, 7); } \
        else { _Pragma("unroll") for (int m = 0; m < 4; ++m) _Pragma("unroll") for (int k = 0; k < 2; ++k) dst[m][k] = *(const PG8_LAS bf16x8*)(lds + PG8_SA(b, h) + aoff + m * 2048 + k * 1024); } } while (0)
#define PG8_LDB(dst, b, h) do { if constexpr (FP8) { _Pragma("unroll") for (int n = 0; n < 2; ++n) dst##8[n] = __builtin_shufflevector(*(const PG8_LAS i32x4_*)(lds + PG8_SB(b, h) + boff + n * 2048), *(const PG8_LAS i32x4_*)(lds + PG8_SB(b, h) + boff + n * 2048 + 1024), 0, 1, 2, 3, 4, 5, 6, 7); } \
        else { _Pragma("unroll") for (int n = 0; n < 2; ++n) _Pragma("unroll") for (int k = 0; k < 2; ++k) dst[n][k] = *(const PG8_LAS bf16x8*)(lds + PG8_SB(b, h) + boff + n * 2048 + k * 1024); } } while (0)
#define PG8_MMA(ai, bj, At, Bt) do { __builtin_amdgcn_s_setprio(1); _Pragma("unroll") for (int m = 0; m < 4; ++m) _Pragma("unroll") for (int n = 0; n < 2; ++n) { \
        if constexpr (FP8) asm volatile("v_mfma_scale_f32_16x16x128_f8f6f4 %0, %1, %2, %0, %3, %4 op_sel_hi:[0,0,0]" : "+v"(acc[ai][bj][m][n]) : "v"(Bt##8[n]), "v"(At##8[m]), "v"(scale_w), "v"(scale_x)); \
        else { _Pragma("unroll") for (int k = 0; k < 2; ++k) acc[ai][bj][m][n] = __builtin_amdgcn_mfma_f32_16x16x32_bf16(Bt[n][k], At[m][k], acc[ai][bj][m][n], 0, 0, 0); } } \
        __builtin_amdgcn_s_setprio(0); } while (0)
#define PG8_WAIT_V(n) asm volatile("s_waitcnt vmcnt(" #n ")" ::: "memory")
#define PG8_WAIT_L(n) asm volatile("s_waitcnt lgkmcnt(" #n ")" ::: "memory")
#define PG8_BAR __builtin_amdgcn_s_barrier()
#define PG8_SCHED __builtin_amdgcn_sched_barrier(0)
    Unit cur, nxt; int ui = 0, seg = 0;
    if (!S.next(0, cur)) return;
    f32x4 acc[2][2][4][2];
#pragma unroll
    for (int a = 0; a < 2; ++a)
#pragma unroll
        for (int b = 0; b < 2; ++b)
#pragma unroll
            for (int m = 0; m < 4; ++m)
#pragma unroll
                for (int n = 0; n < 2; ++n) acc[a][b][m][n] = (f32x4){0.f, 0.f, 0.f, 0.f};
    typedef int i32x4_ __attribute__((ext_vector_type(4))); typedef int i32x8_ __attribute__((ext_vector_type(8)));
    int scale_w = 122, scale_x = 123; asm volatile("" : "+v"(scale_w), "+v"(scale_x));
    bf16x8 At[4][2], B0[2][2], B1[2][2]; i32x8_ At8[4], B08[2], B18[2];
    int Kc = g.K[0];
    const char* cA = (const char*)g.A[0] + (size_t)cur.pm * 512 * Kc; const char* cB = (const char*)g.Bt[0] + (size_t)cur.pn * 512 * Kc;
    {   const size_t hs = (size_t)256 * Kc;
        PG8_STAGEK(PG8_SB(0, 0), cB, R2B, Kc); PG8_STAGEK(PG8_SA(0, 0), cA, R2A, Kc); PG8_STAGEK(PG8_SB(0, 1), cB + hs, R2B, Kc); PG8_STAGEK(PG8_SA(0, 1), cA + hs, R2A, Kc);
        if (wr == 1) PG8_BAR;
        PG8_WAIT_V(4); PG8_BAR;
        PG8_STAGEK(PG8_SB(1, 0), cB + kstep, R2B, Kc); PG8_STAGEK(PG8_SA(1, 0), cA + kstep, R2A, Kc); PG8_STAGEK(PG8_SB(1, 1), cB + hs + kstep, R2B, Kc);
        PG8_WAIT_V(6); PG8_BAR; }
    for (;;) {
        bool has_next_tile = false; int nseg = seg + 1; Unit nu = cur;
        if (nseg == 3) { nseg = 0; has_next_tile = S.next(ui + 1, nxt); nu = nxt; }
        const bool more = (seg < 2) || has_next_tile;
        const int Kn = more ? (nseg == 0 ? g.K[0] : (nseg == 1 ? g.K[1] : g.K[2])) : Kc;
        const bf16_t* gA = nseg == 0 ? g.A[0] : (nseg == 1 ? g.A[1] : g.A[2]); const bf16_t* gB = nseg == 0 ? g.Bt[0] : (nseg == 1 ? g.Bt[1] : g.Bt[2]);
        const char* nA = more ? (const char*)gA + (size_t)nu.pm * 512 * Kn : cA; const char* nB = more ? (const char*)gB + (size_t)nu.pn * 512 * Kn : cB;
        const int nt = Kc / BK; const size_t hsc = (size_t)256 * Kc, hsn = (size_t)256 * Kn;
        for (int t = 0; t < nt; t += 2) {
            const bool last = (t == nt - 2);
            const char* a1 = cA + (size_t)(t + 1) * kstep;
            const char* a2 = last ? nA : cA + (size_t)(t + 2) * kstep; const char* b2 = last ? nB : cB + (size_t)(t + 2) * kstep;
            const char* a3 = a2 + kstep; const char* b3 = b2 + kstep;
            const int K2 = last ? Kn : Kc; const size_t hs2 = last ? hsn : hsc;
            PG8_LDB(B0, 0, 0); PG8_SCHED; PG8_LDA(At, 0, 0); PG8_STAGEK(PG8_SA(1, 1), a1 + hsc, R2A, Kc);
            PG8_WAIT_L(8); PG8_BAR; PG8_WAIT_L(0); PG8_MMA(0, 0, At, B0); PG8_BAR; PG8_SCHED;
            PG8_LDB(B1, 0, 1); PG8_STAGEK(PG8_SB(0, 0), b2, R2B, K2);
            PG8_BAR; PG8_WAIT_L(0); PG8_MMA(0, 1, At, B1); PG8_BAR;
            PG8_LDA(At, 0, 1); PG8_STAGEK(PG8_SA(0, 0), a2, R2A, K2);
            PG8_BAR; PG8_WAIT_L(0); PG8_MMA(1, 0, At, B0); PG8_BAR; PG8_SCHED;
            PG8_STAGEK(PG8_SB(0, 1), b2 + hs2, R2B, K2);
            PG8_WAIT_V(6); PG8_BAR; PG8_MMA(1, 1, At, B1); PG8_BAR;
            PG8_LDB(B0, 1, 0); PG8_SCHED; PG8_LDA(At, 1, 0); PG8_STAGEK(PG8_SA(0, 1), a2 + hs2, R2A, K2);
            PG8_WAIT_L(8); PG8_BAR; PG8_WAIT_L(0); PG8_MMA(0, 0, At, B0); PG8_BAR; PG8_SCHED;
            PG8_LDB(B1, 1, 1); PG8_STAGEK(PG8_SB(1, 0), b3, R2B, K2);
            PG8_BAR; PG8_WAIT_L(0); PG8_MMA(0, 1, At, B1); PG8_BAR;
            PG8_LDA(At, 1, 1); PG8_STAGEK(PG8_SA(1, 0), a3, R2A, K2);
            PG8_BAR; PG8_WAIT_L(0); PG8_MMA(1, 0, At, B0); PG8_BAR; PG8_SCHED;
            PG8_STAGEK(PG8_SB(1, 1), b3 + hs2, R2B, K2);
            PG8_WAIT_V(6); PG8_BAR; PG8_MMA(1, 1, At, B1); PG8_BAR;
        }
        if constexpr (FP8) { asm volatile("s_nop 15\n\ts_nop 15" ::: "memory");
#pragma unroll
            for (int a = 0; a < 2; ++a)
#pragma unroll
                for (int b = 0; b < 2; ++b)
#pragma unroll
                    for (int mm = 0; mm < 4; ++mm)
#pragma unroll
                        for (int n = 0; n < 2; ++n) asm volatile("" : "+v"(acc[a][b][mm][n])); }
        {   const int row0 = cur.pm * 256 + wr * 64 + fr, col0 = cur.pn * 256 + wc * 32 + 8 * fq;
            const unsigned char* gb_s = (const unsigned char*)g.gates + ((size_t)(seg * 128 + cur.pm) * 4 + cur.pn) * 65536 + (size_t)tid * 16;
            const unsigned char* gb_n = gb_s + (size_t)128 * 4 * 65536;
            u32x4 GS[2][2], GN[2][2]; typedef float f32x2_m __attribute__((ext_vector_type(2)));
#define MRG_LOAD(buf, bt) do { _Pragma("unroll") for (int cp = 0; cp < 2; ++cp) { GS[buf][cp] = *(const u32x4*)(gb_s + (size_t)(((bt) * 2 + cp) * 512) * 16); \
                GN[buf][cp] = (seg < 2) ? *(const u32x4*)(gb_n + (size_t)(((bt) * 2 + cp) * 512) * 16) : (u32x4){0x78787878u, 0x78787878u, 0x78787878u, 0x78787878u}; } } while (0)
#define MRG_APPLY(buf, bt) do { _Pragma("unroll") for (int c = 0; c < 4; ++c) { const int idx = (bt) * 4 + c, ai = idx >> 3, m = (idx >> 1) & 3, bj = idx & 1; \
                const unsigned gs0 = bj ? GS[buf][c >> 1].z : GS[buf][c >> 1].x, gs1 = bj ? GS[buf][c >> 1].w : GS[buf][c >> 1].y, gn0 = bj ? GN[buf][c >> 1].z : GN[buf][c >> 1].x, gn1 = bj ? GN[buf][c >> 1].w : GN[buf][c >> 1].y; \
                const f32x2_m fa = __builtin_amdgcn_cvt_pk_f32_fp8((int)gs0, false), fb = __builtin_amdgcn_cvt_pk_f32_fp8((int)gs0, true), fc = __builtin_amdgcn_cvt_pk_f32_fp8((int)gs1, false), fd = __builtin_amdgcn_cvt_pk_f32_fp8((int)gs1, true); \
                const f32x2_m da = __builtin_amdgcn_cvt_pk_f32_fp8((int)gn0, false), db = __builtin_amdgcn_cvt_pk_f32_fp8((int)gn0, true), dc = __builtin_amdgcn_cvt_pk_f32_fp8((int)gn1, false), dd = __builtin_amdgcn_cvt_pk_f32_fp8((int)gn1, true); \
                float f[8] = {fa.x, fa.y, fb.x, fb.y, fc.x, fc.y, fd.x, fd.y}; const float d[8] = {da.x, da.y, db.x, db.y, dc.x, dc.y, dd.x, dd.y}; \
                _Pragma("unroll") for (int j = 0; j < 8; ++j) f[j] = f[j] * __builtin_amdgcn_rcpf(d[j]);        \
                f32x4 v0 = acc[ai][bj][m][0], v1 = acc[ai][bj][m][1]; \
                v0[0] *= f[0]; v0[1] *= f[1]; v0[2] *= f[2]; v0[3] *= f[3]; v1[0] *= f[4]; v1[1] *= f[5]; v1[2] *= f[6]; v1[3] *= f[7]; \
                if (seg < 2) { acc[ai][bj][m][0] = v0; acc[ai][bj][m][1] = v1; } \
                else { typedef unsigned u32x2_ __attribute__((ext_vector_type(2))); u32x2_ w; int t8 = 0; t8 = __builtin_amdgcn_cvt_pk_fp8_f32(v0[0] * 16.f, v0[1] * 16.f, t8, false); t8 = __builtin_amdgcn_cvt_pk_fp8_f32(v0[2] * 16.f, v0[3] * 16.f, t8, true); w.x = (unsigned)t8; \
                    t8 = 0; t8 = __builtin_amdgcn_cvt_pk_fp8_f32(v1[0] * 16.f, v1[1] * 16.f, t8, false); t8 = __builtin_amdgcn_cvt_pk_fp8_f32(v1[2] * 16.f, v1[3] * 16.f, t8, true); w.y = (unsigned)t8; \
                    *(u32x2_*)(g.mb + (size_t)(row0 + ai * 128 + m * 16) * 1024 + col0 + bj * 128) = w;        \
                    acc[ai][bj][m][0] = (f32x4){0.f, 0.f, 0.f, 0.f}; acc[ai][bj][m][1] = (f32x4){0.f, 0.f, 0.f, 0.f}; } } } while (0)
            MRG_LOAD(0, 0);
#pragma unroll
            for (int bt = 0; bt < 4; bt += 2) {
                MRG_LOAD(1, bt + 1); asm volatile("" ::: "memory"); MRG_APPLY(0, bt);
                if (bt + 2 < 4) { MRG_LOAD(0, bt + 2); } asm volatile("" ::: "memory"); MRG_APPLY(1, bt + 1); }
#undef MRG_LOAD
#undef MRG_APPLY
        }
        if (!more) break;
        if (nseg == 0) { cur = nxt; ++ui; }
        seg = nseg; Kc = Kn; cA = nA; cB = nB;
    }
    PG8_WAIT_V(0);
    if (wr == 0) PG8_BAR;
    PG8_BAR;
#undef PG8_SA
#undef PG8_SB
#undef PG8_STAGEK
#undef PG8_LDA
#undef PG8_LDB
#undef PG8_MMA
#undef PG8_WAIT_V
#undef PG8_WAIT_L
#undef PG8_BAR
#undef PG8_SCHED
}
}
#define XB_TMO      128
#define XB_XCNT(j)  (256  + 64 * (j))
#define XB_XSUB(j)  (1280 + 64 * (j))
#define XB_XGEN(j)  (2304 + 64 * (j))
#define XB_TOP      3328
#define XB_TOPGEN   3392
#define XCD_BAR_WORDS 3456
#define XB_SPIN_CAP (1u << 18)
#define LAS __attribute__((address_space(3)))

__device__ __forceinline__ unsigned xb_ld(unsigned* p)              { return __hip_atomic_load(p, __ATOMIC_RELAXED, __HIP_MEMORY_SCOPE_AGENT); }
__device__ __forceinline__ unsigned xb_add(unsigned* p, unsigned v) { return __hip_atomic_fetch_add(p, v, __ATOMIC_RELAXED, __HIP_MEMORY_SCOPE_AGENT); }
__device__ __forceinline__ unsigned xb_xcc_id() { return (unsigned)__builtin_amdgcn_s_getreg((3 << 11) | 20) & 0xFu; }
#define XB_SPIN(cond, bar) do { unsigned _sp = 0; while (cond) { __builtin_amdgcn_s_sleep(1); \
    if ((++_sp & 255u) == 0u) { if (xb_ld(&(bar)[XB_TMO])) break; if (_sp > XB_SPIN_CAP) { atomicAdd(&(bar)[XB_TMO], 1u); break; } } } } while (0)

struct XcdBarrier {
    unsigned* bar; unsigned x;
    volatile LAS unsigned* st;
};

__device__ __forceinline__ XcdBarrier xcd_barrier_post(unsigned* bar, volatile LAS unsigned* st) {
    XcdBarrier b; b.bar = bar; b.x = xb_xcc_id(); b.st = st;
    if (threadIdx.x == 0) (void)xb_add(&bar[XB_XCNT(b.x)], 1u);
    return b;
}
__device__ __forceinline__ void xcd_barrier_complete(unsigned* bar, unsigned x, unsigned& nloc, unsigned& nx) {
    const unsigned G = gridDim.x * gridDim.y * gridDim.z;
    unsigned sum, cnt, mine, sp = 0u;
    for (;;) {
        sum = 0u; cnt = 0u; mine = 0u;
#pragma unroll
        for (unsigned j = 0; j < 16; ++j) { const unsigned c = xb_ld(&bar[XB_XCNT(j)]); sum += c; cnt += (c > 0u) ? 1u : 0u; mine = (j == x) ? c : mine; }
        if (sum == G) break;
        __builtin_amdgcn_s_sleep(1);
        if ((++sp & 255u) == 0u) { if (xb_ld(&bar[XB_TMO])) break; if (sp > XB_SPIN_CAP) { atomicAdd(&bar[XB_TMO], 1u); break; } }
    }
    nloc = mine > 0u ? mine : 1u; nx = cnt > 0u ? cnt : 1u;
}

__device__ __forceinline__ void xcd_barrier(const XcdBarrier& b) {
    asm volatile("s_waitcnt vmcnt(0)" ::: "memory");
    __syncthreads();
    if (threadIdx.x == 0) {
        unsigned* bar = b.bar;
        __builtin_amdgcn_s_waitcnt(0);
        unsigned nloc = b.st[0], nx = b.st[1];
        if (nloc == 0u) { xcd_barrier_complete(bar, b.x, nloc, nx); b.st[0] = nloc; b.st[1] = nx; }
        const unsigned old = xb_add(&bar[XB_XSUB(b.x)], 1u);
        const unsigned gen = old / nloc;
        if (old + 1u == (gen + 1u) * nloc) {
            __builtin_amdgcn_fence(__ATOMIC_RELEASE, "agent");
            asm volatile("s_waitcnt vmcnt(0)" ::: "memory");
            const unsigned og = xb_add(&bar[XB_TOP], 1u);
            const unsigned tg = og / nx;
            if (og + 1u == (tg + 1u) * nx) xb_add(&bar[XB_TOPGEN], 1u);
            else XB_SPIN(xb_ld(&bar[XB_TOPGEN]) == tg, bar);
            __builtin_amdgcn_fence(__ATOMIC_ACQUIRE, "agent");
            xb_add(&bar[XB_XGEN(b.x)], 1u);
            asm volatile("s_waitcnt vmcnt(0)" ::: "memory");
        } else {
            XB_SPIN(xb_ld(&bar[XB_XGEN(b.x)]) == gen, bar);
            __builtin_amdgcn_fence(__ATOMIC_ACQUIRE, "agent");
            asm volatile("s_waitcnt vmcnt(0)" ::: "memory");
        }
    }
    __syncthreads();
}


typedef unsigned short bf16_t;
typedef float f32x4 __attribute__((ext_vector_type(4)));
typedef unsigned u32x4 __attribute__((ext_vector_type(4)));
typedef unsigned u32x2 __attribute__((ext_vector_type(2)));
typedef __bf16 bf16x2_t __attribute__((ext_vector_type(2)));
constexpr int D = 1024, BATCH = 8, SEQ = 4096, T = BATCH * SEQ, MEMLEN = 256;
constexpr int HQW = 3584, GW = 3072, INW = 6656, NEXP = 16384;
constexpr int C_AQ = 0, C_AK = 768, C_AV = 1536, C_BQ = 2304, C_BK = 2816, C_BV = 2944, C_CQ = 3072;
constexpr float ALPHA = 1.189207115002721f, LOG2E = 1.4426950408889634f, LN2F = 0.6931471805599453f, LN_EPS = 1e-5f, NEGBIG = -1e30f;
constexpr size_t MiB = 1u << 20;
#ifndef DBG_CHECK
#define DBG_CHECK 0
#endif
#ifndef DBG_DROP
#define DBG_DROP 0
#endif
constexpr size_t WS_CTL = 0, WS_WMEMKV = 1 * MiB, WS_WA = 3 * MiB, WS_WB = WS_WA + MiB / 2, WS_WC = WS_WB + MiB, WS_WOUT = WS_WC + MiB, WS_WQ = WS_WOUT + 2 * MiB,
                 WS_SUBK = WS_WQ + 2 * MiB, WS_MEMB = 10 * MiB, WS_KVM = 14 * MiB, WS_STATS = 18 * MiB, WS_LSE = 19 * MiB;
constexpr size_t WS_RA = 24 * MiB, WS_RB = 248 * MiB, WS_RC = 440 * MiB, WS_END = 504 * MiB;
constexpr size_t WS_HQ = WS_RA, WS_GATES = WS_RB, WS_XB = WS_RC;
constexpr size_t WS_MF = WS_RA, WS_MB = WS_RA + 128 * MiB;
constexpr size_t WS_Z = WS_RB, WS_X1B = WS_RB + 128 * MiB;
constexpr size_t WS_Q = WS_RA, WS_EIDX = WS_RA + 88 * MiB - 24 * MiB, WS_GATE = WS_EIDX + 16 * MiB;
constexpr size_t WS_UB = WS_RC, WS_VB = WS_RC + 32 * MiB;
constexpr size_t DO_WINT = 0;
constexpr size_t DO_OA = 0, DO_YB = 48 * MiB, DO_YC = 80 * MiB, DO_YA = 112 * MiB;

__device__ __forceinline__ size_t hq_off64(int slot, size_t tok) { return ((size_t)slot * T + tok) * 64; }
__device__ __forceinline__ size_t hq_offc(int head, size_t tok) { return (size_t)48 * T * 64 + ((size_t)head * T + tok) * 128; }
__device__ const unsigned char kBucket[3][132] = {
{0,1,2,3,4,5,6,7,8,9,10,11,12,13,14,15,16,16,16,16,16,16,17,17,17,17,17,17,17,17,18,18,18,18,18,18,18,18,18,18,19,19,19,19,19,19,19,19,19,19,19,19,19,19,20,20,20,20,20,20,20,20,20,20,20,20,20,20,20,20,20,20,20,21,21,21,21,21,21,21,21,21,21,21,21,21,21,21,21,21,21,21,21,21,21,21,21,21,21,22,22,22,22,22,22,22,22,22,22,22,22,22,22,22,22,22,22,22,22,22,22,22,22,22,22,22,22,22,22,22,22,22},
{0,4,8,12,16,16,17,17,18,18,19,19,19,19,20,20,20,20,20,21,21,21,21,21,21,22,22,22,22,22,22,22,22,22,23,23,23,23,23,23,23,23,23,23,23,23,24,24,24,24,24,24,24,24,24,24,24,24,24,24,24,24,25,25,25,25,25,25,25,25,25,25,25,25,25,25,25,25,25,25,25,25,25,26,26,26,26,26,26,26,26,26,26,26,26,26,26,26,26,26,26,26,26,26,26,26,26,26,26,26,26,26,26,27,27,27,27,27,27,27,27,27,27,27,27,27,27,27,27,27,27,27},
{0,16,18,19,20,21,21,22,22,23,23,23,24,24,24,24,25,25,25,25,25,26,26,26,26,26,26,26,26,27,27,27,27,27,27,27,27,27,27,28,28,28,28,28,28,28,28,28,28,28,28,28,29,29,29,29,29,29,29,29,29,29,29,29,29,29,29,29,29,29,30,30,30,30,30,30,30,30,30,30,30,30,30,30,30,30,30,30,30,30,30,30,30,30,30,31,31,31,31,31,31,31,31,31,31,31,31,31,31,31,31,31,31,31,31,31,31,31,31,31,31,31,31,31,31,31,31,31,31,31,31,31}};

__device__ __forceinline__ bf16_t f2bf(float x) { unsigned u = __float_as_uint(x); u += 0x7fffu + ((u >> 16) & 1u); return (bf16_t)(u >> 16); }
__device__ __forceinline__ float bf2f(bf16_t h) { return __uint_as_float((unsigned)h << 16); }
__device__ __forceinline__ float bflo(unsigned w) { return __uint_as_float(w << 16); }
__device__ __forceinline__ float bfhi(unsigned w) { return __uint_as_float(w & 0xffff0000u); }
__device__ __forceinline__ unsigned pk2(float lo, float hi) { bf16x2_t v; v.x = (__bf16)lo; v.y = (__bf16)hi; return __builtin_bit_cast(unsigned, v); }
__device__ __forceinline__ float dot2bf(unsigned a, unsigned b, float acc) { return __builtin_amdgcn_fdot2_f32_bf16(__builtin_bit_cast(bf16x2_t, a), __builtin_bit_cast(bf16x2_t, b), acc, false); }
__device__ __forceinline__ float wave_sum(float v) { for (int o = 32; o >= 1; o >>= 1) v += __shfl_xor(v, o, 64); return v; }
__device__ __forceinline__ float wave_max(float v) { for (int o = 32; o >= 1; o >>= 1) v = fmaxf(v, __shfl_xor(v, o, 64)); return v; }

struct EpiIn {
    static constexpr bool PERM = true, AFTER_DRAIN = false;
    bf16_t* hq; bf16_t* gates; const float* bgate;
    __device__ __forceinline__ void operator()(const pg8::f32x4 (&acc)[2][2][4][2], const pg8::Unit& u, int wr, int wc, int fr, int fq) const {
        const int row0 = u.pm * 256 + wr * 64 + fr;
        if (u.pn < 14) {
            const float sc = (u.pn < 3 || u.pn == 9 || u.pn == 10) ? 0.125f * LOG2E : ((u.pn >= 12) ? 0.08838834764831845f * LOG2E : 1.0f);
            const int col0 = u.pn * 256 + wc * 32 + 8 * fq;
#pragma unroll
            for (int ai = 0; ai < 2; ++ai)
#pragma unroll
                for (int m = 0; m < 4; ++m) { const size_t tok = (size_t)(row0 + ai * 128 + m * 16);
#pragma unroll
                    for (int bj = 0; bj < 2; ++bj) { const pg8::f32x4 v0 = acc[ai][bj][m][0] * sc, v1 = acc[ai][bj][m][1] * sc; const int col = col0 + bj * 128;
                        u32x4 w; w.x = pk2(v0[0], v0[1]); w.y = pk2(v0[2], v0[3]); w.z = pk2(v1[0], v1[1]); w.w = pk2(v1[2], v1[3]);
                        bf16_t* dst = (col < 3072) ? hq + hq_off64(col >> 6, tok) + (col & 63) : hq + hq_offc((col - 3072) >> 7, tok) + ((col - 3072) & 127);
                        *(u32x4*)dst = w; } }
        } else {
            const int gi = u.pn - 14, s = gi >> 2, pn = gi & 3, col0 = gi * 256 + wc * 32 + 8 * fq, tid = (wr * 4 + wc) * 64 + fq * 16 + fr;
            unsigned char* blk = (unsigned char*)gates + ((size_t)(s * 128 + u.pm) * 4 + pn) * 65536 + (size_t)tid * 16;
            pg8::f32x4 bv[2][2];
#pragma unroll
            for (int bj = 0; bj < 2; ++bj)
#pragma unroll
                for (int n = 0; n < 2; ++n) bv[bj][n] = *(const pg8::f32x4*)(bgate + col0 + bj * 128 + 4 * n);
#pragma unroll
            for (int ai = 0; ai < 2; ++ai)
#pragma unroll
                for (int m = 0; m < 4; ++m) { u32x4 w;
#pragma unroll
                    for (int bj = 0; bj < 2; ++bj) { pg8::f32x4 v0 = acc[ai][bj][m][0] + bv[bj][0], v1 = acc[ai][bj][m][1] + bv[bj][1];
#pragma unroll
                        for (int j = 0; j < 4; ++j) { v0[j] = fmaxf(256.0f * __builtin_amdgcn_rcpf(1.0f + __builtin_amdgcn_exp2f(-LOG2E * v0[j])), 0.001953125f); v1[j] = fmaxf(256.0f * __builtin_amdgcn_rcpf(1.0f + __builtin_amdgcn_exp2f(-LOG2E * v1[j])), 0.001953125f); }
                        int t8 = 0; t8 = __builtin_amdgcn_cvt_pk_fp8_f32(v0[0], v0[1], t8, false); t8 = __builtin_amdgcn_cvt_pk_fp8_f32(v0[2], v0[3], t8, true); w[2 * bj] = (unsigned)t8;
                        t8 = 0; t8 = __builtin_amdgcn_cvt_pk_fp8_f32(v1[0], v1[1], t8, false); t8 = __builtin_amdgcn_cvt_pk_fp8_f32(v1[2], v1[3], t8, true); w[2 * bj + 1] = (unsigned)t8; }
                    *(u32x4*)(blk + (size_t)((ai * 4 + m) * 512) * 16) = w; }
        }
    }
};
struct EpiPlain {
    static constexpr bool PERM = true, AFTER_DRAIN = false;
    bf16_t* O; int ldc;
    __device__ __forceinline__ void operator()(const pg8::f32x4 (&acc)[2][2][4][2], const pg8::Unit& u, int wr, int wc, int fr, int fq) const {
        const int row0 = u.pm * 256 + wr * 64 + fr, col0 = u.pn * 256 + wc * 32 + 8 * fq;
#pragma unroll
        for (int ai = 0; ai < 2; ++ai)
#pragma unroll
            for (int m = 0; m < 4; ++m) { bf16_t* rowp = O + (size_t)(row0 + ai * 128 + m * 16) * ldc + col0;
#pragma unroll
                for (int bj = 0; bj < 2; ++bj) { const pg8::f32x4 v0 = acc[ai][bj][m][0], v1 = acc[ai][bj][m][1];
                    u32x4 w; w.x = pk2(v0[0], v0[1]); w.y = pk2(v0[2], v0[3]); w.z = pk2(v1[0], v1[1]); w.w = pk2(v1[2], v1[3]);
                    *(u32x4*)(rowp + bj * 128) = w; } }
    }
};
struct EpiOut {
    static constexpr bool PERM = true, AFTER_DRAIN = false;
    const float* x; bf16_t* z; float* stats;
    __device__ __forceinline__ void operator()(const pg8::f32x4 (&acc)[2][2][4][2], const pg8::Unit& u, int wr, int wc, int fr, int fq) const {
        const int row0 = u.pm * 256 + wr * 64 + fr, col0 = u.pn * 256 + wc * 32 + 8 * fq;
#pragma unroll
        for (int ai = 0; ai < 2; ++ai)
#pragma unroll
            for (int m = 0; m < 4; ++m) { const size_t row = (size_t)(row0 + ai * 128 + m * 16); float s = 0.f, ss = 0.f;
#pragma unroll
                for (int bj = 0; bj < 2; ++bj) { const size_t o = row * D + col0 + bj * 128;
                    pg8::f32x4 v0 = *(const pg8::f32x4*)(x + o) * ALPHA + acc[ai][bj][m][0], v1 = *(const pg8::f32x4*)(x + o + 4) * ALPHA + acc[ai][bj][m][1];
                    { u32x4 w; w.x = pk2(v0[0], v0[1]); w.y = pk2(v0[2], v0[3]); w.z = pk2(v1[0], v1[1]); w.w = pk2(v1[2], v1[3]); *(u32x4*)(z + o) = w; }
#pragma unroll
                    for (int j = 0; j < 4; ++j) { s += v0[j] + v1[j]; ss += v0[j] * v0[j] + v1[j] * v1[j]; } }
                s += __shfl_xor(s, 16, 64); ss += __shfl_xor(ss, 16, 64); s += __shfl_xor(s, 32, 64); ss += __shfl_xor(ss, 32, 64);
                if (fq == 0) { atomicAdd(stats + row * 2, s); atomicAdd(stats + row * 2 + 1, ss); } }
    }
};

__device__ __forceinline__ void t_mix(size_t i, const bf16_t* __restrict__ oA, const float* __restrict__ lseA, bf16_t* __restrict__ ya) {
    const size_t t = i >> 5; const int col = (int)(i & 31) * 8, h = col >> 6; const size_t e = t * 256 + col;
    const float l0 = lseA[((size_t)0 * T + t) * 4 + h], l1 = lseA[((size_t)1 * T + t) * 4 + h], l2 = lseA[((size_t)2 * T + t) * 4 + h];
    const u32x4 a = *(const u32x4*)(oA + e), b = *(const u32x4*)(oA + (size_t)T * 256 + e), c = *(const u32x4*)(oA + (size_t)2 * T * 256 + e);
    const float mx = fmaxf(l0, fmaxf(l1, l2)), e0 = __expf(l0 - mx), e1 = __expf(l1 - mx), e2 = __expf(l2 - mx), inv = 1.f / (e0 + e1 + e2); float w0 = e0 * inv, w1 = e1 * inv, w2 = e2 * inv;
    w0 *= 16.f; w1 *= 16.f; w2 *= 16.f;
    u32x2 o; int t8 = 0;
    t8 = __builtin_amdgcn_cvt_pk_fp8_f32(w0 * bflo(a.x) + w1 * bflo(b.x) + w2 * bflo(c.x), w0 * bfhi(a.x) + w1 * bfhi(b.x) + w2 * bfhi(c.x), t8, false); t8 = __builtin_amdgcn_cvt_pk_fp8_f32(w0 * bflo(a.y) + w1 * bflo(b.y) + w2 * bflo(c.y), w0 * bfhi(a.y) + w1 * bfhi(b.y) + w2 * bfhi(c.y), t8, true); o.x = (unsigned)t8;
    t8 = 0; t8 = __builtin_amdgcn_cvt_pk_fp8_f32(w0 * bflo(a.z) + w1 * bflo(b.z) + w2 * bflo(c.z), w0 * bfhi(a.z) + w1 * bfhi(b.z) + w2 * bfhi(c.z), t8, false); t8 = __builtin_amdgcn_cvt_pk_fp8_f32(w0 * bflo(a.w) + w1 * bflo(b.w) + w2 * bflo(c.w), w0 * bfhi(a.w) + w1 * bfhi(b.w) + w2 * bfhi(c.w), t8, true); o.y = (unsigned)t8;
    *(u32x2*)((unsigned char*)ya + e) = o;
}
template <int NT>
__device__ __forceinline__ void t_res_ln1(size_t t0, size_t tstride, const float* __restrict__ x, const bf16_t* __restrict__ mo, const float* g, const float* b, bf16_t* __restrict__ x1b) {
    const int lane = threadIdx.x & 63, c = 16 * lane;
    f32x4 xv[NT][4]; u32x4 mv[NT][2];
#pragma unroll
    for (int k = 0; k < NT; ++k) { const size_t t = t0 + k * tstride;
#pragma unroll
        for (int q = 0; q < 4; ++q) xv[k][q] = *(const f32x4*)(x + t * D + c + 4 * q);
        mv[k][0] = *(const u32x4*)(mo + t * D + c); mv[k][1] = *(const u32x4*)(mo + t * D + c + 8); }
    f32x4 gg[4], bb[4];
#pragma unroll
    for (int q = 0; q < 4; ++q) { gg[q] = *(const f32x4*)(g + c + 4 * q); bb[q] = *(const f32x4*)(b + c + 4 * q); }
#pragma unroll
    for (int k = 0; k < NT; ++k) { const size_t t = t0 + k * tstride;
        const float mm[16] = {bflo(mv[k][0].x), bfhi(mv[k][0].x), bflo(mv[k][0].y), bfhi(mv[k][0].y), bflo(mv[k][0].z), bfhi(mv[k][0].z), bflo(mv[k][0].w), bfhi(mv[k][0].w),
                              bflo(mv[k][1].x), bfhi(mv[k][1].x), bflo(mv[k][1].y), bfhi(mv[k][1].y), bflo(mv[k][1].z), bfhi(mv[k][1].z), bflo(mv[k][1].w), bfhi(mv[k][1].w)};
        float zz[16]; float s = 0.f;
#pragma unroll
        for (int i = 0; i < 16; ++i) { zz[i] = ALPHA * xv[k][i >> 2][i & 3] + mm[i]; s += zz[i]; }
        const float mean = wave_sum(s) * (1.f / D); float ss = 0.f;
#pragma unroll
        for (int i = 0; i < 16; ++i) { const float d = zz[i] - mean; ss += d * d; }
        const float rstd = rsqrtf(wave_sum(ss) * (1.f / D) + LN_EPS);
        float y[16];
#pragma unroll
        for (int i = 0; i < 16; ++i) y[i] = (zz[i] - mean) * rstd * gg[i >> 2][i & 3] + bb[i >> 2][i & 3];
        u32x4 w0, w1; w0.x = pk2(y[0], y[1]); w0.y = pk2(y[2], y[3]); w0.z = pk2(y[4], y[5]); w0.w = pk2(y[6], y[7]); w1.x = pk2(y[8], y[9]); w1.y = pk2(y[10], y[11]); w1.z = pk2(y[12], y[13]); w1.w = pk2(y[14], y[15]);
        *(u32x4*)(x1b + t * D + c) = w0; *(u32x4*)(x1b + t * D + c + 8) = w1; }
}
typedef float f32x2 __attribute__((ext_vector_type(2)));
__device__ __forceinline__ void cvt_row_fp8_finish(const f32x4 a, const f32x4 b, const f32x4 c, const f32x4 d, unsigned char* __restrict__ dst, float* __restrict__ inv_scale, int row, int lane) {
    float mx = 0.f;
#pragma unroll
    for (int j = 0; j < 4; ++j) mx = fmaxf(mx, fmaxf(fmaxf(fabsf(a[j]), fabsf(b[j])), fmaxf(fabsf(c[j]), fabsf(d[j]))));
    mx = wave_max(mx);
    const unsigned E = (__float_as_uint(mx) >> 23) & 255u;
    const float sc = (E == 0u || E > 250u) ? 1.0f : __uint_as_float((260u - E) << 23), isc = (E == 0u || E > 250u) ? 1.0f : __uint_as_float((E - 6u) << 23);
    u32x4 w; int t;
    t = 0; t = __builtin_amdgcn_cvt_pk_fp8_f32(a[0] * sc, a[1] * sc, t, false); t = __builtin_amdgcn_cvt_pk_fp8_f32(a[2] * sc, a[3] * sc, t, true); w.x = (unsigned)t;
    t = 0; t = __builtin_amdgcn_cvt_pk_fp8_f32(b[0] * sc, b[1] * sc, t, false); t = __builtin_amdgcn_cvt_pk_fp8_f32(b[2] * sc, b[3] * sc, t, true); w.y = (unsigned)t;
    t = 0; t = __builtin_amdgcn_cvt_pk_fp8_f32(c[0] * sc, c[1] * sc, t, false); t = __builtin_amdgcn_cvt_pk_fp8_f32(c[2] * sc, c[3] * sc, t, true); w.z = (unsigned)t;
    t = 0; t = __builtin_amdgcn_cvt_pk_fp8_f32(d[0] * sc, d[1] * sc, t, false); t = __builtin_amdgcn_cvt_pk_fp8_f32(d[2] * sc, d[3] * sc, t, true); w.w = (unsigned)t;
    *(u32x4*)(dst + (size_t)row * D + 16 * lane) = w;
    if (lane == 0) inv_scale[row] = isc;
}
__device__ __forceinline__ void cvt_rows_fp8(const float* __restrict__ pu, const float* __restrict__ pv, unsigned char* __restrict__ ub8, unsigned char* __restrict__ vb8, float* __restrict__ usc, float* __restrict__ vsc, int r0, int r1) {
    const int lane = threadIdx.x & 63;
    const float* s0 = pu + (size_t)r0 * D + 16 * lane; const float* s1 = pv + (size_t)r0 * D + 16 * lane; const float* s2 = pu + (size_t)r1 * D + 16 * lane; const float* s3 = pv + (size_t)r1 * D + 16 * lane;
    f32x4 q[4][4];
#pragma unroll
    for (int j = 0; j < 4; ++j) { q[0][j] = ((const f32x4*)s0)[j]; q[1][j] = ((const f32x4*)s1)[j]; q[2][j] = ((const f32x4*)s2)[j]; q[3][j] = ((const f32x4*)s3)[j]; }
    cvt_row_fp8_finish(q[0][0], q[0][1], q[0][2], q[0][3], ub8, usc, r0, lane); cvt_row_fp8_finish(q[1][0], q[1][1], q[1][2], q[1][3], vb8, vsc, r0, lane);
    cvt_row_fp8_finish(q[2][0], q[2][1], q[2][2], q[2][3], ub8, usc, r1, lane); cvt_row_fp8_finish(q[3][0], q[3][1], q[3][2], q[3][3], vb8, vsc, r1, lane);
}
__device__ __forceinline__ float xsel_add(float keep_lo, float keep_hi, bool hi, int mask) {
    const float send = hi ? keep_lo : keep_hi, keep = hi ? keep_hi : keep_lo; return keep + __shfl_xor(send, mask, 64);
}

typedef short s16x4 __attribute__((ext_vector_type(4)));
constexpr int NTHREADS_ = 512;
#define ATT_M0 (-30000.0f)
__device__ __forceinline__ float red_max_16_32(float x) { typedef unsigned u2_ __attribute__((ext_vector_type(2)));
    u2_ r = __builtin_amdgcn_permlane16_swap(__float_as_uint(x), __float_as_uint(x), false, false); x = fmaxf(__uint_as_float(r.x), __uint_as_float(r.y));
    r = __builtin_amdgcn_permlane32_swap(__float_as_uint(x), __float_as_uint(x), false, false); return fmaxf(__uint_as_float(r.x), __uint_as_float(r.y)); }
__device__ __forceinline__ float red_sum_16_32(float x) { typedef unsigned u2_ __attribute__((ext_vector_type(2)));
    u2_ r = __builtin_amdgcn_permlane16_swap(__float_as_uint(x), __float_as_uint(x), false, false); x = __uint_as_float(r.x) + __uint_as_float(r.y);
    r = __builtin_amdgcn_permlane32_swap(__float_as_uint(x), __float_as_uint(x), false, false); return __uint_as_float(r.x) + __uint_as_float(r.y); }
template <int DH, int PITCH, class MaskF>
__device__ __forceinline__ void attn_step(const pg8::bf16x8 (&qf)[DH / 32], LAS unsigned char* kl, LAS unsigned char* vl, int t0, int t1, const MaskF& mf, float& m, float& l, f32x4 (&oT)[DH / 16]) {
    const int lane = threadIdx.x & 63, r16 = lane & 15, kq = lane >> 4;
    f32x4 s0 = {0.f, 0.f, 0.f, 0.f}, s1 = {0.f, 0.f, 0.f, 0.f};
    LAS unsigned char* ka0 = kl + (16 * t0 + r16) * PITCH + 16 * kq; LAS unsigned char* ka1 = kl + (16 * t1 + r16) * PITCH + 16 * kq;
#pragma unroll
    for (int s = 0; s < DH / 32; ++s) { const pg8::bf16x8 a0 = *(const LAS pg8::bf16x8*)(ka0 + 64 * s), a1 = *(const LAS pg8::bf16x8*)(ka1 + 64 * s);
        s0 = __builtin_amdgcn_mfma_f32_16x16x32_bf16(a0, qf[s], s0, 0, 0, 0); s1 = __builtin_amdgcn_mfma_f32_16x16x32_bf16(a1, qf[s], s1, 0, 0, 0); }
    float mx = -1e30f;
#pragma unroll
    for (int j = 0; j < 4; ++j) { s0[j] = mf(t0, 4 * kq + j, s0[j]); s1[j] = mf(t1, 4 * kq + j, s1[j]); mx = fmaxf(mx, fmaxf(s0[j], s1[j])); }
    mx = red_max_16_32(mx);
    const float mn = fmaxf(m, mx), sc = __builtin_amdgcn_exp2f(m - mn);
    float rs = 0.f;
#pragma unroll
    for (int j = 0; j < 4; ++j) { s0[j] = __builtin_amdgcn_exp2f(s0[j] - mn); s1[j] = __builtin_amdgcn_exp2f(s1[j] - mn); rs += s0[j] + s1[j]; }
    rs = red_sum_16_32(rs);
    l = l * sc + rs; m = mn;
    u32x4 pw; pw.x = pk2(s0[0], s0[1]); pw.y = pk2(s0[2], s0[3]); pw.z = pk2(s1[0], s1[1]); pw.w = pk2(s1[2], s1[3]);
    const pg8::bf16x8 pb = __builtin_bit_cast(pg8::bf16x8, pw);
    const int q = r16 >> 2, p = r16 & 3;
    LAS unsigned char* va0 = vl + (16 * t0 + 4 * kq + q) * PITCH + 8 * p; LAS unsigned char* va1 = vl + (16 * t1 + 4 * kq + q) * PITCH + 8 * p;
#pragma unroll
    for (int dt = 0; dt < DH / 16; ++dt) {
        const s16x4 lo = __builtin_amdgcn_ds_read_tr16_b64_v4i16((LAS s16x4*)(va0 + 32 * dt)), hi = __builtin_amdgcn_ds_read_tr16_b64_v4i16((LAS s16x4*)(va1 + 32 * dt));
        const pg8::bf16x8 va = __builtin_shufflevector(lo, hi, 0, 1, 2, 3, 4, 5, 6, 7);
        oT[dt] = oT[dt] * sc; oT[dt] = __builtin_amdgcn_mfma_f32_16x16x32_bf16(va, pb, oT[dt], 0, 0, 0); }
}
__device__ __forceinline__ void lds_put16(LAS unsigned char* dst, const bf16_t* src) { *(LAS u32x4*)dst = src ? *(const u32x4*)src : (u32x4){0u, 0u, 0u, 0u}; }

constexpr int ATT_KV64 = 272 * 160;
__device__ __forceinline__ void attnA_fetch(int u, int tid, u32x4 (&pfc)[8], float& tabv, const bf16_t* __restrict__ hq, const float* __restrict__ relb) {
    asm volatile("" : "+v"(tid));
    const int h = u & 3, rn = (u >> 2) & 31, b = (u >> 7) & 7, g = u >> 10;
    const int r = (g == 0) ? 1 : (g == 1 ? 4 : 16), nblk = 32 / r, rho = rn / nblk, n = rn % nblk, tb = b * SEQ;
    const bf16_t* kcol = hq + hq_off64(12 + g * 4 + h, 0); const bf16_t* vcol = hq + hq_off64(24 + g * 4 + h, 0);
#pragma unroll
    for (int i = 0; i < 8; ++i) { const int idx = tid + NTHREADS_ * i, isv = idx >> 11, i2 = idx & 2047, row = i2 >> 3, ch = i2 & 7, pos = (n - 1) * 128 + row;
        pfc[i] = (pos >= 0) ? *(const u32x4*)((isv ? vcol : kcol) + (size_t)(tb + rho + r * pos) * 64 + ch * 8) : (u32x4){0u, 0u, 0u, 0u}; }
    tabv = (tid < 129) ? relb[kBucket[g][tid] * 20 + g * 4 + h] * LOG2E : 0.f;
}
__device__ __forceinline__ void attnAB_store(int tid, const u32x4 (&pfc)[8], float tabv, LAS unsigned char* lds, int ntab) {
    asm volatile("" : "+v"(tid));
    LAS unsigned char* kl = lds; LAS unsigned char* vl = lds + ATT_KV64; LAS float* tab = (LAS float*)(lds + 2 * ATT_KV64);
#pragma unroll
    for (int i = 0; i < 8; ++i) { const int idx = tid + NTHREADS_ * i, isv = idx >> 11, i2 = idx & 2047, row = i2 >> 3, ch = i2 & 7; *(LAS u32x4*)((isv ? vl : kl) + row * 160 + ch * 16) = pfc[i]; }
    if (tid < 320) { const int isv = tid >= 160, i2 = isv ? tid - 160 : tid; *(LAS u32x4*)((isv ? vl : kl) + 256 * 160 + i2 * 16) = (u32x4){0u, 0u, 0u, 0u}; }
    if (tid < ntab) tab[tid] = tabv;
}
__device__ __forceinline__ void attnA_compute(int u, int tid, LAS unsigned char* lds, const bf16_t* __restrict__ hq, bf16_t* __restrict__ oA, float* __restrict__ lseA) {
    asm volatile("" : "+v"(tid));
    const int h = u & 3, rn = (u >> 2) & 31, b = (u >> 7) & 7, g = u >> 10;
    const int r = (g == 0) ? 1 : (g == 1 ? 4 : 16), nblk = 32 / r, rho = rn / nblk, n = rn % nblk, tb = b * SEQ;
    LAS unsigned char* kl = lds; LAS unsigned char* vl = lds + ATT_KV64; LAS float* tab = (LAS float*)(lds + 2 * ATT_KV64);
    const int w = tid >> 6, lane = tid & 63, r16 = lane & 15, kq = lane >> 4, qi = 16 * w + r16, kmin = (n == 0) ? 128 : 0;
    const size_t tq = (size_t)(tb + rho + r * (n * 128 + qi));
    pg8::bf16x8 qf[2];
#pragma unroll
    for (int s = 0; s < 2; ++s) qf[s] = *(const pg8::bf16x8*)(hq + hq_off64(g * 4 + h, tq) + 32 * s + 8 * kq);
    float m = ATT_M0, l = 0.f; f32x4 oT[4];
#pragma unroll
    for (int dt = 0; dt < 4; ++dt) oT[dt] = (f32x4){0.f, 0.f, 0.f, 0.f};
    auto mf = [&](int tile, int kr, float s) -> float { const int kk = 16 * tile + kr, off = qi + 128 - kk; const bool ok = (off >= 0) && (off <= 128) && (kk >= kmin);
        const int oc = off < 0 ? 0 : (off > 128 ? 128 : off); return ok ? s + tab[oc] : -1e30f; };
    auto mfi = [&](int tile, int kr, float s) -> float { return s + tab[qi + 128 - 16 * tile - kr]; };
    attn_step<64, 160>(qf, kl, vl, w, w + 1, mf, m, l, oT);
    if (n != 0) { for (int st = 1; st < 4; ++st) attn_step<64, 160>(qf, kl, vl, w + 2 * st, w + 2 * st + 1, mfi, m, l, oT); }
    else { for (int st = 1; st < 4; ++st) attn_step<64, 160>(qf, kl, vl, w + 2 * st, w + 2 * st + 1, mf, m, l, oT); }
    attn_step<64, 160>(qf, kl, vl, w + 8, w + 9, mf, m, l, oT);
    const float inv = 1.0f / l;
    bf16_t* op = oA + ((size_t)g * T + tq) * 256 + h * 64 + 4 * kq;
#pragma unroll
    for (int dt = 0; dt < 4; ++dt) { u32x2 wv; wv.x = pk2(oT[dt][0] * inv, oT[dt][1] * inv); wv.y = pk2(oT[dt][2] * inv, oT[dt][3] * inv); *(u32x2*)(op + 16 * dt) = wv; }
    if (kq == 0) lseA[((size_t)g * T + tq) * 4 + h] = (m + __builtin_amdgcn_logf(l)) * LN2F;
}
__device__ __forceinline__ void attnB_fetch(int u, int tid, u32x4 (&pfc)[8], float& tabv, const bf16_t* __restrict__ hq, const float* __restrict__ relb) {
    asm volatile("" : "+v"(tid));
    const int kvh = u & 1, n = (u >> 1) & 31, b = u >> 6, tb = b * SEQ;
    const bf16_t* kcol = hq + hq_off64(44 + kvh, 0); const bf16_t* vcol = hq + hq_off64(46 + kvh, 0);
#pragma unroll
    for (int i = 0; i < 8; ++i) { const int idx = tid + NTHREADS_ * i, isv = idx >> 11, i2 = idx & 2047, row = i2 >> 3, ch = i2 & 7, pos = (n - 1) * 128 + row;
        pfc[i] = (pos >= 0) ? *(const u32x4*)((isv ? vcol : kcol) + (size_t)(tb + pos) * 64 + ch * 8) : (u32x4){0u, 0u, 0u, 0u}; }
    { const int hd = tid >> 7, off = tid & 127; tabv = relb[kBucket[0][off] * 20 + 12 + kvh * 4 + hd] * LOG2E; }
}
__device__ __forceinline__ void attnB_compute(int u, int tid, LAS unsigned char* lds, const bf16_t* __restrict__ hq, const float* __restrict__ sinks, bf16_t* __restrict__ yb) {
    asm volatile("" : "+v"(tid));
    const int kvh = u & 1, n = (u >> 1) & 31, b = u >> 6, tb = b * SEQ;
    LAS unsigned char* kl = lds; LAS unsigned char* vl = lds + ATT_KV64; LAS float* tab = (LAS float*)(lds + 2 * ATT_KV64);
    const int w = tid >> 6, lane = tid & 63, r16 = lane & 15, kq = lane >> 4, kmin = (n == 0) ? 128 : 0;
    for (int i = 0; i < 4; ++i) {
        const int task = w + 8 * i, hd = task >> 3, sub = task & 7, head = kvh * 4 + hd, qi = 16 * sub + r16;
        const size_t tq = (size_t)(tb + n * 128 + qi);
        pg8::bf16x8 qf[2];
#pragma unroll
        for (int s = 0; s < 2; ++s) qf[s] = *(const pg8::bf16x8*)(hq + hq_off64(36 + head, tq) + 32 * s + 8 * kq);
        float m = sinks[head] * LOG2E, l = 1.0f; f32x4 oT[4];
#pragma unroll
        for (int dt = 0; dt < 4; ++dt) oT[dt] = (f32x4){0.f, 0.f, 0.f, 0.f};
        LAS float* tb_h = tab + hd * 128;
        auto mf = [&](int tile, int kr, float s) -> float { const int kk = 16 * tile + kr, off = qi + 128 - kk; const bool ok = (off >= 0) && (off <= 127) && (kk >= kmin);
            const int oc = off < 0 ? 0 : (off > 127 ? 127 : off); return ok ? s + tb_h[oc] : -1e30f; };
        auto mfi = [&](int tile, int kr, float s) -> float { return s + tb_h[qi + 128 - 16 * tile - kr]; };
        attn_step<64, 160>(qf, kl, vl, sub, sub + 1, mf, m, l, oT);
        if (n != 0) { for (int st = 1; st < 4; ++st) attn_step<64, 160>(qf, kl, vl, sub + 2 * st, sub + 2 * st + 1, mfi, m, l, oT); }
        else { for (int st = 1; st < 4; ++st) attn_step<64, 160>(qf, kl, vl, sub + 2 * st, sub + 2 * st + 1, mf, m, l, oT); }
        attn_step<64, 160>(qf, kl, vl, sub + 8, sub + 9, mf, m, l, oT);
        const float inv = 1.0f / l;
        const float inv16 = inv * 16.f; unsigned char* op = (unsigned char*)yb + tq * 512 + head * 64 + 4 * kq;
#pragma unroll
        for (int dt = 0; dt < 4; ++dt) { int t8 = 0; t8 = __builtin_amdgcn_cvt_pk_fp8_f32(oT[dt][0] * inv16, oT[dt][1] * inv16, t8, false); t8 = __builtin_amdgcn_cvt_pk_fp8_f32(oT[dt][2] * inv16, oT[dt][3] * inv16, t8, true); *(unsigned*)(op + 16 * dt) = (unsigned)t8; }
    }
}
__device__ __forceinline__ void attnAB_phase(LAS unsigned char* lds, const bf16_t* __restrict__ hq, const float* __restrict__ relb, const float* __restrict__ sinks, bf16_t* __restrict__ oA, float* __restrict__ lseA, bf16_t* __restrict__ yb) {
    int tid = threadIdx.x; asm volatile("" : "+v"(tid));
    u32x4 pfc[8]; float tabv = 0.f;
    int u = blockIdx.x;
    if (u < 3072) attnA_fetch(u, tid, pfc, tabv, hq, relb);
    for (; u < 3072; u += gridDim.x) {
        attnAB_store(tid, pfc, tabv, lds, 129);
        __syncthreads();
        const int un = u + gridDim.x;
        if (un < 3072) attnA_fetch(un, tid, pfc, tabv, hq, relb); else if ((int)blockIdx.x < 512) attnB_fetch((int)blockIdx.x, tid, pfc, tabv, hq, relb);
        attnA_compute(u, tid, lds, hq, oA, lseA);
        __syncthreads();
    }
    u = blockIdx.x;
    if (3072 <= (int)blockIdx.x && u < 512) attnB_fetch(u, tid, pfc, tabv, hq, relb);
    for (; u < 512; u += gridDim.x) {
        attnAB_store(tid, pfc, tabv, lds, 512);
        __syncthreads();
        const int un = u + gridDim.x;
        if (un < 512) attnB_fetch(un, tid, pfc, tabv, hq, relb);
        attnB_compute(u, tid, lds, hq, sinks, yb);
        __syncthreads();
    }
}
__device__ __forceinline__ void attnC_unit(int u, LAS unsigned char* lds, const bf16_t* __restrict__ hq, const bf16_t* __restrict__ kvm, bf16_t* __restrict__ yc) {
    int tid = threadIdx.x; asm volatile("" : "+v"(tid));
    const int qc = u & 7, head = (u >> 3) & 3, b = u >> 5, tb = b * SEQ;
    constexpr int CP = 272, IMG = 256 * CP;
    LAS unsigned char* kl = lds; LAS unsigned char* vl = lds + IMG;
    for (int idx = tid; idx < 8192; idx += NTHREADS_) { const int isv = idx >> 12, i2 = idx & 4095, row = i2 >> 4, ch = i2 & 15;
        lds_put16((isv ? vl : kl) + row * CP + ch * 16, kvm + (size_t)(b * MEMLEN + row) * 1024 + isv * 512 + head * 128 + ch * 8); }
    __syncthreads();
    const int w = tid >> 6, lane = tid & 63, r16 = lane & 15, kq = lane >> 4;
    auto mf = [&](int, int, float s) -> float { return s; };
    for (int qt = 0; qt < 4; ++qt) {
        const size_t tq = (size_t)(tb + qc * 512 + qt * 128 + 16 * w + r16);
        pg8::bf16x8 qf[4];
#pragma unroll
        for (int s = 0; s < 4; ++s) qf[s] = *(const pg8::bf16x8*)(hq + hq_offc(head, tq) + 32 * s + 8 * kq);
        float m = ATT_M0, l = 0.f; f32x4 oT[8];
#pragma unroll
        for (int dt = 0; dt < 8; ++dt) oT[dt] = (f32x4){0.f, 0.f, 0.f, 0.f};
        for (int st = 0; st < 8; ++st) attn_step<128, CP>(qf, kl, vl, 2 * st, 2 * st + 1, mf, m, l, oT);
        const float inv = 1.0f / l;
        const float inv16 = inv * 16.f; unsigned char* op = (unsigned char*)yc + tq * 512 + head * 128 + 4 * kq;
#pragma unroll
        for (int dt = 0; dt < 8; ++dt) { int t8 = 0; t8 = __builtin_amdgcn_cvt_pk_fp8_f32(oT[dt][0] * inv16, oT[dt][1] * inv16, t8, false); t8 = __builtin_amdgcn_cvt_pk_fp8_f32(oT[dt][2] * inv16, oT[dt][3] * inv16, t8, true); *(unsigned*)(op + 16 * dt) = (unsigned)t8; }
    }
    __syncthreads();
}

#define CE_DESC(a, b) do { const unsigned _mx = (a) > (b) ? (a) : (b), _mn = (a) > (b) ? (b) : (a); (a) = _mx; (b) = _mn; } while (0)
__device__ __forceinline__ void sort16_desc(unsigned (&v)[16]) {
    CE_DESC(v[0], v[13]); CE_DESC(v[1], v[12]); CE_DESC(v[2], v[15]); CE_DESC(v[3], v[14]); CE_DESC(v[4], v[8]); CE_DESC(v[5], v[6]); CE_DESC(v[7], v[11]); CE_DESC(v[9], v[10]);
    CE_DESC(v[0], v[5]); CE_DESC(v[1], v[7]); CE_DESC(v[2], v[9]); CE_DESC(v[3], v[4]); CE_DESC(v[6], v[13]); CE_DESC(v[8], v[14]); CE_DESC(v[10], v[15]); CE_DESC(v[11], v[12]);
    CE_DESC(v[0], v[1]); CE_DESC(v[2], v[3]); CE_DESC(v[4], v[5]); CE_DESC(v[6], v[8]); CE_DESC(v[7], v[9]); CE_DESC(v[10], v[11]); CE_DESC(v[12], v[13]); CE_DESC(v[14], v[15]);
    CE_DESC(v[0], v[2]); CE_DESC(v[1], v[3]); CE_DESC(v[4], v[10]); CE_DESC(v[5], v[11]); CE_DESC(v[6], v[7]); CE_DESC(v[8], v[9]); CE_DESC(v[12], v[14]); CE_DESC(v[13], v[15]);
    CE_DESC(v[1], v[2]); CE_DESC(v[3], v[12]); CE_DESC(v[4], v[6]); CE_DESC(v[5], v[7]); CE_DESC(v[8], v[10]); CE_DESC(v[9], v[11]); CE_DESC(v[13], v[14]);
    CE_DESC(v[1], v[4]); CE_DESC(v[2], v[6]); CE_DESC(v[5], v[8]); CE_DESC(v[7], v[10]); CE_DESC(v[9], v[13]); CE_DESC(v[11], v[14]);
    CE_DESC(v[2], v[4]); CE_DESC(v[3], v[6]); CE_DESC(v[9], v[12]); CE_DESC(v[11], v[13]);
    CE_DESC(v[3], v[5]); CE_DESC(v[6], v[8]); CE_DESC(v[7], v[9]); CE_DESC(v[10], v[12]);
    CE_DESC(v[3], v[4]); CE_DESC(v[5], v[6]); CE_DESC(v[7], v[8]); CE_DESC(v[9], v[10]); CE_DESC(v[11], v[12]);
    CE_DESC(v[6], v[7]); CE_DESC(v[8], v[9]);
}
__device__ __forceinline__ void bitonic_merge16_desc(unsigned (&v)[16]) {
#pragma unroll
    for (int j = 8; j > 0; j >>= 1)
#pragma unroll
        for (int i = 0; i < 16; ++i) { const int p = i ^ j; if (p > i) CE_DESC(v[i], v[p]); }
}
__device__ __forceinline__ void top16_merge(unsigned (&a)[16], const unsigned (&b)[16]) {
#pragma unroll
    for (int i = 0; i < 16; ++i) a[i] = a[i] > b[15 - i] ? a[i] : b[15 - i];
    bitonic_merge16_desc(a);
}
__device__ __forceinline__ unsigned f2key(float f) { const unsigned u = __float_as_uint(f); return u ^ ((unsigned)((int)u >> 31) | 0x80000000u); }
__device__ __forceinline__ float key2f(unsigned k) { return __uint_as_float((k & 0x80000000u) ? (k ^ 0x80000000u) : ~k); }

constexpr int TK_KIMG = 128 * 144;
__device__ __forceinline__ void topk_unit(int u, LAS unsigned char* lds, const bf16_t* __restrict__ qb, const bf16_t* __restrict__ subk, unsigned short* __restrict__ eidx, float* __restrict__ gate) {
    int tid = threadIdx.x; asm volatile("" : "+v"(tid));
    const int h = u & 7, tile = u >> 3;
    typedef float f32x16 __attribute__((ext_vector_type(16)));
    for (int idx = tid; idx < 2048; idx += NTHREADS_) { const int row = idx >> 3, ch = idx & 7;
        *(LAS u32x4*)(lds + row * 144 + ch * 16) = *(const u32x4*)(subk + ((size_t)(h * 256 + row)) * 64 + ch * 8); }
    __syncthreads();
    const int w = tid >> 6, lane = tid & 63, r32 = lane & 31, hh = lane >> 5;
    const size_t tok = (size_t)tile * 256 + w * 32 + r32;
    unsigned top[2][16];
#pragma unroll
    for (int c = 0; c < 2; ++c) {
        pg8::bf16x8 qf[4];
#pragma unroll
        for (int s = 0; s < 4; ++s) qf[s] = *(const pg8::bf16x8*)(qb + tok * D + h * 128 + c * 64 + 16 * s + 8 * hh);
        unsigned key[4][16];
#pragma unroll
        for (int kt = 0; kt < 4; ++kt) { f32x16 acc;
#pragma unroll
            for (int i = 0; i < 16; ++i) acc[i] = 0.f;
#pragma unroll
            for (int s = 0; s < 4; ++s) { const pg8::bf16x8 a = *(const LAS pg8::bf16x8*)(lds + c * TK_KIMG + (32 * kt + r32) * 144 + (16 * s + 8 * hh) * 2);
                acc = __builtin_amdgcn_mfma_f32_32x32x16_bf16(a, qf[s], acc, 0, 0, 0); }
            const unsigned lowb = 127u - 4u * hh - 32u * kt;
#pragma unroll
            for (int i = 0; i < 16; ++i) key[kt][i] = (f2key(acc[i]) & 0xFFFFFF80u) | (lowb - (unsigned)((i & 3) + 8 * (i >> 2)));
            sort16_desc(key[kt]); }
        top16_merge(key[0], key[1]); top16_merge(key[2], key[3]); top16_merge(key[0], key[2]);
        unsigned other[16];
#pragma unroll
        for (int i = 0; i < 16; ++i) other[i] = (unsigned)__shfl_xor((int)key[0][i], 32, 64);
        top16_merge(key[0], other);
#pragma unroll
        for (int i = 0; i < 16; ++i) top[c][i] = key[0][i];
    }
    float v0[16], v1[16];
#pragma unroll
    for (int i = 0; i < 16; ++i) { v0[i] = key2f(top[0][i] & 0xFFFFFF80u); v1[i] = key2f(top[1][i] & 0xFFFFFF80u); }
    unsigned cand[4][16];
#pragma unroll
    for (int q = 0; q < 4; ++q)
#pragma unroll
        for (int i = 0; i < 16; ++i) cand[q][i] = 0u;
#define CAND_(q, e, i, j) cand[q][e] = (f2key(v0[i] + v1[j]) & 0xFFFFFF00u) | (unsigned)(255 - ((i) * 16 + (j)))
    CAND_(0, 0, 0, 0);
    CAND_(0, 1, 0, 1);
    CAND_(0, 2, 0, 2);
    CAND_(0, 3, 0, 3);
    CAND_(0, 4, 0, 4);
    CAND_(0, 5, 0, 5);
    CAND_(0, 6, 0, 6);
    CAND_(0, 7, 0, 7);
    CAND_(0, 8, 0, 8);
    CAND_(0, 9, 0, 9);
    CAND_(0, 10, 0, 10);
    CAND_(0, 11, 0, 11);
    CAND_(0, 12, 0, 12);
    CAND_(0, 13, 0, 13);
    CAND_(0, 14, 0, 14);
    CAND_(0, 15, 0, 15);
    CAND_(1, 0, 1, 0);
    CAND_(1, 1, 1, 1);
    CAND_(1, 2, 1, 2);
    CAND_(1, 3, 1, 3);
    CAND_(1, 4, 1, 4);
    CAND_(1, 5, 1, 5);
    CAND_(1, 6, 1, 6);
    CAND_(1, 7, 1, 7);
    CAND_(1, 8, 2, 0);
    CAND_(1, 9, 2, 1);
    CAND_(1, 10, 2, 2);
    CAND_(1, 11, 2, 3);
    CAND_(1, 12, 2, 4);
    CAND_(1, 13, 3, 0);
    CAND_(1, 14, 3, 1);
    CAND_(1, 15, 3, 2);
    CAND_(2, 0, 3, 3);
    CAND_(2, 1, 4, 0);
    CAND_(2, 2, 4, 1);
    CAND_(2, 3, 4, 2);
    CAND_(2, 4, 5, 0);
    CAND_(2, 5, 5, 1);
    CAND_(2, 6, 6, 0);
    CAND_(2, 7, 6, 1);
    CAND_(2, 8, 7, 0);
    CAND_(2, 9, 7, 1);
    CAND_(2, 10, 8, 0);
    CAND_(2, 11, 9, 0);
    CAND_(2, 12, 10, 0);
    CAND_(2, 13, 11, 0);
    CAND_(2, 14, 12, 0);
    CAND_(2, 15, 13, 0);
    CAND_(3, 0, 14, 0);
    CAND_(3, 1, 15, 0);
#undef CAND_
#pragma unroll
    for (int q = 0; q < 4; ++q) sort16_desc(cand[q]);
    top16_merge(cand[0], cand[1]); top16_merge(cand[2], cand[3]); top16_merge(cand[0], cand[2]);
    float ev[16]; const float vmax = key2f(cand[0][0] & 0xFFFFFF00u); float esum = 0.f;
#pragma unroll
    for (int k = 0; k < 16; ++k) { ev[k] = __builtin_amdgcn_exp2f((key2f(cand[0][k] & 0xFFFFFF00u) - vmax) * LOG2E); esum += ev[k]; }
    const float einv = 1.0f / esum;
    LAS unsigned char* st = lds + 2 * TK_KIMG + (w * 64 + lane) * 32;
#pragma unroll
    for (int g4 = 0; g4 < 4; ++g4) { unsigned d0 = 0u, d1 = 0u;
#pragma unroll
        for (int e = 0; e < 4; ++e) { d0 |= (127u - (top[0][4 * g4 + e] & 127u)) << (8 * e); d1 |= (127u - (top[1][4 * g4 + e] & 127u)) << (8 * e); }
        *(LAS unsigned*)(st + 4 * g4) = d0; *(LAS unsigned*)(st + 16 + 4 * g4) = d1; }
    int eo[16];
#pragma unroll
    for (int k = 0; k < 16; ++k) { const unsigned code = 255u - (cand[0][k] & 255u); eo[k] = (int)st[code >> 4] * 128 + (int)st[16 + (code & 15u)]; }
    if (hh == 0) {
        u32x4 o0, o1;
        o0.x = (unsigned)eo[0] | ((unsigned)eo[1] << 16); o0.y = (unsigned)eo[2] | ((unsigned)eo[3] << 16); o0.z = (unsigned)eo[4] | ((unsigned)eo[5] << 16); o0.w = (unsigned)eo[6] | ((unsigned)eo[7] << 16);
        o1.x = (unsigned)eo[8] | ((unsigned)eo[9] << 16); o1.y = (unsigned)eo[10] | ((unsigned)eo[11] << 16); o1.z = (unsigned)eo[12] | ((unsigned)eo[13] << 16); o1.w = (unsigned)eo[14] | ((unsigned)eo[15] << 16);
        *(u32x4*)(eidx + tok * 128 + h * 16) = o0; *(u32x4*)(eidx + tok * 128 + h * 16 + 8) = o1;
    } else {
#pragma unroll
        for (int k4 = 0; k4 < 4; ++k4) { f32x4 o; o[0] = ev[4 * k4] * einv; o[1] = ev[4 * k4 + 1] * einv; o[2] = ev[4 * k4 + 2] * einv; o[3] = ev[4 * k4 + 3] * einv;
            *(f32x4*)(gate + tok * 128 + h * 16 + 4 * k4) = o; }
    }
    __syncthreads();
}

__device__ __forceinline__ float fp8dot16(const u32x4 w, const f32x2 (&xp)[8]) {
    f32x2 a0 = __builtin_amdgcn_cvt_pk_f32_fp8((int)w.x, false) * xp[0];
    a0 = __builtin_elementwise_fma(__builtin_amdgcn_cvt_pk_f32_fp8((int)w.x, true), xp[1], a0);
    a0 = __builtin_elementwise_fma(__builtin_amdgcn_cvt_pk_f32_fp8((int)w.y, false), xp[2], a0); a0 = __builtin_elementwise_fma(__builtin_amdgcn_cvt_pk_f32_fp8((int)w.y, true), xp[3], a0);
    a0 = __builtin_elementwise_fma(__builtin_amdgcn_cvt_pk_f32_fp8((int)w.z, false), xp[4], a0); a0 = __builtin_elementwise_fma(__builtin_amdgcn_cvt_pk_f32_fp8((int)w.z, true), xp[5], a0);
    a0 = __builtin_elementwise_fma(__builtin_amdgcn_cvt_pk_f32_fp8((int)w.w, false), xp[6], a0); a0 = __builtin_elementwise_fma(__builtin_amdgcn_cvt_pk_f32_fp8((int)w.w, true), xp[7], a0);
    return a0.x + a0.y;
}
typedef int i32x4 __attribute__((ext_vector_type(4)));
#define PEER_EIDX16(dst, t_) do { const unsigned short* ep_ = eidx + (size_t)(t_) * 128 + 16 * grp; const u32x4 e0_ = *(const u32x4*)ep_, e1_ = *(const u32x4*)(ep_ + 8); \
        dst[0] = (int)(e0_.x & 0xffffu); dst[1] = (int)(e0_.x >> 16); dst[2] = (int)(e0_.y & 0xffffu); dst[3] = (int)(e0_.y >> 16); dst[4] = (int)(e0_.z & 0xffffu); dst[5] = (int)(e0_.z >> 16); dst[6] = (int)(e0_.w & 0xffffu); dst[7] = (int)(e0_.w >> 16); \
        dst[8] = (int)(e1_.x & 0xffffu); dst[9] = (int)(e1_.x >> 16); dst[10] = (int)(e1_.y & 0xffffu); dst[11] = (int)(e1_.y >> 16); dst[12] = (int)(e1_.z & 0xffffu); dst[13] = (int)(e1_.z >> 16); dst[14] = (int)(e1_.w & 0xffffu); dst[15] = (int)(e1_.w >> 16); } while (0)
#define PEER_GATHER16(BUF, base, ev) _Pragma("unroll") for (int i_ = 0; i_ < 16; ++i_) BUF[i_] = *(const u32x4*)((base) + (unsigned)(((unsigned)(ev)[i_] << 10) + (unsigned)colbase))
template <int CTRL> __device__ __forceinline__ float xsel_addf_dpp(float keep_lo, float keep_hi, bool hi) { const float send = hi ? keep_lo : keep_hi, keep = hi ? keep_hi : keep_lo;
    return keep + __uint_as_float(__builtin_amdgcn_update_dpp(0u, __float_as_uint(send), CTRL, 0xf, 0xf, false)); }
__device__ __forceinline__ float swap32_add(float lo, float hi) { typedef unsigned u2_ __attribute__((ext_vector_type(2))); const u2_ r = __builtin_amdgcn_permlane32_swap(__float_as_uint(lo), __float_as_uint(hi), false, false); return __uint_as_float(r.x) + __uint_as_float(r.y); }
__device__ __forceinline__ float swap16_add(float lo, float hi) { typedef unsigned u2_ __attribute__((ext_vector_type(2))); const u2_ r = __builtin_amdgcn_permlane16_swap(__float_as_uint(lo), __float_as_uint(hi), false, false); return __uint_as_float(r.x) + __uint_as_float(r.y); }
#define PEER_GATHER4(R, o, base, E, p) _Pragma("unroll") for (int j_ = 0; j_ < 4; ++j_) R[(o) + j_] = *(const u32x4*)((base) + (unsigned)(((unsigned)(E)[4 * (p) + j_] << 10) + (unsigned)colbase))
__device__ __forceinline__ void peerU_phase(int slice, int tok0, int tok1, const bf16_t* __restrict__ x1b,
                                            const unsigned short* __restrict__ eidx, const unsigned char* __restrict__ ub8, bf16_t* __restrict__ hp) {
    int tid = threadIdx.x; asm volatile("" : "+v"(tid));
    const int wave = tid >> 6, lane = tid & 63, sub = lane & 7, grp = lane >> 3, colbase = 128 * slice + 16 * sub;
    if (tok0 + wave >= tok1) return;
    const bool l0 = lane & 1, l1 = lane & 2, l2 = lane & 4;
    const int tfirst = tok0 + wave, tlast = tfirst + ((tok1 - 1 - tfirst) >> 3) * 8;
    const bf16_t* xl = x1b + colbase;
    const int hoff = 16 * grp + ((lane & 4) ? 8 : 0) + ((lane & 2) ? 4 : 0) + ((lane & 1) ? 2 : 0);
#define TOKC(i) ((tfirst + 8 * (i)) <= tlast ? (tfirst + 8 * (i)) : tlast)
    u32x4 R[32]; int EA[16], EB[16]; u32x4 xrA0, xrA1, xrB0, xrB1;
    { const int t0 = TOKC(0), t1 = TOKC(1);
      PEER_EIDX16(EA, t0); PEER_EIDX16(EB, t1);
      xrA0 = *(const u32x4*)(xl + (size_t)t0 * D); xrA1 = *(const u32x4*)(xl + (size_t)t0 * D + 8); xrB0 = *(const u32x4*)(xl + (size_t)t1 * D); xrB1 = *(const u32x4*)(xl + (size_t)t1 * D + 8);
#pragma unroll
      for (int p = 0; p < 4; ++p) { PEER_GATHER4(R, 4 * p, ub8, EA, p); }
#pragma unroll
      for (int p = 0; p < 4; ++p) { PEER_GATHER4(R, 16 + 4 * p, ub8, EB, p); }
      const int t2 = TOKC(2), t3 = TOKC(3); PEER_EIDX16(EA, t2); PEER_EIDX16(EB, t3); }
    for (int i = 0;; i += 2) {
#define PEER_U_TOKEN(RO, E, xr0, xr1, ti, tnext2, tnext4) do { \
        f32x2 xp[8]; \
        xp[0] = (f32x2){bflo(xr0.x), bfhi(xr0.x)}; xp[1] = (f32x2){bflo(xr0.y), bfhi(xr0.y)}; xp[2] = (f32x2){bflo(xr0.z), bfhi(xr0.z)}; xp[3] = (f32x2){bflo(xr0.w), bfhi(xr0.w)}; \
        xp[4] = (f32x2){bflo(xr1.x), bfhi(xr1.x)}; xp[5] = (f32x2){bflo(xr1.y), bfhi(xr1.y)}; xp[6] = (f32x2){bflo(xr1.z), bfhi(xr1.z)}; xp[7] = (f32x2){bflo(xr1.w), bfhi(xr1.w)}; \
        xr0 = *(const u32x4*)(xl + (size_t)(tnext2) * D); xr1 = *(const u32x4*)(xl + (size_t)(tnext2) * D + 8);        \
        float pd[16]; \
        _Pragma("unroll") for (int p = 0; p < 4; ++p) { \
            _Pragma("unroll") for (int j = 0; j < 4; ++j) pd[4 * p + j] = fp8dot16(R[(RO) + 4 * p + j], xp); \
            PEER_GATHER4(R, (RO) + 4 * p, ub8, E, p); } \
        PEER_EIDX16(E, tnext4); \
        float q8[8]; \
        _Pragma("unroll") for (int k = 0; k < 8; ++k) q8[k] = xsel_addf_dpp<0x141>(pd[k], pd[k + 8], l2);            \
        const float r0 = xsel_addf_dpp<0x4E>(q8[0], q8[4], l1), r1 = xsel_addf_dpp<0x4E>(q8[1], q8[5], l1), r2 = xsel_addf_dpp<0x4E>(q8[2], q8[6], l1), r3 = xsel_addf_dpp<0x4E>(q8[3], q8[7], l1);     \
        f32x2 o; o.x = xsel_addf_dpp<0xB1>(r0, r2, l0); o.y = xsel_addf_dpp<0xB1>(r1, r3, l0);                       \
        if ((tfirst + 8 * (ti)) <= tlast) *(unsigned*)(hp + ((size_t)slice * T + (size_t)(tfirst + 8 * (ti))) * 128 + hoff) = pk2(o.x, o.y); } while (0)
        { const int tn2 = TOKC(i + 2), tn4 = TOKC(i + 4); PEER_U_TOKEN(0, EA, xrA0, xrA1, i, tn2, tn4); }
        { const int tn2 = TOKC(i + 3), tn4 = TOKC(i + 5); PEER_U_TOKEN(16, EB, xrB0, xrB1, i + 1, tn2, tn4); }
        if (tfirst + 8 * (i + 2) > tlast) break;
    }
#undef PEER_U_TOKEN
#undef TOKC
}
#ifdef PROBE_EXP
__device__ __forceinline__ void probe_gather(int slice, int tok0, int tok1, const unsigned short* __restrict__ eidx, const unsigned char* __restrict__ ub8, float* __restrict__ dummy) {
    int tid = threadIdx.x; asm volatile("" : "+v"(tid));
    const int wave = tid >> 6, lane = tid & 63, sub = lane & 7, grp = lane >> 3, colbase = 128 * slice + 16 * sub;
    if (tok0 + wave >= tok1) return;
    const unsigned char* ubl = ub8;
    const int tlast = tok0 + wave + ((tok1 - 1 - tok0 - wave) >> 3) * 8;
    int EA[16], EB[16]; u32x4 UA[16], UB[16];
    int ta = tok0 + wave, tb = ta + 8 <= tlast ? ta + 8 : tlast;
    PEER_EIDX16(EA, ta); PEER_EIDX16(EB, tb);
    PEER_GATHER16(UA, ubl, EA);
    unsigned accx = 0u;
    for (;;) {
        PEER_GATHER16(UB, ubl, EB);
        const int ta2 = ta + 16 <= tlast ? ta + 16 : tlast; PEER_EIDX16(EA, ta2);
#pragma unroll
        for (int i = 0; i < 16; ++i) accx ^= UA[i].x ^ UA[i].y ^ UA[i].z ^ UA[i].w;
        PEER_GATHER16(UA, ubl, EA);
        const int tb2 = ta + 24 <= tlast ? ta + 24 : tlast; PEER_EIDX16(EB, tb2);
#pragma unroll
        for (int i = 0; i < 16; ++i) accx ^= UB[i].x ^ UB[i].y ^ UB[i].z ^ UB[i].w;
        if (ta + 16 > tlast) break;
        ta = ta2; tb = tb2;
    }
    dummy[(size_t)blockIdx.x * 512 + tid] = __uint_as_float(accx & 0x3fffffffu);
}
#endif

#if defined(PROBE_EXP) && PROBE_EXP >= 10 && PROBE_EXP < 20
__device__ __forceinline__ void probe_valu(float* __restrict__ dummy) {
    int tid = threadIdx.x; asm volatile("" : "+v"(tid));
    unsigned w[8]; f32x2 a[8];
#pragma unroll
    for (int i = 0; i < 8; ++i) { w[i] = (unsigned)tid * 2654435761u + i * 40503u; a[i] = (f32x2){(float)i, 1.0f}; }
    for (int it = 0; it < 2048; ++it) {
#pragma unroll
        for (int r = 0; r < 4; ++r)
#pragma unroll
            for (int i = 0; i < 8; ++i) {
#if PROBE_EXP == 10
                asm volatile("v_cvt_pk_f32_fp8_e32 %0, %1" : "=v"(a[i]) : "v"(w[i]));
#elif PROBE_EXP == 11
                asm volatile("v_pk_fma_f32 %0, %1, %1, %0" : "+v"(a[i]) : "v"(a[(i + 1) & 7]));
#elif PROBE_EXP == 12
                asm volatile("v_cvt_f32_ubyte0_e32 %0, %1" : "=v"(a[i].x) : "v"(w[i]));
#elif PROBE_EXP == 13
                asm volatile("v_dot4_i32_i8 %0, %1, %1, %0" : "+v"(w[i]) : "v"(w[(i + 1) & 7]));
#elif PROBE_EXP == 14
                asm volatile("v_fma_f32 %0, %1, %1, %0" : "+v"(a[i].x) : "v"(a[(i + 1) & 7].y));
#elif PROBE_EXP == 15
                asm volatile("v_dot2_f32_bf16 %0, %1, %1, %0" : "+v"(a[i].x) : "v"(w[i]));
#endif
            }
    }
    float s = 0.f;
#pragma unroll
    for (int i = 0; i < 8; ++i) s += a[i].x + a[i].y + __uint_as_float(w[i] & 0x3fffffffu);
    dummy[(size_t)blockIdx.x * 512 + tid] = s;
}
#endif
__device__ __forceinline__ void peerR_phase(const bf16_t* __restrict__ hp, const unsigned short* __restrict__ eidx, const float* __restrict__ gate, const float* __restrict__ usc, const float* __restrict__ vsc, bf16_t* __restrict__ cb) {
    for (size_t i = (size_t)blockIdx.x * 512 + threadIdx.x; i < (size_t)T * 32; i += (size_t)gridDim.x * 512) {
        f32x4 h = (f32x4){0.f, 0.f, 0.f, 0.f};
#pragma unroll
        for (int j = 0; j < 8; ++j) { const u32x2 w = *(const u32x2*)(hp + (size_t)j * T * 128 + 4 * i); h += (f32x4){bflo(w.x), bfhi(w.x), bflo(w.y), bfhi(w.y)}; }
        const u32x2 ew = *(const u32x2*)(eidx + 4 * i); const int e[4] = {(int)(ew.x & 0xffffu), (int)(ew.x >> 16), (int)(ew.y & 0xffffu), (int)(ew.y >> 16)};
        const f32x4 gt = *(const f32x4*)(gate + 4 * i); float c[4];
#pragma unroll
        for (int j = 0; j < 4; ++j) { const float hh = h[j] * usc[e[j]]; const pg8::f32x2 ge = pg8::gelu_pk((pg8::f32x2){hh, hh}); c[j] = gt[j] * ge.x * vsc[e[j]]; }
        u32x2 cw; cw.x = pk2(c[0], c[1]); cw.y = pk2(c[2], c[3]); *(u32x2*)(cb + 4 * i) = cw; }
}
__device__ __forceinline__ void peerV_phase(int slice, int tok0, int tok1, const bf16_t* __restrict__ cb, const unsigned short* __restrict__ eidx, const unsigned char* __restrict__ vb8, bf16_t* __restrict__ yp) {
    int tid = threadIdx.x; asm volatile("" : "+v"(tid));
    const int wave = tid >> 6, lane = tid & 63, sub = lane & 7, grp = lane >> 3, colbase = 128 * slice + 16 * sub;
    if (tok0 + wave >= tok1) return;
    const bool l3 = lane & 8, l4 = lane & 16, l5 = lane & 32;
    const int tfirst = tok0 + wave, tlast = tfirst + ((tok1 - 1 - tfirst) >> 3) * 8;
    const bf16_t* cl = cb + 16 * grp;
    const int yoff = colbase + ((lane & 32) ? 8 : 0) + ((lane & 16) ? 4 : 0) + ((lane & 8) ? 2 : 0);
#define TOKC(i) ((tfirst + 8 * (i)) <= tlast ? (tfirst + 8 * (i)) : tlast)
#define PEER_C16(dst, t_) do { const bf16_t* cp_ = cl + (size_t)(t_) * 128; dst[0] = *(const u32x4*)cp_; dst[1] = *(const u32x4*)(cp_ + 8); } while (0)
    u32x4 R[32]; int EA[16], EB[16]; u32x4 cA[2], cB[2];
    { const int t0 = TOKC(0), t1 = TOKC(1);
      PEER_EIDX16(EA, t0); PEER_EIDX16(EB, t1); PEER_C16(cA, t0); PEER_C16(cB, t1);
#pragma unroll
      for (int p = 0; p < 4; ++p) { PEER_GATHER4(R, 4 * p, vb8, EA, p); }
#pragma unroll
      for (int p = 0; p < 4; ++p) { PEER_GATHER4(R, 16 + 4 * p, vb8, EB, p); }
      const int t2 = TOKC(2), t3 = TOKC(3); PEER_EIDX16(EA, t2); PEER_EIDX16(EB, t3); }
    for (int i = 0;; i += 2) {
#define PEER_V_TOKEN(RO, E, cc, ti, tnext2, tnext4) do { \
        const u32x4 c0_ = cc[0], c1_ = cc[1]; \
        const float cv[16] = {bflo(c0_.x), bfhi(c0_.x), bflo(c0_.y), bfhi(c0_.y), bflo(c0_.z), bfhi(c0_.z), bflo(c0_.w), bfhi(c0_.w), bflo(c1_.x), bfhi(c1_.x), bflo(c1_.y), bfhi(c1_.y), bflo(c1_.z), bfhi(c1_.z), bflo(c1_.w), bfhi(c1_.w)}; \
        PEER_C16(cc, tnext2);                                        \
        f32x2 acc[8]; \
        _Pragma("unroll") for (int k = 0; k < 8; ++k) acc[k] = (f32x2){0.f, 0.f}; \
        _Pragma("unroll") for (int p = 0; p < 4; ++p) { \
            _Pragma("unroll") for (int j = 0; j < 4; ++j) { const u32x4 w = R[(RO) + 4 * p + j]; const f32x2 c2v = (f32x2){cv[4 * p + j], cv[4 * p + j]}; \
                acc[0] = __builtin_elementwise_fma(__builtin_amdgcn_cvt_pk_f32_fp8((int)w.x, false), c2v, acc[0]); acc[1] = __builtin_elementwise_fma(__builtin_amdgcn_cvt_pk_f32_fp8((int)w.x, true), c2v, acc[1]); \
                acc[2] = __builtin_elementwise_fma(__builtin_amdgcn_cvt_pk_f32_fp8((int)w.y, false), c2v, acc[2]); acc[3] = __builtin_elementwise_fma(__builtin_amdgcn_cvt_pk_f32_fp8((int)w.y, true), c2v, acc[3]); \
                acc[4] = __builtin_elementwise_fma(__builtin_amdgcn_cvt_pk_f32_fp8((int)w.z, false), c2v, acc[4]); acc[5] = __builtin_elementwise_fma(__builtin_amdgcn_cvt_pk_f32_fp8((int)w.z, true), c2v, acc[5]); \
                acc[6] = __builtin_elementwise_fma(__builtin_amdgcn_cvt_pk_f32_fp8((int)w.w, false), c2v, acc[6]); acc[7] = __builtin_elementwise_fma(__builtin_amdgcn_cvt_pk_f32_fp8((int)w.w, true), c2v, acc[7]); } \
            PEER_GATHER4(R, (RO) + 4 * p, vb8, E, p); } \
        PEER_EIDX16(E, tnext4); \
        const float a[16] = {acc[0].x, acc[0].y, acc[1].x, acc[1].y, acc[2].x, acc[2].y, acc[3].x, acc[3].y, acc[4].x, acc[4].y, acc[5].x, acc[5].y, acc[6].x, acc[6].y, acc[7].x, acc[7].y}; \
        float q8[8]; \
        _Pragma("unroll") for (int k = 0; k < 8; ++k) q8[k] = swap32_add(a[k], a[k + 8]); \
        const float r0 = swap16_add(q8[0], q8[4]), r1 = swap16_add(q8[1], q8[5]), r2 = swap16_add(q8[2], q8[6]), r3 = swap16_add(q8[3], q8[7]); \
        f32x2 o; o.x = xsel_addf_dpp<0x128>(r0, r2, l3); o.y = xsel_addf_dpp<0x128>(r1, r3, l3);               \
        if ((tfirst + 8 * (ti)) <= tlast) *(unsigned*)(yp + (size_t)(tfirst + 8 * (ti)) * D + yoff) = pk2(o.x, o.y); } while (0)
        { const int tn2 = TOKC(i + 2), tn4 = TOKC(i + 4); PEER_V_TOKEN(0, EA, cA, i, tn2, tn4); }
        { const int tn2 = TOKC(i + 3), tn4 = TOKC(i + 5); PEER_V_TOKEN(16, EB, cB, i + 1, tn2, tn4); }
        if (tfirst + 8 * (i + 2) > tlast) break;
    }
#undef PEER_V_TOKEN
#undef PEER_C16
#undef TOKC
}
template <int NT>
__device__ __forceinline__ void peerL_token(size_t t0, size_t tstride, const bf16_t* __restrict__ x1b, const bf16_t* __restrict__ yp, const float* g2, const float* b2, float* __restrict__ out) {
    const int lane = threadIdx.x & 63;
    u32x4 xw[NT][2], yw[NT][2];
#pragma unroll
    for (int k = 0; k < NT; ++k) { const size_t t = t0 + k * tstride;
#pragma unroll
        for (int hlf = 0; hlf < 2; ++hlf) { const int c = 16 * lane + 8 * hlf; xw[k][hlf] = *(const u32x4*)(x1b + t * D + c); yw[k][hlf] = *(const u32x4*)(yp + t * D + c); } }
#pragma unroll
    for (int k = 0; k < NT; ++k) { const size_t t = t0 + k * tstride;
        float y[16]; float s = 0.f;
#pragma unroll
        for (int hlf = 0; hlf < 2; ++hlf) { const u32x4 xq = xw[k][hlf], yq = yw[k][hlf];
            const float xx[8] = {bflo(xq.x), bfhi(xq.x), bflo(xq.y), bfhi(xq.y), bflo(xq.z), bfhi(xq.z), bflo(xq.w), bfhi(xq.w)}, yy[8] = {bflo(yq.x), bfhi(yq.x), bflo(yq.y), bfhi(yq.y), bflo(yq.z), bfhi(yq.z), bflo(yq.w), bfhi(yq.w)};
#pragma unroll
            for (int j = 0; j < 8; ++j) { const float v = ALPHA * xx[j] + yy[j]; y[8 * hlf + j] = v; s += v; } }
        const float mean2 = wave_sum(s) * (1.f / D); float ss = 0.f;
#pragma unroll
        for (int i = 0; i < 16; ++i) { const float dlt = y[i] - mean2; ss += dlt * dlt; }
        const float rstd2 = rsqrtf(wave_sum(ss) * (1.f / D) + LN_EPS);
#pragma unroll
        for (int q = 0; q < 4; ++q) { const int c = 16 * lane + 4 * q; const f32x4 gg = *(const f32x4*)(g2 + c), bb = *(const f32x4*)(b2 + c); f32x4 o;
#pragma unroll
            for (int j = 0; j < 4; ++j) o[j] = (y[4 * q + j] - mean2) * rstd2 * gg[j] + bb[j];
            *(f32x4*)(out + t * D + c) = o; } }
}

constexpr int NTHREADS = 512, NWAVES = 8;
constexpr int LDS_BYTES = 147456;
constexpr int LDS_MISC = 131072;
constexpr int LDS_XB = LDS_BYTES - 16;
constexpr size_t CTL_ZERO_BYTES = 16384;

struct Params {
    const float *x, *mem, *relb, *w_in, *b_gate, *w_memkv, *sinks, *w_a, *w_b, *w_c, *w_out, *ln1g, *ln1b, *w_q, *subk, *pu, *pv, *ln2g, *ln2b;
    float* out; char* ws; int lo, hi;
};

__device__ __forceinline__ void g_cvt(const float* __restrict__ src, bf16_t* __restrict__ dst, size_t n8) {
    for (size_t i = (size_t)blockIdx.x * NTHREADS + threadIdx.x; i < n8; i += (size_t)gridDim.x * NTHREADS) {
        const f32x4 a = ((const f32x4*)src)[2 * i], b = ((const f32x4*)src)[2 * i + 1];
        u32x4 w; w.x = pk2(a[0], a[1]); w.y = pk2(a[2], a[3]); w.z = pk2(b[0], b[1]); w.w = pk2(b[2], b[3]);
        ((u32x4*)dst)[i] = w; }
}


__device__ __forceinline__ void g_cvt8(const float* __restrict__ src, unsigned char* __restrict__ dst, size_t n16, float sc) {
    for (size_t i = (size_t)blockIdx.x * NTHREADS + threadIdx.x; i < n16; i += (size_t)gridDim.x * NTHREADS) {
        const f32x4 a = ((const f32x4*)src)[4 * i], b = ((const f32x4*)src)[4 * i + 1], c = ((const f32x4*)src)[4 * i + 2], d = ((const f32x4*)src)[4 * i + 3];
        u32x4 w; int t;
        t = 0; t = __builtin_amdgcn_cvt_pk_fp8_f32(a[0] * sc, a[1] * sc, t, false); t = __builtin_amdgcn_cvt_pk_fp8_f32(a[2] * sc, a[3] * sc, t, true); w.x = (unsigned)t;
        t = 0; t = __builtin_amdgcn_cvt_pk_fp8_f32(b[0] * sc, b[1] * sc, t, false); t = __builtin_amdgcn_cvt_pk_fp8_f32(b[2] * sc, b[3] * sc, t, true); w.y = (unsigned)t;
        t = 0; t = __builtin_amdgcn_cvt_pk_fp8_f32(c[0] * sc, c[1] * sc, t, false); t = __builtin_amdgcn_cvt_pk_fp8_f32(c[2] * sc, c[3] * sc, t, true); w.z = (unsigned)t;
        t = 0; t = __builtin_amdgcn_cvt_pk_fp8_f32(d[0] * sc, d[1] * sc, t, false); t = __builtin_amdgcn_cvt_pk_fp8_f32(d[2] * sc, d[3] * sc, t, true); w.w = (unsigned)t;
        ((u32x4*)dst)[i] = w; }
}

template <bool FP8>
__device__ __forceinline__ void transpose_tile_wave(const float* __restrict__ src, int K, int N, void* __restrict__ dstv, int tn, int tk, LAS float* tile, float sc) {
    const int lane = threadIdx.x & 63, n0 = tn * 64, k0 = tk * 64, rq = lane >> 4, c4 = (lane & 15) * 4;
    f32x4 v[16];
#pragma unroll
    for (int i = 0; i < 16; ++i) v[i] = *(const f32x4*)(src + (size_t)(k0 + 4 * i + rq) * N + n0 + c4);
#pragma unroll
    for (int i = 0; i < 16; ++i) *(LAS f32x4*)(tile + (4 * i + rq) * 68 + c4) = v[i];
    asm volatile("s_waitcnt lgkmcnt(0)" ::: "memory");
    float y[64];
#pragma unroll
    for (int k = 0; k < 64; ++k) y[k] = tile[k * 68 + lane];
    if constexpr (FP8) { unsigned char* dst = (unsigned char*)dstv + (size_t)(n0 + lane) * K + k0;
#pragma unroll
        for (int q = 0; q < 4; ++q) { u32x4 w; int t;
#pragma unroll
            for (int d = 0; d < 4; ++d) { t = 0; t = __builtin_amdgcn_cvt_pk_fp8_f32(y[16 * q + 4 * d] * sc, y[16 * q + 4 * d + 1] * sc, t, false); t = __builtin_amdgcn_cvt_pk_fp8_f32(y[16 * q + 4 * d + 2] * sc, y[16 * q + 4 * d + 3] * sc, t, true); w[d] = (unsigned)t; }
            *(u32x4*)(dst + 16 * q) = w; } }
    else { bf16_t* dst = (bf16_t*)dstv + (size_t)(n0 + lane) * K + k0;
#pragma unroll
        for (int q = 0; q < 8; ++q) { u32x4 w; w.x = pk2(y[8 * q], y[8 * q + 1]); w.y = pk2(y[8 * q + 2], y[8 * q + 3]); w.z = pk2(y[8 * q + 4], y[8 * q + 5]); w.w = pk2(y[8 * q + 6], y[8 * q + 7]); *(u32x4*)(dst + 8 * q) = w; } }
    asm volatile("s_waitcnt lgkmcnt(0)" ::: "memory");
}
#define W_ws (p.ws)
#define W_dout ((char*)p.out)
#define W_wmemkv_t ((bf16_t*)(W_ws + WS_WMEMKV))
#define W_wA_t ((bf16_t*)(W_ws + WS_WA))
#define W_wB_t ((bf16_t*)(W_ws + WS_WB))
#define W_wC_t ((bf16_t*)(W_ws + WS_WC))
#define W_wout_t ((bf16_t*)(W_ws + WS_WOUT))
#define W_wq_t ((bf16_t*)(W_ws + WS_WQ))
#define W_subkb ((bf16_t*)(W_ws + WS_SUBK))
#define W_memb ((bf16_t*)(W_ws + WS_MEMB))
#define W_kvm ((bf16_t*)(W_ws + WS_KVM))
#define W_stats ((float*)(W_ws + WS_STATS))
#define W_lseA ((float*)(W_ws + WS_LSE))
#define W_hq ((bf16_t*)(W_ws + WS_HQ))
#define W_gates ((bf16_t*)(W_ws + WS_GATES))
#define W_xb ((bf16_t*)(W_ws + WS_XB))
#define W_mf ((float*)(W_ws + WS_MF))
#define W_mb ((unsigned char*)(W_ws + WS_MB))
#define W_z ((bf16_t*)(W_ws + WS_Z))
#define W_x1b ((bf16_t*)(W_ws + WS_X1B))
#define W_qb ((bf16_t*)(W_ws + WS_Q))
#define W_eidx ((unsigned short*)(W_ws + WS_EIDX))
#define W_gate ((float*)(W_ws + WS_GATE))
#define W_ub8 ((unsigned char*)(W_ws + WS_UB))
#define W_vb8 ((unsigned char*)(W_ws + WS_UB + 16 * MiB))
#define W_usc ((float*)(W_ws + WS_UB + 32 * MiB))
#define W_vsc (W_usc + NEXP)
#define W_w_in_t ((bf16_t*)(W_dout + DO_WINT))
#define W_oA ((bf16_t*)(W_dout + DO_OA))
#define W_yb ((bf16_t*)(W_dout + DO_YB))
#define W_yc ((bf16_t*)(W_dout + DO_YC))
#define W_ya ((bf16_t*)(W_dout + DO_YA))
#define W_x8 ((unsigned char*)W_dout)
#define W_hp ((bf16_t*)(W_ws + 120 * MiB))
#define W_cbuf ((bf16_t*)(W_ws + 24 * MiB))
#define W_yp W_hp
__global__ void __launch_bounds__(NTHREADS, 2) mk_fwd(Params p) {
    extern __shared__ __attribute__((aligned(16))) unsigned char lds[];
#define LAUNDER_TID int tid = threadIdx.x; asm volatile("" : "+v"(tid)); const int wave = tid >> 6; const int gw = blockIdx.x * NWAVES + wave, nw = gridDim.x * NWAVES; (void)wave; (void)gw; (void)nw;
    if (threadIdx.x == 0) *(uint4*)(lds + LDS_XB) = make_uint4(0u, 0u, 0u, 0u);
    __syncthreads();
    XcdBarrier bar = xcd_barrier_post((unsigned*)(W_ws + WS_CTL), (volatile LAS unsigned*)(lds + LDS_XB));
#define PH(k) (p.lo <= (k) && (k) < p.hi)
#define SEAM(k) do { if (PH(k) && PH((k) + 1)) xcd_barrier(bar); } while (0)

    if (PH(0)) { LAUNDER_TID
        g_cvt8(p.x, (unsigned char*)W_xb, (size_t)T * D / 16, 1.0f);
        g_cvt(p.mem, W_memb, (size_t)BATCH * MEMLEN * D / 8);
        g_cvt(p.subk, W_subkb, (size_t)8 * 2 * 128 * 64 / 8);
        LAS float* tile = (LAS float*)((LAS unsigned char*)lds + wave * (64 * 68 * 4));
        for (int u = gw; u < 2752; u += nw) {
            if (u < 1664) transpose_tile_wave<true>(p.w_in, D, INW, W_w_in_t, u % 104, u / 104, tile, 32.0f);
            else if (u < 1920) { const int v = u - 1664; transpose_tile_wave<false>(p.w_memkv, D, 1024, W_wmemkv_t, v & 15, v >> 4, tile, 1.f); }
            else if (u < 1984) { const int v = u - 1920; transpose_tile_wave<true>(p.w_a, 256, 1024, W_wA_t, v & 15, v >> 4, tile, 32.0f); }
            else if (u < 2112) { const int v = u - 1984; transpose_tile_wave<true>(p.w_b, 512, 1024, W_wB_t, v & 15, v >> 4, tile, 32.0f); }
            else if (u < 2240) { const int v = u - 2112; transpose_tile_wave<true>(p.w_c, 512, 1024, W_wC_t, v & 15, v >> 4, tile, 32.0f); }
            else if (u < 2496) { const int v = u - 2240; transpose_tile_wave<true>(p.w_out, D, 1024, W_wout_t, v & 15, v >> 4, tile, 32.0f); }
            else { const int v = u - 2496; transpose_tile_wave<false>(p.w_q, D, 1024, W_wq_t, v & 15, v >> 4, tile, 1.f); }
        }
    }
    SEAM(0);
    if (PH(1)) {
        { pg8::Gemm g; g.A = W_memb; g.Bt = W_wmemkv_t; g.M = BATCH * MEMLEN; g.N = 1024; g.K = D; EpiPlain E; E.O = W_kvm; E.ldc = 1024;
          pg8::StaticOrder S; S.init(g.M, g.N, (int)gridDim.x, (int)blockIdx.x); pg8::gemm_phase<EpiPlain, pg8::StaticOrder, false>((PG8_LAS unsigned char*)lds, g, S, E, nullptr); }
        __syncthreads();
        { pg8::Gemm g; g.A = W_xb; g.Bt = W_w_in_t; g.M = T; g.N = INW; g.K = D / 2; EpiIn E; E.hq = W_hq; E.gates = W_gates; E.bgate = p.b_gate;
          pg8::StaticOrder S; S.init(g.M, g.N, (int)gridDim.x, (int)blockIdx.x); pg8::gemm_phase<EpiIn, pg8::StaticOrder, false, true>((PG8_LAS unsigned char*)lds, g, S, E, nullptr); }
    }
    SEAM(1);
    if (PH(2)) { LAUNDER_TID
        LAS unsigned char* L = (LAS unsigned char*)lds;
        attnAB_phase(L, W_hq, p.relb, p.sinks, W_oA, W_lseA, W_yb);
        for (int u = blockIdx.x; u < 256; u += gridDim.x) attnC_unit(u, L, W_hq, W_kvm, W_yc);
        for (int row = gw; row < NEXP / 2; row += nw) cvt_rows_fp8(p.pu, p.pv, W_ub8, W_vb8, W_usc, W_vsc, row, row + NEXP / 2);
    }
    SEAM(2);
    if (PH(3)) { LAUNDER_TID for (size_t i = (size_t)blockIdx.x * NTHREADS + tid; i < (size_t)T * 32; i += (size_t)gridDim.x * NTHREADS) t_mix(i, W_oA, W_lseA, W_ya); }
    SEAM(3);
    if (PH(4)) {
        pg8::MergeArgs g; g.A[0] = W_ya; g.A[1] = W_yb; g.A[2] = W_yc; g.Bt[0] = W_wA_t; g.Bt[1] = W_wB_t; g.Bt[2] = W_wC_t; g.K[0] = 128; g.K[1] = 256; g.K[2] = 256; g.gates = W_gates; g.mb = W_mb;
        pg8::StaticOrder S; S.init(T, D, (int)gridDim.x, (int)blockIdx.x); pg8::gemm_phase_merge<pg8::StaticOrder, true>((PG8_LAS unsigned char*)lds, g, S);
    }
    SEAM(4);
    if (PH(5)) {
        pg8::Gemm g; g.A = (const bf16_t*)W_mb; g.Bt = W_wout_t; g.M = T; g.N = D; g.K = D / 2; EpiPlain E; E.O = W_z; E.ldc = 1024;
        pg8::StaticOrder S; S.init(g.M, g.N, (int)gridDim.x, (int)blockIdx.x); pg8::gemm_phase<EpiPlain, pg8::StaticOrder, false, true, 123>((PG8_LAS unsigned char*)lds, g, S, E, nullptr);
    }
    SEAM(5);
    if (PH(6)) { LAUNDER_TID int t = gw; for (; t + 3 * nw < T; t += 4 * nw) t_res_ln1<4>((size_t)t, (size_t)nw, p.x, W_z, p.ln1g, p.ln1b, W_x1b);
        for (; t < T; t += nw) t_res_ln1<1>((size_t)t, (size_t)nw, p.x, W_z, p.ln1g, p.ln1b, W_x1b); }
    SEAM(6);
    if (PH(7)) {
        pg8::Gemm g; g.A = W_x1b; g.Bt = W_wq_t; g.M = T; g.N = D; g.K = D; EpiPlain E; E.O = W_qb; E.ldc = 1024;
        pg8::StaticOrder S; S.init(g.M, g.N, (int)gridDim.x, (int)blockIdx.x); pg8::gemm_phase<EpiPlain, pg8::StaticOrder, false>((PG8_LAS unsigned char*)lds, g, S, E, nullptr);
    }
    SEAM(7);
    if (PH(8)) { for (int u = blockIdx.x; u < (T / 256) * 8; u += gridDim.x) topk_unit(u, (LAS unsigned char*)lds, W_qb, W_subkb, W_eidx, W_gate); }
    SEAM(8);
    if (PH(9)) { const int ngrp = (int)(gridDim.x >> 3), tpc = ((T + ngrp - 1) / ngrp + 7) & ~7, sl_tok0 = (int)(blockIdx.x >> 3) * tpc, sl_tok1 = ((int)(blockIdx.x >> 3) < ngrp) ? (sl_tok0 + tpc < T ? sl_tok0 + tpc : T) : 0; peerU_phase((int)(blockIdx.x & 7), sl_tok0, sl_tok1, W_x1b, W_eidx, W_ub8, W_hp); }
    SEAM(9);
    if (PH(10)) { peerR_phase(W_hp, W_eidx, W_gate, W_usc, W_vsc, W_cbuf); }
    SEAM(10);
    if (PH(11)) { const int ngrp = (int)(gridDim.x >> 3), tpc = ((T + ngrp - 1) / ngrp + 7) & ~7, sl_tok0 = (int)(blockIdx.x >> 3) * tpc, sl_tok1 = ((int)(blockIdx.x >> 3) < ngrp) ? (sl_tok0 + tpc < T ? sl_tok0 + tpc : T) : 0; peerV_phase((int)(blockIdx.x & 7), sl_tok0, sl_tok1, W_cbuf, W_eidx, W_vb8, W_yp); }
    SEAM(11);
#ifdef PROBE_EXP
    if (PH(13)) { const int ngrp = (int)(gridDim.x >> 3), tpc = ((T + ngrp - 1) / ngrp + 7) & ~7, sl_tok0 = (int)(blockIdx.x >> 3) * tpc, sl_tok1 = ((int)(blockIdx.x >> 3) < ngrp) ? (sl_tok0 + tpc < T ? sl_tok0 + tpc : T) : 0;
        const int sl = (PROBE_EXP == 0) ? (int)(blockIdx.x & 7) : (int)((blockIdx.x + (blockIdx.x >> 3)) & 7);
#if PROBE_EXP == 20
        for (int rep = 0; rep < 20; ++rep) xcd_barrier(bar); (void)sl; (void)sl_tok0; (void)sl_tok1; }
#elif PROBE_EXP >= 10
        probe_valu((float*)(W_ws + 24 * MiB)); (void)sl; (void)sl_tok0; (void)sl_tok1; }
#else
        probe_gather(sl, sl_tok0, sl_tok1, W_eidx, W_ub8, (float*)(W_ws + 24 * MiB)); }
#endif
#endif
    if (PH(12)) { LAUNDER_TID int t = gw; for (; t + 3 * nw < T; t += 4 * nw) peerL_token<4>((size_t)t, (size_t)nw, W_x1b, W_yp, p.ln2g, p.ln2b, p.out);
        for (; t < T; t += nw) peerL_token<1>((size_t)t, (size_t)nw, W_x1b, W_yp, p.ln2g, p.ln2b, p.out); }
}

#ifndef MK_CUTS
#define MK_CUTS 0
#endif
extern "C" void kernel_launch(void* const* d_in, const int* in_sizes, int n_in, void* d_out, int out_size, void* d_ws, size_t ws_size, hipStream_t stream) {
    if (n_in != 19 || in_sizes[0] != T * D || out_size != T * D || ws_size < WS_END) { fprintf(stderr, "kernel_launch: unexpected shapes / workspace (%d inputs, ws %zu)\n", n_in, ws_size); return; }
    static int grid = 0;
    if (!grid) {
        int dev = 0, cus = 0, per_cu = 0;
        if (hipGetDevice(&dev) != hipSuccess || hipDeviceGetAttribute(&cus, hipDeviceAttributeMultiprocessorCount, dev) != hipSuccess) { fprintf(stderr, "kernel_launch: device query failed\n"); return; }
        if (hipFuncSetAttribute((const void*)mk_fwd, hipFuncAttributeMaxDynamicSharedMemorySize, LDS_BYTES) != hipSuccess) { fprintf(stderr, "kernel_launch: hipFuncSetAttribute failed\n"); return; }
        if (hipOccupancyMaxActiveBlocksPerMultiprocessor(&per_cu, (const void*)mk_fwd, NTHREADS, LDS_BYTES) != hipSuccess || per_cu < 1) { fprintf(stderr, "kernel_launch: occupancy query says %d\n", per_cu); return; }
        grid = cus;
    }
    Params p{};
    p.x = (const float*)d_in[0]; p.mem = (const float*)d_in[1]; p.relb = (const float*)d_in[2]; p.w_in = (const float*)d_in[3]; p.b_gate = (const float*)d_in[4]; p.w_memkv = (const float*)d_in[5];
    p.sinks = (const float*)d_in[6]; p.w_a = (const float*)d_in[7]; p.w_b = (const float*)d_in[8]; p.w_c = (const float*)d_in[9]; p.w_out = (const float*)d_in[10]; p.ln1g = (const float*)d_in[11];
    p.ln1b = (const float*)d_in[12]; p.w_q = (const float*)d_in[13]; p.subk = (const float*)d_in[14]; p.pu = (const float*)d_in[15]; p.pv = (const float*)d_in[16]; p.ln2g = (const float*)d_in[17];
    p.ln2b = (const float*)d_in[18]; p.out = (float*)d_out; p.ws = (char*)d_ws;
    if (hipMemsetAsync((char*)d_ws + WS_CTL, 0, CTL_ZERO_BYTES, stream) != hipSuccess) { fprintf(stderr, "kernel_launch: memset failed\n"); return; }
#if MK_CUTS
    for (int k = 0; k < 13; ++k) { p.lo = k; p.hi = k + 1; hipLaunchKernelGGL(mk_fwd, dim3(grid), dim3(NTHREADS), LDS_BYTES, stream, p); }
#else
#ifdef PROBE_SPLITK
    p.lo = 0; p.hi = PROBE_SPLITK + 1; hipLaunchKernelGGL(mk_fwd, dim3(grid), dim3(NTHREADS), LDS_BYTES, stream, p);
#ifndef PROBE_SPLITK_BASE
    (void)hipMemsetAsync((char*)d_ws + WS_CTL, 0, CTL_ZERO_BYTES, stream);
    p.lo = PROBE_SPLITK; p.hi = PROBE_SPLITK + 1; hipLaunchKernelGGL(mk_fwd, dim3(grid), dim3(NTHREADS), LDS_BYTES, stream, p);
#endif
    (void)hipMemsetAsync((char*)d_ws + WS_CTL, 0, CTL_ZERO_BYTES, stream);
    p.lo = PROBE_SPLITK + 1; p.hi = 13; hipLaunchKernelGGL(mk_fwd, dim3(grid), dim3(NTHREADS), LDS_BYTES, stream, p);
#else
    p.lo = 0; p.hi = 13; hipLaunchKernelGGL(mk_fwd, dim3(grid), dim3(NTHREADS), LDS_BYTES, stream, p);
#endif
#endif
#ifdef PROBE_EXP
    (void)hipMemsetAsync((char*)d_ws + WS_CTL, 0, CTL_ZERO_BYTES, stream);
    p.lo = 13; p.hi = 14; hipLaunchKernelGGL(mk_fwd, dim3(grid), dim3(NTHREADS), LDS_BYTES, stream, p);
#endif
#ifdef PROBE_RELAUNCH
    p.lo = PROBE_RELAUNCH; p.hi = PROBE_RELAUNCH + 1; hipLaunchKernelGGL(mk_fwd, dim3(grid), dim3(NTHREADS), LDS_BYTES, stream, p);
#endif
}
```

```cpp
#include <hip/hip_runtime.h>
#include <cstdio>
#include <cstdint>
namespace pg8 {
#define PG8_LAS __attribute__((address_space(3)))
typedef unsigned short bf16_t;
typedef short bf16x8 __attribute__((ext_vector_type(8)));
typedef float f32x4 __attribute__((ext_vector_type(4)));
typedef unsigned u32x4 __attribute__((ext_vector_type(4)));
constexpr int BM = 256, BK = 64, HALF = 128, HTB = HALF * BK * 2  , STAGE_BYTES = 8 * HTB, NXCD = 8, WGM = 8;

__host__ __device__ __forceinline__ int lds_byte(int r, int c) { const int st = (r >> 4) * 2 + (c >> 5), rr = r & 15, cc = c & 31, ob = rr * 64 + cc * 2; return st * 1024 + (ob ^ (((ob >> 9) & 1) << 5)); }
__host__ __device__ __forceinline__ void stage_rc(int b, int& R, int& C) { const int st = b / 1024, sb = b % 1024, swz = sb ^ (((sb >> 9) & 1) << 5); R = (st >> 1) * 16 + swz / 64; C = (st & 1) * 32 + (swz % 64) / 2; }
__host__ __device__ __forceinline__ int perm32(int rho) { const int n = rho >> 4, i = rho & 15; return 8 * (i >> 2) + 4 * n + (i & 3); }

struct Unit { int pm, pn; };
struct Gemm { const bf16_t* A; const bf16_t* Bt; int M, N, K; };

struct StaticOrder {
    int nM, nN, nwg, G, c;
    __host__ __device__ void init(int M, int N, int G_, int c_) { nM = M / BM; nN = N / BM; nwg = nM * nN; G = G_; c = c_; }
    __host__ __device__ bool next(int i, Unit& u) const {
        const long L = (long)i * G + c; if (L >= nwg) return false;
        int wgid = (int)L; { const int q = nwg / NXCD, r = nwg % NXCD, xcd = wgid % NXCD, off = wgid / NXCD; wgid = (xcd < r ? xcd * (q + 1) : r * (q + 1) + (xcd - r) * q) + off; }
        const int nig = WGM * nN, gid = wgid / nig, fm = gid * WGM, gsz = (nM - fm) < WGM ? (nM - fm) : WGM;
        u.pm = fm + ((wgid % nig) % gsz); u.pn = (wgid % nig) / gsz; return true;
    }
    __device__ __forceinline__ void a_ready(const Unit&) const {}
    __device__ __forceinline__ void done(const Unit&) const {}
};
__device__ __forceinline__ unsigned cvt_pk_bf16(float lo, float hi) { unsigned r; asm volatile("v_cvt_pk_bf16_f32 %0, %1, %2" : "=v"(r) : "v"(lo), "v"(hi)); return r; }
typedef float f32x2 __attribute__((ext_vector_type(2)));
__device__ __forceinline__ f32x2 gelu_pk(f32x2 v) {
    const f32x2 av = __builtin_elementwise_abs(v), d = av * 0.2316418882f + 1.0f;
    f32x2 t; t.x = __builtin_amdgcn_rcpf(d.x); t.y = __builtin_amdgcn_rcpf(d.y);
    f32x2 q = t * 0.5307027145f + (-0.7265760135f); q = q * t + 0.7107068705f; q = q * t + (-0.142248368f); q = q * t + 0.127414796f; q = q * t;
    const f32x2 s = (v * v) * (-0.72134752044f);
    f32x2 e; e.x = __builtin_amdgcn_exp2f(s.x); e.y = __builtin_amdgcn_exp2f(s.y);
    const f32x2 m = v * (q * e), r = v - m;
    f32x2 o; o.x = v.x < 0.f ? m.x : r.x; o.y = v.y < 0.f ? m.y : r.y; return o;
}
template <class Epi, class Sched, bool STAMP = false, bool FP8 = false, int XSCALE = 127>
__device__ __forceinline__ void gemm_phase(PG8_LAS unsigned char* lds, const Gemm g, const Sched& S, const Epi& E, unsigned long long* stamps) {
    int tid_l = threadIdx.x; asm volatile("" : "+v"(tid_l));
    const int tid = tid_l, wid = __builtin_amdgcn_readfirstlane(tid >> 6), lane = tid & 63, wr = wid >> 2, wc = wid & 3, fr = lane & 15, fq = lane >> 4;
    const int K = g.K, nt = K / BK;
    int ts_lo = 0, ts_hi = 0, nts = 0; const unsigned long long rt_entry = STAMP ? (unsigned long long)wall_clock64() : 0ull;
#define PG8_STAMP() do { if (STAMP && wid == 0 && nts < 64) { const unsigned long long _c = (unsigned long long)clock64(); \
        ts_lo = (lane == nts) ? (int)(unsigned)_c : ts_lo; ts_hi = (lane == nts) ? (int)(unsigned)(_c >> 32) : ts_hi; ++nts; } } while (0)
    PG8_STAMP();
    unsigned voffA[2], voffB[2];
#pragma unroll
    for (int i = 0; i < 2; ++i) { int R, C; stage_rc(tid * 16 + i * 8192, R, C); const int Rb = Epi::PERM ? ((R & ~31) + perm32(R & 31)) : R;
        voffA[i] = (unsigned)(R * K + C) * 2u; voffB[i] = (unsigned)(Rb * K + C) * 2u; }
    const size_t kstep = (size_t)(BK * 2);
    const size_t hstep = (size_t)HALF * K * 2;
    const size_t tstep = 2 * hstep;
    const unsigned ldsw = (unsigned)wid * 1024u;
    const int aoff = lds_byte(wr * 64 + fr, fq * 8), boff = lds_byte(wc * 32 + fr, fq * 8);
#define PG8_SA(b, h) (((b) * 2 + (h)) * HTB)
#define PG8_SB(b, h) ((4 + (b) * 2 + (h)) * HTB)
#define PG8_STAGE(bufoff, gbase, voff) do { _Pragma("unroll") for (int _i = 0; _i < 2; ++_i) \
        __builtin_amdgcn_global_load_lds((const unsigned*)((const char*)(gbase) + (voff)[_i]), (PG8_LAS unsigned*)(lds + (bufoff) + ldsw + _i * 8192), 16, 0, 0); } while (0)
#define PG8_LDA(dst, b, h) do { if constexpr (FP8) { _Pragma("unroll") for (int m = 0; m < 4; ++m) dst##8[m] = __builtin_shufflevector(*(const PG8_LAS i32x4_*)(lds + PG8_SA(b, h) + aoff + m * 2048), *(const PG8_LAS i32x4_*)(lds + PG8_SA(b, h) + aoff + m * 2048 + 1024), 0, 1, 2, 3, 4, 5, 6, 7); } \
        else { _Pragma("unroll") for (int m = 0; m < 4; ++m) _Pragma("unroll") for (int k = 0; k < 2; ++k) dst[m][k] = *(const PG8_LAS bf16x8*)(lds + PG8_SA(b, h) + aoff + m * 2048 + k * 1024); } } while (0)
#define PG8_LDB(dst, b, h) do { if constexpr (FP8) { _Pragma("unroll") for (int n = 0; n < 2; ++n) dst##8[n] = __builtin_shufflevector(*(const PG8_LAS i32x4_*)(lds + PG8_SB(b, h) + boff + n * 2048), *(const PG8_LAS i32x4_*)(lds + PG8_SB(b, h) + boff + n * 2048 + 1024), 0, 1, 2, 3, 4, 5, 6, 7); } \
        else { _Pragma("unroll") for (int n = 0; n < 2; ++n) _Pragma("unroll") for (int k = 0; k < 2; ++k) dst[n][k] = *(const PG8_LAS bf16x8*)(lds + PG8_SB(b, h) + boff + n * 2048 + k * 1024); } } while (0)
#define PG8_MMA(ai, bj, At, Bt) do { __builtin_amdgcn_s_setprio(1); _Pragma("unroll") for (int m = 0; m < 4; ++m) _Pragma("unroll") for (int n = 0; n < 2; ++n) { \
        if constexpr (FP8) asm volatile("v_mfma_scale_f32_16x16x128_f8f6f4 %0, %1, %2, %0, %3, %4 op_sel_hi:[0,0,0]" : "+v"(acc[ai][bj][m][n]) : "v"(Bt##8[n]), "v"(At##8[m]), "v"(scale_w), "v"(scale_x));        \
        else { _Pragma("unroll") for (int k = 0; k < 2; ++k) acc[ai][bj][m][n] = __builtin_amdgcn_mfma_f32_16x16x32_bf16(Bt[n][k], At[m][k], acc[ai][bj][m][n], 0, 0, 0); } } \
        __builtin_amdgcn_s_setprio(0); } while (0)
#define PG8_WAIT_V(n) asm volatile("s_waitcnt vmcnt(" #n ")" ::: "memory")
#define PG8_WAIT_L(n) asm volatile("s_waitcnt lgkmcnt(" #n ")" ::: "memory")
#define PG8_BAR __builtin_amdgcn_s_barrier()
#define PG8_SCHED __builtin_amdgcn_sched_barrier(0)
    Unit cur, nxt; int ui = 0;
    if (!S.next(0, cur)) return;
    f32x4 acc[2][2][4][2];
#pragma unroll
    for (int a = 0; a < 2; ++a)
#pragma unroll
        for (int b = 0; b < 2; ++b)
#pragma unroll
            for (int m = 0; m < 4; ++m)
#pragma unroll
                for (int n = 0; n < 2; ++n) acc[a][b][m][n] = (f32x4){0.f, 0.f, 0.f, 0.f};
    typedef int i32x4_ __attribute__((ext_vector_type(4))); typedef int i32x8_ __attribute__((ext_vector_type(8)));
    int scale_w = 122, scale_x = XSCALE; asm volatile("" : "+v"(scale_w), "+v"(scale_x));
    bf16x8 At[4][2], B0[2][2], B1[2][2]; i32x8_ At8[4], B08[2], B18[2];
    const char* cA = (const char*)g.A + (size_t)cur.pm * tstep; const char* cB = (const char*)g.Bt + (size_t)cur.pn * tstep;
    S.a_ready(cur);
    PG8_STAGE(PG8_SB(0, 0), cB, voffB); PG8_STAGE(PG8_SA(0, 0), cA, voffA); PG8_STAGE(PG8_SB(0, 1), cB + hstep, voffB); PG8_STAGE(PG8_SA(0, 1), cA + hstep, voffA);
    if (wr == 1) PG8_BAR;
    PG8_WAIT_V(4); PG8_BAR;
    PG8_STAGE(PG8_SB(1, 0), cB + kstep, voffB); PG8_STAGE(PG8_SA(1, 0), cA + kstep, voffA); PG8_STAGE(PG8_SB(1, 1), cB + hstep + kstep, voffB);
    PG8_WAIT_V(6); PG8_BAR;
    PG8_STAMP();
    for (;;) {
        const bool has_next = S.next(ui + 1, nxt);
        const char* nA = has_next ? (const char*)g.A + (size_t)nxt.pm * tstep : cA; const char* nB = has_next ? (const char*)g.Bt + (size_t)nxt.pn * tstep : cB;
        for (int t = 0; t < nt; t += 2) {
            const bool last = (t == nt - 2);
            const char* a1 = cA + (size_t)(t + 1) * kstep;
            const char* a2 = last ? nA : cA + (size_t)(t + 2) * kstep; const char* b2 = last ? nB : cB + (size_t)(t + 2) * kstep;
            const char* a3 = a2 + kstep; const char* b3 = b2 + kstep;
            if (last && has_next) S.a_ready(nxt);
            PG8_LDB(B0, 0, 0); PG8_SCHED; PG8_LDA(At, 0, 0); PG8_STAGE(PG8_SA(1, 1), a1 + hstep, voffA);
            PG8_WAIT_L(8); PG8_BAR; PG8_WAIT_L(0); PG8_MMA(0, 0, At, B0); PG8_BAR; PG8_SCHED;
            PG8_LDB(B1, 0, 1); PG8_STAGE(PG8_SB(0, 0), b2, voffB);
            PG8_BAR; PG8_WAIT_L(0); PG8_MMA(0, 1, At, B1); PG8_BAR;
            PG8_LDA(At, 0, 1); PG8_STAGE(PG8_SA(0, 0), a2, voffA);
            PG8_BAR; PG8_WAIT_L(0); PG8_MMA(1, 0, At, B0); PG8_BAR; PG8_SCHED;
            PG8_STAGE(PG8_SB(0, 1), b2 + hstep, voffB);
            PG8_WAIT_V(6); PG8_BAR; PG8_MMA(1, 1, At, B1); PG8_BAR;
            PG8_LDB(B0, 1, 0); PG8_SCHED; PG8_LDA(At, 1, 0); PG8_STAGE(PG8_SA(0, 1), a2 + hstep, voffA);
            PG8_WAIT_L(8); PG8_BAR; PG8_WAIT_L(0); PG8_MMA(0, 0, At, B0); PG8_BAR; PG8_SCHED;
            PG8_LDB(B1, 1, 1); PG8_STAGE(PG8_SB(1, 0), b3, voffB);
            PG8_BAR; PG8_WAIT_L(0); PG8_MMA(0, 1, At, B1); PG8_BAR;
            PG8_LDA(At, 1, 1); PG8_STAGE(PG8_SA(1, 0), a3, voffA);
            PG8_BAR; PG8_WAIT_L(0); PG8_MMA(1, 0, At, B0); PG8_BAR; PG8_SCHED;
            PG8_STAGE(PG8_SB(1, 1), b3 + hstep, voffB);
            PG8_WAIT_V(6); PG8_BAR; PG8_MMA(1, 1, At, B1); PG8_BAR;
        }
        PG8_STAMP();
        if constexpr (FP8) { asm volatile("s_nop 15\n\ts_nop 15" ::: "memory");
#pragma unroll
            for (int a = 0; a < 2; ++a)
#pragma unroll
                for (int b = 0; b < 2; ++b)
#pragma unroll
                    for (int m = 0; m < 4; ++m)
#pragma unroll
                        for (int n = 0; n < 2; ++n) asm volatile("" : "+v"(acc[a][b][m][n])); }
        if constexpr (!Epi::AFTER_DRAIN) { E(acc, cur, wr, wc, fr, fq); S.done(cur); }
        PG8_STAMP();
        if (!has_next) break;
#pragma unroll
        for (int a = 0; a < 2; ++a)
#pragma unroll
            for (int b = 0; b < 2; ++b)
#pragma unroll
                for (int m = 0; m < 4; ++m)
#pragma unroll
                    for (int n = 0; n < 2; ++n) acc[a][b][m][n] = (f32x4){0.f, 0.f, 0.f, 0.f};
        cur = nxt; cA = nA; cB = nB; ++ui;
    }
    PG8_WAIT_V(0);
    if (wr == 0) PG8_BAR;
    PG8_BAR;
    if constexpr (Epi::AFTER_DRAIN) { E.fused(acc, cur, wr, wc, fr, fq, lds, wid, lane); S.done(cur); }
    PG8_STAMP();
    if (STAMP && wid == 0) { stamps[lane] = lane < nts ? (((unsigned long long)(unsigned)ts_hi << 32) | (unsigned)ts_lo) : 0ull;
        if (lane == 62) stamps[62] = rt_entry; if (lane == 63) stamps[63] = (unsigned long long)wall_clock64(); }
#undef PG8_STAMP
#undef PG8_SA
#undef PG8_SB
#undef PG8_STAGE
#undef PG8_LDA
#undef PG8_LDB
#undef PG8_MMA
#undef PG8_WAIT_V
#undef PG8_WAIT_L
#undef PG8_BAR
#undef PG8_SCHED
}
}

namespace pg8 {
struct MergeArgs { const bf16_t* A[3]; const bf16_t* Bt[3]; int K[3]; const bf16_t* gates; unsigned char* mb; };
template <class Sched, bool FP8 = false>
__device__ __forceinline__ void gemm_phase_merge(PG8_LAS unsigned char* lds, const MergeArgs g, const Sched& S) {
    int tid_l = threadIdx.x; asm volatile("" : "+v"(tid_l));
    const int tid = tid_l, wid = __builtin_amdgcn_readfirstlane(tid >> 6), lane = tid & 63, wr = wid >> 2, wc = wid & 3, fr = lane & 15, fq = lane >> 4;
    unsigned R2A[2], R2B[2], C2[2];
#pragma unroll
    for (int i = 0; i < 2; ++i) { int R, C; stage_rc(tid * 16 + i * 8192, R, C); const int Rb = (R & ~31) + perm32(R & 31); R2A[i] = (unsigned)R * 2u; R2B[i] = (unsigned)Rb * 2u; C2[i] = (unsigned)C * 2u; }
    const size_t kstep = (size_t)(BK * 2);
    const unsigned ldsw = (unsigned)wid * 1024u;
    const int aoff = lds_byte(wr * 64 + fr, fq * 8), boff = lds_byte(wc * 32 + fr, fq * 8);
#define PG8_SA(b, h) (((b) * 2 + (h)) * HTB)
#define PG8_SB(b, h) ((4 + (b) * 2 + (h)) * HTB)
#define PG8_STAGEK(bufoff, gbase, R2, KK) do { _Pragma("unroll") for (int _i = 0; _i < 2; ++_i) \
        __builtin_amdgcn_global_load_lds((const unsigned*)((const char*)(gbase) + (R2)[_i] * (unsigned)(KK) + C2[_i]), (PG8_LAS unsigned*)(lds + (bufoff) + ldsw + _i * 8192), 16, 0, 0); } while (0)
#define PG8_LDA(dst, b, h) do { if constexpr (FP8) { _Pragma("unroll") for (int m = 0; m < 4; ++m) dst##8[m] = __builtin_shufflevector(*(const PG8_LAS i32x4_*)(lds + PG8_SA(b, h) + aoff + m * 2048), *(const PG8_LAS i32x4_*)(lds + PG8_SA(b, h) + aoff + m * 2048 + 1024), 0, 1, 2, 3, 4, 5, 6, 7); } \
        else { _Pragma("unroll") for (int m = 0; m < 4; ++m) _Pragma("unroll") for (int k = 0; k < 2; ++k) dst[m][k] = *(const PG8_LAS bf16x8*)(lds + PG8_SA(b, h) + aoff + m * 2048 + k * 1024); } } while (0)
#define PG8_LDB(dst, b, h) do { if constexpr (FP8) { _Pragma("unroll") for (int n = 0; n < 2; ++n) dst##8[n] = __builtin_shufflevector(*(const PG8_LAS i32x4_*)(lds + PG8_SB(b, h) + boff + n * 2048), *(const PG8_LAS i32x4_*)(lds + PG8_SB(b, h) + boff + n * 2048 + 1024), 0, 1, 2, 3, 4, 5, 6, 7); } \
        else { _Pragma("unroll") for (int n = 0; n < 2; ++n) _Pragma("unroll") for (int k = 0; k < 2; ++k) dst[n][k] = *(const PG8_LAS bf16x8*)(lds + PG8_SB(b, h) + boff + n * 2048 + k * 1024); } } while (0)
#define PG8_MMA(ai, bj, At, Bt) do { __builtin_amdgcn_s_setprio(1); _Pragma("unroll") for (int m = 0; m < 4; ++m) _Pragma("unroll") for (int n = 0; n < 2; ++n) { \
        if constexpr (FP8) asm volatile("v_mfma_scale_f32_16x16x128_f8f6f4 %0, %1, %2, %0, %3, %4 op_sel_hi:[0,0,0]" : "+v"(acc[ai][bj][m][n]) : "v"(Bt##8[n]), "v"(At##8[m]), "v"(scale_w), "v"(scale_x)); \
        else { _Pragma("unroll") for (int k = 0; k < 2; ++k) acc[ai][bj][m][n] = __builtin_amdgcn_mfma_f32_16x16x32_bf16(Bt[n][k], At[m][k], acc[ai][bj][m][n], 0, 0, 0); } } \
        __builtin_amdgcn_s_setprio(0); } while (0)
#define PG8_WAIT_V(n) asm volatile("s_waitcnt vmcnt(" #n ")" ::: "memory")
#define PG8_WAIT_L(n) asm volatile("s_waitcnt lgkmcnt(" #n ")" ::: "memory")
#define PG8_BAR __builtin_amdgcn_s_barrier()
#define PG8_SCHED __builtin_amdgcn_sched_barrier(0)
    Unit cur, nxt; int ui = 0, seg = 0;
    if (!S.next(0, cur)) return;
    f32x4 acc[2][2][4][2];
#pragma unroll
    for (int a = 0; a < 2; ++a)
#pragma unroll
        for (int b = 0; b < 2; ++b)
#pragma unroll
            for (int m = 0; m < 4; ++m)
#pragma unroll
                for (int n = 0; n < 2; ++n) acc[a][b][m][n] = (f32x4){0.f, 0.f, 0.f, 0.f};
    typedef int i32x4_ __attribute__((ext_vector_type(4))); typedef int i32x8_ __attribute__((ext_vector_type(8)));
    int scale_w = 122, scale_x = 123; asm volatile("" : "+v"(scale_w), "+v"(scale_x));
    bf16x8 At[4][2], B0[2][2], B1[2][2]; i32x8_ At8[4], B08[2], B18[2];
    int Kc = g.K[0];
    const char* cA = (const char*)g.A[0] + (size_t)cur.pm * 512 * Kc; const char* cB = (const char*)g.Bt[0] + (size_t)cur.pn * 512 * Kc;
    {   const size_t hs = (size_t)256 * Kc;
        PG8_STAGEK(PG8_SB(0, 0), cB, R2B, Kc); PG8_STAGEK(PG8_SA(0, 0), cA, R2A, Kc); PG8_STAGEK(PG8_SB(0, 1), cB + hs, R2B, Kc); PG8_STAGEK(PG8_SA(0, 1), cA + hs, R2A, Kc);
        if (wr == 1) PG8_BAR;
        PG8_WAIT_V(4); PG8_BAR;
        PG8_STAGEK(PG8_SB(1, 0), cB + kstep, R2B, Kc); PG8_STAGEK(PG8_SA(1, 0), cA + kstep, R2A, Kc); PG8_STAGEK(PG8_SB(1, 1), cB + hs + kstep, R2B, Kc);
        PG8_WAIT_V(6); PG8_BAR; }
    for (;;) {
        bool has_next_tile = false; int nseg = seg + 1; Unit nu = cur;
        if (nseg == 3) { nseg = 0; has_next_tile = S.next(ui + 1, nxt); nu = nxt; }
        const bool more = (seg < 2) || has_next_tile;
        const int Kn = more ? (nseg == 0 ? g.K[0] : (nseg == 1 ? g.K[1] : g.K[2])) : Kc;
        const bf16_t* gA = nseg == 0 ? g.A[0] : (nseg == 1 ? g.A[1] : g.A[2]); const bf16_t* gB = nseg == 0 ? g.Bt[0] : (nseg == 1 ? g.Bt[1] : g.Bt[2]);
        const char* nA = more ? (const char*)gA + (size_t)nu.pm * 512 * Kn : cA; const char* nB = more ? (const char*)gB + (size_t)nu.pn * 512 * Kn : cB;
        const int nt = Kc / BK; const size_t hsc = (size_t)256 * Kc, hsn = (size_t)256 * Kn;
        for (int t = 0; t < nt; t += 2) {
            const bool last = (t == nt - 2);
            const char* a1 = cA + (size_t)(t + 1) * kstep;
            const char* a2 = last ? nA : cA + (size_t)(t + 2) * kstep; const char* b2 = last ? nB : cB + (size_t)(t + 2) * kstep;
            const char* a3 = a2 + kstep; const char* b3 = b2 + kstep;
            const int K2 = last ? Kn : Kc; const size_t hs2 = last ? hsn : hsc;
            PG8_LDB(B0, 0, 0); PG8_SCHED; PG8_LDA(At, 0, 0); PG8_STAGEK(PG8_SA(1, 1), a1 + hsc, R2A, Kc);
            PG8_WAIT_L(8); PG8_BAR; PG8_WAIT_L(0); PG8_MMA(0, 0, At, B0); PG8_BAR; PG8_SCHED;
            PG8_LDB(B1, 0, 1); PG8_STAGEK(PG8_SB(0, 0), b2, R2B, K2);
            PG8_BAR; PG8_WAIT_L(0); PG8_MMA(0, 1, At, B1); PG8_BAR;
            PG8_LDA(At, 0, 1); PG8_STAGEK(PG8_SA(0, 0), a2, R2A, K2);
            PG8_BAR; PG8_WAIT_L(0); PG8_MMA(1, 0, At, B0); PG8_BAR; PG8_SCHED;
            PG8_STAGEK(PG8_SB(0, 1), b2 + hs2, R2B, K2);
            PG8_WAIT_V(6); PG8_BAR; PG8_MMA(1, 1, At, B1); PG8_BAR;
            PG8_LDB(B0, 1, 0); PG8_SCHED; PG8_LDA(At, 1, 0); PG8_STAGEK(PG8_SA(0, 1), a2 + hs2, R2A, K2);
            PG8_WAIT_L(8); PG8_BAR; PG8_WAIT_L(0); PG8_MMA(0, 0, At, B0); PG8_BAR; PG8_SCHED;
            PG8_LDB(B1, 1, 1); PG8_STAGEK(PG8_SB(1, 0), b3, R2B, K2);
            PG8_BAR; PG8_WAIT_L(0); PG8_MMA(0, 1, At, B1); PG8_BAR;
            PG8_LDA(At, 1, 1); PG8_STAGEK(PG8_SA(1, 0), a3, R2A, K2);
            PG8_BAR; PG8_WAIT_L(0); PG8_MMA(1, 0, At, B0); PG8_BAR; PG8_SCHED;
            PG8_STAGEK(PG8_SB(1, 1), b3 + hs2, R2B, K2);
            PG8_WAIT_V(6); PG8_BAR; PG8_MMA(1, 1, At, B1); PG8_BAR;
        }
        if constexpr (FP8) { asm volatile("s_nop 15\n\ts_nop 15" ::: "memory");
#pragma unroll
            for (int a = 0; a < 2; ++a)
#pragma unroll
                for (int b = 0; b < 2; ++b)
#pragma unroll
                    for (int mm = 0; mm < 4; ++mm)
#pragma unroll
                        for (int n = 0; n < 2; ++n) asm volatile("" : "+v"(acc[a][b][mm][n])); }
        {   const int row0 = cur.pm * 256 + wr * 64 + fr, col0 = cur.pn * 256 + wc * 32 + 8 * fq;
            const unsigned char* gb_s = (const unsigned char*)g.gates + ((size_t)(seg * 128 + cur.pm) * 4 + cur.pn) * 65536 + (size_t)tid * 16;
            const unsigned char* gb_n = gb_s + (size_t)128 * 4 * 65536;
            u32x4 GS[2][2], GN[2][2]; typedef float f32x2_m __attribute__((ext_vector_type(2)));
#define MRG_LOAD(buf, bt) do { _Pragma("unroll") for (int cp = 0; cp < 2; ++cp) { GS[buf][cp] = *(const u32x4*)(gb_s + (size_t)(((bt) * 2 + cp) * 512) * 16); \
                GN[buf][cp] = (seg < 2) ? *(const u32x4*)(gb_n + (size_t)(((bt) * 2 + cp) * 512) * 16) : (u32x4){0x38383838u, 0x38383838u, 0x38383838u, 0x38383838u}; } } while (0)
#define MRG_APPLY(buf, bt) do { _Pragma("unroll") for (int c = 0; c < 4; ++c) { const int idx = (bt) * 4 + c, ai = idx >> 3, m = (idx >> 1) & 3, bj = idx & 1; \
                const unsigned gs0 = bj ? GS[buf][c >> 1].z : GS[buf][c >> 1].x, gs1 = bj ? GS[buf][c >> 1].w : GS[buf][c >> 1].y, gn0 = bj ? GN[buf][c >> 1].z : GN[buf][c >> 1].x, gn1 = bj ? GN[buf][c >> 1].w : GN[buf][c >> 1].y; \
                const f32x2_m fa = __builtin_amdgcn_cvt_pk_f32_fp8((int)gs0, false), fb = __builtin_amdgcn_cvt_pk_f32_fp8((int)gs0, true), fc = __builtin_amdgcn_cvt_pk_f32_fp8((int)gs1, false), fd = __builtin_amdgcn_cvt_pk_f32_fp8((int)gs1, true); \
                const f32x2_m da = __builtin_amdgcn_cvt_pk_f32_fp8((int)gn0, false), db = __builtin_amdgcn_cvt_pk_f32_fp8((int)gn0, true), dc = __builtin_amdgcn_cvt_pk_f32_fp8((int)gn1, false), dd = __builtin_amdgcn_cvt_pk_f32_fp8((int)gn1, true); \
                float f[8] = {fa.x, fa.y, fb.x, fb.y, fc.x, fc.y, fd.x, fd.y}; const float d[8] = {da.x, da.y, db.x, db.y, dc.x, dc.y, dd.x, dd.y}; \
                _Pragma("unroll") for (int j = 0; j < 8; ++j) f[j] = d[j] * __builtin_amdgcn_rcpf(f[j]);        \
                f32x4 v0 = acc[ai][bj][m][0], v1 = acc[ai][bj][m][1]; \
                v0[0] *= f[0]; v0[1] *= f[1]; v0[2] *= f[2]; v0[3] *= f[3]; v1[0] *= f[4]; v1[1] *= f[5]; v1[2] *= f[6]; v1[3] *= f[7]; \
                if (seg < 2) { acc[ai][bj][m][0] = v0; acc[ai][bj][m][1] = v1; } \
                else { typedef unsigned u32x2_ __attribute__((ext_vector_type(2))); u32x2_ w; int t8 = 0; t8 = __builtin_amdgcn_cvt_pk_fp8_f32(v0[0] * 0.25f, v0[1] * 0.25f, t8, false); t8 = __builtin_amdgcn_cvt_pk_fp8_f32(v0[2] * 0.25f, v0[3] * 0.25f, t8, true); w.x = (unsigned)t8; \
                    t8 = 0; t8 = __builtin_amdgcn_cvt_pk_fp8_f32(v1[0] * 0.25f, v1[1] * 0.25f, t8, false); t8 = __builtin_amdgcn_cvt_pk_fp8_f32(v1[2] * 0.25f, v1[3] * 0.25f, t8, true); w.y = (unsigned)t8; \
                    *(u32x2_*)(g.mb + (size_t)(row0 + ai * 128 + m * 16) * 1024 + col0 + bj * 128) = w;        \
                    acc[ai][bj][m][0] = (f32x4){0.f, 0.f, 0.f, 0.f}; acc[ai][bj][m][1] = (f32x4){0.f, 0.f, 0.f, 0.f}; } } } while (0)
            MRG_LOAD(0, 0);
#pragma unroll
            for (int bt = 0; bt < 4; bt += 2) {
                MRG_LOAD(1, bt + 1); asm volatile("" ::: "memory"); MRG_APPLY(0, bt);
                if (bt + 2 < 4) { MRG_LOAD(0, bt + 2); } asm volatile("" ::: "memory"); MRG_APPLY(1, bt + 1); }
#undef MRG_LOAD
#undef MRG_APPLY
        }
        if (!more) break;
        if (nseg == 0) { cur = nxt; ++ui; }
        seg = nseg; Kc = Kn; cA = nA; cB = nB;
    }
    PG8_WAIT_V(0);
    if (wr == 0) PG8_BAR;
    PG8_BAR;
#undef PG8_SA
#undef PG8_SB
#undef PG8_STAGEK
#undef PG8_LDA
#undef PG8_LDB
#undef PG8_MMA
#undef PG8_WAIT_V
#undef PG8_WAIT_L
#undef PG8_BAR
#undef PG8_SCHED
}
}
#define XB_TMO      128
#define XB_XCNT(j)  (256  + 64 * (j))
#define XB_XSUB(j)  (1280 + 64 * (j))
#define XB_XGEN(j)  (2304 + 64 * (j))
#define XB_TOP      3328
#define XB_TOPGEN   3392
#define XCD_BAR_WORDS 3456
#define XB_SPIN_CAP (1u << 18)
#define LAS __attribute__((address_space(3)))

__device__ __forceinline__ unsigned xb_ld(unsigned* p)              { return __hip_atomic_load(p, __ATOMIC_RELAXED, __HIP_MEMORY_SCOPE_AGENT); }
__device__ __forceinline__ unsigned xb_add(unsigned* p, unsigned v) { return __hip_atomic_fetch_add(p, v, __ATOMIC_RELAXED, __HIP_MEMORY_SCOPE_AGENT); }
__device__ __forceinline__ unsigned xb_xcc_id() { return (unsigned)__builtin_amdgcn_s_getreg((3 << 11) | 20) & 0xFu; }
#define XB_SPIN(cond, bar) do { unsigned _sp = 0; while (cond) { __builtin_amdgcn_s_sleep(1); \
    if ((++_sp & 255u) == 0u) { if (xb_ld(&(bar)[XB_TMO])) break; if (_sp > XB_SPIN_CAP) { atomicAdd(&(bar)[XB_TMO], 1u); break; } } } } while (0)

struct XcdBarrier {
    unsigned* bar; unsigned x;
    volatile LAS unsigned* st;
};

__device__ __forceinline__ XcdBarrier xcd_barrier_post(unsigned* bar, volatile LAS unsigned* st) {
    XcdBarrier b; b.bar = bar; b.x = xb_xcc_id(); b.st = st;
    if (threadIdx.x == 0) (void)xb_add(&bar[XB_XCNT(b.x)], 1u);
    return b;
}
__device__ __forceinline__ void xcd_barrier_complete(unsigned* bar, unsigned x, unsigned& nloc, unsigned& nx) {
    const unsigned G = gridDim.x * gridDim.y * gridDim.z;
    unsigned sum, cnt, mine, sp = 0u;
    for (;;) {
        sum = 0u; cnt = 0u; mine = 0u;
#pragma unroll
        for (unsigned j = 0; j < 16; ++j) { const unsigned c = xb_ld(&bar[XB_XCNT(j)]); sum += c; cnt += (c > 0u) ? 1u : 0u; mine = (j == x) ? c : mine; }
        if (sum == G) break;
        __builtin_amdgcn_s_sleep(1);
        if ((++sp & 255u) == 0u) { if (xb_ld(&bar[XB_TMO])) break; if (sp > XB_SPIN_CAP) { atomicAdd(&bar[XB_TMO], 1u); break; } }
    }
    nloc = mine > 0u ? mine : 1u; nx = cnt > 0u ? cnt : 1u;
}

__device__ __forceinline__ void xcd_barrier(const XcdBarrier& b) {
    asm volatile("s_waitcnt vmcnt(0)" ::: "memory");
    __syncthreads();
    if (threadIdx.x == 0) {
        unsigned* bar = b.bar;
        __builtin_amdgcn_s_waitcnt(0);
        unsigned nloc = b.st[0], nx = b.st[1];
        if (nloc == 0u) { xcd_barrier_complete(bar, b.x, nloc, nx); b.st[0] = nloc; b.st[1] = nx; }
        const unsigned old = xb_add(&bar[XB_XSUB(b.x)], 1u);
        const unsigned gen = old / nloc;
        if (old + 1u == (gen + 1u) * nloc) {
            __builtin_amdgcn_fence(__ATOMIC_RELEASE, "agent");
            asm volatile("s_waitcnt vmcnt(0)" ::: "memory");
            const unsigned og = xb_add(&bar[XB_TOP], 1u);
            const unsigned tg = og / nx;
            if (og + 1u == (tg + 1u) * nx) xb_add(&bar[XB_TOPGEN], 1u);
            else XB_SPIN(xb_ld(&bar[XB_TOPGEN]) == tg, bar);
            __builtin_amdgcn_fence(__ATOMIC_ACQUIRE, "agent");
            xb_add(&bar[XB_XGEN(b.x)], 1u);
            asm volatile("s_waitcnt vmcnt(0)" ::: "memory");
        } else {
            XB_SPIN(xb_ld(&bar[XB_XGEN(b.x)]) == gen, bar);
            __builtin_amdgcn_fence(__ATOMIC_ACQUIRE, "agent");
            asm volatile("s_waitcnt vmcnt(0)" ::: "memory");
        }
    }
    __syncthreads();
}


typedef unsigned short bf16_t;
typedef float f32x4 __attribute__((ext_vector_type(4)));
typedef unsigned u32x4 __attribute__((ext_vector_type(4)));
typedef unsigned u32x2 __attribute__((ext_vector_type(2)));
typedef __bf16 bf16x2_t __attribute__((ext_vector_type(2)));
constexpr int D = 1024, BATCH = 8, SEQ = 4096, T = BATCH * SEQ, MEMLEN = 256;
constexpr int HQW = 3584, GW = 3072, INW = 6656, NEXP = 16384;
constexpr int C_AQ = 0, C_AK = 768, C_AV = 1536, C_BQ = 2304, C_BK = 2816, C_BV = 2944, C_CQ = 3072;
constexpr float ALPHA = 1.189207115002721f, LOG2E = 1.4426950408889634f, LN2F = 0.6931471805599453f, LN_EPS = 1e-5f, NEGBIG = -1e30f;
constexpr size_t MiB = 1u << 20;
#ifndef DBG_CHECK
#define DBG_CHECK 0
#endif
#ifndef DBG_DROP
#define DBG_DROP 0
#endif
constexpr size_t WS_CTL = 0, WS_WMEMKV = 1 * MiB, WS_WA = 3 * MiB, WS_WB = WS_WA + MiB / 2, WS_WC = WS_WB + MiB, WS_WOUT = WS_WC + MiB, WS_WQ = WS_WOUT + 2 * MiB,
                 WS_SUBK = WS_WQ + 2 * MiB, WS_MEMB = 10 * MiB, WS_KVM = 14 * MiB, WS_STATS = 18 * MiB, WS_LSE = 19 * MiB;
constexpr size_t WS_RA = 24 * MiB, WS_RB = 248 * MiB, WS_RC = 440 * MiB, WS_END = 504 * MiB;
constexpr size_t WS_HQ = WS_RA, WS_GATES = WS_RB, WS_XB = WS_RC;
constexpr size_t WS_MF = WS_RA, WS_MB = WS_RA + 128 * MiB;
constexpr size_t WS_Z = WS_RB, WS_X1B = WS_RB + 128 * MiB;
constexpr size_t WS_Q = WS_RA, WS_EIDX = WS_RA + 88 * MiB - 24 * MiB, WS_GATE = WS_EIDX + 16 * MiB;
constexpr size_t WS_UB = WS_RC, WS_VB = WS_RC + 32 * MiB;
constexpr size_t DO_WINT = 0;
constexpr size_t DO_OA = 0, DO_YB = 48 * MiB, DO_YC = 80 * MiB, DO_YA = 112 * MiB;

__device__ __forceinline__ size_t hq_off64(int slot, size_t tok) { return ((size_t)slot * T + tok) * 64; }
__device__ __forceinline__ size_t hq_offc(int head, size_t tok) { return (size_t)48 * T * 64 + ((size_t)head * T + tok) * 128; }
__device__ const unsigned char kBucket[3][132] = {
{0,1,2,3,4,5,6,7,8,9,10,11,12,13,14,15,16,16,16,16,16,16,17,17,17,17,17,17,17,17,18,18,18,18,18,18,18,18,18,18,19,19,19,19,19,19,19,19,19,19,19,19,19,19,20,20,20,20,20,20,20,20,20,20,20,20,20,20,20,20,20,20,20,21,21,21,21,21,21,21,21,21,21,21,21,21,21,21,21,21,21,21,21,21,21,21,21,21,21,22,22,22,22,22,22,22,22,22,22,22,22,22,22,22,22,22,22,22,22,22,22,22,22,22,22,22,22,22,22,22,22,22},
{0,4,8,12,16,16,17,17,18,18,19,19,19,19,20,20,20,20,20,21,21,21,21,21,21,22,22,22,22,22,22,22,22,22,23,23,23,23,23,23,23,23,23,23,23,23,24,24,24,24,24,24,24,24,24,24,24,24,24,24,24,24,25,25,25,25,25,25,25,25,25,25,25,25,25,25,25,25,25,25,25,25,25,26,26,26,26,26,26,26,26,26,26,26,26,26,26,26,26,26,26,26,26,26,26,26,26,26,26,26,26,26,26,27,27,27,27,27,27,27,27,27,27,27,27,27,27,27,27,27,27,27},
{0,16,18,19,20,21,21,22,22,23,23,23,24,24,24,24,25,25,25,25,25,26,26,26,26,26,26,26,26,27,27,27,27,27,27,27,27,27,27,28,28,28,28,28,28,28,28,28,28,28,28,28,29,29,29,29,29,29,29,29,29,29,29,29,29,29,29,29,29,29,30,30,30,30,30,30,30,30,30,30,30,30,30,30,30,30,30,30,30,30,30,30,30,30,30,31,31,31,31,31,31,31,31,31,31,31,31,31,31,31,31,31,31,31,31,31,31,31,31,31,31,31,31,31,31,31,31,31,31,31,31,31}};

__device__ __forceinline__ bf16_t f2bf(float x) { unsigned u = __float_as_uint(x); u += 0x7fffu + ((u >> 16) & 1u); return (bf16_t)(u >> 16); }
__device__ __forceinline__ float bf2f(bf16_t h) { return __uint_as_float((unsigned)h << 16); }
__device__ __forceinline__ float bflo(unsigned w) { return __uint_as_float(w << 16); }
__device__ __forceinline__ float bfhi(unsigned w) { return __uint_as_float(w & 0xffff0000u); }
__device__ __forceinline__ unsigned pk2(float lo, float hi) { bf16x2_t v; v.x = (__bf16)lo; v.y = (__bf16)hi; return __builtin_bit_cast(unsigned, v); }
__device__ __forceinline__ float dot2bf(unsigned a, unsigned b, float acc) { return __builtin_amdgcn_fdot2_f32_bf16(__builtin_bit_cast(bf16x2_t, a), __builtin_bit_cast(bf16x2_t, b), acc, false); }
__device__ __forceinline__ float wave_sum(float v) { for (int o = 32; o >= 1; o >>= 1) v += __shfl_xor(v, o, 64); return v; }
__device__ __forceinline__ float wave_max(float v) { for (int o = 32; o >= 1; o >>= 1) v = fmaxf(v, __shfl_xor(v, o, 64)); return v; }

struct EpiIn {
    static constexpr bool PERM = true, AFTER_DRAIN = false;
    bf16_t* hq; bf16_t* gates; const float* bgate;
    __device__ __forceinline__ void operator()(const pg8::f32x4 (&acc)[2][2][4][2], const pg8::Unit& u, int wr, int wc, int fr, int fq) const {
        const int row0 = u.pm * 256 + wr * 64 + fr;
        if (u.pn < 14) {
            const float sc = (u.pn < 3 || u.pn == 9 || u.pn == 10) ? 0.125f * LOG2E : ((u.pn >= 12) ? 0.08838834764831845f * LOG2E : 1.0f);
            const int col0 = u.pn * 256 + wc * 32 + 8 * fq;
#pragma unroll
            for (int ai = 0; ai < 2; ++ai)
#pragma unroll
                for (int m = 0; m < 4; ++m) { const size_t tok = (size_t)(row0 + ai * 128 + m * 16);
#pragma unroll
                    for (int bj = 0; bj < 2; ++bj) { const pg8::f32x4 v0 = acc[ai][bj][m][0] * sc, v1 = acc[ai][bj][m][1] * sc; const int col = col0 + bj * 128;
                        u32x4 w; w.x = pk2(v0[0], v0[1]); w.y = pk2(v0[2], v0[3]); w.z = pk2(v1[0], v1[1]); w.w = pk2(v1[2], v1[3]);
                        bf16_t* dst = (col < 3072) ? hq + hq_off64(col >> 6, tok) + (col & 63) : hq + hq_offc((col - 3072) >> 7, tok) + ((col - 3072) & 127);
                        *(u32x4*)dst = w; } }
        } else {
            const int gi = u.pn - 14, s = gi >> 2, pn = gi & 3, col0 = gi * 256 + wc * 32 + 8 * fq, tid = (wr * 4 + wc) * 64 + fq * 16 + fr;
            unsigned char* blk = (unsigned char*)gates + ((size_t)(s * 128 + u.pm) * 4 + pn) * 65536 + (size_t)tid * 16;
            pg8::f32x4 bv[2][2];
#pragma unroll
            for (int bj = 0; bj < 2; ++bj)
#pragma unroll
                for (int n = 0; n < 2; ++n) bv[bj][n] = *(const pg8::f32x4*)(bgate + col0 + bj * 128 + 4 * n) * (-LOG2E);
#pragma unroll
            for (int ai = 0; ai < 2; ++ai)
#pragma unroll
                for (int m = 0; m < 4; ++m) { u32x4 w;
#pragma unroll
                    for (int bj = 0; bj < 2; ++bj) { pg8::f32x4 v0 = acc[ai][bj][m][0] * (-LOG2E) + bv[bj][0], v1 = acc[ai][bj][m][1] * (-LOG2E) + bv[bj][1];
#pragma unroll
                        for (int j = 0; j < 4; ++j) { v0[j] = fminf(__builtin_amdgcn_exp2f(v0[j]), 16384.0f) * 0.015625f + 0.015625f; v1[j] = fminf(__builtin_amdgcn_exp2f(v1[j]), 16384.0f) * 0.015625f + 0.015625f; }
                        int t8 = 0; t8 = __builtin_amdgcn_cvt_pk_fp8_f32(v0[0], v0[1], t8, false); t8 = __builtin_amdgcn_cvt_pk_fp8_f32(v0[2], v0[3], t8, true); w[2 * bj] = (unsigned)t8;
                        t8 = 0; t8 = __builtin_amdgcn_cvt_pk_fp8_f32(v1[0], v1[1], t8, false); t8 = __builtin_amdgcn_cvt_pk_fp8_f32(v1[2], v1[3], t8, true); w[2 * bj + 1] = (unsigned)t8; }
                    *(u32x4*)(blk + (size_t)((ai * 4 + m) * 512) * 16) = w; }
        }
    }
};
struct EpiPlain {
    static constexpr bool PERM = true, AFTER_DRAIN = false;
    bf16_t* O; int ldc;
    __device__ __forceinline__ void operator()(const pg8::f32x4 (&acc)[2][2][4][2], const pg8::Unit& u, int wr, int wc, int fr, int fq) const {
        const int row0 = u.pm * 256 + wr * 64 + fr, col0 = u.pn * 256 + wc * 32 + 8 * fq;
#pragma unroll
        for (int ai = 0; ai < 2; ++ai)
#pragma unroll
            for (int m = 0; m < 4; ++m) { bf16_t* rowp = O + (size_t)(row0 + ai * 128 + m * 16) * ldc + col0;
#pragma unroll
                for (int bj = 0; bj < 2; ++bj) { const pg8::f32x4 v0 = acc[ai][bj][m][0], v1 = acc[ai][bj][m][1];
                    u32x4 w; w.x = pk2(v0[0], v0[1]); w.y = pk2(v0[2], v0[3]); w.z = pk2(v1[0], v1[1]); w.w = pk2(v1[2], v1[3]);
                    *(u32x4*)(rowp + bj * 128) = w; } }
    }
};
struct EpiOut {
    static constexpr bool PERM = true, AFTER_DRAIN = false;
    const float* x; bf16_t* z; float* stats;
    __device__ __forceinline__ void operator()(const pg8::f32x4 (&acc)[2][2][4][2], const pg8::Unit& u, int wr, int wc, int fr, int fq) const {
        const int row0 = u.pm * 256 + wr * 64 + fr, col0 = u.pn * 256 + wc * 32 + 8 * fq;
#pragma unroll
        for (int ai = 0; ai < 2; ++ai)
#pragma unroll
            for (int m = 0; m < 4; ++m) { const size_t row = (size_t)(row0 + ai * 128 + m * 16); float s = 0.f, ss = 0.f;
#pragma unroll
                for (int bj = 0; bj < 2; ++bj) { const size_t o = row * D + col0 + bj * 128;
                    pg8::f32x4 v0 = *(const pg8::f32x4*)(x + o) * ALPHA + acc[ai][bj][m][0], v1 = *(const pg8::f32x4*)(x + o + 4) * ALPHA + acc[ai][bj][m][1];
                    { u32x4 w; w.x = pk2(v0[0], v0[1]); w.y = pk2(v0[2], v0[3]); w.z = pk2(v1[0], v1[1]); w.w = pk2(v1[2], v1[3]); *(u32x4*)(z + o) = w; }
#pragma unroll
                    for (int j = 0; j < 4; ++j) { s += v0[j] + v1[j]; ss += v0[j] * v0[j] + v1[j] * v1[j]; } }
                s += __shfl_xor(s, 16, 64); ss += __shfl_xor(ss, 16, 64); s += __shfl_xor(s, 32, 64); ss += __shfl_xor(ss, 32, 64);
                if (fq == 0) { atomicAdd(stats + row * 2, s); atomicAdd(stats + row * 2 + 1, ss); } }
    }
};

__device__ __forceinline__ void t_mix(size_t i, const bf16_t* __restrict__ oA, const float* __restrict__ lseA, bf16_t* __restrict__ ya) {
    const size_t t = i >> 5; const int col = (int)(i & 31) * 8, h = col >> 6; const size_t e = t * 256 + col;
    const float l0 = lseA[((size_t)0 * T + t) * 4 + h], l1 = lseA[((size_t)1 * T + t) * 4 + h], l2 = lseA[((size_t)2 * T + t) * 4 + h];
    const u32x4 a = *(const u32x4*)(oA + e), b = *(const u32x4*)(oA + (size_t)T * 256 + e), c = *(const u32x4*)(oA + (size_t)2 * T * 256 + e);
    const float mx = fmaxf(l0, fmaxf(l1, l2)), e0 = __expf(l0 - mx), e1 = __expf(l1 - mx), e2 = __expf(l2 - mx), inv = 1.f / (e0 + e1 + e2); float w0 = e0 * inv, w1 = e1 * inv, w2 = e2 * inv;
    w0 *= 16.f; w1 *= 16.f; w2 *= 16.f;
    u32x2 o; int t8 = 0;
    t8 = __builtin_amdgcn_cvt_pk_fp8_f32(w0 * bflo(a.x) + w1 * bflo(b.x) + w2 * bflo(c.x), w0 * bfhi(a.x) + w1 * bfhi(b.x) + w2 * bfhi(c.x), t8, false); t8 = __builtin_amdgcn_cvt_pk_fp8_f32(w0 * bflo(a.y) + w1 * bflo(b.y) + w2 * bflo(c.y), w0 * bfhi(a.y) + w1 * bfhi(b.y) + w2 * bfhi(c.y), t8, true); o.x = (unsigned)t8;
    t8 = 0; t8 = __builtin_amdgcn_cvt_pk_fp8_f32(w0 * bflo(a.z) + w1 * bflo(b.z) + w2 * bflo(c.z), w0 * bfhi(a.z) + w1 * bfhi(b.z) + w2 * bfhi(c.z), t8, false); t8 = __builtin_amdgcn_cvt_pk_fp8_f32(w0 * bflo(a.w) + w1 * bflo(b.w) + w2 * bflo(c.w), w0 * bfhi(a.w) + w1 * bfhi(b.w) + w2 * bfhi(c.w), t8, true); o.y = (unsigned)t8;
    *(u32x2*)((unsigned char*)ya + e) = o;
}
template <int NT>
__device__ __forceinline__ void t_res_ln1(size_t t0, size_t tstride, const float* __restrict__ x, const bf16_t* __restrict__ mo, const float* g, const float* b, bf16_t* __restrict__ x1b) {
    const int lane = threadIdx.x & 63, c = 16 * lane;
    f32x4 xv[NT][4]; u32x4 mv[NT][2];
#pragma unroll
    for (int k = 0; k < NT; ++k) { const size_t t = t0 + k * tstride;
#pragma unroll
        for (int q = 0; q < 4; ++q) xv[k][q] = *(const f32x4*)(x + t * D + c + 4 * q);
        mv[k][0] = *(const u32x4*)(mo + t * D + c); mv[k][1] = *(const u32x4*)(mo + t * D + c + 8); }
    f32x4 gg[4], bb[4];
#pragma unroll
    for (int q = 0; q < 4; ++q) { gg[q] = *(const f32x4*)(g + c + 4 * q); bb[q] = *(const f32x4*)(b + c + 4 * q); }
#pragma unroll
    for (int k = 0; k < NT; ++k) { const size_t t = t0 + k * tstride;
        const float mm[16] = {bflo(mv[k][0].x), bfhi(mv[k][0].x), bflo(mv[k][0].y), bfhi(mv[k][0].y), bflo(mv[k][0].z), bfhi(mv[k][0].z), bflo(mv[k][0].w), bfhi(mv[k][0].w),
                              bflo(mv[k][1].x), bfhi(mv[k][1].x), bflo(mv[k][1].y), bfhi(mv[k][1].y), bflo(mv[k][1].z), bfhi(mv[k][1].z), bflo(mv[k][1].w), bfhi(mv[k][1].w)};
        float zz[16]; float s = 0.f;
#pragma unroll
        for (int i = 0; i < 16; ++i) { zz[i] = ALPHA * xv[k][i >> 2][i & 3] + mm[i]; s += zz[i]; }
        const float mean = wave_sum(s) * (1.f / D); float ss = 0.f;
#pragma unroll
        for (int i = 0; i < 16; ++i) { const float d = zz[i] - mean; ss += d * d; }
        const float rstd = rsqrtf(wave_sum(ss) * (1.f / D) + LN_EPS);
        float y[16];
#pragma unroll
        for (int i = 0; i < 16; ++i) y[i] = (zz[i] - mean) * rstd * gg[i >> 2][i & 3] + bb[i >> 2][i & 3];
        u32x4 w0, w1; w0.x = pk2(y[0], y[1]); w0.y = pk2(y[2], y[3]); w0.z = pk2(y[4], y[5]); w0.w = pk2(y[6], y[7]); w1.x = pk2(y[8], y[9]); w1.y = pk2(y[10], y[11]); w1.z = pk2(y[12], y[13]); w1.w = pk2(y[14], y[15]);
        *(u32x4*)(x1b + t * D + c) = w0; *(u32x4*)(x1b + t * D + c + 8) = w1; }
}
typedef float f32x2 __attribute__((ext_vector_type(2)));
__device__ __forceinline__ void cvt_row_fp8_finish(const f32x4 a, const f32x4 b, const f32x4 c, const f32x4 d, unsigned char* __restrict__ dst, float* __restrict__ inv_scale, int row, int lane) {
    float mx = 0.f;
#pragma unroll
    for (int j = 0; j < 4; ++j) mx = fmaxf(mx, fmaxf(fmaxf(fabsf(a[j]), fabsf(b[j])), fmaxf(fabsf(c[j]), fabsf(d[j]))));
    mx = wave_max(mx);
    const unsigned E = (__float_as_uint(mx) >> 23) & 255u;
    const float sc = (E == 0u || E > 250u) ? 1.0f : __uint_as_float((260u - E) << 23), isc = (E == 0u || E > 250u) ? 1.0f : __uint_as_float((E - 6u) << 23);
    u32x4 w; int t;
    t = 0; t = __builtin_amdgcn_cvt_pk_fp8_f32(a[0] * sc, a[1] * sc, t, false); t = __builtin_amdgcn_cvt_pk_fp8_f32(a[2] * sc, a[3] * sc, t, true); w.x = (unsigned)t;
    t = 0; t = __builtin_amdgcn_cvt_pk_fp8_f32(b[0] * sc, b[1] * sc, t, false); t = __builtin_amdgcn_cvt_pk_fp8_f32(b[2] * sc, b[3] * sc, t, true); w.y = (unsigned)t;
    t = 0; t = __builtin_amdgcn_cvt_pk_fp8_f32(c[0] * sc, c[1] * sc, t, false); t = __builtin_amdgcn_cvt_pk_fp8_f32(c[2] * sc, c[3] * sc, t, true); w.z = (unsigned)t;
    t = 0; t = __builtin_amdgcn_cvt_pk_fp8_f32(d[0] * sc, d[1] * sc, t, false); t = __builtin_amdgcn_cvt_pk_fp8_f32(d[2] * sc, d[3] * sc, t, true); w.w = (unsigned)t;
    *(u32x4*)(dst + (size_t)row * D + 16 * lane) = w;
    if (lane == 0) inv_scale[row] = isc;
}
__device__ __forceinline__ void cvt_rows_fp8(const float* __restrict__ pu, const float* __restrict__ pv, unsigned char* __restrict__ ub8, unsigned char* __restrict__ vb8, float* __restrict__ usc, float* __restrict__ vsc, int r0, int r1) {
    const int lane = threadIdx.x & 63;
    const float* s0 = pu + (size_t)r0 * D + 16 * lane; const float* s1 = pv + (size_t)r0 * D + 16 * lane; const float* s2 = pu + (size_t)r1 * D + 16 * lane; const float* s3 = pv + (size_t)r1 * D + 16 * lane;
    f32x4 q[4][4];
#pragma unroll
    for (int j = 0; j < 4; ++j) { q[0][j] = ((const f32x4*)s0)[j]; q[1][j] = ((const f32x4*)s1)[j]; q[2][j] = ((const f32x4*)s2)[j]; q[3][j] = ((const f32x4*)s3)[j]; }
    cvt_row_fp8_finish(q[0][0], q[0][1], q[0][2], q[0][3], ub8, usc, r0, lane); cvt_row_fp8_finish(q[1][0], q[1][1], q[1][2], q[1][3], vb8, vsc, r0, lane);
    cvt_row_fp8_finish(q[2][0], q[2][1], q[2][2], q[2][3], ub8, usc, r1, lane); cvt_row_fp8_finish(q[3][0], q[3][1], q[3][2], q[3][3], vb8, vsc, r1, lane);
}
__device__ __forceinline__ float xsel_add(float keep_lo, float keep_hi, bool hi, int mask) {
    const float send = hi ? keep_lo : keep_hi, keep = hi ? keep_hi : keep_lo; return keep + __shfl_xor(send, mask, 64);
}

typedef short s16x4 __attribute__((ext_vector_type(4)));
constexpr int NTHREADS_ = 512;
#define ATT_M0 (-30000.0f)
__device__ __forceinline__ float red_max_16_32(float x) { typedef unsigned u2_ __attribute__((ext_vector_type(2)));
    u2_ r = __builtin_amdgcn_permlane16_swap(__float_as_uint(x), __float_as_uint(x), false, false); x = fmaxf(__uint_as_float(r.x), __uint_as_float(r.y));
    r = __builtin_amdgcn_permlane32_swap(__float_as_uint(x), __float_as_uint(x), false, false); return fmaxf(__uint_as_float(r.x), __uint_as_float(r.y)); }
__device__ __forceinline__ float red_sum_16_32(float x) { typedef unsigned u2_ __attribute__((ext_vector_type(2)));
    u2_ r = __builtin_amdgcn_permlane16_swap(__float_as_uint(x), __float_as_uint(x), false, false); x = __uint_as_float(r.x) + __uint_as_float(r.y);
    r = __builtin_amdgcn_permlane32_swap(__float_as_uint(x), __float_as_uint(x), false, false); return __uint_as_float(r.x) + __uint_as_float(r.y); }
template <int DH, int PITCH, class MaskF>
__device__ __forceinline__ void attn_step(const pg8::bf16x8 (&qf)[DH / 32], LAS unsigned char* kl, LAS unsigned char* vl, int t0, int t1, const MaskF& mf, float& m, float& l, f32x4 (&oT)[DH / 16]) {
    const int lane = threadIdx.x & 63, r16 = lane & 15, kq = lane >> 4;
    f32x4 s0 = {0.f, 0.f, 0.f, 0.f}, s1 = {0.f, 0.f, 0.f, 0.f};
    LAS unsigned char* ka0 = kl + (16 * t0 + r16) * PITCH + 16 * kq; LAS unsigned char* ka1 = kl + (16 * t1 + r16) * PITCH + 16 * kq;
#pragma unroll
    for (int s = 0; s < DH / 32; ++s) { const pg8::bf16x8 a0 = *(const LAS pg8::bf16x8*)(ka0 + 64 * s), a1 = *(const LAS pg8::bf16x8*)(ka1 + 64 * s);
        s0 = __builtin_amdgcn_mfma_f32_16x16x32_bf16(a0, qf[s], s0, 0, 0, 0); s1 = __builtin_amdgcn_mfma_f32_16x16x32_bf16(a1, qf[s], s1, 0, 0, 0); }
    float mx = -1e30f;
#pragma unroll
    for (int j = 0; j < 4; ++j) { s0[j] = mf(t0, 4 * kq + j, s0[j]); s1[j] = mf(t1, 4 * kq + j, s1[j]); mx = fmaxf(mx, fmaxf(s0[j], s1[j])); }
    mx = red_max_16_32(mx);
    const float mn = fmaxf(m, mx), sc = __builtin_amdgcn_exp2f(m - mn);
    float rs = 0.f;
#pragma unroll
    for (int j = 0; j < 4; ++j) { s0[j] = __builtin_amdgcn_exp2f(s0[j] - mn); s1[j] = __builtin_amdgcn_exp2f(s1[j] - mn); rs += s0[j] + s1[j]; }
    rs = red_sum_16_32(rs);
    l = l * sc + rs; m = mn;
    u32x4 pw; pw.x = pk2(s0[0], s0[1]); pw.y = pk2(s0[2], s0[3]); pw.z = pk2(s1[0], s1[1]); pw.w = pk2(s1[2], s1[3]);
    const pg8::bf16x8 pb = __builtin_bit_cast(pg8::bf16x8, pw);
    const int q = r16 >> 2, p = r16 & 3;
    LAS unsigned char* va0 = vl + (16 * t0 + 4 * kq + q) * PITCH + 8 * p; LAS unsigned char* va1 = vl + (16 * t1 + 4 * kq + q) * PITCH + 8 * p;
#pragma unroll
    for (int dt = 0; dt < DH / 16; ++dt) {
        const s16x4 lo = __builtin_amdgcn_ds_read_tr16_b64_v4i16((LAS s16x4*)(va0 + 32 * dt)), hi = __builtin_amdgcn_ds_read_tr16_b64_v4i16((LAS s16x4*)(va1 + 32 * dt));
        const pg8::bf16x8 va = __builtin_shufflevector(lo, hi, 0, 1, 2, 3, 4, 5, 6, 7);
        oT[dt] = oT[dt] * sc; oT[dt] = __builtin_amdgcn_mfma_f32_16x16x32_bf16(va, pb, oT[dt], 0, 0, 0); }
}
__device__ __forceinline__ void lds_put16(LAS unsigned char* dst, const bf16_t* src) { *(LAS u32x4*)dst = src ? *(const u32x4*)src : (u32x4){0u, 0u, 0u, 0u}; }

constexpr int ATT_KV64 = 272 * 160;
__device__ __forceinline__ void attnA_fetch(int u, int tid, u32x4 (&pfc)[8], float& tabv, const bf16_t* __restrict__ hq, const float* __restrict__ relb) {
    asm volatile("" : "+v"(tid));
    const int h = u & 3, rn = (u >> 2) & 31, b = (u >> 7) & 7, g = u >> 10;
    const int r = (g == 0) ? 1 : (g == 1 ? 4 : 16), nblk = 32 / r, rho = rn / nblk, n = rn % nblk, tb = b * SEQ;
    const bf16_t* kcol = hq + hq_off64(12 + g * 4 + h, 0); const bf16_t* vcol = hq + hq_off64(24 + g * 4 + h, 0);
#pragma unroll
    for (int i = 0; i < 8; ++i) { const int idx = tid + NTHREADS_ * i, isv = idx >> 11, i2 = idx & 2047, row = i2 >> 3, ch = i2 & 7, pos = (n - 1) * 128 + row;
        pfc[i] = (pos >= 0) ? *(const u32x4*)((isv ? vcol : kcol) + (size_t)(tb + rho + r * pos) * 64 + ch * 8) : (u32x4){0u, 0u, 0u, 0u}; }
    tabv = (tid < 129) ? relb[kBucket[g][tid] * 20 + g * 4 + h] * LOG2E : 0.f;
}
__device__ __forceinline__ void attnAB_store(int tid, const u32x4 (&pfc)[8], float tabv, LAS unsigned char* lds, int ntab) {
    asm volatile("" : "+v"(tid));
    LAS unsigned char* kl = lds; LAS unsigned char* vl = lds + ATT_KV64; LAS float* tab = (LAS float*)(lds + 2 * ATT_KV64);
#pragma unroll
    for (int i = 0; i < 8; ++i) { const int idx = tid + NTHREADS_ * i, isv = idx >> 11, i2 = idx & 2047, row = i2 >> 3, ch = i2 & 7; *(LAS u32x4*)((isv ? vl : kl) + row * 160 + ch * 16) = pfc[i]; }
    if (tid < 320) { const int isv = tid >= 160, i2 = isv ? tid - 160 : tid; *(LAS u32x4*)((isv ? vl : kl) + 256 * 160 + i2 * 16) = (u32x4){0u, 0u, 0u, 0u}; }
    if (tid < ntab) tab[tid] = tabv;
}
__device__ __forceinline__ void attnA_compute(int u, int tid, LAS unsigned char* lds, const bf16_t* __restrict__ hq, bf16_t* __restrict__ oA, float* __restrict__ lseA) {
    asm volatile("" : "+v"(tid));
    const int h = u & 3, rn = (u >> 2) & 31, b = (u >> 7) & 7, g = u >> 10;
    const int r = (g == 0) ? 1 : (g == 1 ? 4 : 16), nblk = 32 / r, rho = rn / nblk, n = rn % nblk, tb = b * SEQ;
    LAS unsigned char* kl = lds; LAS unsigned char* vl = lds + ATT_KV64; LAS float* tab = (LAS float*)(lds + 2 * ATT_KV64);
    const int w = tid >> 6, lane = tid & 63, r16 = lane & 15, kq = lane >> 4, qi = 16 * w + r16, kmin = (n == 0) ? 128 : 0;
    const size_t tq = (size_t)(tb + rho + r * (n * 128 + qi));
    pg8::bf16x8 qf[2];
#pragma unroll
    for (int s = 0; s < 2; ++s) qf[s] = *(const pg8::bf16x8*)(hq + hq_off64(g * 4 + h, tq) + 32 * s + 8 * kq);
    float m = ATT_M0, l = 0.f; f32x4 oT[4];
#pragma unroll
    for (int dt = 0; dt < 4; ++dt) oT[dt] = (f32x4){0.f, 0.f, 0.f, 0.f};
    auto mf = [&](int tile, int kr, float s) -> float { const int kk = 16 * tile + kr, off = qi + 128 - kk; const bool ok = (off >= 0) && (off <= 128) && (kk >= kmin);
        const int oc = off < 0 ? 0 : (off > 128 ? 128 : off); return ok ? s + tab[oc] : -1e30f; };
    auto mfi = [&](int tile, int kr, float s) -> float { return s + tab[qi + 128 - 16 * tile - kr]; };
    attn_step<64, 160>(qf, kl, vl, w, w + 1, mf, m, l, oT);
    if (n != 0) { for (int st = 1; st < 4; ++st) attn_step<64, 160>(qf, kl, vl, w + 2 * st, w + 2 * st + 1, mfi, m, l, oT); }
    else { for (int st = 1; st < 4; ++st) attn_step<64, 160>(qf, kl, vl, w + 2 * st, w + 2 * st + 1, mf, m, l, oT); }
    attn_step<64, 160>(qf, kl, vl, w + 8, w + 9, mf, m, l, oT);
    const float inv = 1.0f / l;
    bf16_t* op = oA + ((size_t)g * T + tq) * 256 + h * 64 + 4 * kq;
#pragma unroll
    for (int dt = 0; dt < 4; ++dt) { u32x2 wv; wv.x = pk2(oT[dt][0] * inv, oT[dt][1] * inv); wv.y = pk2(oT[dt][2] * inv, oT[dt][3] * inv); *(u32x2*)(op + 16 * dt) = wv; }
    if (kq == 0) lseA[((size_t)g * T + tq) * 4 + h] = (m + __builtin_amdgcn_logf(l)) * LN2F;
}
__device__ __forceinline__ void attnB_fetch(int u, int tid, u32x4 (&pfc)[8], float& tabv, const bf16_t* __restrict__ hq, const float* __restrict__ relb) {
    asm volatile("" : "+v"(tid));
    const int kvh = u & 1, n = (u >> 1) & 31, b = u >> 6, tb = b * SEQ;
    const bf16_t* kcol = hq + hq_off64(44 + kvh, 0); const bf16_t* vcol = hq + hq_off64(46 + kvh, 0);
#pragma unroll
    for (int i = 0; i < 8; ++i) { const int idx = tid + NTHREADS_ * i, isv = idx >> 11, i2 = idx & 2047, row = i2 >> 3, ch = i2 & 7, pos = (n - 1) * 128 + row;
        pfc[i] = (pos >= 0) ? *(const u32x4*)((isv ? vcol : kcol) + (size_t)(tb + pos) * 64 + ch * 8) : (u32x4){0u, 0u, 0u, 0u}; }
    { const int hd = tid >> 7, off = tid & 127; tabv = relb[kBucket[0][off] * 20 + 12 + kvh * 4 + hd] * LOG2E; }
}
__device__ __forceinline__ void attnB_compute(int u, int tid, LAS unsigned char* lds, const bf16_t* __restrict__ hq, const float* __restrict__ sinks, bf16_t* __restrict__ yb) {
    asm volatile("" : "+v"(tid));
    const int kvh = u & 1, n = (u >> 1) & 31, b = u >> 6, tb = b * SEQ;
    LAS unsigned char* kl = lds; LAS unsigned char* vl = lds + ATT_KV64; LAS float* tab = (LAS float*)(lds + 2 * ATT_KV64);
    const int w = tid >> 6, lane = tid & 63, r16 = lane & 15, kq = lane >> 4, kmin = (n == 0) ? 128 : 0;
    for (int i = 0; i < 4; ++i) {
        const int task = w + 8 * i, hd = task >> 3, sub = task & 7, head = kvh * 4 + hd, qi = 16 * sub + r16;
        const size_t tq = (size_t)(tb + n * 128 + qi);
        pg8::bf16x8 qf[2];
#pragma unroll
        for (int s = 0; s < 2; ++s) qf[s] = *(const pg8::bf16x8*)(hq + hq_off64(36 + head, tq) + 32 * s + 8 * kq);
        float m = sinks[head] * LOG2E, l = 1.0f; f32x4 oT[4];
#pragma unroll
        for (int dt = 0; dt < 4; ++dt) oT[dt] = (f32x4){0.f, 0.f, 0.f, 0.f};
        LAS float* tb_h = tab + hd * 128;
        auto mf = [&](int tile, int kr, float s) -> float { const int kk = 16 * tile + kr, off = qi + 128 - kk; const bool ok = (off >= 0) && (off <= 127) && (kk >= kmin);
            const int oc = off < 0 ? 0 : (off > 127 ? 127 : off); return ok ? s + tb_h[oc] : -1e30f; };
        auto mfi = [&](int tile, int kr, float s) -> float { return s + tb_h[qi + 128 - 16 * tile - kr]; };
        attn_step<64, 160>(qf, kl, vl, sub, sub + 1, mf, m, l, oT);
        if (n != 0) { for (int st = 1; st < 4; ++st) attn_step<64, 160>(qf, kl, vl, sub + 2 * st, sub + 2 * st + 1, mfi, m, l, oT); }
        else { for (int st = 1; st < 4; ++st) attn_step<64, 160>(qf, kl, vl, sub + 2 * st, sub + 2 * st + 1, mf, m, l, oT); }
        attn_step<64, 160>(qf, kl, vl, sub + 8, sub + 9, mf, m, l, oT);
        const float inv = 1.0f / l;
        const float inv16 = inv * 16.f; unsigned char* op = (unsigned char*)yb + tq * 512 + head * 64 + 4 * kq;
#pragma unroll
        for (int dt = 0; dt < 4; ++dt) { int t8 = 0; t8 = __builtin_amdgcn_cvt_pk_fp8_f32(oT[dt][0] * inv16, oT[dt][1] * inv16, t8, false); t8 = __builtin_amdgcn_cvt_pk_fp8_f32(oT[dt][2] * inv16, oT[dt][3] * inv16, t8, true); *(unsigned*)(op + 16 * dt) = (unsigned)t8; }
    }
}
__device__ __forceinline__ void attnAB_phase(LAS unsigned char* lds, const bf16_t* __restrict__ hq, const float* __restrict__ relb, const float* __restrict__ sinks, bf16_t* __restrict__ oA, float* __restrict__ lseA, bf16_t* __restrict__ yb) {
    int tid = threadIdx.x; asm volatile("" : "+v"(tid));
    u32x4 pfc[8]; float tabv = 0.f;
    int u = blockIdx.x;
    if (u < 3072) attnA_fetch(u, tid, pfc, tabv, hq, relb);
    for (; u < 3072; u += gridDim.x) {
        attnAB_store(tid, pfc, tabv, lds, 129);
        __syncthreads();
        const int un = u + gridDim.x;
        if (un < 3072) attnA_fetch(un, tid, pfc, tabv, hq, relb); else if ((int)blockIdx.x < 512) attnB_fetch((int)blockIdx.x, tid, pfc, tabv, hq, relb);
        attnA_compute(u, tid, lds, hq, oA, lseA);
        __syncthreads();
    }
    u = blockIdx.x;
    if (3072 <= (int)blockIdx.x && u < 512) attnB_fetch(u, tid, pfc, tabv, hq, relb);
    for (; u < 512; u += gridDim.x) {
        attnAB_store(tid, pfc, tabv, lds, 512);
        __syncthreads();
        const int un = u + gridDim.x;
        if (un < 512) attnB_fetch(un, tid, pfc, tabv, hq, relb);
        attnB_compute(u, tid, lds, hq, sinks, yb);
        __syncthreads();
    }
}
__device__ __forceinline__ void attnC_unit(int u, LAS unsigned char* lds, const bf16_t* __restrict__ hq, const bf16_t* __restrict__ kvm, bf16_t* __restrict__ yc) {
    int tid = threadIdx.x; asm volatile("" : "+v"(tid));
    const int qc = u & 7, head = (u >> 3) & 3, b = u >> 5, tb = b * SEQ;
    constexpr int CP = 272, IMG = 256 * CP;
    LAS unsigned char* kl = lds; LAS unsigned char* vl = lds + IMG;
    for (int idx = tid; idx < 8192; idx += NTHREADS_) { const int isv = idx >> 12, i2 = idx & 4095, row = i2 >> 4, ch = i2 & 15;
        lds_put16((isv ? vl : kl) + row * CP + ch * 16, kvm + (size_t)(b * MEMLEN + row) * 1024 + isv * 512 + head * 128 + ch * 8); }
    __syncthreads();
    const int w = tid >> 6, lane = tid & 63, r16 = lane & 15, kq = lane >> 4;
    auto mf = [&](int, int, float s) -> float { return s; };
    for (int qt = 0; qt < 4; ++qt) {
        const size_t tq = (size_t)(tb + qc * 512 + qt * 128 + 16 * w + r16);
        pg8::bf16x8 qf[4];
#pragma unroll
        for (int s = 0; s < 4; ++s) qf[s] = *(const pg8::bf16x8*)(hq + hq_offc(head, tq) + 32 * s + 8 * kq);
        float m = ATT_M0, l = 0.f; f32x4 oT[8];
#pragma unroll
        for (int dt = 0; dt < 8; ++dt) oT[dt] = (f32x4){0.f, 0.f, 0.f, 0.f};
        for (int st = 0; st < 8; ++st) attn_step<128, CP>(qf, kl, vl, 2 * st, 2 * st + 1, mf, m, l, oT);
        const float inv = 1.0f / l;
        const float inv16 = inv * 16.f; unsigned char* op = (unsigned char*)yc + tq * 512 + head * 128 + 4 * kq;
#pragma unroll
        for (int dt = 0; dt < 8; ++dt) { int t8 = 0; t8 = __builtin_amdgcn_cvt_pk_fp8_f32(oT[dt][0] * inv16, oT[dt][1] * inv16, t8, false); t8 = __builtin_amdgcn_cvt_pk_fp8_f32(oT[dt][2] * inv16, oT[dt][3] * inv16, t8, true); *(unsigned*)(op + 16 * dt) = (unsigned)t8; }
    }
    __syncthreads();
}

#define CE_DESC(a, b) do { const unsigned _mx = (a) > (b) ? (a) : (b), _mn = (a) > (b) ? (b) : (a); (a) = _mx; (b) = _mn; } while (0)
__device__ __forceinline__ void sort16_desc(unsigned (&v)[16]) {
    CE_DESC(v[0], v[13]); CE_DESC(v[1], v[12]); CE_DESC(v[2], v[15]); CE_DESC(v[3], v[14]); CE_DESC(v[4], v[8]); CE_DESC(v[5], v[6]); CE_DESC(v[7], v[11]); CE_DESC(v[9], v[10]);
    CE_DESC(v[0], v[5]); CE_DESC(v[1], v[7]); CE_DESC(v[2], v[9]); CE_DESC(v[3], v[4]); CE_DESC(v[6], v[13]); CE_DESC(v[8], v[14]); CE_DESC(v[10], v[15]); CE_DESC(v[11], v[12]);
    CE_DESC(v[0], v[1]); CE_DESC(v[2], v[3]); CE_DESC(v[4], v[5]); CE_DESC(v[6], v[8]); CE_DESC(v[7], v[9]); CE_DESC(v[10], v[11]); CE_DESC(v[12], v[13]); CE_DESC(v[14], v[15]);
    CE_DESC(v[0], v[2]); CE_DESC(v[1], v[3]); CE_DESC(v[4], v[10]); CE_DESC(v[5], v[11]); CE_DESC(v[6], v[7]); CE_DESC(v[8], v[9]); CE_DESC(v[12], v[14]); CE_DESC(v[13], v[15]);
    CE_DESC(v[1], v[2]); CE_DESC(v[3], v[12]); CE_DESC(v[4], v[6]); CE_DESC(v[5], v[7]); CE_DESC(v[8], v[10]); CE_DESC(v[9], v[11]); CE_DESC(v[13], v[14]);
    CE_DESC(v[1], v[4]); CE_DESC(v[2], v[6]); CE_DESC(v[5], v[8]); CE_DESC(v[7], v[10]); CE_DESC(v[9], v[13]); CE_DESC(v[11], v[14]);
    CE_DESC(v[2], v[4]); CE_DESC(v[3], v[6]); CE_DESC(v[9], v[12]); CE_DESC(v[11], v[13]);
    CE_DESC(v[3], v[5]); CE_DESC(v[6], v[8]); CE_DESC(v[7], v[9]); CE_DESC(v[10], v[12]);
    CE_DESC(v[3], v[4]); CE_DESC(v[5], v[6]); CE_DESC(v[7], v[8]); CE_DESC(v[9], v[10]); CE_DESC(v[11], v[12]);
    CE_DESC(v[6], v[7]); CE_DESC(v[8], v[9]);
}
__device__ __forceinline__ void bitonic_merge16_desc(unsigned (&v)[16]) {
#pragma unroll
    for (int j = 8; j > 0; j >>= 1)
#pragma unroll
        for (int i = 0; i < 16; ++i) { const int p = i ^ j; if (p > i) CE_DESC(v[i], v[p]); }
}
__device__ __forceinline__ void top16_merge(unsigned (&a)[16], const unsigned (&b)[16]) {
#pragma unroll
    for (int i = 0; i < 16; ++i) a[i] = a[i] > b[15 - i] ? a[i] : b[15 - i];
    bitonic_merge16_desc(a);
}
__device__ __forceinline__ unsigned f2key(float f) { const unsigned u = __float_as_uint(f); return u ^ ((unsigned)((int)u >> 31) | 0x80000000u); }
__device__ __forceinline__ float key2f(unsigned k) { return __uint_as_float((k & 0x80000000u) ? (k ^ 0x80000000u) : ~k); }

constexpr int TK_KIMG = 128 * 144;
__device__ __forceinline__ void topk_unit(int u, LAS unsigned char* lds, const bf16_t* __restrict__ qb, const bf16_t* __restrict__ subk, unsigned short* __restrict__ eidx, float* __restrict__ gate) {
    int tid = threadIdx.x; asm volatile("" : "+v"(tid));
    const int h = u & 7, tile = u >> 3;
    typedef float f32x16 __attribute__((ext_vector_type(16)));
    for (int idx = tid; idx < 2048; idx += NTHREADS_) { const int row = idx >> 3, ch = idx & 7;
        *(LAS u32x4*)(lds + row * 144 + ch * 16) = *(const u32x4*)(subk + ((size_t)(h * 256 + row)) * 64 + ch * 8); }
    __syncthreads();
    const int w = tid >> 6, lane = tid & 63, r32 = lane & 31, hh = lane >> 5;
    const size_t tok = (size_t)tile * 256 + w * 32 + r32;
    unsigned top[2][16];
#pragma unroll
    for (int c = 0; c < 2; ++c) {
        pg8::bf16x8 qf[4];
#pragma unroll
        for (int s = 0; s < 4; ++s) qf[s] = *(const pg8::bf16x8*)(qb + tok * D + h * 128 + c * 64 + 16 * s + 8 * hh);
        unsigned key[4][16];
#pragma unroll
        for (int kt = 0; kt < 4; ++kt) { f32x16 acc;
#pragma unroll
            for (int i = 0; i < 16; ++i) acc[i] = 0.f;
#pragma unroll
            for (int s = 0; s < 4; ++s) { const pg8::bf16x8 a = *(const LAS pg8::bf16x8*)(lds + c * TK_KIMG + (32 * kt + r32) * 144 + (16 * s + 8 * hh) * 2);
                acc = __builtin_amdgcn_mfma_f32_32x32x16_bf16(a, qf[s], acc, 0, 0, 0); }
            const unsigned lowb = 127u - 4u * hh - 32u * kt;
#pragma unroll
            for (int i = 0; i < 16; ++i) key[kt][i] = (f2key(acc[i]) & 0xFFFFFF80u) | (lowb - (unsigned)((i & 3) + 8 * (i >> 2)));
            sort16_desc(key[kt]); }
        top16_merge(key[0], key[1]); top16_merge(key[2], key[3]); top16_merge(key[0], key[2]);
        unsigned other[16];
#pragma unroll
        for (int i = 0; i < 16; ++i) other[i] = (unsigned)__shfl_xor((int)key[0][i], 32, 64);
        top16_merge(key[0], other);
#pragma unroll
        for (int i = 0; i < 16; ++i) top[c][i] = key[0][i];
    }
    float v0[16], v1[16];
#pragma unroll
    for (int i = 0; i < 16; ++i) { v0[i] = key2f(top[0][i] & 0xFFFFFF80u); v1[i] = key2f(top[1][i] & 0xFFFFFF80u); }
    unsigned cand[4][16];
#pragma unroll
    for (int q = 0; q < 4; ++q)
#pragma unroll
        for (int i = 0; i < 16; ++i) cand[q][i] = 0u;
#define CAND_(q, e, i, j) cand[q][e] = (f2key(v0[i] + v1[j]) & 0xFFFFFF00u) | (unsigned)(255 - ((i) * 16 + (j)))
    CAND_(0, 0, 0, 0);
    CAND_(0, 1, 0, 1);
    CAND_(0, 2, 0, 2);
    CAND_(0, 3, 0, 3);
    CAND_(0, 4, 0, 4);
    CAND_(0, 5, 0, 5);
    CAND_(0, 6, 0, 6);
    CAND_(0, 7, 0, 7);
    CAND_(0, 8, 0, 8);
    CAND_(0, 9, 0, 9);
    CAND_(0, 10, 0, 10);
    CAND_(0, 11, 0, 11);
    CAND_(0, 12, 0, 12);
    CAND_(0, 13, 0, 13);
    CAND_(0, 14, 0, 14);
    CAND_(0, 15, 0, 15);
    CAND_(1, 0, 1, 0);
    CAND_(1, 1, 1, 1);
    CAND_(1, 2, 1, 2);
    CAND_(1, 3, 1, 3);
    CAND_(1, 4, 1, 4);
    CAND_(1, 5, 1, 5);
    CAND_(1, 6, 1, 6);
    CAND_(1, 7, 1, 7);
    CAND_(1, 8, 2, 0);
    CAND_(1, 9, 2, 1);
    CAND_(1, 10, 2, 2);
    CAND_(1, 11, 2, 3);
    CAND_(1, 12, 2, 4);
    CAND_(1, 13, 3, 0);
    CAND_(1, 14, 3, 1);
    CAND_(1, 15, 3, 2);
    CAND_(2, 0, 3, 3);
    CAND_(2, 1, 4, 0);
    CAND_(2, 2, 4, 1);
    CAND_(2, 3, 4, 2);
    CAND_(2, 4, 5, 0);
    CAND_(2, 5, 5, 1);
    CAND_(2, 6, 6, 0);
    CAND_(2, 7, 6, 1);
    CAND_(2, 8, 7, 0);
    CAND_(2, 9, 7, 1);
    CAND_(2, 10, 8, 0);
    CAND_(2, 11, 9, 0);
    CAND_(2, 12, 10, 0);
    CAND_(2, 13, 11, 0);
    CAND_(2, 14, 12, 0);
    CAND_(2, 15, 13, 0);
    CAND_(3, 0, 14, 0);
    CAND_(3, 1, 15, 0);
#undef CAND_
#pragma unroll
    for (int q = 0; q < 4; ++q) sort16_desc(cand[q]);
    top16_merge(cand[0], cand[1]); top16_merge(cand[2], cand[3]); top16_merge(cand[0], cand[2]);
    float ev[16]; const float vmax = key2f(cand[0][0] & 0xFFFFFF00u); float esum = 0.f;
#pragma unroll
    for (int k = 0; k < 16; ++k) { ev[k] = __builtin_amdgcn_exp2f((key2f(cand[0][k] & 0xFFFFFF00u) - vmax) * LOG2E); esum += ev[k]; }
    const float einv = 1.0f / esum;
    LAS unsigned char* st = lds + 2 * TK_KIMG + (w * 64 + lane) * 32;
#pragma unroll
    for (int g4 = 0; g4 < 4; ++g4) { unsigned d0 = 0u, d1 = 0u;
#pragma unroll
        for (int e = 0; e < 4; ++e) { d0 |= (127u - (top[0][4 * g4 + e] & 127u)) << (8 * e); d1 |= (127u - (top[1][4 * g4 + e] & 127u)) << (8 * e); }
        *(LAS unsigned*)(st + 4 * g4) = d0; *(LAS unsigned*)(st + 16 + 4 * g4) = d1; }
    int eo[16];
#pragma unroll
    for (int k = 0; k < 16; ++k) { const unsigned code = 255u - (cand[0][k] & 255u); eo[k] = (int)st[code >> 4] * 128 + (int)st[16 + (code & 15u)]; }
    if (hh == 0) {
        u32x4 o0, o1;
        o0.x = (unsigned)eo[0] | ((unsigned)eo[1] << 16); o0.y = (unsigned)eo[2] | ((unsigned)eo[3] << 16); o0.z = (unsigned)eo[4] | ((unsigned)eo[5] << 16); o0.w = (unsigned)eo[6] | ((unsigned)eo[7] << 16);
        o1.x = (unsigned)eo[8] | ((unsigned)eo[9] << 16); o1.y = (unsigned)eo[10] | ((unsigned)eo[11] << 16); o1.z = (unsigned)eo[12] | ((unsigned)eo[13] << 16); o1.w = (unsigned)eo[14] | ((unsigned)eo[15] << 16);
        *(u32x4*)(eidx + tok * 128 + h * 16) = o0; *(u32x4*)(eidx + tok * 128 + h * 16 + 8) = o1;
    } else {
#pragma unroll
        for (int k4 = 0; k4 < 4; ++k4) { f32x4 o; o[0] = ev[4 * k4] * einv; o[1] = ev[4 * k4 + 1] * einv; o[2] = ev[4 * k4 + 2] * einv; o[3] = ev[4 * k4 + 3] * einv;
            *(f32x4*)(gate + tok * 128 + h * 16 + 4 * k4) = o; }
    }
    __syncthreads();
}

__device__ __forceinline__ float fp8dot16(const u32x4 w, const f32x2 (&xp)[8]) {
    f32x2 a0 = __builtin_amdgcn_cvt_pk_f32_fp8((int)w.x, false) * xp[0];
    a0 = __builtin_elementwise_fma(__builtin_amdgcn_cvt_pk_f32_fp8((int)w.x, true), xp[1], a0);
    a0 = __builtin_elementwise_fma(__builtin_amdgcn_cvt_pk_f32_fp8((int)w.y, false), xp[2], a0); a0 = __builtin_elementwise_fma(__builtin_amdgcn_cvt_pk_f32_fp8((int)w.y, true), xp[3], a0);
    a0 = __builtin_elementwise_fma(__builtin_amdgcn_cvt_pk_f32_fp8((int)w.z, false), xp[4], a0); a0 = __builtin_elementwise_fma(__builtin_amdgcn_cvt_pk_f32_fp8((int)w.z, true), xp[5], a0);
    a0 = __builtin_elementwise_fma(__builtin_amdgcn_cvt_pk_f32_fp8((int)w.w, false), xp[6], a0); a0 = __builtin_elementwise_fma(__builtin_amdgcn_cvt_pk_f32_fp8((int)w.w, true), xp[7], a0);
    return a0.x + a0.y;
}
typedef int i32x4 __attribute__((ext_vector_type(4)));
#define PEER_EIDX16(dst, t_) do { const unsigned short* ep_ = eidx + (size_t)(t_) * 128 + 16 * grp; const u32x4 e0_ = *(const u32x4*)ep_, e1_ = *(const u32x4*)(ep_ + 8); \
        dst[0] = (int)(e0_.x & 0xffffu); dst[1] = (int)(e0_.x >> 16); dst[2] = (int)(e0_.y & 0xffffu); dst[3] = (int)(e0_.y >> 16); dst[4] = (int)(e0_.z & 0xffffu); dst[5] = (int)(e0_.z >> 16); dst[6] = (int)(e0_.w & 0xffffu); dst[7] = (int)(e0_.w >> 16); \
        dst[8] = (int)(e1_.x & 0xffffu); dst[9] = (int)(e1_.x >> 16); dst[10] = (int)(e1_.y & 0xffffu); dst[11] = (int)(e1_.y >> 16); dst[12] = (int)(e1_.z & 0xffffu); dst[13] = (int)(e1_.z >> 16); dst[14] = (int)(e1_.w & 0xffffu); dst[15] = (int)(e1_.w >> 16); } while (0)
#define PEER_GATHER16(BUF, base, ev) _Pragma("unroll") for (int i_ = 0; i_ < 16; ++i_) BUF[i_] = *(const u32x4*)((base) + (unsigned)(((unsigned)(ev)[i_] << 10) + (unsigned)colbase))
template <int CTRL> __device__ __forceinline__ float xsel_addf_dpp(float keep_lo, float keep_hi, bool hi) { const float send = hi ? keep_lo : keep_hi, keep = hi ? keep_hi : keep_lo;
    return keep + __uint_as_float(__builtin_amdgcn_update_dpp(0u, __float_as_uint(send), CTRL, 0xf, 0xf, false)); }
__device__ __forceinline__ float swap32_add(float lo, float hi) { typedef unsigned u2_ __attribute__((ext_vector_type(2))); const u2_ r = __builtin_amdgcn_permlane32_swap(__float_as_uint(lo), __float_as_uint(hi), false, false); return __uint_as_float(r.x) + __uint_as_float(r.y); }
__device__ __forceinline__ float swap16_add(float lo, float hi) { typedef unsigned u2_ __attribute__((ext_vector_type(2))); const u2_ r = __builtin_amdgcn_permlane16_swap(__float_as_uint(lo), __float_as_uint(hi), false, false); return __uint_as_float(r.x) + __uint_as_float(r.y); }
#define PEER_GATHER4(R, o, base, E, p) _Pragma("unroll") for (int j_ = 0; j_ < 4; ++j_) R[(o) + j_] = *(const u32x4*)((base) + (unsigned)(((unsigned)(E)[4 * (p) + j_] << 10) + (unsigned)colbase))
__device__ __forceinline__ void peerU_phase(int slice, int tok0, int tok1, const bf16_t* __restrict__ x1b,
                                            const unsigned short* __restrict__ eidx, const unsigned char* __restrict__ ub8, bf16_t* __restrict__ hp) {
    int tid = threadIdx.x; asm volatile("" : "+v"(tid));
    const int wave = tid >> 6, lane = tid & 63, sub = lane & 7, grp = lane >> 3, colbase = 128 * slice + 16 * sub;
    if (tok0 + wave >= tok1) return;
    const bool l0 = lane & 1, l1 = lane & 2, l2 = lane & 4;
    const int tfirst = tok0 + wave, tlast = tfirst + ((tok1 - 1 - tfirst) >> 3) * 8;
    const bf16_t* xl = x1b + colbase;
    const int hoff = 16 * grp + ((lane & 4) ? 8 : 0) + ((lane & 2) ? 4 : 0) + ((lane & 1) ? 2 : 0);
#define TOKC(i) ((tfirst + 8 * (i)) <= tlast ? (tfirst + 8 * (i)) : tlast)
    u32x4 R[32]; int EA[16], EB[16]; u32x4 xrA0, xrA1, xrB0, xrB1;
    { const int t0 = TOKC(0), t1 = TOKC(1);
      PEER_EIDX16(EA, t0); PEER_EIDX16(EB, t1);
      xrA0 = *(const u32x4*)(xl + (size_t)t0 * D); xrA1 = *(const u32x4*)(xl + (size_t)t0 * D + 8); xrB0 = *(const u32x4*)(xl + (size_t)t1 * D); xrB1 = *(const u32x4*)(xl + (size_t)t1 * D + 8);
#pragma unroll
      for (int p = 0; p < 4; ++p) { PEER_GATHER4(R, 4 * p, ub8, EA, p); }
#pragma unroll
      for (int p = 0; p < 4; ++p) { PEER_GATHER4(R, 16 + 4 * p, ub8, EB, p); }
      const int t2 = TOKC(2), t3 = TOKC(3); PEER_EIDX16(EA, t2); PEER_EIDX16(EB, t3); }
    for (int i = 0;; i += 2) {
#define PEER_U_TOKEN(RO, E, xr0, xr1, ti, tnext2, tnext4) do { \
        f32x2 xp[8]; \
        xp[0] = (f32x2){bflo(xr0.x), bfhi(xr0.x)}; xp[1] = (f32x2){bflo(xr0.y), bfhi(xr0.y)}; xp[2] = (f32x2){bflo(xr0.z), bfhi(xr0.z)}; xp[3] = (f32x2){bflo(xr0.w), bfhi(xr0.w)}; \
        xp[4] = (f32x2){bflo(xr1.x), bfhi(xr1.x)}; xp[5] = (f32x2){bflo(xr1.y), bfhi(xr1.y)}; xp[6] = (f32x2){bflo(xr1.z), bfhi(xr1.z)}; xp[7] = (f32x2){bflo(xr1.w), bfhi(xr1.w)}; \
        xr0 = *(const u32x4*)(xl + (size_t)(tnext2) * D); xr1 = *(const u32x4*)(xl + (size_t)(tnext2) * D + 8);        \
        float pd[16]; \
        _Pragma("unroll") for (int p = 0; p < 4; ++p) { \
            _Pragma("unroll") for (int j = 0; j < 4; ++j) pd[4 * p + j] = fp8dot16(R[(RO) + 4 * p + j], xp); \
            PEER_GATHER4(R, (RO) + 4 * p, ub8, E, p); } \
        PEER_EIDX16(E, tnext4); \
        float q8[8]; \
        _Pragma("unroll") for (int k = 0; k < 8; ++k) q8[k] = xsel_addf_dpp<0x141>(pd[k], pd[k + 8], l2);            \
        const float r0 = xsel_addf_dpp<0x4E>(q8[0], q8[4], l1), r1 = xsel_addf_dpp<0x4E>(q8[1], q8[5], l1), r2 = xsel_addf_dpp<0x4E>(q8[2], q8[6], l1), r3 = xsel_addf_dpp<0x4E>(q8[3], q8[7], l1);     \
        f32x2 o; o.x = xsel_addf_dpp<0xB1>(r0, r2, l0); o.y = xsel_addf_dpp<0xB1>(r1, r3, l0);                       \
        if ((tfirst + 8 * (ti)) <= tlast) *(unsigned*)(hp + ((size_t)slice * T + (size_t)(tfirst + 8 * (ti))) * 128 + hoff) = pk2(o.x, o.y); } while (0)
        { const int tn2 = TOKC(i + 2), tn4 = TOKC(i + 4); PEER_U_TOKEN(0, EA, xrA0, xrA1, i, tn2, tn4); }
        { const int tn2 = TOKC(i + 3), tn4 = TOKC(i + 5); PEER_U_TOKEN(16, EB, xrB0, xrB1, i + 1, tn2, tn4); }
        if (tfirst + 8 * (i + 2) > tlast) break;
    }
#undef PEER_U_TOKEN
#undef TOKC
}
#ifdef PROBE_EXP
__device__ __forceinline__ void probe_gather(int slice, int tok0, int tok1, const unsigned short* __restrict__ eidx, const unsigned char* __restrict__ ub8, float* __restrict__ dummy) {
    int tid = threadIdx.x; asm volatile("" : "+v"(tid));
    const int wave = tid >> 6, lane = tid & 63, sub = lane & 7, grp = lane >> 3, colbase = 128 * slice + 16 * sub;
    if (tok0 + wave >= tok1) return;
    const unsigned char* ubl = ub8;
    const int tlast = tok0 + wave + ((tok1 - 1 - tok0 - wave) >> 3) * 8;
    int EA[16], EB[16]; u32x4 UA[16], UB[16];
    int ta = tok0 + wave, tb = ta + 8 <= tlast ? ta + 8 : tlast;
    PEER_EIDX16(EA, ta); PEER_EIDX16(EB, tb);
    PEER_GATHER16(UA, ubl, EA);
    unsigned accx = 0u;
    for (;;) {
        PEER_GATHER16(UB, ubl, EB);
        const int ta2 = ta + 16 <= tlast ? ta + 16 : tlast; PEER_EIDX16(EA, ta2);
#pragma unroll
        for (int i = 0; i < 16; ++i) accx ^= UA[i].x ^ UA[i].y ^ UA[i].z ^ UA[i].w;
        PEER_GATHER16(UA, ubl, EA);
        const int tb2 = ta + 24 <= tlast ? ta + 24 : tlast; PEER_EIDX16(EB, tb2);
#pragma unroll
        for (int i = 0; i < 16; ++i) accx ^= UB[i].x ^ UB[i].y ^ UB[i].z ^ UB[i].w;
        if (ta + 16 > tlast) break;
        ta = ta2; tb = tb2;
    }
    dummy[(size_t)blockIdx.x * 512 + tid] = __uint_as_float(accx & 0x3fffffffu);
}
#endif

#if defined(PROBE_EXP) && PROBE_EXP >= 10 && PROBE_EXP < 20
__device__ __forceinline__ void probe_valu(float* __restrict__ dummy) {
    int tid = threadIdx.x; asm volatile("" : "+v"(tid));
    unsigned w[8]; f32x2 a[8];
#pragma unroll
    for (int i = 0; i < 8; ++i) { w[i] = (unsigned)tid * 2654435761u + i * 40503u; a[i] = (f32x2){(float)i, 1.0f}; }
    for (int it = 0; it < 2048; ++it) {
#pragma unroll
        for (int r = 0; r < 4; ++r)
#pragma unroll
            for (int i = 0; i < 8; ++i) {
#if PROBE_EXP == 10
                asm volatile("v_cvt_pk_f32_fp8_e32 %0, %1" : "=v"(a[i]) : "v"(w[i]));
#elif PROBE_EXP == 11
                asm volatile("v_pk_fma_f32 %0, %1, %1, %0" : "+v"(a[i]) : "v"(a[(i + 1) & 7]));
#elif PROBE_EXP == 12
                asm volatile("v_cvt_f32_ubyte0_e32 %0, %1" : "=v"(a[i].x) : "v"(w[i]));
#elif PROBE_EXP == 13
                asm volatile("v_dot4_i32_i8 %0, %1, %1, %0" : "+v"(w[i]) : "v"(w[(i + 1) & 7]));
#elif PROBE_EXP == 14
                asm volatile("v_fma_f32 %0, %1, %1, %0" : "+v"(a[i].x) : "v"(a[(i + 1) & 7].y));
#elif PROBE_EXP == 15
                asm volatile("v_dot2_f32_bf16 %0, %1, %1, %0" : "+v"(a[i].x) : "v"(w[i]));
#endif
            }
    }
    float s = 0.f;
#pragma unroll
    for (int i = 0; i < 8; ++i) s += a[i].x + a[i].y + __uint_as_float(w[i] & 0x3fffffffu);
    dummy[(size_t)blockIdx.x * 512 + tid] = s;
}
#endif
__device__ __forceinline__ void peerR_phase(const bf16_t* __restrict__ hp, const unsigned short* __restrict__ eidx, const float* __restrict__ gate, const float* __restrict__ usc, const float* __restrict__ vsc, bf16_t* __restrict__ cb) {
    for (size_t i = (size_t)blockIdx.x * 512 + threadIdx.x; i < (size_t)T * 32; i += (size_t)gridDim.x * 512) {
        f32x4 h = (f32x4){0.f, 0.f, 0.f, 0.f};
#pragma unroll
        for (int j = 0; j < 8; ++j) { const u32x2 w = *(const u32x2*)(hp + (size_t)j * T * 128 + 4 * i); h += (f32x4){bflo(w.x), bfhi(w.x), bflo(w.y), bfhi(w.y)}; }
        const u32x2 ew = *(const u32x2*)(eidx + 4 * i); const int e[4] = {(int)(ew.x & 0xffffu), (int)(ew.x >> 16), (int)(ew.y & 0xffffu), (int)(ew.y >> 16)};
        const f32x4 gt = *(const f32x4*)(gate + 4 * i); float c[4];
#pragma unroll
        for (int j = 0; j < 4; ++j) { const float hh = h[j] * usc[e[j]]; const pg8::f32x2 ge = pg8::gelu_pk((pg8::f32x2){hh, hh}); c[j] = gt[j] * ge.x * vsc[e[j]]; }
        u32x2 cw; cw.x = pk2(c[0], c[1]); cw.y = pk2(c[2], c[3]); *(u32x2*)(cb + 4 * i) = cw; }
}
__device__ __forceinline__ void peerV_phase(int slice, int tok0, int tok1, const bf16_t* __restrict__ cb, const unsigned short* __restrict__ eidx, const unsigned char* __restrict__ vb8, bf16_t* __restrict__ yp) {
    int tid = threadIdx.x; asm volatile("" : "+v"(tid));
    const int wave = tid >> 6, lane = tid & 63, sub = lane & 7, grp = lane >> 3, colbase = 128 * slice + 16 * sub;
    if (tok0 + wave >= tok1) return;
    const bool l3 = lane & 8, l4 = lane & 16, l5 = lane & 32;
    const int tfirst = tok0 + wave, tlast = tfirst + ((tok1 - 1 - tfirst) >> 3) * 8;
    const bf16_t* cl = cb + 16 * grp;
    const int yoff = colbase + ((lane & 32) ? 8 : 0) + ((lane & 16) ? 4 : 0) + ((lane & 8) ? 2 : 0);
#define TOKC(i) ((tfirst + 8 * (i)) <= tlast ? (tfirst + 8 * (i)) : tlast)
#define PEER_C16(dst, t_) do { const bf16_t* cp_ = cl + (size_t)(t_) * 128; dst[0] = *(const u32x4*)cp_; dst[1] = *(const u32x4*)(cp_ + 8); } while (0)
    u32x4 R[32]; int EA[16], EB[16]; u32x4 cA[2], cB[2];
    { const int t0 = TOKC(0), t1 = TOKC(1);
      PEER_EIDX16(EA, t0); PEER_EIDX16(EB, t1); PEER_C16(cA, t0); PEER_C16(cB, t1);
#pragma unroll
      for (int p = 0; p < 4; ++p) { PEER_GATHER4(R, 4 * p, vb8, EA, p); }
#pragma unroll
      for (int p = 0; p < 4; ++p) { PEER_GATHER4(R, 16 + 4 * p, vb8, EB, p); }
      const int t2 = TOKC(2), t3 = TOKC(3); PEER_EIDX16(EA, t2); PEER_EIDX16(EB, t3); }
    for (int i = 0;; i += 2) {
#define PEER_V_TOKEN(RO, E, cc, ti, tnext2, tnext4) do { \
        const u32x4 c0_ = cc[0], c1_ = cc[1]; \
        const float cv[16] = {bflo(c0_.x), bfhi(c0_.x), bflo(c0_.y), bfhi(c0_.y), bflo(c0_.z), bfhi(c0_.z), bflo(c0_.w), bfhi(c0_.w), bflo(c1_.x), bfhi(c1_.x), bflo(c1_.y), bfhi(c1_.y), bflo(c1_.z), bfhi(c1_.z), bflo(c1_.w), bfhi(c1_.w)}; \
        PEER_C16(cc, tnext2);                                        \
        f32x2 acc[8]; \
        _Pragma("unroll") for (int k = 0; k < 8; ++k) acc[k] = (f32x2){0.f, 0.f}; \
        _Pragma("unroll") for (int p = 0; p < 4; ++p) { \
            _Pragma("unroll") for (int j = 0; j < 4; ++j) { const u32x4 w = R[(RO) + 4 * p + j]; const f32x2 c2v = (f32x2){cv[4 * p + j], cv[4 * p + j]}; \
                acc[0] = __builtin_elementwise_fma(__builtin_amdgcn_cvt_pk_f32_fp8((int)w.x, false), c2v, acc[0]); acc[1] = __builtin_elementwise_fma(__builtin_amdgcn_cvt_pk_f32_fp8((int)w.x, true), c2v, acc[1]); \
                acc[2] = __builtin_elementwise_fma(__builtin_amdgcn_cvt_pk_f32_fp8((int)w.y, false), c2v, acc[2]); acc[3] = __builtin_elementwise_fma(__builtin_amdgcn_cvt_pk_f32_fp8((int)w.y, true), c2v, acc[3]); \
                acc[4] = __builtin_elementwise_fma(__builtin_amdgcn_cvt_pk_f32_fp8((int)w.z, false), c2v, acc[4]); acc[5] = __builtin_elementwise_fma(__builtin_amdgcn_cvt_pk_f32_fp8((int)w.z, true), c2v, acc[5]); \
                acc[6] = __builtin_elementwise_fma(__builtin_amdgcn_cvt_pk_f32_fp8((int)w.w, false), c2v, acc[6]); acc[7] = __builtin_elementwise_fma(__builtin_amdgcn_cvt_pk_f32_fp8((int)w.w, true), c2v, acc[7]); } \
            PEER_GATHER4(R, (RO) + 4 * p, vb8, E, p); } \
        PEER_EIDX16(E, tnext4); \
        const float a[16] = {acc[0].x, acc[0].y, acc[1].x, acc[1].y, acc[2].x, acc[2].y, acc[3].x, acc[3].y, acc[4].x, acc[4].y, acc[5].x, acc[5].y, acc[6].x, acc[6].y, acc[7].x, acc[7].y}; \
        float q8[8]; \
        _Pragma("unroll") for (int k = 0; k < 8; ++k) q8[k] = swap32_add(a[k], a[k + 8]); \
        const float r0 = swap16_add(q8[0], q8[4]), r1 = swap16_add(q8[1], q8[5]), r2 = swap16_add(q8[2], q8[6]), r3 = swap16_add(q8[3], q8[7]); \
        f32x2 o; o.x = xsel_addf_dpp<0x128>(r0, r2, l3); o.y = xsel_addf_dpp<0x128>(r1, r3, l3);               \
        if ((tfirst + 8 * (ti)) <= tlast) *(unsigned*)(yp + (size_t)(tfirst + 8 * (ti)) * D + yoff) = pk2(o.x, o.y); } while (0)
        { const int tn2 = TOKC(i + 2), tn4 = TOKC(i + 4); PEER_V_TOKEN(0, EA, cA, i, tn2, tn4); }
        { const int tn2 = TOKC(i + 3), tn4 = TOKC(i + 5); PEER_V_TOKEN(16, EB, cB, i + 1, tn2, tn4); }
        if (tfirst + 8 * (i + 2) > tlast) break;
    }
#undef PEER_V_TOKEN
#undef PEER_C16
#undef TOKC
}
template <int NT>
__device__ __forceinline__ void peerL_token(size_t t0, size_t tstride, const bf16_t* __restrict__ x1b, const bf16_t* __restrict__ yp, const float* g2, const float* b2, float* __restrict__ out) {
    const int lane = threadIdx.x & 63;
    u32x4 xw[NT][2], yw[NT][2];
#pragma unroll
    for (int k = 0; k < NT; ++k) { const size_t t = t0 + k * tstride;
#pragma unroll
        for (int hlf = 0; hlf < 2; ++hlf) { const int c = 16 * lane + 8 * hlf; xw[k][hlf] = *(const u32x4*)(x1b + t * D + c); yw[k][hlf] = *(const u32x4*)(yp + t * D + c); } }
#pragma unroll
    for (int k = 0; k < NT; ++k) { const size_t t = t0 + k * tstride;
        float y[16]; float s = 0.f;
#pragma unroll
        for (int hlf = 0; hlf < 2; ++hlf) { const u32x4 xq = xw[k][hlf], yq = yw[k][hlf];
            const float xx[8] = {bflo(xq.x), bfhi(xq.x), bflo(xq.y), bfhi(xq.y), bflo(xq.z), bfhi(xq.z), bflo(xq.w), bfhi(xq.w)}, yy[8] = {bflo(yq.x), bfhi(yq.x), bflo(yq.y), bfhi(yq.y), bflo(yq.z), bfhi(yq.z), bflo(yq.w), bfhi(yq.w)};
#pragma unroll
            for (int j = 0; j < 8; ++j) { const float v = ALPHA * xx[j] + yy[j]; y[8 * hlf + j] = v; s += v; } }
        const float mean2 = wave_sum(s) * (1.f / D); float ss = 0.f;
#pragma unroll
        for (int i = 0; i < 16; ++i) { const float dlt = y[i] - mean2; ss += dlt * dlt; }
        const float rstd2 = rsqrtf(wave_sum(ss) * (1.f / D) + LN_EPS);
#pragma unroll
        for (int q = 0; q < 4; ++q) { const int c = 16 * lane + 4 * q; const f32x4 gg = *(const f32x4*)(g2 + c), bb = *(const f32x4*)(b2 + c); f32x4 o;
#pragma unroll
            for (int j = 0; j < 4; ++j) o[j] = (y[4 * q + j] - mean2) * rstd2 * gg[j] + bb[j];
            *(f32x4*)(out + t * D + c) = o; } }
}

constexpr int NTHREADS = 512, NWAVES = 8;
constexpr int LDS_BYTES = 147456;
constexpr int LDS_MISC = 131072;
constexpr int LDS_XB = LDS_BYTES - 16;
constexpr size_t CTL_ZERO_BYTES = 16384;

struct Params {
    const float *x, *mem, *relb, *w_in, *b_gate, *w_memkv, *sinks, *w_a, *w_b, *w_c, *w_out, *ln1g, *ln1b, *w_q, *subk, *pu, *pv, *ln2g, *ln2b;
    float* out; char* ws; int lo, hi;
};

__device__ __forceinline__ void g_cvt(const float* __restrict__ src, bf16_t* __restrict__ dst, size_t n8) {
    for (size_t i = (size_t)blockIdx.x * NTHREADS + threadIdx.x; i < n8; i += (size_t)gridDim.x * NTHREADS) {
        const f32x4 a = ((const f32x4*)src)[2 * i], b = ((const f32x4*)src)[2 * i + 1];
        u32x4 w; w.x = pk2(a[0], a[1]); w.y = pk2(a[2], a[3]); w.z = pk2(b[0], b[1]); w.w = pk2(b[2], b[3]);
        ((u32x4*)dst)[i] = w; }
}


__device__ __forceinline__ void g_cvt8(const float* __restrict__ src, unsigned char* __restrict__ dst, size_t n16, float sc) {
    for (size_t i = (size_t)blockIdx.x * NTHREADS + threadIdx.x; i < n16; i += (size_t)gridDim.x * NTHREADS) {
        const f32x4 a = ((const f32x4*)src)[4 * i], b = ((const f32x4*)src)[4 * i + 1], c = ((const f32x4*)src)[4 * i + 2], d = ((const f32x4*)src)[4 * i + 3];
        u32x4 w; int t;
        t = 0; t = __builtin_amdgcn_cvt_pk_fp8_f32(a[0] * sc, a[1] * sc, t, false); t = __builtin_amdgcn_cvt_pk_fp8_f32(a[2] * sc, a[3] * sc, t, true); w.x = (unsigned)t;
        t = 0; t = __builtin_amdgcn_cvt_pk_fp8_f32(b[0] * sc, b[1] * sc, t, false); t = __builtin_amdgcn_cvt_pk_fp8_f32(b[2] * sc, b[3] * sc, t, true); w.y = (unsigned)t;
        t = 0; t = __builtin_amdgcn_cvt_pk_fp8_f32(c[0] * sc, c[1] * sc, t, false); t = __builtin_amdgcn_cvt_pk_fp8_f32(c[2] * sc, c[3] * sc, t, true); w.z = (unsigned)t;
        t = 0; t = __builtin_amdgcn_cvt_pk_fp8_f32(d[0] * sc, d[1] * sc, t, false); t = __builtin_amdgcn_cvt_pk_fp8_f32(d[2] * sc, d[3] * sc, t, true); w.w = (unsigned)t;
        ((u32x4*)dst)[i] = w; }
}

template <bool FP8>
__device__ __forceinline__ void transpose_tile_wave(const float* __restrict__ src, int K, int N, void* __restrict__ dstv, int tn, int tk, LAS float* tile, float sc) {
    const int lane = threadIdx.x & 63, n0 = tn * 64, k0 = tk * 64, rq = lane >> 4, c4 = (lane & 15) * 4;
    f32x4 v[16];
#pragma unroll
    for (int i = 0; i < 16; ++i) v[i] = *(const f32x4*)(src + (size_t)(k0 + 4 * i + rq) * N + n0 + c4);
#pragma unroll
    for (int i = 0; i < 16; ++i) *(LAS f32x4*)(tile + (4 * i + rq) * 68 + c4) = v[i];
    asm volatile("s_waitcnt lgkmcnt(0)" ::: "memory");
    float y[64];
#pragma unroll
    for (int k = 0; k < 64; ++k) y[k] = tile[k * 68 + lane];
    if constexpr (FP8) { unsigned char* dst = (unsigned char*)dstv + (size_t)(n0 + lane) * K + k0;
#pragma unroll
        for (int q = 0; q < 4; ++q) { u32x4 w; int t;
#pragma unroll
            for (int d = 0; d < 4; ++d) { t = 0; t = __builtin_amdgcn_cvt_pk_fp8_f32(y[16 * q + 4 * d] * sc, y[16 * q + 4 * d + 1] * sc, t, false); t = __builtin_amdgcn_cvt_pk_fp8_f32(y[16 * q + 4 * d + 2] * sc, y[16 * q + 4 * d + 3] * sc, t, true); w[d] = (unsigned)t; }
            *(u32x4*)(dst + 16 * q) = w; } }
    else { bf16_t* dst = (bf16_t*)dstv + (size_t)(n0 + lane) * K + k0;
#pragma unroll
        for (int q = 0; q < 8; ++q) { u32x4 w; w.x = pk2(y[8 * q], y[8 * q + 1]); w.y = pk2(y[8 * q + 2], y[8 * q + 3]); w.z = pk2(y[8 * q + 4], y[8 * q + 5]); w.w = pk2(y[8 * q + 6], y[8 * q + 7]); *(u32x4*)(dst + 8 * q) = w; } }
    asm volatile("s_waitcnt lgkmcnt(0)" ::: "memory");
}
#define W_ws (p.ws)
#define W_dout ((char*)p.out)
#define W_wmemkv_t ((bf16_t*)(W_ws + WS_WMEMKV))
#define W_wA_t ((bf16_t*)(W_ws + WS_WA))
#define W_wB_t ((bf16_t*)(W_ws + WS_WB))
#define W_wC_t ((bf16_t*)(W_ws + WS_WC))
#define W_wout_t ((bf16_t*)(W_ws + WS_WOUT))
#define W_wq_t ((bf16_t*)(W_ws + WS_WQ))
#define W_subkb ((bf16_t*)(W_ws + WS_SUBK))
#define W_memb ((bf16_t*)(W_ws + WS_MEMB))
#define W_kvm ((bf16_t*)(W_ws + WS_KVM))
#define W_stats ((float*)(W_ws + WS_STATS))
#define W_lseA ((float*)(W_ws + WS_LSE))
#define W_hq ((bf16_t*)(W_ws + WS_HQ))
#define W_gates ((bf16_t*)(W_ws + WS_GATES))
#define W_xb ((bf16_t*)(W_ws + WS_XB))
#define W_mf ((float*)(W_ws + WS_MF))
#define W_mb ((unsigned char*)(W_ws + WS_MB))
#define W_z ((bf16_t*)(W_ws + WS_Z))
#define W_x1b ((bf16_t*)(W_ws + WS_X1B))
#define W_qb ((bf16_t*)(W_ws + WS_Q))
#define W_eidx ((unsigned short*)(W_ws + WS_EIDX))
#define W_gate ((float*)(W_ws + WS_GATE))
#define W_ub8 ((unsigned char*)(W_ws + WS_UB))
#define W_vb8 ((unsigned char*)(W_ws + WS_UB + 16 * MiB))
#define W_usc ((float*)(W_ws + WS_UB + 32 * MiB))
#define W_vsc (W_usc + NEXP)
#define W_w_in_t ((bf16_t*)(W_dout + DO_WINT))
#define W_oA ((bf16_t*)(W_dout + DO_OA))
#define W_yb ((bf16_t*)(W_dout + DO_YB))
#define W_yc ((bf16_t*)(W_dout + DO_YC))
#define W_ya ((bf16_t*)(W_dout + DO_YA))
#define W_x8 ((unsigned char*)W_dout)
#define W_hp ((bf16_t*)(W_ws + 120 * MiB))
#define W_cbuf ((bf16_t*)(W_ws + 24 * MiB))
#define W_yp W_hp
__global__ void __launch_bounds__(NTHREADS, 2) mk_fwd(Params p) {
    extern __shared__ __attribute__((aligned(16))) unsigned char lds[];
#define LAUNDER_TID int tid = threadIdx.x; asm volatile("" : "+v"(tid)); const int wave = tid >> 6; const int gw = blockIdx.x * NWAVES + wave, nw = gridDim.x * NWAVES; (void)wave; (void)gw; (void)nw;
    if (threadIdx.x == 0) *(uint4*)(lds + LDS_XB) = make_uint4(0u, 0u, 0u, 0u);
    __syncthreads();
    XcdBarrier bar = xcd_barrier_post((unsigned*)(W_ws + WS_CTL), (volatile LAS unsigned*)(lds + LDS_XB));
#define PH(k) (p.lo <= (k) && (k) < p.hi)
#define SEAM(k) do { if (PH(k) && PH((k) + 1)) xcd_barrier(bar); } while (0)

    if (PH(0)) { LAUNDER_TID
        g_cvt8(p.x, (unsigned char*)W_xb, (size_t)T * D / 16, 1.0f);
        g_cvt(p.mem, W_memb, (size_t)BATCH * MEMLEN * D / 8);
        g_cvt(p.subk, W_subkb, (size_t)8 * 2 * 128 * 64 / 8);
        LAS float* tile = (LAS float*)((LAS unsigned char*)lds + wave * (64 * 68 * 4));
        for (int u = gw; u < 2752; u += nw) {
            if (u < 1664) transpose_tile_wave<true>(p.w_in, D, INW, W_w_in_t, u % 104, u / 104, tile, 32.0f);
            else if (u < 1920) { const int v = u - 1664; transpose_tile_wave<false>(p.w_memkv, D, 1024, W_wmemkv_t, v & 15, v >> 4, tile, 1.f); }
            else if (u < 1984) { const int v = u - 1920; transpose_tile_wave<true>(p.w_a, 256, 1024, W_wA_t, v & 15, v >> 4, tile, 32.0f); }
            else if (u < 2112) { const int v = u - 1984; transpose_tile_wave<true>(p.w_b, 512, 1024, W_wB_t, v & 15, v >> 4, tile, 32.0f); }
            else if (u < 2240) { const int v = u - 2112; transpose_tile_wave<true>(p.w_c, 512, 1024, W_wC_t, v & 15, v >> 4, tile, 32.0f); }
            else if (u < 2496) { const int v = u - 2240; transpose_tile_wave<true>(p.w_out, D, 1024, W_wout_t, v & 15, v >> 4, tile, 32.0f); }
            else { const int v = u - 2496; transpose_tile_wave<false>(p.w_q, D, 1024, W_wq_t, v & 15, v >> 4, tile, 1.f); }
        }
    }
    SEAM(0);
    if (PH(1)) {
        { pg8::Gemm g; g.A = W_memb; g.Bt = W_wmemkv_t; g.M = BATCH * MEMLEN; g.N = 1024; g.K = D; EpiPlain E; E.O = W_kvm; E.ldc = 1024;
          pg8::StaticOrder S; S.init(g.M, g.N, (int)gridDim.x, (int)blockIdx.x); pg8::gemm_phase<EpiPlain, pg8::StaticOrder, false>((PG8_LAS unsigned char*)lds, g, S, E, nullptr); }
        __syncthreads();
        { pg8::Gemm g; g.A = W_xb; g.Bt = W_w_in_t; g.M = T; g.N = INW; g.K = D / 2; EpiIn E; E.hq = W_hq; E.gates = W_gates; E.bgate = p.b_gate;
          pg8::StaticOrder S; S.init(g.M, g.N, (int)gridDim.x, (int)blockIdx.x); pg8::gemm_phase<EpiIn, pg8::StaticOrder, false, true>((PG8_LAS unsigned char*)lds, g, S, E, nullptr); }
    }
    SEAM(1);
    if (PH(2)) { LAUNDER_TID
        LAS unsigned char* L = (LAS unsigned char*)lds;
        attnAB_phase(L, W_hq, p.relb, p.sinks, W_oA, W_lseA, W_yb);
        for (int u = blockIdx.x; u < 256; u += gridDim.x) attnC_unit(u, L, W_hq, W_kvm, W_yc);
        for (int row = gw; row < NEXP / 2; row += nw) cvt_rows_fp8(p.pu, p.pv, W_ub8, W_vb8, W_usc, W_vsc, row, row + NEXP / 2);
    }
    SEAM(2);
    if (PH(3)) { LAUNDER_TID for (size_t i = (size_t)blockIdx.x * NTHREADS + tid; i < (size_t)T * 32; i += (size_t)gridDim.x * NTHREADS) t_mix(i, W_oA, W_lseA, W_ya); }
    SEAM(3);
    if (PH(4)) {
        pg8::MergeArgs g; g.A[0] = W_ya; g.A[1] = W_yb; g.A[2] = W_yc; g.Bt[0] = W_wA_t; g.Bt[1] = W_wB_t; g.Bt[2] = W_wC_t; g.K[0] = 128; g.K[1] = 256; g.K[2] = 256; g.gates = W_gates; g.mb = W_mb;
        pg8::StaticOrder S; S.init(T, D, (int)gridDim.x, (int)blockIdx.x); pg8::gemm_phase_merge<pg8::StaticOrder, true>((PG8_LAS unsigned char*)lds, g, S);
    }
    SEAM(4);
    if (PH(5)) {
        pg8::Gemm g; g.A = (const bf16_t*)W_mb; g.Bt = W_wout_t; g.M = T; g.N = D; g.K = D / 2; EpiPlain E; E.O = W_z; E.ldc = 1024;
        pg8::StaticOrder S; S.init(g.M, g.N, (int)gridDim.x, (int)blockIdx.x); pg8::gemm_phase<EpiPlain, pg8::StaticOrder, false, true, 123>((PG8_LAS unsigned char*)lds, g, S, E, nullptr);
    }
    SEAM(5);
    if (PH(6)) { LAUNDER_TID int t = gw; for (; t + 3 * nw < T; t += 4 * nw) t_res_ln1<4>((size_t)t, (size_t)nw, p.x, W_z, p.ln1g, p.ln1b, W_x1b);
        for (; t < T; t += nw) t_res_ln1<1>((size_t)t, (size_t)nw, p.x, W_z, p.ln1g, p.ln1b, W_x1b); }
    SEAM(6);
    if (PH(7)) {
        pg8::Gemm g; g.A = W_x1b; g.Bt = W_wq_t; g.M = T; g.N = D; g.K = D; EpiPlain E; E.O = W_qb; E.ldc = 1024;
        pg8::StaticOrder S; S.init(g.M, g.N, (int)gridDim.x, (int)blockIdx.x); pg8::gemm_phase<EpiPlain, pg8::StaticOrder, false>((PG8_LAS unsigned char*)lds, g, S, E, nullptr);
    }
    SEAM(7);
    if (PH(8)) { for (int u = blockIdx.x; u < (T / 256) * 8; u += gridDim.x) topk_unit(u, (LAS unsigned char*)lds, W_qb, W_subkb, W_eidx, W_gate); }
    SEAM(8);
    if (PH(9)) { const int ngrp = (int)(gridDim.x >> 3), tpc = ((T + ngrp - 1) / ngrp + 7) & ~7, sl_tok0 = (int)(blockIdx.x >> 3) * tpc, sl_tok1 = ((int)(blockIdx.x >> 3) < ngrp) ? (sl_tok0 + tpc < T ? sl_tok0 + tpc : T) : 0; peerU_phase((int)(blockIdx.x & 7), sl_tok0, sl_tok1, W_x1b, W_eidx, W_ub8, W_hp); }
    SEAM(9);
    if (PH(10)) { peerR_phase(W_hp, W_eidx, W_gate, W_usc, W_vsc, W_cbuf); }
    SEAM(10);
    if (PH(11)) { const int ngrp = (int)(gridDim.x >> 3), tpc = ((T + ngrp - 1) / ngrp + 7) & ~7, sl_tok0 = (int)(blockIdx.x >> 3) * tpc, sl_tok1 = ((int)(blockIdx.x >> 3) < ngrp) ? (sl_tok0 + tpc < T ? sl_tok0 + tpc : T) : 0; peerV_phase((int)(blockIdx.x & 7), sl_tok0, sl_tok1, W_cbuf, W_eidx, W_vb8, W_yp); }
    SEAM(11);
#ifdef PROBE_EXP
    if (PH(13)) { const int ngrp = (int)(gridDim.x >> 3), tpc = ((T + ngrp - 1) / ngrp + 7) & ~7, sl_tok0 = (int)(blockIdx.x >> 3) * tpc, sl_tok1 = ((int)(blockIdx.x >> 3) < ngrp) ? (sl_tok0 + tpc < T ? sl_tok0 + tpc : T) : 0;
        const int sl = (PROBE_EXP == 0) ? (int)(blockIdx.x & 7) : (int)((blockIdx.x + (blockIdx.x >> 3)) & 7);
#if PROBE_EXP == 20
        for (int rep = 0; rep < 20; ++rep) xcd_barrier(bar); (void)sl; (void)sl_tok0; (void)sl_tok1; }
#elif PROBE_EXP >= 10
        probe_valu((float*)(W_ws + 24 * MiB)); (void)sl; (void)sl_tok0; (void)sl_tok1; }
#else
        probe_gather(sl, sl_tok0, sl_tok1, W_eidx, W_ub8, (float*)(W_ws + 24 * MiB)); }
#endif
#endif
    if (PH(12)) { LAUNDER_TID int t = gw; for (; t + 3 * nw < T; t += 4 * nw) peerL_token<4>((size_t)t, (size_t)nw, W_x1b, W_yp, p.ln2g, p.ln2b, p.out);
        for (; t < T; t += nw) peerL_token<1>((size_t)t, (size_t)nw, W_x1b, W_yp, p.ln2g, p.ln2b, p.out); }
}

#ifndef MK_CUTS
#define MK_CUTS 0
#endif
extern "C" void kernel_launch(void* const* d_in, const int* in_sizes, int n_in, void* d_out, int out_size, void* d_ws, size_t ws_size, hipStream_t stream) {
    if (n_in != 19 || in_sizes[0] != T * D || out_size != T * D || ws_size < WS_END) { fprintf(stderr, "kernel_launch: unexpected shapes / workspace (%d inputs, ws %zu)\n", n_in, ws_size); return; }
    static int grid = 0;
    if (!grid) {
        int dev = 0, cus = 0, per_cu = 0;
        if (hipGetDevice(&dev) != hipSuccess || hipDeviceGetAttribute(&cus, hipDeviceAttributeMultiprocessorCount, dev) != hipSuccess) { fprintf(stderr, "kernel_launch: device query failed\n"); return; }
        if (hipFuncSetAttribute((const void*)mk_fwd, hipFuncAttributeMaxDynamicSharedMemorySize, LDS_BYTES) != hipSuccess) { fprintf(stderr, "kernel_launch: hipFuncSetAttribute failed\n"); return; }
        if (hipOccupancyMaxActiveBlocksPerMultiprocessor(&per_cu, (const void*)mk_fwd, NTHREADS, LDS_BYTES) != hipSuccess || per_cu < 1) { fprintf(stderr, "kernel_launch: occupancy query says %d\n", per_cu); return; }
        grid = cus;
    }
    Params p{};
    p.x = (const float*)d_in[0]; p.mem = (const float*)d_in[1]; p.relb = (const float*)d_in[2]; p.w_in = (const float*)d_in[3]; p.b_gate = (const float*)d_in[4]; p.w_memkv = (const float*)d_in[5];
    p.sinks = (const float*)d_in[6]; p.w_a = (const float*)d_in[7]; p.w_b = (const float*)d_in[8]; p.w_c = (const float*)d_in[9]; p.w_out = (const float*)d_in[10]; p.ln1g = (const float*)d_in[11];
    p.ln1b = (const float*)d_in[12]; p.w_q = (const float*)d_in[13]; p.subk = (const float*)d_in[14]; p.pu = (const float*)d_in[15]; p.pv = (const float*)d_in[16]; p.ln2g = (const float*)d_in[17];
    p.ln2b = (const float*)d_in[18]; p.out = (float*)d_out; p.ws = (char*)d_ws;
    if (hipMemsetAsync((char*)d_ws + WS_CTL, 0, CTL_ZERO_BYTES, stream) != hipSuccess) { fprintf(stderr, "kernel_launch: memset failed\n"); return; }
#if MK_CUTS
    for (int k = 0; k < 13; ++k) { p.lo = k; p.hi = k + 1; hipLaunchKernelGGL(mk_fwd, dim3(grid), dim3(NTHREADS), LDS_BYTES, stream, p); }
#else
#ifdef PROBE_SPLITK
    p.lo = 0; p.hi = PROBE_SPLITK + 1; hipLaunchKernelGGL(mk_fwd, dim3(grid), dim3(NTHREADS), LDS_BYTES, stream, p);
#ifndef PROBE_SPLITK_BASE
    (void)hipMemsetAsync((char*)d_ws + WS_CTL, 0, CTL_ZERO_BYTES, stream);
    p.lo = PROBE_SPLITK; p.hi = PROBE_SPLITK + 1; hipLaunchKernelGGL(mk_fwd, dim3(grid), dim3(NTHREADS), LDS_BYTES, stream, p);
#endif
    (void)hipMemsetAsync((char*)d_ws + WS_CTL, 0, CTL_ZERO_BYTES, stream);
    p.lo = PROBE_SPLITK + 1; p.hi = 13; hipLaunchKernelGGL(mk_fwd, dim3(grid), dim3(NTHREADS), LDS_BYTES, stream, p);
#else
    p.lo = 0; p.hi = 13; hipLaunchKernelGGL(mk_fwd, dim3(grid), dim3(NTHREADS), LDS_BYTES, stream, p);
#endif
#endif
#ifdef PROBE_EXP
    (void)hipMemsetAsync((char*)d_ws + WS_CTL, 0, CTL_ZERO_BYTES, stream);
    p.lo = 13; p.hi = 14; hipLaunchKernelGGL(mk_fwd, dim3(grid), dim3(NTHREADS), LDS_BYTES, stream, p);
#endif
#ifdef PROBE_RELAUNCH
    p.lo = PROBE_RELAUNCH; p.hi = PROBE_RELAUNCH + 1; hipLaunchKernelGGL(mk_fwd, dim3(grid), dim3(NTHREADS), LDS_BYTES, stream, p);
#endif
}
```

```cpp
#include <hip/hip_runtime.h>
#include <cstdio>
#include <cstdint>
namespace pg8 {
#define PG8_LAS __attribute__((address_space(3)))
typedef unsigned short bf16_t;
typedef short bf16x8 __attribute__((ext_vector_type(8)));
typedef float f32x4 __attribute__((ext_vector_type(4)));
typedef unsigned u32x4 __attribute__((ext_vector_type(4)));
constexpr int BM = 256, BK = 64, HALF = 128, HTB = HALF * BK * 2  , STAGE_BYTES = 8 * HTB, NXCD = 8, WGM = 8;

__host__ __device__ __forceinline__ int lds_byte(int r, int c) { const int st = (r >> 4) * 2 + (c >> 5), rr = r & 15, cc = c & 31, ob = rr * 64 + cc * 2; return st * 1024 + (ob ^ (((ob >> 9) & 1) << 5)); }
__host__ __device__ __forceinline__ void stage_rc(int b, int& R, int& C) { const int st = b / 1024, sb = b % 1024, swz = sb ^ (((sb >> 9) & 1) << 5); R = (st >> 1) * 16 + swz / 64; C = (st & 1) * 32 + (swz % 64) / 2; }
__host__ __device__ __forceinline__ int perm32(int rho) { const int n = rho >> 4, i = rho & 15; return 8 * (i >> 2) + 4 * n + (i & 3); }

struct Unit { int pm, pn; };
struct Gemm { const bf16_t* A; const bf16_t* Bt; int M, N, K; };

struct StaticOrder {
    int nM, nN, nwg, G, c;
    __host__ __device__ void init(int M, int N, int G_, int c_) { nM = M / BM; nN = N / BM; nwg = nM * nN; G = G_; c = c_; }
    __host__ __device__ bool next(int i, Unit& u) const {
        const long L = (long)i * G + c; if (L >= nwg) return false;
        int wgid = (int)L; { const int q = nwg / NXCD, r = nwg % NXCD, xcd = wgid % NXCD, off = wgid / NXCD; wgid = (xcd < r ? xcd * (q + 1) : r * (q + 1) + (xcd - r) * q) + off; }
        const int nig = WGM * nN, gid = wgid / nig, fm = gid * WGM, gsz = (nM - fm) < WGM ? (nM - fm) : WGM;
        u.pm = fm + ((wgid % nig) % gsz); u.pn = (wgid % nig) / gsz; return true;
    }
    __device__ __forceinline__ void a_ready(const Unit&) const {}
    __device__ __forceinline__ void done(const Unit&) const {}
};
__device__ __forceinline__ unsigned cvt_pk_bf16(float lo, float hi) { unsigned r; asm volatile("v_cvt_pk_bf16_f32 %0, %1, %2" : "=v"(r) : "v"(lo), "v"(hi)); return r; }
typedef float f32x2 __attribute__((ext_vector_type(2)));
__device__ __forceinline__ f32x2 gelu_pk(f32x2 v) {
    const f32x2 av = __builtin_elementwise_abs(v), d = av * 0.2316418882f + 1.0f;
    f32x2 t; t.x = __builtin_amdgcn_rcpf(d.x); t.y = __builtin_amdgcn_rcpf(d.y);
    f32x2 q = t * 0.5307027145f + (-0.7265760135f); q = q * t + 0.7107068705f; q = q * t + (-0.142248368f); q = q * t + 0.127414796f; q = q * t;
    const f32x2 s = (v * v) * (-0.72134752044f);
    f32x2 e; e.x = __builtin_amdgcn_exp2f(s.x); e.y = __builtin_amdgcn_exp2f(s.y);
    const f32x2 m = v * (q * e), r = v - m;
    f32x2 o; o.x = v.x < 0.f ? m.x : r.x; o.y = v.y < 0.f ? m.y : r.y; return o;
}
template <class Epi, class Sched, bool STAMP = false, bool FP8 = false, int XSCALE = 127>
__device__ __forceinline__ void gemm_phase(PG8_LAS unsigned char* lds, const Gemm g, const Sched& S, const Epi& E, unsigned long long* stamps) {
    int tid_l = threadIdx.x; asm volatile("" : "+v"(tid_l));
    const int tid = tid_l, wid = __builtin_amdgcn_readfirstlane(tid >> 6), lane = tid & 63, wr = wid >> 2, wc = wid & 3, fr = lane & 15, fq = lane >> 4;
    const int K = g.K, nt = K / BK;
    int ts_lo = 0, ts_hi = 0, nts = 0; const unsigned long long rt_entry = STAMP ? (unsigned long long)wall_clock64() : 0ull;
#define PG8_STAMP() do { if (STAMP && wid == 0 && nts < 64) { const unsigned long long _c = (unsigned long long)clock64(); \
        ts_lo = (lane == nts) ? (int)(unsigned)_c : ts_lo; ts_hi = (lane == nts) ? (int)(unsigned)(_c >> 32) : ts_hi; ++nts; } } while (0)
    PG8_STAMP();
    unsigned voffA[2], voffB[2];
#pragma unroll
    for (int i = 0; i < 2; ++i) { int R, C; stage_rc(tid * 16 + i * 8192, R, C); const int Rb = Epi::PERM ? ((R & ~31) + perm32(R & 31)) : R;
        voffA[i] = (unsigned)(R * K + C) * 2u; voffB[i] = (unsigned)(Rb * K + C) * 2u; }
    const size_t kstep = (size_t)(BK * 2);
    const size_t hstep = (size_t)HALF * K * 2;
    const size_t tstep = 2 * hstep;
    const unsigned ldsw = (unsigned)wid * 1024u;
    const int aoff = lds_byte(wr * 64 + fr, fq * 8), boff = lds_byte(wc * 32 + fr, fq * 8);
#define PG8_SA(b, h) (((b) * 2 + (h)) * HTB)
#define PG8_SB(b, h) ((4 + (b) * 2 + (h)) * HTB)
#define PG8_STAGE(bufoff, gbase, voff) do { _Pragma("unroll") for (int _i = 0; _i < 2; ++_i) \
        __builtin_amdgcn_global_load_lds((const unsigned*)((const char*)(gbase) + (voff)[_i]), (PG8_LAS unsigned*)(lds + (bufoff) + ldsw + _i * 8192), 16, 0, 0); } while (0)
#define PG8_LDA(dst, b, h) do { if constexpr (FP8) { _Pragma("unroll") for (int m = 0; m < 4; ++m) dst##8[m] = __builtin_shufflevector(*(const PG8_LAS i32x4_*)(lds + PG8_SA(b, h) + aoff + m * 2048), *(const PG8_LAS i32x4_*)(lds + PG8_SA(b, h) + aoff + m * 2048 + 1024), 0, 1, 2, 3, 4, 5, 6, 7); } \
        else { _Pragma("unroll") for (int m = 0; m < 4; ++m) _Pragma("unroll") for (int k = 0; k < 2; ++k) dst[m][k] = *(const PG8_LAS bf16x8*)(lds + PG8_SA(b, h) + aoff + m * 2048 + k * 1024); } } while (0)
#define PG8_LDB(dst, b, h) do { if constexpr (FP8) { _Pragma("unroll") for (int n = 0; n < 2; ++n) dst##8[n] = __builtin_shufflevector(*(const PG8_LAS i32x4_*)(lds + PG8_SB(b, h) + boff + n * 2048), *(const PG8_LAS i32x4_*)(lds + PG8_SB(b, h) + boff + n * 2048 + 1024), 0, 1, 2, 3, 4, 5, 6, 7); } \
        else { _Pragma("unroll") for (int n = 0; n < 2; ++n) _Pragma("unroll") for (int k = 0; k < 2; ++k) dst[n][k] = *(const PG8_LAS bf16x8*)(lds + PG8_SB(b, h) + boff + n * 2048 + k * 1024); } } while (0)
#define PG8_MMA(ai, bj, At, Bt) do { __builtin_amdgcn_s_setprio(1); _Pragma("unroll") for (int m = 0; m < 4; ++m) _Pragma("unroll") for (int n = 0; n < 2; ++n) { \
        if constexpr (FP8) asm volatile("v_mfma_scale_f32_16x16x128_f8f6f4 %0, %1, %2, %0, %3, %4 op_sel_hi:[0,0,0]" : "+v"(acc[ai][bj][m][n]) : "v"(Bt##8[n]), "v"(At##8[m]), "v"(scale_w), "v"(scale_x));        \
        else { _Pragma("unroll") for (int k = 0; k < 2; ++k) acc[ai][bj][m][n] = __builtin_amdgcn_mfma_f32_16x16x32_bf16(Bt[n][k], At[m][k], acc[ai][bj][m][n], 0, 0, 0); } } \
        __builtin_amdgcn_s_setprio(0); } while (0)
#define PG8_WAIT_V(n) asm volatile("s_waitcnt vmcnt(" #n ")" ::: "memory")
#define PG8_WAIT_L(n) asm volatile("s_waitcnt lgkmcnt(" #n ")" ::: "memory")
#define PG8_BAR __builtin_amdgcn_s_barrier()
#define PG8_SCHED __builtin_amdgcn_sched_barrier(0)
    Unit cur, nxt; int ui = 0;
    if (!S.next(0, cur)) return;
    f32x4 acc[2][2][4][2];
#pragma unroll
    for (int a = 0; a < 2; ++a)
#pragma unroll
        for (int b = 0; b < 2; ++b)
#pragma unroll
            for (int m = 0; m < 4; ++m)
#pragma unroll
                for (int n = 0; n < 2; ++n) acc[a][b][m][n] = (f32x4){0.f, 0.f, 0.f, 0.f};
    typedef int i32x4_ __attribute__((ext_vector_type(4))); typedef int i32x8_ __attribute__((ext_vector_type(8)));
    int scale_w = 122, scale_x = XSCALE; asm volatile("" : "+v"(scale_w), "+v"(scale_x));
    bf16x8 At[4][2], B0[2][2], B1[2][2]; i32x8_ At8[4], B08[2], B18[2];
    const char* cA = (const char*)g.A + (size_t)cur.pm * tstep; const char* cB = (const char*)g.Bt + (size_t)cur.pn * tstep;
    S.a_ready(cur);
    PG8_STAGE(PG8_SB(0, 0), cB, voffB); PG8_STAGE(PG8_SA(0, 0), cA, voffA); PG8_STAGE(PG8_SB(0, 1), cB + hstep, voffB); PG8_STAGE(PG8_SA(0, 1), cA + hstep, voffA);
    if (wr == 1) PG8_BAR;
    PG8_WAIT_V(4); PG8_BAR;
    PG8_STAGE(PG8_SB(1, 0), cB + kstep, voffB); PG8_STAGE(PG8_SA(1, 0), cA + kstep, voffA); PG8_STAGE(PG8_SB(1, 1), cB + hstep + kstep, voffB);
    PG8_WAIT_V(6); PG8_BAR;
    PG8_STAMP();
    for (;;) {
        const bool has_next = S.next(ui + 1, nxt);
        const char* nA = has_next ? (const char*)g.A + (size_t)nxt.pm * tstep : cA; const char* nB = has_next ? (const char*)g.Bt + (size_t)nxt.pn * tstep : cB;
        for (int t = 0; t < nt; t += 2) {
            const bool last = (t == nt - 2);
            const char* a1 = cA + (size_t)(t + 1) * kstep;
            const char* a2 = last ? nA : cA + (size_t)(t + 2) * kstep; const char* b2 = last ? nB : cB + (size_t)(t + 2) * kstep;
            const char* a3 = a2 + kstep; const char* b3 = b2 + kstep;
            if (last && has_next) S.a_ready(nxt);
            PG8_LDB(B0, 0, 0); PG8_SCHED; PG8_LDA(At, 0, 0); PG8_STAGE(PG8_SA(1, 1), a1 + hstep, voffA);
            PG8_WAIT_L(8); PG8_BAR; PG8_WAIT_L(0); PG8_MMA(0, 0, At, B0); PG8_BAR; PG8_SCHED;
            PG8_LDB(B1, 0, 1); PG8_STAGE(PG8_SB(0, 0), b2, voffB);
            PG8_BAR; PG8_WAIT_L(0); PG8_MMA(0, 1, At, B1); PG8_BAR;
            PG8_LDA(At, 0, 1); PG8_STAGE(PG8_SA(0, 0), a2, voffA);
            PG8_BAR; PG8_WAIT_L(0); PG8_MMA(1, 0, At, B0); PG8_BAR; PG8_SCHED;
            PG8_STAGE(PG8_SB(0, 1), b2 + hstep, voffB);
            PG8_WAIT_V(6); PG8_BAR; PG8_MMA(1, 1, At, B1); PG8_BAR;
            PG8_LDB(B0, 1, 0); PG8_SCHED; PG8_LDA(At, 1, 0); PG8_STAGE(PG8_SA(0, 1), a2 + hstep, voffA);
            PG8_WAIT_L(8); PG8_BAR; PG8_WAIT_L(0); PG8_MMA(0, 0, At, B0); PG8_BAR; PG8_SCHED;
            PG8_LDB(B1, 1, 1); PG8_STAGE(PG8_SB(1, 0), b3, voffB);
            PG8_BAR; PG8_WAIT_L(0); PG8_MMA(0, 1, At, B1); PG8_BAR;
            PG8_LDA(At, 1, 1); PG8_STAGE(PG8_SA(1, 0), a3, voffA);
            PG8_BAR; PG8_WAIT_L(0); PG8_MMA(1, 0, At, B0); PG8_BAR; PG8_SCHED;
            PG8_STAGE(PG8_SB(1, 1), b3 + hstep, voffB);
            PG8_WAIT_V(6); PG8_BAR; PG8_MMA(1, 1, At, B1); PG8_BAR;
        }
        PG8_STAMP();
        if constexpr (FP8) { asm volatile("s_nop 15\n\ts_nop 15" ::: "memory");
#pragma unroll
            for (int a = 0; a < 2; ++a)
#pragma unroll
                for (int b = 0; b < 2; ++b)
#pragma unroll
                    for (int m = 0; m < 4; ++m)
#pragma unroll
                        for (int n = 0; n < 2; ++n) asm volatile("" : "+v"(acc[a][b][m][n])); }
        if constexpr (!Epi::AFTER_DRAIN) { E(acc, cur, wr, wc, fr, fq); S.done(cur); }
        PG8_STAMP();
        if (!has_next) break;
#pragma unroll
        for (int a = 0; a < 2; ++a)
#pragma unroll
            for (int b = 0; b < 2; ++b)
#pragma unroll
                for (int m = 0; m < 4; ++m)
#pragma unroll
                    for (int n = 0; n < 2; ++n) acc[a][b][m][n] = (f32x4){0.f, 0.f, 0.f, 0.f};
        cur = nxt; cA = nA; cB = nB; ++ui;
    }
    PG8_WAIT_V(0);
    if (wr == 0) PG8_BAR;
    PG8_BAR;
    if constexpr (Epi::AFTER_DRAIN) { E.fused(acc, cur, wr, wc, fr, fq, lds, wid, lane); S.done(cur); }
    PG8_STAMP();
    if (STAMP && wid == 0) { stamps[lane] = lane < nts ? (((unsigned long long)(unsigned)ts_hi << 32) | (unsigned)ts_lo) : 0ull;
        if (lane == 62) stamps[62] = rt_entry; if (lane == 63) stamps[63] = (unsigned long long)wall_clock64(); }
#undef PG8_STAMP
#undef PG8_SA
#undef PG8_SB
#undef PG8_STAGE
#undef PG8_LDA
#undef PG8_LDB
#undef PG8_MMA
#undef PG8_WAIT_V
#undef PG8_WAIT_L
#undef PG8_BAR
#undef PG8_SCHED
}
}

namespace pg8 {
struct MergeArgs { const bf16_t* A[3]; const bf16_t* Bt[3]; int K[3]; const bf16_t* gates; unsigned char* mb; };
template <class Sched, bool FP8 = false>
__device__ __forceinline__ void gemm_phase_merge(PG8_LAS unsigned char* lds, const MergeArgs g, const Sched& S) {
    int tid_l = threadIdx.x; asm volatile("" : "+v"(tid_l));
    const int tid = tid_l, wid = __builtin_amdgcn_readfirstlane(tid >> 6), lane = tid & 63, wr = wid >> 2, wc = wid & 3, fr = lane & 15, fq = lane >> 4;
    unsigned R2A[2], R2B[2], C2[2];
#pragma unroll
    for (int i = 0; i < 2; ++i) { int R, C; stage_rc(tid * 16 + i * 8192, R, C); const int Rb = (R & ~31) + perm32(R & 31); R2A[i] = (unsigned)R * 2u; R2B[i] = (unsigned)Rb * 2u; C2[i] = (unsigned)C * 2u; }
    const size_t kstep = (size_t)(BK * 2);
    const unsigned ldsw = (unsigned)wid * 1024u;
    const int aoff = lds_byte(wr * 64 + fr, fq * 8), boff = lds_byte(wc * 32 + fr, fq * 8);
#define PG8_SA(b, h) (((b) * 2 + (h)) * HTB)
#define PG8_SB(b, h) ((4 + (b) * 2 + (h)) * HTB)
#define PG8_STAGEK(bufoff, gbase, R2, KK) do { _Pragma("unroll") for (int _i = 0; _i < 2; ++_i) \
        __builtin_amdgcn_global_load_lds((const unsigned*)((const char*)(gbase) + (R2)[_i] * (unsigned)(KK) + C2[_i]), (PG8_LAS unsigned*)(lds + (bufoff) + ldsw + _i * 8192), 16, 0, 0); } while (0)
#define PG8_LDA(dst, b, h) do { if constexpr (FP8) { _Pragma("unroll") for (int m = 0; m < 4; ++m) dst##8[m] = __builtin_shufflevector(*(const PG8_LAS i32x4_*)(lds + PG8_SA(b, h) + aoff + m * 2048), *(const PG8_LAS i32x4_*)(lds + PG8_SA(b, h) + aoff + m * 2048 + 1024), 0, 1, 2, 3, 4, 5, 6, 7); } \
        else { _Pragma("unroll") for (int m = 0; m < 4; ++m) _Pragma("unroll") for (int k = 0; k < 2; ++k) dst[m][k] = *(const PG8_LAS bf16x8*)(lds + PG8_SA(b, h) + aoff + m * 2048 + k * 1024); } } while (0)
#define PG8_LDB(dst, b, h) do { if constexpr (FP8) { _Pragma("unroll") for (int n = 0; n < 2; ++n) dst##8[n] = __builtin_shufflevector(*(const PG8_LAS i32x4_*)(lds + PG8_SB(b, h) + boff + n * 2048), *(const PG8_LAS i32x4_*)(lds + PG8_SB(b, h) + boff + n * 2048 + 1024), 0, 1, 2, 3, 4, 5, 6, 7); } \
        else { _Pragma("unroll") for (int n = 0; n < 2; ++n) _Pragma("unroll") for (int k = 0; k < 2; ++k) dst[n][k] = *(const PG8_LAS bf16x8*)(lds + PG8_SB(b, h) + boff + n * 2048 + k * 1024); } } while (0)
#define PG8_MMA(ai, bj, At, Bt) do { __builtin_amdgcn_s_setprio(1); _Pragma("unroll") for (int m = 0; m < 4; ++m) _Pragma("unroll") for (int n = 0; n < 2; ++n) { \
        if constexpr (FP8) asm volatile("v_mfma_scale_f32_16x16x128_f8f6f4 %0, %1, %2, %0, %3, %4 op_sel_hi:[0,0,0]" : "+v"(acc[ai][bj][m][n]) : "v"(Bt##8[n]), "v"(At##8[m]), "v"(scale_w), "v"(scale_x)); \
        else { _Pragma("unroll") for (int k = 0; k < 2; ++k) acc[ai][bj][m][n] = __builtin_amdgcn_mfma_f32_16x16x32_bf16(Bt[n][k], At[m][k], acc[ai][bj][m][n], 0, 0, 0); } } \
        __builtin_amdgcn_s_setprio(0); } while (0)
#define PG8_WAIT_V(n) asm volatile("s_waitcnt vmcnt(" #n ")" ::: "memory")
#define PG8_WAIT_L(n) asm volatile("s_waitcnt lgkmcnt(" #n ")" ::: "memory")
#define PG8_BAR __builtin_amdgcn_s_barrier()
#define PG8_SCHED __builtin_amdgcn_sched_barrier(0)
    Unit cur, nxt; int ui = 0, seg = 0;
    if (!S.next(0, cur)) return;
    f32x4 acc[2][2][4][2];
#pragma unroll
    for (int a = 0; a < 2; ++a)
#pragma unroll
        for (int b = 0; b < 2; ++b)
#pragma unroll
            for (int m = 0; m < 4; ++m)
#pragma unroll
                for (int n = 0; n < 2; ++n) acc[a][b][m][n] = (f32x4){0.f, 0.f, 0.f, 0.f};
    typedef int i32x4_ __attribute__((ext_vector_type(4))); typedef int i32x8_ __attribute__((ext_vector_type(8)));
    int scale_w = 122, scale_x = 123; asm volatile("" : "+v"(scale_w), "+v"(scale_x));
    bf16x8 At[4][2], B0[2][2], B1[2][2]; i32x8_ At8[4], B08[2], B18[2];
    int Kc = g.K[0];
    const char* cA = (const char*)g.A[0] + (size_t)cur.pm * 512 * Kc; const char* cB = (const char*)g.Bt[0] + (size_t)cur.pn * 512 * Kc;
    {   const size_t hs = (size_t)256 * Kc;
        PG8_STAGEK(PG8_SB(0, 0), cB, R2B, Kc); PG8_STAGEK(PG8_SA(0, 0), cA, R2A, Kc); PG8_STAGEK(PG8_SB(0, 1), cB + hs, R2B, Kc); PG8_STAGEK(PG8_SA(0, 1), cA + hs, R2A, Kc);
        if (wr == 1) PG8_BAR;
        PG8_WAIT_V(4); PG8_BAR;
        PG8_STAGEK(PG8_SB(1, 0), cB + kstep, R2B, Kc); PG8_STAGEK(PG8_SA(1, 0), cA + kstep, R2A, Kc); PG8_STAGEK(PG8_SB(1, 1), cB + hs + kstep, R2B, Kc);
        PG8_WAIT_V(6); PG8_BAR; }
    for (;;) {
        bool has_next_tile = false; int nseg = seg + 1; Unit nu = cur;
        if (nseg == 3) { nseg = 0; has_next_tile = S.next(ui + 1, nxt); nu = nxt; }
        const bool more = (seg < 2) || has_next_tile;
        const int Kn = more ? (nseg == 0 ? g.K[0] : (nseg == 1 ? g.K[1] : g.K[2])) : Kc;
        const bf16_t* gA = nseg == 0 ? g.A[0] : (nseg == 1 ? g.A[1] : g.A[2]); const bf16_t* gB = nseg == 0 ? g.Bt[0] : (nseg == 1 ? g.Bt[1] : g.Bt[2]);
        const char* nA = more ? (const char*)gA + (size_t)nu.pm * 512 * Kn : cA; const char* nB = more ? (const char*)gB + (size_t)nu.pn * 512 * Kn : cB;
        const int nt = Kc / BK; const size_t hsc = (size_t)256 * Kc, hsn = (size_t)256 * Kn;
        for (int t = 0; t < nt; t += 2) {
            const bool last = (t == nt - 2);
            const char* a1 = cA + (size_t)(t + 1) * kstep;
            const char* a2 = last ? nA : cA + (size_t)(t + 2) * kstep; const char* b2 = last ? nB : cB + (size_t)(t + 2) * kstep;
            const char* a3 = a2 + kstep; const char* b3 = b2 + kstep;
            const int K2 = last ? Kn : Kc; const size_t hs2 = last ? hsn : hsc;
            PG8_LDB(B0, 0, 0); PG8_SCHED; PG8_LDA(At, 0, 0); PG8_STAGEK(PG8_SA(1, 1), a1 + hsc, R2A, Kc);
            PG8_WAIT_L(8); PG8_BAR; PG8_WAIT_L(0); PG8_MMA(0, 0, At, B0); PG8_BAR; PG8_SCHED;
            PG8_LDB(B1, 0, 1); PG8_STAGEK(PG8_SB(0, 0), b2, R2B, K2);
            PG8_BAR; PG8_WAIT_L(0); PG8_MMA(0, 1, At, B1); PG8_BAR;
            PG8_LDA(At, 0, 1); PG8_STAGEK(PG8_SA(0, 0), a2, R2A, K2);
            PG8_BAR; PG8_WAIT_L(0); PG8_MMA(1, 0, At, B0); PG8_BAR; PG8_SCHED;
            PG8_STAGEK(PG8_SB(0, 1), b2 + hs2, R2B, K2);
            PG8_WAIT_V(6); PG8_BAR; PG8_MMA(1, 1, At, B1); PG8_BAR;
            PG8_LDB(B0, 1, 0); PG8_SCHED; PG8_LDA(At, 1, 0); PG8_STAGEK(PG8_SA(0, 1), a2 + hs2, R2A, K2);
            PG8_WAIT_L(8); PG8_BAR; PG8_WAIT_L(0); PG8_MMA(0, 0, At, B0); PG8_BAR; PG8_SCHED;
            PG8_LDB(B1, 1, 1); PG8_STAGEK(PG8_SB(1, 0), b3, R2B, K2);
            PG8_BAR; PG8_WAIT_L(0); PG8_MMA(0, 1, At, B1); PG8_BAR;
            PG8_LDA(At, 1, 1); PG8_STAGEK(PG8_SA(1, 0), a3, R2A, K2);
            PG8_BAR; PG8_WAIT_L(0); PG8_MMA(1, 0, At, B0); PG8_BAR; PG8_SCHED;
            PG8_STAGEK(PG8_SB(1, 1), b3 + hs2, R2B, K2);
            PG8_WAIT_V(6); PG8_BAR; PG8_MMA(1, 1, At, B1); PG8_BAR;
        }
        if constexpr (FP8) { asm volatile("s_nop 15\n\ts_nop 15" ::: "memory");
#pragma unroll
            for (int a = 0; a < 2; ++a)
#pragma unroll
                for (int b = 0; b < 2; ++b)
#pragma unroll
                    for (int mm = 0; mm < 4; ++mm)
#pragma unroll
                        for (int n = 0; n < 2; ++n) asm volatile("" : "+v"(acc[a][b][mm][n])); }
        {   const int row0 = cur.pm * 256 + wr * 64 + fr, col0 = cur.pn * 256 + wc * 32 + 8 * fq;
            const unsigned char* gb_s = (const unsigned char*)g.gates + ((size_t)(seg * 128 + cur.pm) * 4 + cur.pn) * 65536 + (size_t)tid * 16;
            const unsigned char* gb_n = gb_s + (size_t)128 * 4 * 65536;
            u32x4 GS[2][2], GN[2][2]; typedef float f32x2_m __attribute__((ext_vector_type(2)));
#define MRG_LOAD(buf, bt) do { _Pragma("unroll") for (int cp = 0; cp < 2; ++cp) { GS[buf][cp] = *(const u32x4*)(gb_s + (size_t)(((bt) * 2 + cp) * 512) * 16); \
                GN[buf][cp] = (seg < 2) ? *(const u32x4*)(gb_n + (size_t)(((bt) * 2 + cp) * 512) * 16) : (u32x4){0x38383838u, 0x38383838u, 0x38383838u, 0x38383838u}; } } while (0)
#define MRG_APPLY(buf, bt) do { _Pragma("unroll") for (int c = 0; c < 4; ++c) { const int idx = (bt) * 4 + c, ai = idx >> 3, m = (idx >> 1) & 3, bj = idx & 1; \
                const unsigned gs0 = bj ? GS[buf][c >> 1].z : GS[buf][c >> 1].x, gs1 = bj ? GS[buf][c >> 1].w : GS[buf][c >> 1].y, gn0 = bj ? GN[buf][c >> 1].z : GN[buf][c >> 1].x, gn1 = bj ? GN[buf][c >> 1].w : GN[buf][c >> 1].y; \
                const f32x2_m fa = __builtin_amdgcn_cvt_pk_f32_fp8((int)gs0, false), fb = __builtin_amdgcn_cvt_pk_f32_fp8((int)gs0, true), fc = __builtin_amdgcn_cvt_pk_f32_fp8((int)gs1, false), fd = __builtin_amdgcn_cvt_pk_f32_fp8((int)gs1, true); \
                const f32x2_m da = __builtin_amdgcn_cvt_pk_f32_fp8((int)gn0, false), db = __builtin_amdgcn_cvt_pk_f32_fp8((int)gn0, true), dc = __builtin_amdgcn_cvt_pk_f32_fp8((int)gn1, false), dd = __builtin_amdgcn_cvt_pk_f32_fp8((int)gn1, true); \
                float f[8] = {fa.x, fa.y, fb.x, fb.y, fc.x, fc.y, fd.x, fd.y}; const float d[8] = {da.x, da.y, db.x, db.y, dc.x, dc.y, dd.x, dd.y}; \
                _Pragma("unroll") for (int j = 0; j < 8; ++j) f[j] = d[j] * __builtin_amdgcn_rcpf(f[j]);        \
                f32x4 v0 = acc[ai][bj][m][0], v1 = acc[ai][bj][m][1]; \
                v0[0] *= f[0]; v0[1] *= f[1]; v0[2] *= f[2]; v0[3] *= f[3]; v1[0] *= f[4]; v1[1] *= f[5]; v1[2] *= f[6]; v1[3] *= f[7]; \
                if (seg < 2) { acc[ai][bj][m][0] = v0; acc[ai][bj][m][1] = v1; } \
                else { typedef unsigned u32x2_ __attribute__((ext_vector_type(2))); u32x2_ w; int t8 = 0; t8 = __builtin_amdgcn_cvt_pk_fp8_f32(v0[0] * 0.25f, v0[1] * 0.25f, t8, false); t8 = __builtin_amdgcn_cvt_pk_fp8_f32(v0[2] * 0.25f, v0[3] * 0.25f, t8, true); w.x = (unsigned)t8; \
                    t8 = 0; t8 = __builtin_amdgcn_cvt_pk_fp8_f32(v1[0] * 0.25f, v1[1] * 0.25f, t8, false); t8 = __builtin_amdgcn_cvt_pk_fp8_f32(v1[2] * 0.25f, v1[3] * 0.25f, t8, true); w.y = (unsigned)t8; \
                    *(u32x2_*)(g.mb + (size_t)(row0 + ai * 128 + m * 16) * 1024 + col0 + bj * 128) = w;        \
                    acc[ai][bj][m][0] = (f32x4){0.f, 0.f, 0.f, 0.f}; acc[ai][bj][m][1] = (f32x4){0.f, 0.f, 0.f, 0.f}; } } } while (0)
            MRG_LOAD(0, 0);
#pragma unroll
            for (int bt = 0; bt < 4; bt += 2) {
                MRG_LOAD(1, bt + 1); asm volatile("" ::: "memory"); MRG_APPLY(0, bt);
                if (bt + 2 < 4) { MRG_LOAD(0, bt + 2); } asm volatile("" ::: "memory"); MRG_APPLY(1, bt + 1); }
#undef MRG_LOAD
#undef MRG_APPLY
        }
        if (!more) break;
        if (nseg == 0) { cur = nxt; ++ui; }
        seg = nseg; Kc = Kn; cA = nA; cB = nB;
    }
    PG8_WAIT_V(0);
    if (wr == 0) PG8_BAR;
    PG8_BAR;
#undef PG8_SA
#undef PG8_SB
#undef PG8_STAGEK
#undef PG8_LDA
#undef PG8_LDB
#undef PG8_MMA
#undef PG8_WAIT_V
#undef PG8_WAIT_L
#undef PG8_BAR
#undef PG8_SCHED
}
}
#define XB_TMO      128
#define XB_XCNT(j)  (256  + 64 * (j))
#define XB_XSUB(j)  (1280 + 64 * (j))
#define XB_XGEN(j)  (2304 + 64 * (j))
#define XB_TOP      3328
#define XB_TOPGEN   3392
#define XCD_BAR_WORDS 3456
#define XB_SPIN_CAP (1u << 18)
#define LAS __attribute__((address_space(3)))

__device__ __forceinline__ unsigned xb_ld(unsigned* p)              { return __hip_atomic_load(p, __ATOMIC_RELAXED, __HIP_MEMORY_SCOPE_AGENT); }
__device__ __forceinline__ unsigned xb_add(unsigned* p, unsigned v) { return __hip_atomic_fetch_add(p, v, __ATOMIC_RELAXED, __HIP_MEMORY_SCOPE_AGENT); }
__device__ __forceinline__ unsigned xb_xcc_id() { return (unsigned)__builtin_amdgcn_s_getreg((3 << 11) | 20) & 0xFu; }
#define XB_SPIN(cond, bar) do { unsigned _sp = 0; while (cond) { __builtin_amdgcn_s_sleep(1); \
    if ((++_sp & 255u) == 0u) { if (xb_ld(&(bar)[XB_TMO])) break; if (_sp > XB_SPIN_CAP) { atomicAdd(&(bar)[XB_TMO], 1u); break; } } } } while (0)

struct XcdBarrier {
    unsigned* bar; unsigned x;
    volatile LAS unsigned* st;
};

__device__ __forceinline__ XcdBarrier xcd_barrier_post(unsigned* bar, volatile LAS unsigned* st) {
    XcdBarrier b; b.bar = bar; b.x = xb_xcc_id(); b.st = st;
    if (threadIdx.x == 0) (void)xb_add(&bar[XB_XCNT(b.x)], 1u);
    return b;
}
__device__ __forceinline__ void xcd_barrier_complete(unsigned* bar, unsigned x, unsigned& nloc, unsigned& nx) {
    const unsigned G = gridDim.x * gridDim.y * gridDim.z;
    unsigned sum, cnt, mine, sp = 0u;
    for (;;) {
        sum = 0u; cnt = 0u; mine = 0u;
#pragma unroll
        for (unsigned j = 0; j < 16; ++j) { const unsigned c = xb_ld(&bar[XB_XCNT(j)]); sum += c; cnt += (c > 0u) ? 1u : 0u; mine = (j == x) ? c : mine; }
        if (sum == G) break;
        __builtin_amdgcn_s_sleep(1);
        if ((++sp & 255u) == 0u) { if (xb_ld(&bar[XB_TMO])) break; if (sp > XB_SPIN_CAP) { atomicAdd(&bar[XB_TMO], 1u); break; } }
    }
    nloc = mine > 0u ? mine : 1u; nx = cnt > 0u ? cnt : 1u;
}

__device__ __forceinline__ void xcd_barrier(const XcdBarrier& b) {
    asm volatile("s_waitcnt vmcnt(0)" ::: "memory");
    __syncthreads();
    if (threadIdx.x == 0) {
        unsigned* bar = b.bar;
        __builtin_amdgcn_s_waitcnt(0);
        unsigned nloc = b.st[0], nx = b.st[1];
        if (nloc == 0u) { xcd_barrier_complete(bar, b.x, nloc, nx); b.st[0] = nloc; b.st[1] = nx; }
        const unsigned old = xb_add(&bar[XB_XSUB(b.x)], 1u);
        const unsigned gen = old / nloc;
        if (old + 1u == (gen + 1u) * nloc) {
            __builtin_amdgcn_fence(__ATOMIC_RELEASE, "agent");
            asm volatile("s_waitcnt vmcnt(0)" ::: "memory");
            const unsigned og = xb_add(&bar[XB_TOP], 1u);
            const unsigned tg = og / nx;
            if (og + 1u == (tg + 1u) * nx) xb_add(&bar[XB_TOPGEN], 1u);
            else XB_SPIN(xb_ld(&bar[XB_TOPGEN]) == tg, bar);
            __builtin_amdgcn_fence(__ATOMIC_ACQUIRE, "agent");
            xb_add(&bar[XB_XGEN(b.x)], 1u);
            asm volatile("s_waitcnt vmcnt(0)" ::: "memory");
        } else {
            XB_SPIN(xb_ld(&bar[XB_XGEN(b.x)]) == gen, bar);
            __builtin_amdgcn_fence(__ATOMIC_ACQUIRE, "agent");
            asm volatile("s_waitcnt vmcnt(0)" ::: "memory");
        }
    }
    __syncthreads();
}


typedef unsigned short bf16_t;
typedef float f32x4 __attribute__((ext_vector_type(4)));
typedef unsigned u32x4 __attribute__((ext_vector_type(4)));
typedef unsigned u32x2 __attribute__((ext_vector_type(2)));
typedef __bf16 bf16x2_t __attribute__((ext_vector_type(2)));
constexpr int D = 1024, BATCH = 8, SEQ = 4096, T = BATCH * SEQ, MEMLEN = 256;
constexpr int HQW = 3584, GW = 3072, INW = 6656, NEXP = 16384;
constexpr int C_AQ = 0, C_AK = 768, C_AV = 1536, C_BQ = 2304, C_BK = 2816, C_BV = 2944, C_CQ = 3072;
constexpr float ALPHA = 1.189207115002721f, LOG2E = 1.4426950408889634f, LN2F = 0.6931471805599453f, LN_EPS = 1e-5f, NEGBIG = -1e30f;
constexpr size_t MiB = 1u << 20;
#ifndef DBG_CHECK
#define DBG_CHECK 0
#endif
#ifndef DBG_DROP
#define DBG_DROP 0
#endif
constexpr size_t WS_CTL = 0, WS_WMEMKV = 1 * MiB, WS_WA = 3 * MiB, WS_WB = WS_WA + MiB / 2, WS_WC = WS_WB + MiB, WS_WOUT = WS_WC + MiB, WS_WQ = WS_WOUT + 2 * MiB,
                 WS_SUBK = WS_WQ + 2 * MiB, WS_MEMB = 10 * MiB, WS_KVM = 14 * MiB, WS_STATS = 18 * MiB, WS_LSE = 19 * MiB;
constexpr size_t WS_RA = 24 * MiB, WS_RB = 248 * MiB, WS_RC = 440 * MiB, WS_END = 504 * MiB;
constexpr size_t WS_HQ = WS_RA, WS_GATES = WS_RB, WS_XB = WS_RC;
constexpr size_t WS_MF = WS_RA, WS_MB = WS_RA + 128 * MiB;
constexpr size_t WS_Z = WS_RB, WS_X1B = WS_RB + 128 * MiB;
constexpr size_t WS_Q = WS_RA, WS_EIDX = WS_RA + 88 * MiB - 24 * MiB, WS_GATE = WS_EIDX + 16 * MiB;
constexpr size_t WS_UB = WS_RC, WS_VB = WS_RC + 32 * MiB;
constexpr size_t DO_WINT = 0;
constexpr size_t DO_OA = 0, DO_YB = 48 * MiB, DO_YC = 80 * MiB, DO_YA = 112 * MiB;

__device__ __forceinline__ size_t hq_off64(int slot, size_t tok) { return ((size_t)slot * T + tok) * 64; }
__device__ __forceinline__ size_t hq_offc(int head, size_t tok) { return (size_t)48 * T * 64 + ((size_t)head * T + tok) * 128; }
__device__ const unsigned char kBucket[3][132] = {
{0,1,2,3,4,5,6,7,8,9,10,11,12,13,14,15,16,16,16,16,16,16,17,17,17,17,17,17,17,17,18,18,18,18,18,18,18,18,18,18,19,19,19,19,19,19,19,19,19,19,19,19,19,19,20,20,20,20,20,20,20,20,20,20,20,20,20,20,20,20,20,20,20,21,21,21,21,21,21,21,21,21,21,21,21,21,21,21,21,21,21,21,21,21,21,21,21,21,21,22,22,22,22,22,22,22,22,22,22,22,22,22,22,22,22,22,22,22,22,22,22,22,22,22,22,22,22,22,22,22,22,22},
{0,4,8,12,16,16,17,17,18,18,19,19,19,19,20,20,20,20,20,21,21,21,21,21,21,22,22,22,22,22,22,22,22,22,23,23,23,23,23,23,23,23,23,23,23,23,24,24,24,24,24,24,24,24,24,24,24,24,24,24,24,24,25,25,25,25,25,25,25,25,25,25,25,25,25,25,25,25,25,25,25,25,25,26,26,26,26,26,26,26,26,26,26,26,26,26,26,26,26,26,26,26,26,26,26,26,26,26,26,26,26,26,26,27,27,27,27,27,27,27,27,27,27,27,27,27,27,27,27,27,27,27},
{0,16,18,19,20,21,21,22,22,23,23,23,24,24,24,24,25,25,25,25,25,26,26,26,26,26,26,26,26,27,27,27,27,27,27,27,27,27,27,28,28,28,28,28,28,28,28,28,28,28,28,28,29,29,29,29,29,29,29,29,29,29,29,29,29,29,29,29,29,29,30,30,30,30,30,30,30,30,30,30,30,30,30,30,30,30,30,30,30,30,30,30,30,30,30,31,31,31,31,31,31,31,31,31,31,31,31,31,31,31,31,31,31,31,31,31,31,31,31,31,31,31,31,31,31,31,31,31,31,31,31,31}};

__device__ __forceinline__ bf16_t f2bf(float x) { unsigned u = __float_as_uint(x); u += 0x7fffu + ((u >> 16) & 1u); return (bf16_t)(u >> 16); }
__device__ __forceinline__ float bf2f(bf16_t h) { return __uint_as_float((unsigned)h << 16); }
__device__ __forceinline__ float bflo(unsigned w) { return __uint_as_float(w << 16); }
__device__ __forceinline__ float bfhi(unsigned w) { return __uint_as_float(w & 0xffff0000u); }
__device__ __forceinline__ unsigned pk2(float lo, float hi) { bf16x2_t v; v.x = (__bf16)lo; v.y = (__bf16)hi; return __builtin_bit_cast(unsigned, v); }
__device__ __forceinline__ float dot2bf(unsigned a, unsigned b, float acc) { return __builtin_amdgcn_fdot2_f32_bf16(__builtin_bit_cast(bf16x2_t, a), __builtin_bit_cast(bf16x2_t, b), acc, false); }
__device__ __forceinline__ float wave_sum(float v) { for (int o = 32; o >= 1; o >>= 1) v += __shfl_xor(v, o, 64); return v; }
__device__ __forceinline__ float wave_max(float v) { for (int o = 32; o >= 1; o >>= 1) v = fmaxf(v, __shfl_xor(v, o, 64)); return v; }

struct EpiIn {
    static constexpr bool PERM = true, AFTER_DRAIN = false;
    bf16_t* hq; bf16_t* gates; const float* bgate;
    __device__ __forceinline__ void operator()(const pg8::f32x4 (&acc)[2][2][4][2], const pg8::Unit& u, int wr, int wc, int fr, int fq) const {
        const int row0 = u.pm * 256 + wr * 64 + fr;
        if (u.pn < 14) {
            const float sc = (u.pn < 3 || u.pn == 9 || u.pn == 10) ? 0.125f * LOG2E : ((u.pn >= 12) ? 0.08838834764831845f * LOG2E : 1.0f);
            const int col0 = u.pn * 256 + wc * 32 + 8 * fq;
#pragma unroll
            for (int ai = 0; ai < 2; ++ai)
#pragma unroll
                for (int m = 0; m < 4; ++m) { const size_t tok = (size_t)(row0 + ai * 128 + m * 16);
#pragma unroll
                    for (int bj = 0; bj < 2; ++bj) { const pg8::f32x4 v0 = acc[ai][bj][m][0] * sc, v1 = acc[ai][bj][m][1] * sc; const int col = col0 + bj * 128;
                        u32x4 w; w.x = pk2(v0[0], v0[1]); w.y = pk2(v0[2], v0[3]); w.z = pk2(v1[0], v1[1]); w.w = pk2(v1[2], v1[3]);
                        bf16_t* dst = (col < 3072) ? hq + hq_off64(col >> 6, tok) + (col & 63) : hq + hq_offc((col - 3072) >> 7, tok) + ((col - 3072) & 127);
                        *(u32x4*)dst = w; } }
        } else {
            const int gi = u.pn - 14, s = gi >> 2, pn = gi & 3, col0 = gi * 256 + wc * 32 + 8 * fq, tid = (wr * 4 + wc) * 64 + fq * 16 + fr;
            unsigned char* blk = (unsigned char*)gates + ((size_t)(s * 128 + u.pm) * 4 + pn) * 65536 + (size_t)tid * 16;
            pg8::f32x4 bv[2][2];
#pragma unroll
            for (int bj = 0; bj < 2; ++bj)
#pragma unroll
                for (int n = 0; n < 2; ++n) bv[bj][n] = *(const pg8::f32x4*)(bgate + col0 + bj * 128 + 4 * n) * (-LOG2E);
#pragma unroll
            for (int ai = 0; ai < 2; ++ai)
#pragma unroll
                for (int m = 0; m < 4; ++m) { u32x4 w;
#pragma unroll
                    for (int bj = 0; bj < 2; ++bj) { pg8::f32x4 v0 = acc[ai][bj][m][0] * (-LOG2E) + bv[bj][0], v1 = acc[ai][bj][m][1] * (-LOG2E) + bv[bj][1];
#pragma unroll
                        for (int j = 0; j < 4; ++j) { v0[j] = fminf(__builtin_amdgcn_exp2f(v0[j]), 16384.0f) * 0.015625f + 0.015625f; v1[j] = fminf(__builtin_amdgcn_exp2f(v1[j]), 16384.0f) * 0.015625f + 0.015625f; }
                        int t8 = 0; t8 = __builtin_amdgcn_cvt_pk_fp8_f32(v0[0], v0[1], t8, false); t8 = __builtin_amdgcn_cvt_pk_fp8_f32(v0[2], v0[3], t8, true); w[2 * bj] = (unsigned)t8;
                        t8 = 0; t8 = __builtin_amdgcn_cvt_pk_fp8_f32(v1[0], v1[1], t8, false); t8 = __builtin_amdgcn_cvt_pk_fp8_f32(v1[2], v1[3], t8, true); w[2 * bj + 1] = (unsigned)t8; }
                    *(u32x4*)(blk + (size_t)((ai * 4 + m) * 512) * 16) = w; }
        }
    }
};
struct EpiPlain {
    static constexpr bool PERM = true, AFTER_DRAIN = false;
    bf16_t* O; int ldc;
    __device__ __forceinline__ void operator()(const pg8::f32x4 (&acc)[2][2][4][2], const pg8::Unit& u, int wr, int wc, int fr, int fq) const {
        const int row0 = u.pm * 256 + wr * 64 + fr, col0 = u.pn * 256 + wc * 32 + 8 * fq;
#pragma unroll
        for (int ai = 0; ai < 2; ++ai)
#pragma unroll
            for (int m = 0; m < 4; ++m) { bf16_t* rowp = O + (size_t)(row0 + ai * 128 + m * 16) * ldc + col0;
#pragma unroll
                for (int bj = 0; bj < 2; ++bj) { const pg8::f32x4 v0 = acc[ai][bj][m][0], v1 = acc[ai][bj][m][1];
                    u32x4 w; w.x = pk2(v0[0], v0[1]); w.y = pk2(v0[2], v0[3]); w.z = pk2(v1[0], v1[1]); w.w = pk2(v1[2], v1[3]);
                    *(u32x4*)(rowp + bj * 128) = w; } }
    }
};
struct EpiOut {
    static constexpr bool PERM = true, AFTER_DRAIN = false;
    const float* x; bf16_t* z; float* stats;
    __device__ __forceinline__ void operator()(const pg8::f32x4 (&acc)[2][2][4][2], const pg8::Unit& u, int wr, int wc, int fr, int fq) const {
        const int row0 = u.pm * 256 + wr * 64 + fr, col0 = u.pn * 256 + wc * 32 + 8 * fq;
#pragma unroll
        for (int ai = 0; ai < 2; ++ai)
#pragma unroll
            for (int m = 0; m < 4; ++m) { const size_t row = (size_t)(row0 + ai * 128 + m * 16); float s = 0.f, ss = 0.f;
#pragma unroll
                for (int bj = 0; bj < 2; ++bj) { const size_t o = row * D + col0 + bj * 128;
                    pg8::f32x4 v0 = *(const pg8::f32x4*)(x + o) * ALPHA + acc[ai][bj][m][0], v1 = *(const pg8::f32x4*)(x + o + 4) * ALPHA + acc[ai][bj][m][1];
                    { u32x4 w; w.x = pk2(v0[0], v0[1]); w.y = pk2(v0[2], v0[3]); w.z = pk2(v1[0], v1[1]); w.w = pk2(v1[2], v1[3]); *(u32x4*)(z + o) = w; }
#pragma unroll
                    for (int j = 0; j < 4; ++j) { s += v0[j] + v1[j]; ss += v0[j] * v0[j] + v1[j] * v1[j]; } }
                s += __shfl_xor(s, 16, 64); ss += __shfl_xor(ss, 16, 64); s += __shfl_xor(s, 32, 64); ss += __shfl_xor(ss, 32, 64);
                if (fq == 0) { atomicAdd(stats + row * 2, s); atomicAdd(stats + row * 2 + 1, ss); } }
    }
};

__device__ __forceinline__ void t_mix(size_t i, const bf16_t* __restrict__ oA, const float* __restrict__ lseA, bf16_t* __restrict__ ya) {
    const size_t t = i >> 5; const int col = (int)(i & 31) * 8, h = col >> 6; const size_t e = t * 256 + col;
    const float l0 = lseA[((size_t)0 * T + t) * 4 + h], l1 = lseA[((size_t)1 * T + t) * 4 + h], l2 = lseA[((size_t)2 * T + t) * 4 + h];
    const u32x4 a = *(const u32x4*)(oA + e), b = *(const u32x4*)(oA + (size_t)T * 256 + e), c = *(const u32x4*)(oA + (size_t)2 * T * 256 + e);
    const float mx = fmaxf(l0, fmaxf(l1, l2)), e0 = __expf(l0 - mx), e1 = __expf(l1 - mx), e2 = __expf(l2 - mx), inv = 1.f / (e0 + e1 + e2); float w0 = e0 * inv, w1 = e1 * inv, w2 = e2 * inv;
    w0 *= 16.f; w1 *= 16.f; w2 *= 16.f;
    u32x2 o; int t8 = 0;
    t8 = __builtin_amdgcn_cvt_pk_fp8_f32(w0 * bflo(a.x) + w1 * bflo(b.x) + w2 * bflo(c.x), w0 * bfhi(a.x) + w1 * bfhi(b.x) + w2 * bfhi(c.x), t8, false); t8 = __builtin_amdgcn_cvt_pk_fp8_f32(w0 * bflo(a.y) + w1 * bflo(b.y) + w2 * bflo(c.y), w0 * bfhi(a.y) + w1 * bfhi(b.y) + w2 * bfhi(c.y), t8, true); o.x = (unsigned)t8;
    t8 = 0; t8 = __builtin_amdgcn_cvt_pk_fp8_f32(w0 * bflo(a.z) + w1 * bflo(b.z) + w2 * bflo(c.z), w0 * bfhi(a.z) + w1 * bfhi(b.z) + w2 * bfhi(c.z), t8, false); t8 = __builtin_amdgcn_cvt_pk_fp8_f32(w0 * bflo(a.w) + w1 * bflo(b.w) + w2 * bflo(c.w), w0 * bfhi(a.w) + w1 * bfhi(b.w) + w2 * bfhi(c.w), t8, true); o.y = (unsigned)t8;
    *(u32x2*)((unsigned char*)ya + e) = o;
}
template <int NT>
__device__ __forceinline__ void t_res_ln1(size_t t0, size_t tstride, const float* __restrict__ x, const bf16_t* __restrict__ mo, const float* g, const float* b, bf16_t* __restrict__ x1b) {
    const int lane = threadIdx.x & 63, c = 16 * lane;
    f32x4 xv[NT][4]; u32x4 mv[NT][2];
#pragma unroll
    for (int k = 0; k < NT; ++k) { const size_t t = t0 + k * tstride;
#pragma unroll
        for (int q = 0; q < 4; ++q) xv[k][q] = *(const f32x4*)(x + t * D + c + 4 * q);
        mv[k][0] = *(const u32x4*)(mo + t * D + c); mv[k][1] = *(const u32x4*)(mo + t * D + c + 8); }
    f32x4 gg[4], bb[4];
#pragma unroll
    for (int q = 0; q < 4; ++q) { gg[q] = *(const f32x4*)(g + c + 4 * q); bb[q] = *(const f32x4*)(b + c + 4 * q); }
#pragma unroll
    for (int k = 0; k < NT; ++k) { const size_t t = t0 + k * tstride;
        const float mm[16] = {bflo(mv[k][0].x), bfhi(mv[k][0].x), bflo(mv[k][0].y), bfhi(mv[k][0].y), bflo(mv[k][0].z), bfhi(mv[k][0].z), bflo(mv[k][0].w), bfhi(mv[k][0].w),
                              bflo(mv[k][1].x), bfhi(mv[k][1].x), bflo(mv[k][1].y), bfhi(mv[k][1].y), bflo(mv[k][1].z), bfhi(mv[k][1].z), bflo(mv[k][1].w), bfhi(mv[k][1].w)};
        float zz[16]; float s = 0.f;
#pragma unroll
        for (int i = 0; i < 16; ++i) { zz[i] = ALPHA * xv[k][i >> 2][i & 3] + mm[i]; s += zz[i]; }
        const float mean = wave_sum(s) * (1.f / D); float ss = 0.f;
#pragma unroll
        for (int i = 0; i < 16; ++i) { const float d = zz[i] - mean; ss += d * d; }
        const float rstd = rsqrtf(wave_sum(ss) * (1.f / D) + LN_EPS);
        float y[16];
#pragma unroll
        for (int i = 0; i < 16; ++i) y[i] = (zz[i] - mean) * rstd * gg[i >> 2][i & 3] + bb[i >> 2][i & 3];
        u32x4 w0, w1; w0.x = pk2(y[0], y[1]); w0.y = pk2(y[2], y[3]); w0.z = pk2(y[4], y[5]); w0.w = pk2(y[6], y[7]); w1.x = pk2(y[8], y[9]); w1.y = pk2(y[10], y[11]); w1.z = pk2(y[12], y[13]); w1.w = pk2(y[14], y[15]);
        *(u32x4*)(x1b + t * D + c) = w0; *(u32x4*)(x1b + t * D + c + 8) = w1; }
}
typedef float f32x2 __attribute__((ext_vector_type(2)));
__device__ __forceinline__ void cvt_row_fp8_finish(const f32x4 a, const f32x4 b, const f32x4 c, const f32x4 d, unsigned char* __restrict__ dst, float* __restrict__ inv_scale, int row, int lane) {
    float mx = 0.f;
#pragma unroll
    for (int j = 0; j < 4; ++j) mx = fmaxf(mx, fmaxf(fmaxf(fabsf(a[j]), fabsf(b[j])), fmaxf(fabsf(c[j]), fabsf(d[j]))));
    mx = wave_max(mx);
    const unsigned E = (__float_as_uint(mx) >> 23) & 255u;
    const float sc = (E == 0u || E > 250u) ? 1.0f : __uint_as_float((260u - E) << 23), isc = (E == 0u || E > 250u) ? 1.0f : __uint_as_float((E - 6u) << 23);
    u32x4 w; int t;
    t = 0; t = __builtin_amdgcn_cvt_pk_fp8_f32(a[0] * sc, a[1] * sc, t, false); t = __builtin_amdgcn_cvt_pk_fp8_f32(a[2] * sc, a[3] * sc, t, true); w.x = (unsigned)t;
    t = 0; t = __builtin_amdgcn_cvt_pk_fp8_f32(b[0] * sc, b[1] * sc, t, false); t = __builtin_amdgcn_cvt_pk_fp8_f32(b[2] * sc, b[3] * sc, t, true); w.y = (unsigned)t;
    t = 0; t = __builtin_amdgcn_cvt_pk_fp8_f32(c[0] * sc, c[1] * sc, t, false); t = __builtin_amdgcn_cvt_pk_fp8_f32(c[2] * sc, c[3] * sc, t, true); w.z = (unsigned)t;
    t = 0; t = __builtin_amdgcn_cvt_pk_fp8_f32(d[0] * sc, d[1] * sc, t, false); t = __builtin_amdgcn_cvt_pk_fp8_f32(d[2] * sc, d[3] * sc, t, true); w.w = (unsigned)t;
    *(u32x4*)(dst + (size_t)row * D + 16 * lane) = w;
    if (lane == 0) inv_scale[row] = isc;
}
__device__ __forceinline__ void cvt_rows_fp8(const float* __restrict__ pu, const float* __restrict__ pv, unsigned char* __restrict__ ub8, unsigned char* __restrict__ vb8, float* __restrict__ usc, float* __restrict__ vsc, int r0, int r1) {
    const int lane = threadIdx.x & 63;
    const float* s0 = pu + (size_t)r0 * D + 16 * lane; const float* s1 = pv + (size_t)r0 * D + 16 * lane; const float* s2 = pu + (size_t)r1 * D + 16 * lane; const float* s3 = pv + (size_t)r1 * D + 16 * lane;
    f32x4 q[4][4];
#pragma unroll
    for (int j = 0; j < 4; ++j) { q[0][j] = ((const f32x4*)s0)[j]; q[1][j] = ((const f32x4*)s1)[j]; q[2][j] = ((const f32x4*)s2)[j]; q[3][j] = ((const f32x4*)s3)[j]; }
    cvt_row_fp8_finish(q[0][0], q[0][1], q[0][2], q[0][3], ub8, usc, r0, lane); cvt_row_fp8_finish(q[1][0], q[1][1], q[1][2], q[1][3], vb8, vsc, r0, lane);
    cvt_row_fp8_finish(q[2][0], q[2][1], q[2][2], q[2][3], ub8, usc, r1, lane); cvt_row_fp8_finish(q[3][0], q[3][1], q[3][2], q[3][3], vb8, vsc, r1, lane);
}
__device__ __forceinline__ float xsel_add(float keep_lo, float keep_hi, bool hi, int mask) {
    const float send = hi ? keep_lo : keep_hi, keep = hi ? keep_hi : keep_lo; return keep + __shfl_xor(send, mask, 64);
}

typedef short s16x4 __attribute__((ext_vector_type(4)));
constexpr int NTHREADS_ = 512;
#define ATT_M0 (-30000.0f)
__device__ __forceinline__ float red_max_16_32(float x) { typedef unsigned u2_ __attribute__((ext_vector_type(2)));
    u2_ r = __builtin_amdgcn_permlane16_swap(__float_as_uint(x), __float_as_uint(x), false, false); x = fmaxf(__uint_as_float(r.x), __uint_as_float(r.y));
    r = __builtin_amdgcn_permlane32_swap(__float_as_uint(x), __float_as_uint(x), false, false); return fmaxf(__uint_as_float(r.x), __uint_as_float(r.y)); }
__device__ __forceinline__ float red_sum_16_32(float x) { typedef unsigned u2_ __attribute__((ext_vector_type(2)));
    u2_ r = __builtin_amdgcn_permlane16_swap(__float_as_uint(x), __float_as_uint(x), false, false); x = __uint_as_float(r.x) + __uint_as_float(r.y);
    r = __builtin_amdgcn_permlane32_swap(__float_as_uint(x), __float_as_uint(x), false, false); return __uint_as_float(r.x) + __uint_as_float(r.y); }
template <int DH, int PITCH, class MaskF>
__device__ __forceinline__ void attn_step(const pg8::bf16x8 (&qf)[DH / 32], LAS unsigned char* kl, LAS unsigned char* vl, int t0, int t1, const MaskF& mf, float& m, float& l, f32x4 (&oT)[DH / 16]) {
    const int lane = threadIdx.x & 63, r16 = lane & 15, kq = lane >> 4;
    f32x4 s0 = {0.f, 0.f, 0.f, 0.f}, s1 = {0.f, 0.f, 0.f, 0.f};
    LAS unsigned char* ka0 = kl + (16 * t0 + r16) * PITCH + 16 * kq; LAS unsigned char* ka1 = kl + (16 * t1 + r16) * PITCH + 16 * kq;
#pragma unroll
    for (int s = 0; s < DH / 32; ++s) { const pg8::bf16x8 a0 = *(const LAS pg8::bf16x8*)(ka0 + 64 * s), a1 = *(const LAS pg8::bf16x8*)(ka1 + 64 * s);
        s0 = __builtin_amdgcn_mfma_f32_16x16x32_bf16(a0, qf[s], s0, 0, 0, 0); s1 = __builtin_amdgcn_mfma_f32_16x16x32_bf16(a1, qf[s], s1, 0, 0, 0); }
    float mx = -1e30f;
#pragma unroll
    for (int j = 0; j < 4; ++j) { s0[j] = mf(t0, 4 * kq + j, s0[j]); s1[j] = mf(t1, 4 * kq + j, s1[j]); mx = fmaxf(mx, fmaxf(s0[j], s1[j])); }
    mx = red_max_16_32(mx);
    const float mn = fmaxf(m, mx), sc = __builtin_amdgcn_exp2f(m - mn);
    float rs = 0.f;
#pragma unroll
    for (int j = 0; j < 4; ++j) { s0[j] = __builtin_amdgcn_exp2f(s0[j] - mn); s1[j] = __builtin_amdgcn_exp2f(s1[j] - mn); rs += s0[j] + s1[j]; }
    rs = red_sum_16_32(rs);
    l = l * sc + rs; m = mn;
    u32x4 pw; pw.x = pk2(s0[0], s0[1]); pw.y = pk2(s0[2], s0[3]); pw.z = pk2(s1[0], s1[1]); pw.w = pk2(s1[2], s1[3]);
    const pg8::bf16x8 pb = __builtin_bit_cast(pg8::bf16x8, pw);
    const int q = r16 >> 2, p = r16 & 3;
    LAS unsigned char* va0 = vl + (16 * t0 + 4 * kq + q) * PITCH + 8 * p; LAS unsigned char* va1 = vl + (16 * t1 + 4 * kq + q) * PITCH + 8 * p;
#pragma unroll
    for (int dt = 0; dt < DH / 16; ++dt) {
        const s16x4 lo = __builtin_amdgcn_ds_read_tr16_b64_v4i16((LAS s16x4*)(va0 + 32 * dt)), hi = __builtin_amdgcn_ds_read_tr16_b64_v4i16((LAS s16x4*)(va1 + 32 * dt));
        const pg8::bf16x8 va = __builtin_shufflevector(lo, hi, 0, 1, 2, 3, 4, 5, 6, 7);
        oT[dt] = oT[dt] * sc; oT[dt] = __builtin_amdgcn_mfma_f32_16x16x32_bf16(va, pb, oT[dt], 0, 0, 0); }
}
__device__ __forceinline__ void lds_put16(LAS unsigned char* dst, const bf16_t* src) { *(LAS u32x4*)dst = src ? *(const u32x4*)src : (u32x4){0u, 0u, 0u, 0u}; }

constexpr int ATT_KV64 = 272 * 160;
__device__ __forceinline__ void attnA_fetch(int u, int tid, u32x4 (&pfc)[8], float& tabv, const bf16_t* __restrict__ hq, const float* __restrict__ relb) {
    asm volatile("" : "+v"(tid));
    const int h = u & 3, rn = (u >> 2) & 31, b = (u >> 7) & 7, g = u >> 10;
    const int r = (g == 0) ? 1 : (g == 1 ? 4 : 16), nblk = 32 / r, rho = rn / nblk, n = rn % nblk, tb = b * SEQ;
    const bf16_t* kcol = hq + hq_off64(12 + g * 4 + h, 0); const bf16_t* vcol = hq + hq_off64(24 + g * 4 + h, 0);
#pragma unroll
    for (int i = 0; i < 8; ++i) { const int idx = tid + NTHREADS_ * i, isv = idx >> 11, i2 = idx & 2047, row = i2 >> 3, ch = i2 & 7, pos = (n - 1) * 128 + row;
        pfc[i] = (pos >= 0) ? *(const u32x4*)((isv ? vcol : kcol) + (size_t)(tb + rho + r * pos) * 64 + ch * 8) : (u32x4){0u, 0u, 0u, 0u}; }
    tabv = (tid < 129) ? relb[kBucket[g][tid] * 20 + g * 4 + h] * LOG2E : 0.f;
}
__device__ __forceinline__ void attnAB_store(int tid, const u32x4 (&pfc)[8], float tabv, LAS unsigned char* lds, int ntab) {
    asm volatile("" : "+v"(tid));
    LAS unsigned char* kl = lds; LAS unsigned char* vl = lds + ATT_KV64; LAS float* tab = (LAS float*)(lds + 2 * ATT_KV64);
#pragma unroll
    for (int i = 0; i < 8; ++i) { const int idx = tid + NTHREADS_ * i, isv = idx >> 11, i2 = idx & 2047, row = i2 >> 3, ch = i2 & 7; *(LAS u32x4*)((isv ? vl : kl) + row * 160 + ch * 16) = pfc[i]; }
    if (tid < 320) { const int isv = tid >= 160, i2 = isv ? tid - 160 : tid; *(LAS u32x4*)((isv ? vl : kl) + 256 * 160 + i2 * 16) = (u32x4){0u, 0u, 0u, 0u}; }
    if (tid < ntab) tab[tid] = tabv;
}
__device__ __forceinline__ void attnA_compute(int u, int tid, LAS unsigned char* lds, const bf16_t* __restrict__ hq, bf16_t* __restrict__ oA, float* __restrict__ lseA) {
    asm volatile("" : "+v"(tid));
    const int h = u & 3, rn = (u >> 2) & 31, b = (u >> 7) & 7, g = u >> 10;
    const int r = (g == 0) ? 1 : (g == 1 ? 4 : 16), nblk = 32 / r, rho = rn / nblk, n = rn % nblk, tb = b * SEQ;
    LAS unsigned char* kl = lds; LAS unsigned char* vl = lds + ATT_KV64; LAS float* tab = (LAS float*)(lds + 2 * ATT_KV64);
    const int w = tid >> 6, lane = tid & 63, r16 = lane & 15, kq = lane >> 4, qi = 16 * w + r16, kmin = (n == 0) ? 128 : 0;
    const size_t tq = (size_t)(tb + rho + r * (n * 128 + qi));
    pg8::bf16x8 qf[2];
#pragma unroll
    for (int s = 0; s < 2; ++s) qf[s] = *(const pg8::bf16x8*)(hq + hq_off64(g * 4 + h, tq) + 32 * s + 8 * kq);
    float m = ATT_M0, l = 0.f; f32x4 oT[4];
#pragma unroll
    for (int dt = 0; dt < 4; ++dt) oT[dt] = (f32x4){0.f, 0.f, 0.f, 0.f};
    auto mf = [&](int tile, int kr, float s) -> float { const int kk = 16 * tile + kr, off = qi + 128 - kk; const bool ok = (off >= 0) && (off <= 128) && (kk >= kmin);
        const int oc = off < 0 ? 0 : (off > 128 ? 128 : off); return ok ? s + tab[oc] : -1e30f; };
    auto mfi = [&](int tile, int kr, float s) -> float { return s + tab[qi + 128 - 16 * tile - kr]; };
    attn_step<64, 160>(qf, kl, vl, w, w + 1, mf, m, l, oT);
    if (n != 0) { for (int st = 1; st < 4; ++st) attn_step<64, 160>(qf, kl, vl, w + 2 * st, w + 2 * st + 1, mfi, m, l, oT); }
    else { for (int st = 1; st < 4; ++st) attn_step<64, 160>(qf, kl, vl, w + 2 * st, w + 2 * st + 1, mf, m, l, oT); }
    attn_step<64, 160>(qf, kl, vl, w + 8, w + 9, mf, m, l, oT);
    const float inv = 1.0f / l;
    bf16_t* op = oA + ((size_t)g * T + tq) * 256 + h * 64 + 4 * kq;
#pragma unroll
    for (int dt = 0; dt < 4; ++dt) { u32x2 wv; wv.x = pk2(oT[dt][0] * inv, oT[dt][1] * inv); wv.y = pk2(oT[dt][2] * inv, oT[dt][3] * inv); *(u32x2*)(op + 16 * dt) = wv; }
    if (kq == 0) lseA[((size_t)g * T + tq) * 4 + h] = (m + __builtin_amdgcn_logf(l)) * LN2F;
}
__device__ __forceinline__ void attnB_fetch(int u, int tid, u32x4 (&pfc)[8], float& tabv, const bf16_t* __restrict__ hq, const float* __restrict__ relb) {
    asm volatile("" : "+v"(tid));
    const int kvh = u & 1, n = (u >> 1) & 31, b = u >> 6, tb = b * SEQ;
    const bf16_t* kcol = hq + hq_off64(44 + kvh, 0); const bf16_t* vcol = hq + hq_off64(46 + kvh, 0);
#pragma unroll
    for (int i = 0; i < 8; ++i) { const int idx = tid + NTHREADS_ * i, isv = idx >> 11, i2 = idx & 2047, row = i2 >> 3, ch = i2 & 7, pos = (n - 1) * 128 + row;
        pfc[i] = (pos >= 0) ? *(const u32x4*)((isv ? vcol : kcol) + (size_t)(tb + pos) * 64 + ch * 8) : (u32x4){0u, 0u, 0u, 0u}; }
    { const int hd = tid >> 7, off = tid & 127; tabv = relb[kBucket[0][off] * 20 + 12 + kvh * 4 + hd] * LOG2E; }
}
__device__ __forceinline__ void attnB_compute(int u, int tid, LAS unsigned char* lds, const bf16_t* __restrict__ hq, const float* __restrict__ sinks, bf16_t* __restrict__ yb) {
    asm volatile("" : "+v"(tid));
    const int kvh = u & 1, n = (u >> 1) & 31, b = u >> 6, tb = b * SEQ;
    LAS unsigned char* kl = lds; LAS unsigned char* vl = lds + ATT_KV64; LAS float* tab = (LAS float*)(lds + 2 * ATT_KV64);
    const int w = tid >> 6, lane = tid & 63, r16 = lane & 15, kq = lane >> 4, kmin = (n == 0) ? 128 : 0;
    for (int i = 0; i < 4; ++i) {
        const int task = w + 8 * i, hd = task >> 3, sub = task & 7, head = kvh * 4 + hd, qi = 16 * sub + r16;
        const size_t tq = (size_t)(tb + n * 128 + qi);
        pg8::bf16x8 qf[2];
#pragma unroll
        for (int s = 0; s < 2; ++s) qf[s] = *(const pg8::bf16x8*)(hq + hq_off64(36 + head, tq) + 32 * s + 8 * kq);
        float m = sinks[head] * LOG2E, l = 1.0f; f32x4 oT[4];
#pragma unroll
        for (int dt = 0; dt < 4; ++dt) oT[dt] = (f32x4){0.f, 0.f, 0.f, 0.f};
        LAS float* tb_h = tab + hd * 128;
        auto mf = [&](int tile, int kr, float s) -> float { const int kk = 16 * tile + kr, off = qi + 128 - kk; const bool ok = (off >= 0) && (off <= 127) && (kk >= kmin);
            const int oc = off < 0 ? 0 : (off > 127 ? 127 : off); return ok ? s + tb_h[oc] : -1e30f; };
        auto mfi = [&](int tile, int kr, float s) -> float { return s + tb_h[qi + 128 - 16 * tile - kr]; };
        attn_step<64, 160>(qf, kl, vl, sub, sub + 1, mf, m, l, oT);
        if (n != 0) { for (int st = 1; st < 4; ++st) attn_step<64, 160>(qf, kl, vl, sub + 2 * st, sub + 2 * st + 1, mfi, m, l, oT); }
        else { for (int st = 1; st < 4; ++st) attn_step<64, 160>(qf, kl, vl, sub + 2 * st, sub + 2 * st + 1, mf, m, l, oT); }
        attn_step<64, 160>(qf, kl, vl, sub + 8, sub + 9, mf, m, l, oT);
        const float inv = 1.0f / l;
        const float inv16 = inv * 16.f; unsigned char* op = (unsigned char*)yb + tq * 512 + head * 64 + 4 * kq;
#pragma unroll
        for (int dt = 0; dt < 4; ++dt) { int t8 = 0; t8 = __builtin_amdgcn_cvt_pk_fp8_f32(oT[dt][0] * inv16, oT[dt][1] * inv16, t8, false); t8 = __builtin_amdgcn_cvt_pk_fp8_f32(oT[dt][2] * inv16, oT[dt][3] * inv16, t8, true); *(unsigned*)(op + 16 * dt) = (unsigned)t8; }
    }
}
__device__ __forceinline__ void attnAB_phase(LAS unsigned char* lds, const bf16_t* __restrict__ hq, const float* __restrict__ relb, const float* __restrict__ sinks, bf16_t* __restrict__ oA, float* __restrict__ lseA, bf16_t* __restrict__ yb) {
    int tid = threadIdx.x; asm volatile("" : "+v"(tid));
    u32x4 pfc[8]; float tabv = 0.f;
    int u = blockIdx.x;
    if (u < 3072) attnA_fetch(u, tid, pfc, tabv, hq, relb);
    for (; u < 3072; u += gridDim.x) {
        attnAB_store(tid, pfc, tabv, lds, 129);
        __syncthreads();
        const int un = u + gridDim.x;
        if (un < 3072) attnA_fetch(un, tid, pfc, tabv, hq, relb); else if ((int)blockIdx.x < 512) attnB_fetch((int)blockIdx.x, tid, pfc, tabv, hq, relb);
        attnA_compute(u, tid, lds, hq, oA, lseA);
        __syncthreads();
    }
    u = blockIdx.x;
    if (3072 <= (int)blockIdx.x && u < 512) attnB_fetch(u, tid, pfc, tabv, hq, relb);
    for (; u < 512; u += gridDim.x) {
        attnAB_store(tid, pfc, tabv, lds, 512);
        __syncthreads();
        const int un = u + gridDim.x;
        if (un < 512) attnB_fetch(un, tid, pfc, tabv, hq, relb);
        attnB_compute(u, tid, lds, hq, sinks, yb);
        __syncthreads();
    }
}
__device__ __forceinline__ void attnC_unit(int u, LAS unsigned char* lds, const bf16_t* __restrict__ hq, const bf16_t* __restrict__ kvm, bf16_t* __restrict__ yc) {
    int tid = threadIdx.x; asm volatile("" : "+v"(tid));
    const int qc = u & 7, head = (u >> 3) & 3, b = u >> 5, tb = b * SEQ;
    constexpr int CP = 272, IMG = 256 * CP;
    LAS unsigned char* kl = lds; LAS unsigned char* vl = lds + IMG;
    for (int idx = tid; idx < 8192; idx += NTHREADS_) { const int isv = idx >> 12, i2 = idx & 4095, row = i2 >> 4, ch = i2 & 15;
        lds_put16((isv ? vl : kl) + row * CP + ch * 16, kvm + (size_t)(b * MEMLEN + row) * 1024 + isv * 512 + head * 128 + ch * 8); }
    __syncthreads();
    const int w = tid >> 6, lane = tid & 63, r16 = lane & 15, kq = lane >> 4;
    auto mf = [&](int, int, float s) -> float { return s; };
    for (int qt = 0; qt < 4; ++qt) {
        const size_t tq = (size_t)(tb + qc * 512 + qt * 128 + 16 * w + r16);
        pg8::bf16x8 qf[4];
#pragma unroll
        for (int s = 0; s < 4; ++s) qf[s] = *(const pg8::bf16x8*)(hq + hq_offc(head, tq) + 32 * s + 8 * kq);
        float m = ATT_M0, l = 0.f; f32x4 oT[8];
#pragma unroll
        for (int dt = 0; dt < 8; ++dt) oT[dt] = (f32x4){0.f, 0.f, 0.f, 0.f};
        for (int st = 0; st < 8; ++st) attn_step<128, CP>(qf, kl, vl, 2 * st, 2 * st + 1, mf, m, l, oT);
        const float inv = 1.0f / l;
        const float inv16 = inv * 16.f; unsigned char* op = (unsigned char*)yc + tq * 512 + head * 128 + 4 * kq;
#pragma unroll
        for (int dt = 0; dt < 8; ++dt) { int t8 = 0; t8 = __builtin_amdgcn_cvt_pk_fp8_f32(oT[dt][0] * inv16, oT[dt][1] * inv16, t8, false); t8 = __builtin_amdgcn_cvt_pk_fp8_f32(oT[dt][2] * inv16, oT[dt][3] * inv16, t8, true); *(unsigned*)(op + 16 * dt) = (unsigned)t8; }
    }
    __syncthreads();
}

#define CE_DESC(a, b) do { const unsigned _mx = (a) > (b) ? (a) : (b), _mn = (a) > (b) ? (b) : (a); (a) = _mx; (b) = _mn; } while (0)
__device__ __forceinline__ void sort16_desc(unsigned (&v)[16]) {
    CE_DESC(v[0], v[13]); CE_DESC(v[1], v[12]); CE_DESC(v[2], v[15]); CE_DESC(v[3], v[14]); CE_DESC(v[4], v[8]); CE_DESC(v[5], v[6]); CE_DESC(v[7], v[11]); CE_DESC(v[9], v[10]);
    CE_DESC(v[0], v[5]); CE_DESC(v[1], v[7]); CE_DESC(v[2], v[9]); CE_DESC(v[3], v[4]); CE_DESC(v[6], v[13]); CE_DESC(v[8], v[14]); CE_DESC(v[10], v[15]); CE_DESC(v[11], v[12]);
    CE_DESC(v[0], v[1]); CE_DESC(v[2], v[3]); CE_DESC(v[4], v[5]); CE_DESC(v[6], v[8]); CE_DESC(v[7], v[9]); CE_DESC(v[10], v[11]); CE_DESC(v[12], v[13]); CE_DESC(v[14], v[15]);
    CE_DESC(v[0], v[2]); CE_DESC(v[1], v[3]); CE_DESC(v[4], v[10]); CE_DESC(v[5], v[11]); CE_DESC(v[6], v[7]); CE_DESC(v[8], v[9]); CE_DESC(v[12], v[14]); CE_DESC(v[13], v[15]);
    CE_DESC(v[1], v[2]); CE_DESC(v[3], v[12]); CE_DESC(v[4], v[6]); CE_DESC(v[5], v[7]); CE_DESC(v[8], v[10]); CE_DESC(v[9], v[11]); CE_DESC(v[13], v[14]);
    CE_DESC(v[1], v[4]); CE_DESC(v[2], v[6]); CE_DESC(v[5], v[8]); CE_DESC(v[7], v[10]); CE_DESC(v[9], v[13]); CE_DESC(v[11], v[14]);
    CE_DESC(v[2], v[4]); CE_DESC(v[3], v[6]); CE_DESC(v[9], v[12]); CE_DESC(v[11], v[13]);
    CE_DESC(v[3], v[5]); CE_DESC(v[6], v[8]); CE_DESC(v[7], v[9]); CE_DESC(v[10], v[12]);
    CE_DESC(v[3], v[4]); CE_DESC(v[5], v[6]); CE_DESC(v[7], v[8]); CE_DESC(v[9], v[10]); CE_DESC(v[11], v[12]);
    CE_DESC(v[6], v[7]); CE_DESC(v[8], v[9]);
}
__device__ __forceinline__ void bitonic_merge16_desc(unsigned (&v)[16]) {
#pragma unroll
    for (int j = 8; j > 0; j >>= 1)
#pragma unroll
        for (int i = 0; i < 16; ++i) { const int p = i ^ j; if (p > i) CE_DESC(v[i], v[p]); }
}
__device__ __forceinline__ void top16_merge(unsigned (&a)[16], const unsigned (&b)[16]) {
#pragma unroll
    for (int i = 0; i < 16; ++i) a[i] = a[i] > b[15 - i] ? a[i] : b[15 - i];
    bitonic_merge16_desc(a);
}
__device__ __forceinline__ unsigned f2key(float f) { const unsigned u = __float_as_uint(f); return u ^ ((unsigned)((int)u >> 31) | 0x80000000u); }
__device__ __forceinline__ float key2f(unsigned k) { return __uint_as_float((k & 0x80000000u) ? (k ^ 0x80000000u) : ~k); }

constexpr int TK_KIMG = 128 * 144;
__device__ __forceinline__ void topk_unit(int u, LAS unsigned char* lds, const bf16_t* __restrict__ qb, const bf16_t* __restrict__ subk, unsigned short* __restrict__ eidx, float* __restrict__ gate) {
    int tid = threadIdx.x; asm volatile("" : "+v"(tid));
    const int h = u & 7, tile = u >> 3;
    typedef float f32x16 __attribute__((ext_vector_type(16)));
    for (int idx = tid; idx < 2048; idx += NTHREADS_) { const int row = idx >> 3, ch = idx & 7;
        *(LAS u32x4*)(lds + row * 144 + ch * 16) = *(const u32x4*)(subk + ((size_t)(h * 256 + row)) * 64 + ch * 8); }
    __syncthreads();
    const int w = tid >> 6, lane = tid & 63, r32 = lane & 31, hh = lane >> 5;
    const size_t tok = (size_t)tile * 256 + w * 32 + r32;
    unsigned top[2][16];
#pragma unroll
    for (int c = 0; c < 2; ++c) {
        pg8::bf16x8 qf[4];
#pragma unroll
        for (int s = 0; s < 4; ++s) qf[s] = *(const pg8::bf16x8*)(qb + tok * D + h * 128 + c * 64 + 16 * s + 8 * hh);
        unsigned key[4][16];
#pragma unroll
        for (int kt = 0; kt < 4; ++kt) { f32x16 acc;
#pragma unroll
            for (int i = 0; i < 16; ++i) acc[i] = 0.f;
#pragma unroll
            for (int s = 0; s < 4; ++s) { const pg8::bf16x8 a = *(const LAS pg8::bf16x8*)(lds + c * TK_KIMG + (32 * kt + r32) * 144 + (16 * s + 8 * hh) * 2);
                acc = __builtin_amdgcn_mfma_f32_32x32x16_bf16(a, qf[s], acc, 0, 0, 0); }
            const unsigned lowb = 127u - 4u * hh - 32u * kt;
#pragma unroll
            for (int i = 0; i < 16; ++i) key[kt][i] = (f2key(acc[i]) & 0xFFFFFF80u) | (lowb - (unsigned)((i & 3) + 8 * (i >> 2)));
            sort16_desc(key[kt]); }
        top16_merge(key[0], key[1]); top16_merge(key[2], key[3]); top16_merge(key[0], key[2]);
        unsigned other[16];
#pragma unroll
        for (int i = 0; i < 16; ++i) other[i] = (unsigned)__shfl_xor((int)key[0][i], 32, 64);
        top16_merge(key[0], other);
#pragma unroll
        for (int i = 0; i < 16; ++i) top[c][i] = key[0][i];
    }
    float v0[16], v1[16];
#pragma unroll
    for (int i = 0; i < 16; ++i) { v0[i] = key2f(top[0][i] & 0xFFFFFF80u); v1[i] = key2f(top[1][i] & 0xFFFFFF80u); }
    unsigned cand[4][16];
#pragma unroll
    for (int q = 0; q < 4; ++q)
#pragma unroll
        for (int i = 0; i < 16; ++i) cand[q][i] = 0u;
#define CAND_(q, e, i, j) cand[q][e] = (f2key(v0[i] + v1[j]) & 0xFFFFFF00u) | (unsigned)(255 - ((i) * 16 + (j)))
    CAND_(0, 0, 0, 0);
    CAND_(0, 1, 0, 1);
    CAND_(0, 2, 0, 2);
    CAND_(0, 3, 0, 3);
    CAND_(0, 4, 0, 4);
    CAND_(0, 5, 0, 5);
    CAND_(0, 6, 0, 6);
    CAND_(0, 7, 0, 7);
    CAND_(0, 8, 0, 8);
    CAND_(0, 9, 0, 9);
    CAND_(0, 10, 0, 10);
    CAND_(0, 11, 0, 11);
    CAND_(0, 12, 0, 12);
    CAND_(0, 13, 0, 13);
    CAND_(0, 14, 0, 14);
    CAND_(0, 15, 0, 15);
    CAND_(1, 0, 1, 0);
    CAND_(1, 1, 1, 1);
    CAND_(1, 2, 1, 2);
    CAND_(1, 3, 1, 3);
    CAND_(1, 4, 1, 4);
    CAND_(1, 5, 1, 5);
    CAND_(1, 6, 1, 6);
    CAND_(1, 7, 1, 7);
    CAND_(1, 8, 2, 0);
    CAND_(1, 9, 2, 1);
    CAND_(1, 10, 2, 2);
    CAND_(1, 11, 2, 3);
    CAND_(1, 12, 2, 4);
    CAND_(1, 13, 3, 0);
    CAND_(1, 14, 3, 1);
    CAND_(1, 15, 3, 2);
    CAND_(2, 0, 3, 3);
    CAND_(2, 1, 4, 0);
    CAND_(2, 2, 4, 1);
    CAND_(2, 3, 4, 2);
    CAND_(2, 4, 5, 0);
    CAND_(2, 5, 5, 1);
    CAND_(2, 6, 6, 0);
    CAND_(2, 7, 6, 1);
    CAND_(2, 8, 7, 0);
    CAND_(2, 9, 7, 1);
    CAND_(2, 10, 8, 0);
    CAND_(2, 11, 9, 0);
    CAND_(2, 12, 10, 0);
    CAND_(2, 13, 11, 0);
    CAND_(2, 14, 12, 0);
    CAND_(2, 15, 13, 0);
    CAND_(3, 0, 14, 0);
    CAND_(3, 1, 15, 0);
#undef CAND_
#pragma unroll
    for (int q = 0; q < 4; ++q) sort16_desc(cand[q]);
    top16_merge(cand[0], cand[1]); top16_merge(cand[2], cand[3]); top16_merge(cand[0], cand[2]);
    float ev[16]; const float vmax = key2f(cand[0][0] & 0xFFFFFF00u); float esum = 0.f;
#pragma unroll
    for (int k = 0; k < 16; ++k) { ev[k] = __builtin_amdgcn_exp2f((key2f(cand[0][k] & 0xFFFFFF00u) - vmax) * LOG2E); esum += ev[k]; }
    const float einv = 1.0f / esum;
    LAS unsigned char* st = lds + 2 * TK_KIMG + (w * 64 + lane) * 32;
#pragma unroll
    for (int g4 = 0; g4 < 4; ++g4) { unsigned d0 = 0u, d1 = 0u;
#pragma unroll
        for (int e = 0; e < 4; ++e) { d0 |= (127u - (top[0][4 * g4 + e] & 127u)) << (8 * e); d1 |= (127u - (top[1][4 * g4 + e] & 127u)) << (8 * e); }
        *(LAS unsigned*)(st + 4 * g4) = d0; *(LAS unsigned*)(st + 16 + 4 * g4) = d1; }
    int eo[16];
#pragma unroll
    for (int k = 0; k < 16; ++k) { const unsigned code = 255u - (cand[0][k] & 255u); eo[k] = (int)st[code >> 4] * 128 + (int)st[16 + (code & 15u)]; }
    if (hh == 0) {
        u32x4 o0, o1;
        o0.x = (unsigned)eo[0] | ((unsigned)eo[1] << 16); o0.y = (unsigned)eo[2] | ((unsigned)eo[3] << 16); o0.z = (unsigned)eo[4] | ((unsigned)eo[5] << 16); o0.w = (unsigned)eo[6] | ((unsigned)eo[7] << 16);
        o1.x = (unsigned)eo[8] | ((unsigned)eo[9] << 16); o1.y = (unsigned)eo[10] | ((unsigned)eo[11] << 16); o1.z = (unsigned)eo[12] | ((unsigned)eo[13] << 16); o1.w = (unsigned)eo[14] | ((unsigned)eo[15] << 16);
        *(u32x4*)(eidx + tok * 128 + h * 16) = o0; *(u32x4*)(eidx + tok * 128 + h * 16 + 8) = o1;
    } else {
#pragma unroll
        for (int k4 = 0; k4 < 4; ++k4) { f32x4 o; o[0] = ev[4 * k4] * einv; o[1] = ev[4 * k4 + 1] * einv; o[2] = ev[4 * k4 + 2] * einv; o[3] = ev[4 * k4 + 3] * einv;
            *(f32x4*)(gate + tok * 128 + h * 16 + 4 * k4) = o; }
    }
    __syncthreads();
}

__device__ __forceinline__ float fp8dot16(const u32x4 w, const f32x2 (&xp)[8]) {
    f32x2 a0 = __builtin_amdgcn_cvt_pk_f32_fp8((int)w.x, false) * xp[0];
    a0 = __builtin_elementwise_fma(__builtin_amdgcn_cvt_pk_f32_fp8((int)w.x, true), xp[1], a0);
    a0 = __builtin_elementwise_fma(__builtin_amdgcn_cvt_pk_f32_fp8((int)w.y, false), xp[2], a0); a0 = __builtin_elementwise_fma(__builtin_amdgcn_cvt_pk_f32_fp8((int)w.y, true), xp[3], a0);
    a0 = __builtin_elementwise_fma(__builtin_amdgcn_cvt_pk_f32_fp8((int)w.z, false), xp[4], a0); a0 = __builtin_elementwise_fma(__builtin_amdgcn_cvt_pk_f32_fp8((int)w.z, true), xp[5], a0);
    a0 = __builtin_elementwise_fma(__builtin_amdgcn_cvt_pk_f32_fp8((int)w.w, false), xp[6], a0); a0 = __builtin_elementwise_fma(__builtin_amdgcn_cvt_pk_f32_fp8((int)w.w, true), xp[7], a0);
    return a0.x + a0.y;
}
typedef int i32x4 __attribute__((ext_vector_type(4)));
#define PEER_EIDX16(dst, t_) do { const unsigned short* ep_ = eidx + (size_t)(t_) * 128 + 16 * grp; const u32x4 e0_ = *(const u32x4*)ep_, e1_ = *(const u32x4*)(ep_ + 8); \
        dst[0] = (int)(e0_.x & 0xffffu); dst[1] = (int)(e0_.x >> 16); dst[2] = (int)(e0_.y & 0xffffu); dst[3] = (int)(e0_.y >> 16); dst[4] = (int)(e0_.z & 0xffffu); dst[5] = (int)(e0_.z >> 16); dst[6] = (int)(e0_.w & 0xffffu); dst[7] = (int)(e0_.w >> 16); \
        dst[8] = (int)(e1_.x & 0xffffu); dst[9] = (int)(e1_.x >> 16); dst[10] = (int)(e1_.y & 0xffffu); dst[11] = (int)(e1_.y >> 16); dst[12] = (int)(e1_.z & 0xffffu); dst[13] = (int)(e1_.z >> 16); dst[14] = (int)(e1_.w & 0xffffu); dst[15] = (int)(e1_.w >> 16); } while (0)
#define PEER_GATHER16(BUF, base, ev) _Pragma("unroll") for (int i_ = 0; i_ < 16; ++i_) BUF[i_] = *(const u32x4*)((base) + (unsigned)(((unsigned)(ev)[i_] << 10) + (unsigned)colbase))
template <int CTRL> __device__ __forceinline__ float xsel_addf_dpp(float keep_lo, float keep_hi, bool hi) { const float send = hi ? keep_lo : keep_hi, keep = hi ? keep_hi : keep_lo;
    return keep + __uint_as_float(__builtin_amdgcn_update_dpp(0u, __float_as_uint(send), CTRL, 0xf, 0xf, false)); }
__device__ __forceinline__ float swap32_add(float lo, float hi) { typedef unsigned u2_ __attribute__((ext_vector_type(2))); const u2_ r = __builtin_amdgcn_permlane32_swap(__float_as_uint(lo), __float_as_uint(hi), false, false); return __uint_as_float(r.x) + __uint_as_float(r.y); }
__device__ __forceinline__ float swap16_add(float lo, float hi) { typedef unsigned u2_ __attribute__((ext_vector_type(2))); const u2_ r = __builtin_amdgcn_permlane16_swap(__float_as_uint(lo), __float_as_uint(hi), false, false); return __uint_as_float(r.x) + __uint_as_float(r.y); }
#define PEER_GATHER4(R, o, base, E, p) _Pragma("unroll") for (int j_ = 0; j_ < 4; ++j_) R[(o) + j_] = *(const u32x4*)((base) + (unsigned)(((unsigned)(E)[4 * (p) + j_] << 10) + (unsigned)colbase))
__device__ __forceinline__ void peerU_phase(int slice, int tok0, int tok1, const bf16_t* __restrict__ x1b,
                                            const unsigned short* __restrict__ eidx, const unsigned char* __restrict__ ub8, bf16_t* __restrict__ hp) {
    int tid = threadIdx.x; asm volatile("" : "+v"(tid));
    const int wave = tid >> 6, lane = tid & 63, sub = lane & 7, grp = lane >> 3, colbase = 128 * slice + 16 * sub;
    if (tok0 + wave >= tok1) return;
    const bool l0 = lane & 1, l1 = lane & 2, l2 = lane & 4;
    const int tfirst = tok0 + wave, tlast = tfirst + ((tok1 - 1 - tfirst) >> 3) * 8;
    const bf16_t* xl = x1b + colbase;
    const int hoff = 16 * grp + ((lane & 4) ? 8 : 0) + ((lane & 2) ? 4 : 0) + ((lane & 1) ? 2 : 0);
#define TOKC(i) ((tfirst + 8 * (i)) <= tlast ? (tfirst + 8 * (i)) : tlast)
    u32x4 R[32]; int EA[16], EB[16]; u32x4 xrA0, xrA1, xrB0, xrB1;
    { const int t0 = TOKC(0), t1 = TOKC(1);
      PEER_EIDX16(EA, t0); PEER_EIDX16(EB, t1);
      xrA0 = *(const u32x4*)(xl + (size_t)t0 * D); xrA1 = *(const u32x4*)(xl + (size_t)t0 * D + 8); xrB0 = *(const u32x4*)(xl + (size_t)t1 * D); xrB1 = *(const u32x4*)(xl + (size_t)t1 * D + 8);
#pragma unroll
      for (int p = 0; p < 4; ++p) { PEER_GATHER4(R, 4 * p, ub8, EA, p); }
#pragma unroll
      for (int p = 0; p < 4; ++p) { PEER_GATHER4(R, 16 + 4 * p, ub8, EB, p); }
      const int t2 = TOKC(2), t3 = TOKC(3); PEER_EIDX16(EA, t2); PEER_EIDX16(EB, t3); }
    for (int i = 0;; i += 2) {
#define PEER_U_TOKEN(RO, E, xr0, xr1, ti, tnext2, tnext4) do { \
        f32x2 xp[8]; \
        xp[0] = (f32x2){bflo(xr0.x), bfhi(xr0.x)}; xp[1] = (f32x2){bflo(xr0.y), bfhi(xr0.y)}; xp[2] = (f32x2){bflo(xr0.z), bfhi(xr0.z)}; xp[3] = (f32x2){bflo(xr0.w), bfhi(xr0.w)}; \
        xp[4] = (f32x2){bflo(xr1.x), bfhi(xr1.x)}; xp[5] = (f32x2){bflo(xr1.y), bfhi(xr1.y)}; xp[6] = (f32x2){bflo(xr1.z), bfhi(xr1.z)}; xp[7] = (f32x2){bflo(xr1.w), bfhi(xr1.w)}; \
        xr0 = *(const u32x4*)(xl + (size_t)(tnext2) * D); xr1 = *(const u32x4*)(xl + (size_t)(tnext2) * D + 8);        \
        float pd[16]; \
        _Pragma("unroll") for (int p = 0; p < 4; ++p) { \
            _Pragma("unroll") for (int j = 0; j < 4; ++j) pd[4 * p + j] = fp8dot16(R[(RO) + 4 * p + j], xp); \
            PEER_GATHER4(R, (RO) + 4 * p, ub8, E, p); } \
        PEER_EIDX16(E, tnext4); \
        float q8[8]; \
        _Pragma("unroll") for (int k = 0; k < 8; ++k) q8[k] = xsel_addf_dpp<0x141>(pd[k], pd[k + 8], l2);            \
        const float r0 = xsel_addf_dpp<0x4E>(q8[0], q8[4], l1), r1 = xsel_addf_dpp<0x4E>(q8[1], q8[5], l1), r2 = xsel_addf_dpp<0x4E>(q8[2], q8[6], l1), r3 = xsel_addf_dpp<0x4E>(q8[3], q8[7], l1);     \
        f32x2 o; o.x = xsel_addf_dpp<0xB1>(r0, r2, l0); o.y = xsel_addf_dpp<0xB1>(r1, r3, l0);                       \
        if ((tfirst + 8 * (ti)) <= tlast) *(unsigned*)(hp + ((size_t)slice * T + (size_t)(tfirst + 8 * (ti))) * 128 + hoff) = pk2(o.x, o.y); } while (0)
        { const int tn2 = TOKC(i + 2), tn4 = TOKC(i + 4); PEER_U_TOKEN(0, EA, xrA0, xrA1, i, tn2, tn4); }
        { const int tn2 = TOKC(i + 3), tn4 = TOKC(i + 5); PEER_U_TOKEN(16, EB, xrB0, xrB1, i + 1, tn2, tn4); }
        if (tfirst + 8 * (i + 2) > tlast) break;
    }
#undef PEER_U_TOKEN
#undef TOKC
}
#ifdef PROBE_EXP
__device__ __forceinline__ void probe_gather(int slice, int tok0, int tok1, const unsigned short* __restrict__ eidx, const unsigned char* __restrict__ ub8, float* __restrict__ dummy) {
    int tid = threadIdx.x; asm volatile("" : "+v"(tid));
    const int wave = tid >> 6, lane = tid & 63, sub = lane & 7, grp = lane >> 3, colbase = 128 * slice + 16 * sub;
    if (tok0 + wave >= tok1) return;
    const unsigned char* ubl = ub8;
    const int tlast = tok0 + wave + ((tok1 - 1 - tok0 - wave) >> 3) * 8;
    int EA[16], EB[16]; u32x4 UA[16], UB[16];
    int ta = tok0 + wave, tb = ta + 8 <= tlast ? ta + 8 : tlast;
    PEER_EIDX16(EA, ta); PEER_EIDX16(EB, tb);
    PEER_GATHER16(UA, ubl, EA);
    unsigned accx = 0u;
    for (;;) {
        PEER_GATHER16(UB, ubl, EB);
        const int ta2 = ta + 16 <= tlast ? ta + 16 : tlast; PEER_EIDX16(EA, ta2);
#pragma unroll
        for (int i = 0; i < 16; ++i) accx ^= UA[i].x ^ UA[i].y ^ UA[i].z ^ UA[i].w;
        PEER_GATHER16(UA, ubl, EA);
        const int tb2 = ta + 24 <= tlast ? ta + 24 : tlast; PEER_EIDX16(EB, tb2);
#pragma unroll
        for (int i = 0; i < 16; ++i) accx ^= UB[i].x ^ UB[i].y ^ UB[i].z ^ UB[i].w;
        if (ta + 16 > tlast) break;
        ta = ta2; tb = tb2;
    }
    dummy[(size_t)blockIdx.x * 512 + tid] = __uint_as_float(accx & 0x3fffffffu);
}
#endif

#if defined(PROBE_EXP) && PROBE_EXP >= 10 && PROBE_EXP < 20
__device__ __forceinline__ void probe_valu(float* __restrict__ dummy) {
    int tid = threadIdx.x; asm volatile("" : "+v"(tid));
    unsigned w[8]; f32x2 a[8];
#pragma unroll
    for (int i = 0; i < 8; ++i) { w[i] = (unsigned)tid * 2654435761u + i * 40503u; a[i] = (f32x2){(float)i, 1.0f}; }
    for (int it = 0; it < 2048; ++it) {
#pragma unroll
        for (int r = 0; r < 4; ++r)
#pragma unroll
            for (int i = 0; i < 8; ++i) {
#if PROBE_EXP == 10
                asm volatile("v_cvt_pk_f32_fp8_e32 %0, %1" : "=v"(a[i]) : "v"(w[i]));
#elif PROBE_EXP == 11
                asm volatile("v_pk_fma_f32 %0, %1, %1, %0" : "+v"(a[i]) : "v"(a[(i + 1) & 7]));
#elif PROBE_EXP == 12
                asm volatile("v_cvt_f32_ubyte0_e32 %0, %1" : "=v"(a[i].x) : "v"(w[i]));
#elif PROBE_EXP == 13
                asm volatile("v_dot4_i32_i8 %0, %1, %1, %0" : "+v"(w[i]) : "v"(w[(i + 1) & 7]));
#elif PROBE_EXP == 14
                asm volatile("v_fma_f32 %0, %1, %1, %0" : "+v"(a[i].x) : "v"(a[(i + 1) & 7].y));
#elif PROBE_EXP == 15
                asm volatile("v_dot2_f32_bf16 %0, %1, %1, %0" : "+v"(a[i].x) : "v"(w[i]));
#endif
            }
    }
    float s = 0.f;
#pragma unroll
    for (int i = 0; i < 8; ++i) s += a[i].x + a[i].y + __uint_as_float(w[i] & 0x3fffffffu);
    dummy[(size_t)blockIdx.x * 512 + tid] = s;
}
#endif
__device__ __forceinline__ void peerR_phase(const bf16_t* __restrict__ hp, const unsigned short* __restrict__ eidx, const float* __restrict__ gate, const float* __restrict__ usc, const float* __restrict__ vsc, bf16_t* __restrict__ cb) {
    for (size_t i = (size_t)blockIdx.x * 512 + threadIdx.x; i < (size_t)T * 32; i += (size_t)gridDim.x * 512) {
        f32x4 h = (f32x4){0.f, 0.f, 0.f, 0.f};
#pragma unroll
        for (int j = 0; j < 8; ++j) { const u32x2 w = *(const u32x2*)(hp + (size_t)j * T * 128 + 4 * i); h += (f32x4){bflo(w.x), bfhi(w.x), bflo(w.y), bfhi(w.y)}; }
        const u32x2 ew = *(const u32x2*)(eidx + 4 * i); const int e[4] = {(int)(ew.x & 0xffffu), (int)(ew.x >> 16), (int)(ew.y & 0xffffu), (int)(ew.y >> 16)};
        const f32x4 gt = *(const f32x4*)(gate + 4 * i); float c[4];
#pragma unroll
        for (int j = 0; j < 4; ++j) { const float hh = h[j] * usc[e[j]]; const pg8::f32x2 ge = pg8::gelu_pk((pg8::f32x2){hh, hh}); c[j] = gt[j] * ge.x * vsc[e[j]]; }
        u32x2 cw; cw.x = pk2(c[0], c[1]); cw.y = pk2(c[2], c[3]); *(u32x2*)(cb + 4 * i) = cw; }
}
__device__ __forceinline__ void peerV_phase(int slice, int tok0, int tok1, const bf16_t* __restrict__ cb, const unsigned short* __restrict__ eidx, const unsigned char* __restrict__ vb8, bf16_t* __restrict__ yp) {
    int tid = threadIdx.x; asm volatile("" : "+v"(tid));
    const int wave = tid >> 6, lane = tid & 63, sub = lane & 7, grp = lane >> 3, colbase = 128 * slice + 16 * sub;
    if (tok0 + wave >= tok1) return;
    const bool l3 = lane & 8, l4 = lane & 16, l5 = lane & 32;
    const int tfirst = tok0 + wave, tlast = tfirst + ((tok1 - 1 - tfirst) >> 3) * 8;
    const bf16_t* cl = cb + 16 * grp;
    const int yoff = colbase + ((lane & 32) ? 8 : 0) + ((lane & 16) ? 4 : 0) + ((lane & 8) ? 2 : 0);
#define TOKC(i) ((tfirst + 8 * (i)) <= tlast ? (tfirst + 8 * (i)) : tlast)
#define PEER_C16(dst, t_) do { const bf16_t* cp_ = cl + (size_t)(t_) * 128; dst[0] = *(const u32x4*)cp_; dst[1] = *(const u32x4*)(cp_ + 8); } while (0)
    u32x4 R[32]; int EA[16], EB[16]; u32x4 cA[2], cB[2];
    { const int t0 = TOKC(0), t1 = TOKC(1);
      PEER_EIDX16(EA, t0); PEER_EIDX16(EB, t1); PEER_C16(cA, t0); PEER_C16(cB, t1);
#pragma unroll
      for (int p = 0; p < 4; ++p) { PEER_GATHER4(R, 4 * p, vb8, EA, p); }
#pragma unroll
      for (int p = 0; p < 4; ++p) { PEER_GATHER4(R, 16 + 4 * p, vb8, EB, p); }
      const int t2 = TOKC(2), t3 = TOKC(3); PEER_EIDX16(EA, t2); PEER_EIDX16(EB, t3); }
    for (int i = 0;; i += 2) {
#define PEER_V_TOKEN(RO, E, cc, ti, tnext2, tnext4) do { \
        const u32x4 c0_ = cc[0], c1_ = cc[1]; \
        const float cv[16] = {bflo(c0_.x), bfhi(c0_.x), bflo(c0_.y), bfhi(c0_.y), bflo(c0_.z), bfhi(c0_.z), bflo(c0_.w), bfhi(c0_.w), bflo(c1_.x), bfhi(c1_.x), bflo(c1_.y), bfhi(c1_.y), bflo(c1_.z), bfhi(c1_.z), bflo(c1_.w), bfhi(c1_.w)}; \
        PEER_C16(cc, tnext2);                                        \
        f32x2 acc[8]; \
        _Pragma("unroll") for (int k = 0; k < 8; ++k) acc[k] = (f32x2){0.f, 0.f}; \
        _Pragma("unroll") for (int p = 0; p < 4; ++p) { \
            _Pragma("unroll") for (int j = 0; j < 4; ++j) { const u32x4 w = R[(RO) + 4 * p + j]; const f32x2 c2v = (f32x2){cv[4 * p + j], cv[4 * p + j]}; \
                acc[0] = __builtin_elementwise_fma(__builtin_amdgcn_cvt_pk_f32_fp8((int)w.x, false), c2v, acc[0]); acc[1] = __builtin_elementwise_fma(__builtin_amdgcn_cvt_pk_f32_fp8((int)w.x, true), c2v, acc[1]); \
                acc[2] = __builtin_elementwise_fma(__builtin_amdgcn_cvt_pk_f32_fp8((int)w.y, false), c2v, acc[2]); acc[3] = __builtin_elementwise_fma(__builtin_amdgcn_cvt_pk_f32_fp8((int)w.y, true), c2v, acc[3]); \
                acc[4] = __builtin_elementwise_fma(__builtin_amdgcn_cvt_pk_f32_fp8((int)w.z, false), c2v, acc[4]); acc[5] = __builtin_elementwise_fma(__builtin_amdgcn_cvt_pk_f32_fp8((int)w.z, true), c2v, acc[5]); \
                acc[6] = __builtin_elementwise_fma(__builtin_amdgcn_cvt_pk_f32_fp8((int)w.w, false), c2v, acc[6]); acc[7] = __builtin_elementwise_fma(__builtin_amdgcn_cvt_pk_f32_fp8((int)w.w, true), c2v, acc[7]); } \
            PEER_GATHER4(R, (RO) + 4 * p, vb8, E, p); } \
        PEER_EIDX16(E, tnext4); \
        const float a[16] = {acc[0].x, acc[0].y, acc[1].x, acc[1].y, acc[2].x, acc[2].y, acc[3].x, acc[3].y, acc[4].x, acc[4].y, acc[5].x, acc[5].y, acc[6].x, acc[6].y, acc[7].x, acc[7].y}; \
        float q8[8]; \
        _Pragma("unroll") for (int k = 0; k < 8; ++k) q8[k] = swap32_add(a[k], a[k + 8]); \
        const float r0 = swap16_add(q8[0], q8[4]), r1 = swap16_add(q8[1], q8[5]), r2 = swap16_add(q8[2], q8[6]), r3 = swap16_add(q8[3], q8[7]); \
        f32x2 o; o.x = xsel_addf_dpp<0x128>(r0, r2, l3); o.y = xsel_addf_dpp<0x128>(r1, r3, l3);               \
        if ((tfirst + 8 * (ti)) <= tlast) *(unsigned*)(yp + (size_t)(tfirst + 8 * (ti)) * D + yoff) = pk2(o.x, o.y); } while (0)
        { const int tn2 = TOKC(i + 2), tn4 = TOKC(i + 4); PEER_V_TOKEN(0, EA, cA, i, tn2, tn4); }
        { const int tn2 = TOKC(i + 3), tn4 = TOKC(i + 5); PEER_V_TOKEN(16, EB, cB, i + 1, tn2, tn4); }
        if (tfirst + 8 * (i + 2) > tlast) break;
    }
#undef PEER_V_TOKEN
#undef PEER_C16
#undef TOKC
}
template <int NT>
__device__ __forceinline__ void peerL_token(size_t t0, size_t tstride, const bf16_t* __restrict__ x1b, const bf16_t* __restrict__ yp, const float* g2, const float* b2, float* __restrict__ out) {
    const int lane = threadIdx.x & 63;
    u32x4 xw[NT][2], yw[NT][2];
#pragma unroll
    for (int k = 0; k < NT; ++k) { const size_t t = t0 + k * tstride;
#pragma unroll
        for (int hlf = 0; hlf < 2; ++hlf) { const int c = 16 * lane + 8 * hlf; xw[k][hlf] = *(const u32x4*)(x1b + t * D + c); yw[k][hlf] = *(const u32x4*)(yp + t * D + c); } }
#pragma unroll
    for (int k = 0; k < NT; ++k) { const size_t t = t0 + k * tstride;
        float y[16]; float s = 0.f;
#pragma unroll
        for (int hlf = 0; hlf < 2; ++hlf) { const u32x4 xq = xw[k][hlf], yq = yw[k][hlf];
            const float xx[8] = {bflo(xq.x), bfhi(xq.x), bflo(xq.y), bfhi(xq.y), bflo(xq.z), bfhi(xq.z), bflo(xq.w), bfhi(xq.w)}, yy[8] = {bflo(yq.x), bfhi(yq.x), bflo(yq.y), bfhi(yq.y), bflo(yq.z), bfhi(yq.z), bflo(yq.w), bfhi(yq.w)};
#pragma unroll
            for (int j = 0; j < 8; ++j) { const float v = ALPHA * xx[j] + yy[j]; y[8 * hlf + j] = v; s += v; } }
        const float mean2 = wave_sum(s) * (1.f / D); float ss = 0.f;
#pragma unroll
        for (int i = 0; i < 16; ++i) { const float dlt = y[i] - mean2; ss += dlt * dlt; }
        const float rstd2 = rsqrtf(wave_sum(ss) * (1.f / D) + LN_EPS);
#pragma unroll
        for (int q = 0; q < 4; ++q) { const int c = 16 * lane + 4 * q; const f32x4 gg = *(const f32x4*)(g2 + c), bb = *(const f32x4*)(b2 + c); f32x4 o;
#pragma unroll
            for (int j = 0; j < 4; ++j) o[j] = (y[4 * q + j] - mean2) * rstd2 * gg[j] + bb[j];
            *(f32x4*)(out + t * D + c) = o; } }
}

constexpr int NTHREADS = 512, NWAVES = 8;
constexpr int LDS_BYTES = 147456;
constexpr int LDS_MISC = 131072;
constexpr int LDS_XB = LDS_BYTES - 16;
constexpr size_t CTL_ZERO_BYTES = 16384;

struct Params {
    const float *x, *mem, *relb, *w_in, *b_gate, *w_memkv, *sinks, *w_a, *w_b, *w_c, *w_out, *ln1g, *ln1b, *w_q, *subk, *pu, *pv, *ln2g, *ln2b;
    float* out; char* ws; int lo, hi;
};

__device__ __forceinline__ void g_cvt(const float* __restrict__ src, bf16_t* __restrict__ dst, size_t n8) {
    for (size_t i = (size_t)blockIdx.x * NTHREADS + threadIdx.x; i < n8; i += (size_t)gridDim.x * NTHREADS) {
        const f32x4 a = ((const f32x4*)src)[2 * i], b = ((const f32x4*)src)[2 * i + 1];
        u32x4 w; w.x = pk2(a[0], a[1]); w.y = pk2(a[2], a[3]); w.z = pk2(b[0], b[1]); w.w = pk2(b[2], b[3]);
        ((u32x4*)dst)[i] = w; }
}


__device__ __forceinline__ void g_cvt8(const float* __restrict__ src, unsigned char* __restrict__ dst, size_t n16, float sc) {
    for (size_t i = (size_t)blockIdx.x * NTHREADS + threadIdx.x; i < n16; i += (size_t)gridDim.x * NTHREADS) {
        const f32x4 a = ((const f32x4*)src)[4 * i], b = ((const f32x4*)src)[4 * i + 1], c = ((const f32x4*)src)[4 * i + 2], d = ((const f32x4*)src)[4 * i + 3];
        u32x4 w; int t;
        t = 0; t = __builtin_amdgcn_cvt_pk_fp8_f32(a[0] * sc, a[1] * sc, t, false); t = __builtin_amdgcn_cvt_pk_fp8_f32(a[2] * sc, a[3] * sc, t, true); w.x = (unsigned)t;
        t = 0; t = __builtin_amdgcn_cvt_pk_fp8_f32(b[0] * sc, b[1] * sc, t, false); t = __builtin_amdgcn_cvt_pk_fp8_f32(b[2] * sc, b[3] * sc, t, true); w.y = (unsigned)t;
        t = 0; t = __builtin_amdgcn_cvt_pk_fp8_f32(c[0] * sc, c[1] * sc, t, false); t = __builtin_amdgcn_cvt_pk_fp8_f32(c[2] * sc, c[3] * sc, t, true); w.z = (unsigned)t;
        t = 0; t = __builtin_amdgcn_cvt_pk_fp8_f32(d[0] * sc, d[1] * sc, t, false); t = __builtin_amdgcn_cvt_pk_fp8_f32(d[2] * sc, d[3] * sc, t, true); w.w = (unsigned)t;
        ((u32x4*)dst)[i] = w; }
}

template <bool FP8>
__device__ __forceinline__ void transpose_tile_wave(const float* __restrict__ src, int K, int N, void* __restrict__ dstv, int tn, int tk, LAS float* tile, float sc) {
    const int lane = threadIdx.x & 63, n0 = tn * 64, k0 = tk * 64, rq = lane >> 4, c4 = (lane & 15) * 4;
    f32x4 v[16];
#pragma unroll
    for (int i = 0; i < 16; ++i) v[i] = *(const f32x4*)(src + (size_t)(k0 + 4 * i + rq) * N + n0 + c4);
#pragma unroll
    for (int i = 0; i < 16; ++i) *(LAS f32x4*)(tile + (4 * i + rq) * 68 + c4) = v[i];
    asm volatile("s_waitcnt lgkmcnt(0)" ::: "memory");
    float y[64];
#pragma unroll
    for (int k = 0; k < 64; ++k) y[k] = tile[k * 68 + lane];
    if constexpr (FP8) { unsigned char* dst = (unsigned char*)dstv + (size_t)(n0 + lane) * K + k0;
#pragma unroll
        for (int q = 0; q < 4; ++q) { u32x4 w; int t;
#pragma unroll
            for (int d = 0; d < 4; ++d) { t = 0; t = __builtin_amdgcn_cvt_pk_fp8_f32(y[16 * q + 4 * d] * sc, y[16 * q + 4 * d + 1] * sc, t, false); t = __builtin_amdgcn_cvt_pk_fp8_f32(y[16 * q + 4 * d + 2] * sc, y[16 * q + 4 * d + 3] * sc, t, true); w[d] = (unsigned)t; }
            *(u32x4*)(dst + 16 * q) = w; } }
    else { bf16_t* dst = (bf16_t*)dstv + (size_t)(n0 + lane) * K + k0;
#pragma unroll
        for (int q = 0; q < 8; ++q) { u32x4 w; w.x = pk2(y[8 * q], y[8 * q + 1]); w.y = pk2(y[8 * q + 2], y[8 * q + 3]); w.z = pk2(y[8 * q + 4], y[8 * q + 5]); w.w = pk2(y[8 * q + 6], y[8 * q + 7]); *(u32x4*)(dst + 8 * q) = w; } }
    asm volatile("s_waitcnt lgkmcnt(0)" ::: "memory");
}
#define W_ws (p.ws)
#define W_dout ((char*)p.out)
#define W_wmemkv_t ((bf16_t*)(W_ws + WS_WMEMKV))
#define W_wA_t ((bf16_t*)(W_ws + WS_WA))
#define W_wB_t ((bf16_t*)(W_ws + WS_WB))
#define W_wC_t ((bf16_t*)(W_ws + WS_WC))
#define W_wout_t ((bf16_t*)(W_ws + WS_WOUT))
#define W_wq_t ((bf16_t*)(W_ws + WS_WQ))
#define W_subkb ((bf16_t*)(W_ws + WS_SUBK))
#define W_memb ((bf16_t*)(W_ws + WS_MEMB))
#define W_kvm ((bf16_t*)(W_ws + WS_KVM))
#define W_stats ((float*)(W_ws + WS_STATS))
#define W_lseA ((float*)(W_ws + WS_LSE))
#define W_hq ((bf16_t*)(W_ws + WS_HQ))
#define W_gates ((bf16_t*)(W_ws + WS_GATES))
#define W_xb ((bf16_t*)(W_ws + WS_XB))
#define W_mf ((float*)(W_ws + WS_MF))
#define W_mb ((unsigned char*)(W_ws + WS_MB))
#define W_z ((bf16_t*)(W_ws + WS_Z))
#define W_x1b ((bf16_t*)(W_ws + WS_X1B))
#define W_qb ((bf16_t*)(W_ws + WS_Q))
#define W_eidx ((unsigned short*)(W_ws + WS_EIDX))
#define W_gate ((float*)(W_ws + WS_GATE))
#define W_ub8 ((unsigned char*)(W_ws + WS_UB))
#define W_vb8 ((unsigned char*)(W_ws + WS_UB + 16 * MiB))
#define W_usc ((float*)(W_ws + WS_UB + 32 * MiB))
#define W_vsc (W_usc + NEXP)
#define W_w_in_t ((bf16_t*)(W_dout + DO_WINT))
#define W_oA ((bf16_t*)(W_dout + DO_OA))
#define W_yb ((bf16_t*)(W_dout + DO_YB))
#define W_yc ((bf16_t*)(W_dout + DO_YC))
#define W_ya ((bf16_t*)(W_dout + DO_YA))
#define W_x8 ((unsigned char*)W_dout)
#define W_hp ((bf16_t*)(W_ws + 120 * MiB))
#define W_cbuf ((bf16_t*)(W_ws + 24 * MiB))
#define W_yp W_hp
__global__ void __launch_bounds__(NTHREADS, 2) mk_fwd(Params p) {
    extern __shared__ __attribute__((aligned(16))) unsigned char lds[];
#define LAUNDER_TID int tid = threadIdx.x; asm volatile("" : "+v"(tid)); const int wave = tid >> 6; const int gw = blockIdx.x * NWAVES + wave, nw = gridDim.x * NWAVES; (void)wave; (void)gw; (void)nw;
    if (threadIdx.x == 0) *(uint4*)(lds + LDS_XB) = make_uint4(0u, 0u, 0u, 0u);
    __syncthreads();
    XcdBarrier bar = xcd_barrier_post((unsigned*)(W_ws + WS_CTL), (volatile LAS unsigned*)(lds + LDS_XB));
#define PH(k) (p.lo <= (k) && (k) < p.hi)
#define SEAM(k) do { if (PH(k) && PH((k) + 1)) xcd_barrier(bar); } while (0)

    if (PH(0)) { LAUNDER_TID
        g_cvt8(p.x, (unsigned char*)W_xb, (size_t)T * D / 16, 1.0f);
        g_cvt8(p.mem, (unsigned char*)W_memb, (size_t)BATCH * MEMLEN * D / 16, 1.0f);
        g_cvt(p.subk, W_subkb, (size_t)8 * 2 * 128 * 64 / 8);
        LAS float* tile = (LAS float*)((LAS unsigned char*)lds + wave * (64 * 68 * 4));
        for (int u = gw; u < 2752; u += nw) {
            if (u < 1664) transpose_tile_wave<true>(p.w_in, D, INW, W_w_in_t, u % 104, u / 104, tile, 32.0f);
            else if (u < 1920) { const int v = u - 1664; transpose_tile_wave<true>(p.w_memkv, D, 1024, W_wmemkv_t, v & 15, v >> 4, tile, 32.0f); }
            else if (u < 1984) { const int v = u - 1920; transpose_tile_wave<true>(p.w_a, 256, 1024, W_wA_t, v & 15, v >> 4, tile, 32.0f); }
            else if (u < 2112) { const int v = u - 1984; transpose_tile_wave<true>(p.w_b, 512, 1024, W_wB_t, v & 15, v >> 4, tile, 32.0f); }
            else if (u < 2240) { const int v = u - 2112; transpose_tile_wave<true>(p.w_c, 512, 1024, W_wC_t, v & 15, v >> 4, tile, 32.0f); }
            else if (u < 2496) { const int v = u - 2240; transpose_tile_wave<true>(p.w_out, D, 1024, W_wout_t, v & 15, v >> 4, tile, 32.0f); }
            else { const int v = u - 2496; transpose_tile_wave<false>(p.w_q, D, 1024, W_wq_t, v & 15, v >> 4, tile, 1.f); }
        }
    }
    SEAM(0);
    if (PH(1)) {
        { pg8::Gemm g; g.A = W_memb; g.Bt = W_wmemkv_t; g.M = BATCH * MEMLEN; g.N = 1024; g.K = D / 2; EpiPlain E; E.O = W_kvm; E.ldc = 1024;
          pg8::StaticOrder S; S.init(g.M, g.N, (int)gridDim.x, (int)blockIdx.x); pg8::gemm_phase<EpiPlain, pg8::StaticOrder, false, true>((PG8_LAS unsigned char*)lds, g, S, E, nullptr); }
        __syncthreads();
        { pg8::Gemm g; g.A = W_xb; g.Bt = W_w_in_t; g.M = T; g.N = INW; g.K = D / 2; EpiIn E; E.hq = W_hq; E.gates = W_gates; E.bgate = p.b_gate;
          pg8::StaticOrder S; S.init(g.M, g.N, (int)gridDim.x, (int)blockIdx.x); pg8::gemm_phase<EpiIn, pg8::StaticOrder, false, true>((PG8_LAS unsigned char*)lds, g, S, E, nullptr); }
    }
    SEAM(1);
    if (PH(2)) { LAUNDER_TID
        LAS unsigned char* L = (LAS unsigned char*)lds;
        attnAB_phase(L, W_hq, p.relb, p.sinks, W_oA, W_lseA, W_yb);
        for (int u = blockIdx.x; u < 256; u += gridDim.x) attnC_unit(u, L, W_hq, W_kvm, W_yc);
        for (int row = gw; row < NEXP / 2; row += nw) cvt_rows_fp8(p.pu, p.pv, W_ub8, W_vb8, W_usc, W_vsc, row, row + NEXP / 2);
    }
    SEAM(2);
    if (PH(3)) { LAUNDER_TID for (size_t i = (size_t)blockIdx.x * NTHREADS + tid; i < (size_t)T * 32; i += (size_t)gridDim.x * NTHREADS) t_mix(i, W_oA, W_lseA, W_ya); }
    SEAM(3);
    if (PH(4)) {
        pg8::MergeArgs g; g.A[0] = W_ya; g.A[1] = W_yb; g.A[2] = W_yc; g.Bt[0] = W_wA_t; g.Bt[1] = W_wB_t; g.Bt[2] = W_wC_t; g.K[0] = 128; g.K[1] = 256; g.K[2] = 256; g.gates = W_gates; g.mb = W_mb;
        pg8::StaticOrder S; S.init(T, D, (int)gridDim.x, (int)blockIdx.x); pg8::gemm_phase_merge<pg8::StaticOrder, true>((PG8_LAS unsigned char*)lds, g, S);
    }
    SEAM(4);
    if (PH(5)) {
        pg8::Gemm g; g.A = (const bf16_t*)W_mb; g.Bt = W_wout_t; g.M = T; g.N = D; g.K = D / 2; EpiPlain E; E.O = W_z; E.ldc = 1024;
        pg8::StaticOrder S; S.init(g.M, g.N, (int)gridDim.x, (int)blockIdx.x); pg8::gemm_phase<EpiPlain, pg8::StaticOrder, false, true, 123>((PG8_LAS unsigned char*)lds, g, S, E, nullptr);
    }
    SEAM(5);
    if (PH(6)) { LAUNDER_TID int t = gw; for (; t + 3 * nw < T; t += 4 * nw) t_res_ln1<4>((size_t)t, (size_t)nw, p.x, W_z, p.ln1g, p.ln1b, W_x1b);
        for (; t < T; t += nw) t_res_ln1<1>((size_t)t, (size_t)nw, p.x, W_z, p.ln1g, p.ln1b, W_x1b); }
    SEAM(6);
    if (PH(7)) {
        pg8::Gemm g; g.A = W_x1b; g.Bt = W_wq_t; g.M = T; g.N = D; g.K = D; EpiPlain E; E.O = W_qb; E.ldc = 1024;
        pg8::StaticOrder S; S.init(g.M, g.N, (int)gridDim.x, (int)blockIdx.x); pg8::gemm_phase<EpiPlain, pg8::StaticOrder, false>((PG8_LAS unsigned char*)lds, g, S, E, nullptr);
    }
    SEAM(7);
    if (PH(8)) { for (int u = blockIdx.x; u < (T / 256) * 8; u += gridDim.x) topk_unit(u, (LAS unsigned char*)lds, W_qb, W_subkb, W_eidx, W_gate); }
    SEAM(8);
    if (PH(9)) { const int ngrp = (int)(gridDim.x >> 3), tpc = ((T + ngrp - 1) / ngrp + 7) & ~7, sl_tok0 = (int)(blockIdx.x >> 3) * tpc, sl_tok1 = ((int)(blockIdx.x >> 3) < ngrp) ? (sl_tok0 + tpc < T ? sl_tok0 + tpc : T) : 0; peerU_phase((int)(blockIdx.x & 7), sl_tok0, sl_tok1, W_x1b, W_eidx, W_ub8, W_hp); }
    SEAM(9);
    if (PH(10)) { peerR_phase(W_hp, W_eidx, W_gate, W_usc, W_vsc, W_cbuf); }
    SEAM(10);
    if (PH(11)) { const int ngrp = (int)(gridDim.x >> 3), tpc = ((T + ngrp - 1) / ngrp + 7) & ~7, sl_tok0 = (int)(blockIdx.x >> 3) * tpc, sl_tok1 = ((int)(blockIdx.x >> 3) < ngrp) ? (sl_tok0 + tpc < T ? sl_tok0 + tpc : T) : 0; peerV_phase((int)(blockIdx.x & 7), sl_tok0, sl_tok1, W_cbuf, W_eidx, W_vb8, W_yp); }
    SEAM(11);
#ifdef PROBE_EXP
    if (PH(13)) { const int ngrp = (int)(gridDim.x >> 3), tpc = ((T + ngrp - 1) / ngrp + 7) & ~7, sl_tok0 = (int)(blockIdx.x >> 3) * tpc, sl_tok1 = ((int)(blockIdx.x >> 3) < ngrp) ? (sl_tok0 + tpc < T ? sl_tok0 + tpc : T) : 0;
        const int sl = (PROBE_EXP == 0) ? (int)(blockIdx.x & 7) : (int)((blockIdx.x + (blockIdx.x >> 3)) & 7);
#if PROBE_EXP == 20
        for (int rep = 0; rep < 20; ++rep) xcd_barrier(bar); (void)sl; (void)sl_tok0; (void)sl_tok1; }
#elif PROBE_EXP >= 10
        probe_valu((float*)(W_ws + 24 * MiB)); (void)sl; (void)sl_tok0; (void)sl_tok1; }
#else
        probe_gather(sl, sl_tok0, sl_tok1, W_eidx, W_ub8, (float*)(W_ws + 24 * MiB)); }
#endif
#endif
    if (PH(12)) { LAUNDER_TID int t = gw; for (; t + 3 * nw < T; t += 4 * nw) peerL_token<4>((size_t)t, (size_t)nw, W_x1b, W_yp, p.ln2g, p.ln2b, p.out);
        for (; t < T; t += nw) peerL_token<1>((size_t)t, (size_t)nw, W_x1b, W_yp, p.ln2g, p.ln2b, p.out); }
}

#ifndef MK_CUTS
#define MK_CUTS 0
#endif
extern "C" void kernel_launch(void* const* d_in, const int* in_sizes, int n_in, void* d_out, int out_size, void* d_ws, size_t ws_size, hipStream_t stream) {
    if (n_in != 19 || in_sizes[0] != T * D || out_size != T * D || ws_size < WS_END) { fprintf(stderr, "kernel_launch: unexpected shapes / workspace (%d inputs, ws %zu)\n", n_in, ws_size); return; }
    static int grid = 0;
    if (!grid) {
        int dev = 0, cus = 0, per_cu = 0;
        if (hipGetDevice(&dev) != hipSuccess || hipDeviceGetAttribute(&cus, hipDeviceAttributeMultiprocessorCount, dev) != hipSuccess) { fprintf(stderr, "kernel_launch: device query failed\n"); return; }
        if (hipFuncSetAttribute((const void*)mk_fwd, hipFuncAttributeMaxDynamicSharedMemorySize, LDS_BYTES) != hipSuccess) { fprintf(stderr, "kernel_launch: hipFuncSetAttribute failed\n"); return; }
        if (hipOccupancyMaxActiveBlocksPerMultiprocessor(&per_cu, (const void*)mk_fwd, NTHREADS, LDS_BYTES) != hipSuccess || per_cu < 1) { fprintf(stderr, "kernel_launch: occupancy query says %d\n", per_cu); return; }
        grid = cus;
    }
    Params p{};
    p.x = (const float*)d_in[0]; p.mem = (const float*)d_in[1]; p.relb = (const float*)d_in[2]; p.w_in = (const float*)d_in[3]; p.b_gate = (const float*)d_in[4]; p.w_memkv = (const float*)d_in[5];
    p.sinks = (const float*)d_in[6]; p.w_a = (const float*)d_in[7]; p.w_b = (const float*)d_in[8]; p.w_c = (const float*)d_in[9]; p.w_out = (const float*)d_in[10]; p.ln1g = (const float*)d_in[11];
    p.ln1b = (const float*)d_in[12]; p.w_q = (const float*)d_in[13]; p.subk = (const float*)d_in[14]; p.pu = (const float*)d_in[15]; p.pv = (const float*)d_in[16]; p.ln2g = (const float*)d_in[17];
    p.ln2b = (const float*)d_in[18]; p.out = (float*)d_out; p.ws = (char*)d_ws;
    if (hipMemsetAsync((char*)d_ws + WS_CTL, 0, CTL_ZERO_BYTES, stream) != hipSuccess) { fprintf(stderr, "kernel_launch: memset failed\n"); return; }
#if MK_CUTS
    for (int k = 0; k < 13; ++k) { p.lo = k; p.hi = k + 1; hipLaunchKernelGGL(mk_fwd, dim3(grid), dim3(NTHREADS), LDS_BYTES, stream, p); }
#else
#ifdef PROBE_SPLITK
    p.lo = 0; p.hi = PROBE_SPLITK + 1; hipLaunchKernelGGL(mk_fwd, dim3(grid), dim3(NTHREADS), LDS_BYTES, stream, p);
#ifndef PROBE_SPLITK_BASE
    (void)hipMemsetAsync((char*)d_ws + WS_CTL, 0, CTL_ZERO_BYTES, stream);
    p.lo = PROBE_SPLITK; p.hi = PROBE_SPLITK + 1; hipLaunchKernelGGL(mk_fwd, dim3(grid), dim3(NTHREADS), LDS_BYTES, stream, p);
#endif
    (void)hipMemsetAsync((char*)d_ws + WS_CTL, 0, CTL_ZERO_BYTES, stream);
    p.lo = PROBE_SPLITK + 1; p.hi = 13; hipLaunchKernelGGL(mk_fwd, dim3(grid), dim3(NTHREADS), LDS_BYTES, stream, p);
#else
    p.lo = 0; p.hi = 13; hipLaunchKernelGGL(mk_fwd, dim3(grid), dim3(NTHREADS), LDS_BYTES, stream, p);
#endif
#endif
#ifdef PROBE_EXP
    (void)hipMemsetAsync((char*)d_ws + WS_CTL, 0, CTL_ZERO_BYTES, stream);
    p.lo = 13; p.hi = 14; hipLaunchKernelGGL(mk_fwd, dim3(grid), dim3(NTHREADS), LDS_BYTES, stream, p);
#endif
#ifdef PROBE_RELAUNCH
    p.lo = PROBE_RELAUNCH; p.hi = PROBE_RELAUNCH + 1; hipLaunchKernelGGL(mk_fwd, dim3(grid), dim3(NTHREADS), LDS_BYTES, stream, p);
#endif
}
```

```cpp
#include <hip/hip_runtime.h>
#include <cstdio>
#include <cstdint>
namespace pg8 {
#define PG8_LAS __attribute__((address_space(3)))
typedef unsigned short bf16_t;
typedef short bf16x8 __attribute__((ext_vector_type(8)));
typedef float f32x4 __attribute__((ext_vector_type(4)));
typedef unsigned u32x4 __attribute__((ext_vector_type(4)));
constexpr int BM = 256, BK = 64, HALF = 128, HTB = HALF * BK * 2  , STAGE_BYTES = 8 * HTB, NXCD = 8, WGM = 8;

__host__ __device__ __forceinline__ int lds_byte(int r, int c) { const int st = (r >> 4) * 2 + (c >> 5), rr = r & 15, cc = c & 31, ob = rr * 64 + cc * 2; return st * 1024 + (ob ^ (((ob >> 9) & 1) << 5)); }
__host__ __device__ __forceinline__ void stage_rc(int b, int& R, int& C) { const int st = b / 1024, sb = b % 1024, swz = sb ^ (((sb >> 9) & 1) << 5); R = (st >> 1) * 16 + swz / 64; C = (st & 1) * 32 + (swz % 64) / 2; }
__host__ __device__ __forceinline__ int perm32(int rho) { const int n = rho >> 4, i = rho & 15; return 8 * (i >> 2) + 4 * n + (i & 3); }

struct Unit { int pm, pn; };
struct Gemm { const bf16_t* A; const bf16_t* Bt; int M, N, K; };

struct StaticOrder {
    int nM, nN, nwg, G, c;
    __host__ __device__ void init(int M, int N, int G_, int c_) { nM = M / BM; nN = N / BM; nwg = nM * nN; G = G_; c = c_; }
    __host__ __device__ bool next(int i, Unit& u) const {
        const long L = (long)i * G + c; if (L >= nwg) return false;
        int wgid = (int)L; { const int q = nwg / NXCD, r = nwg % NXCD, xcd = wgid % NXCD, off = wgid / NXCD; wgid = (xcd < r ? xcd * (q + 1) : r * (q + 1) + (xcd - r) * q) + off; }
        const int nig = WGM * nN, gid = wgid / nig, fm = gid * WGM, gsz = (nM - fm) < WGM ? (nM - fm) : WGM;
        u.pm = fm + ((wgid % nig) % gsz); u.pn = (wgid % nig) / gsz; return true;
    }
    __device__ __forceinline__ void a_ready(const Unit&) const {}
    __device__ __forceinline__ void done(const Unit&) const {}
};
__device__ __forceinline__ unsigned cvt_pk_bf16(float lo, float hi) { unsigned r; asm volatile("v_cvt_pk_bf16_f32 %0, %1, %2" : "=v"(r) : "v"(lo), "v"(hi)); return r; }
typedef float f32x2 __attribute__((ext_vector_type(2)));
__device__ __forceinline__ f32x2 gelu_pk(f32x2 v) {
    const f32x2 av = __builtin_elementwise_abs(v), d = av * 0.2316418882f + 1.0f;
    f32x2 t; t.x = __builtin_amdgcn_rcpf(d.x); t.y = __builtin_amdgcn_rcpf(d.y);
    f32x2 q = t * 0.5307027145f + (-0.7265760135f); q = q * t + 0.7107068705f; q = q * t + (-0.142248368f); q = q * t + 0.127414796f; q = q * t;
    const f32x2 s = (v * v) * (-0.72134752044f);
    f32x2 e; e.x = __builtin_amdgcn_exp2f(s.x); e.y = __builtin_amdgcn_exp2f(s.y);
    const f32x2 m = v * (q * e), r = v - m;
    f32x2 o; o.x = v.x < 0.f ? m.x : r.x; o.y = v.y < 0.f ? m.y : r.y; return o;
}
template <class Epi, class Sched, bool STAMP = false, bool FP8 = false, int XSCALE = 127>
__device__ __forceinline__ void gemm_phase(PG8_LAS unsigned char* lds, const Gemm g, const Sched& S, const Epi& E, unsigned long long* stamps) {
    int tid_l = threadIdx.x; asm volatile("" : "+v"(tid_l));
    const int tid = tid_l, wid = __builtin_amdgcn_readfirstlane(tid >> 6), lane = tid & 63, wr = wid >> 2, wc = wid & 3, fr = lane & 15, fq = lane >> 4;
    const int K = g.K, nt = K / BK;
    int ts_lo = 0, ts_hi = 0, nts = 0; const unsigned long long rt_entry = STAMP ? (unsigned long long)wall_clock64() : 0ull;
#define PG8_STAMP() do { if (STAMP && wid == 0 && nts < 64) { const unsigned long long _c = (unsigned long long)clock64(); \
        ts_lo = (lane == nts) ? (int)(unsigned)_c : ts_lo; ts_hi = (lane == nts) ? (int)(unsigned)(_c >> 32) : ts_hi; ++nts; } } while (0)
    PG8_STAMP();
    unsigned voffA[2], voffB[2];
#pragma unroll
    for (int i = 0; i < 2; ++i) { int R, C; stage_rc(tid * 16 + i * 8192, R, C); const int Rb = Epi::PERM ? ((R & ~31) + perm32(R & 31)) : R;
        voffA[i] = (unsigned)(R * K + C) * 2u; voffB[i] = (unsigned)(Rb * K + C) * 2u; }
    const size_t kstep = (size_t)(BK * 2);
    const size_t hstep = (size_t)HALF * K * 2;
    const size_t tstep = 2 * hstep;
    const unsigned ldsw = (unsigned)wid * 1024u;
    const int aoff = lds_byte(wr * 64 + fr, fq * 8), boff = lds_byte(wc * 32 + fr, fq * 8);
#define PG8_SA(b, h) (((b) * 2 + (h)) * HTB)
#define PG8_SB(b, h) ((4 + (b) * 2 + (h)) * HTB)
#define PG8_STAGE(bufoff, gbase, voff) do { _Pragma("unroll") for (int _i = 0; _i < 2; ++_i) \
        __builtin_amdgcn_global_load_lds((const unsigned*)((const char*)(gbase) + (voff)[_i]), (PG8_LAS unsigned*)(lds + (bufoff) + ldsw + _i * 8192), 16, 0, 0); } while (0)
#define PG8_LDA(dst, b, h) do { if constexpr (FP8) { _Pragma("unroll") for (int m = 0; m < 4; ++m) dst##8[m] = __builtin_shufflevector(*(const PG8_LAS i32x4_*)(lds + PG8_SA(b, h) + aoff + m * 2048), *(const PG8_LAS i32x4_*)(lds + PG8_SA(b, h) + aoff + m * 2048 + 1024), 0, 1, 2, 3, 4, 5, 6, 7); } \
        else { _Pragma("unroll") for (int m = 0; m < 4; ++m) _Pragma("unroll") for (int k = 0; k < 2; ++k) dst[m][k] = *(const PG8_LAS bf16x8*)(lds + PG8_SA(b, h) + aoff + m * 2048 + k * 1024); } } while (0)
#define PG8_LDB(dst, b, h) do { if constexpr (FP8) { _Pragma("unroll") for (int n = 0; n < 2; ++n) dst##8[n] = __builtin_shufflevector(*(const PG8_LAS i32x4_*)(lds + PG8_SB(b, h) + boff + n * 2048), *(const PG8_LAS i32x4_*)(lds + PG8_SB(b, h) + boff + n * 2048 + 1024), 0, 1, 2, 3, 4, 5, 6, 7); } \
        else { _Pragma("unroll") for (int n = 0; n < 2; ++n) _Pragma("unroll") for (int k = 0; k < 2; ++k) dst[n][k] = *(const PG8_LAS bf16x8*)(lds + PG8_SB(b, h) + boff + n * 2048 + k * 1024); } } while (0)
#define PG8_MMA(ai, bj, At, Bt) do { __builtin_amdgcn_s_setprio(1); _Pragma("unroll") for (int m = 0; m < 4; ++m) _Pragma("unroll") for (int n = 0; n < 2; ++n) { \
        if constexpr (FP8) asm volatile("v_mfma_scale_f32_16x16x128_f8f6f4 %0, %1, %2, %0, %3, %4 op_sel_hi:[0,0,0]" : "+v"(acc[ai][bj][m][n]) : "v"(Bt##8[n]), "v"(At##8[m]), "v"(scale_w), "v"(scale_x));        \
        else { _Pragma("unroll") for (int k = 0; k < 2; ++k) acc[ai][bj][m][n] = __builtin_amdgcn_mfma_f32_16x16x32_bf16(Bt[n][k], At[m][k], acc[ai][bj][m][n], 0, 0, 0); } } \
        __builtin_amdgcn_s_setprio(0); } while (0)
#define PG8_WAIT_V(n) asm volatile("s_waitcnt vmcnt(" #n ")" ::: "memory")
#define PG8_WAIT_L(n) asm volatile("s_waitcnt lgkmcnt(" #n ")" ::: "memory")
#define PG8_BAR __builtin_amdgcn_s_barrier()
#define PG8_SCHED __builtin_amdgcn_sched_barrier(0)
    Unit cur, nxt; int ui = 0;
    if (!S.next(0, cur)) return;
    f32x4 acc[2][2][4][2];
#pragma unroll
    for (int a = 0; a < 2; ++a)
#pragma unroll
        for (int b = 0; b < 2; ++b)
#pragma unroll
            for (int m = 0; m < 4; ++m)
#pragma unroll
                for (int n = 0; n < 2; ++n) acc[a][b][m][n] = (f32x4){0.f, 0.f, 0.f, 0.f};
    typedef int i32x4_ __attribute__((ext_vector_type(4))); typedef int i32x8_ __attribute__((ext_vector_type(8)));
    int scale_w = 122, scale_x = XSCALE; asm volatile("" : "+v"(scale_w), "+v"(scale_x));
    bf16x8 At[4][2], B0[2][2], B1[2][2]; i32x8_ At8[4], B08[2], B18[2];
    const char* cA = (const char*)g.A + (size_t)cur.pm * tstep; const char* cB = (const char*)g.Bt + (size_t)cur.pn * tstep;
    S.a_ready(cur);
    PG8_STAGE(PG8_SB(0, 0), cB, voffB); PG8_STAGE(PG8_SA(0, 0), cA, voffA); PG8_STAGE(PG8_SB(0, 1), cB + hstep, voffB); PG8_STAGE(PG8_SA(0, 1), cA + hstep, voffA);
    if (wr == 1) PG8_BAR;
    PG8_WAIT_V(4); PG8_BAR;
    PG8_STAGE(PG8_SB(1, 0), cB + kstep, voffB); PG8_STAGE(PG8_SA(1, 0), cA + kstep, voffA); PG8_STAGE(PG8_SB(1, 1), cB + hstep + kstep, voffB);
    PG8_WAIT_V(6); PG8_BAR;
    PG8_STAMP();
    for (;;) {
        const bool has_next = S.next(ui + 1, nxt);
        const char* nA = has_next ? (const char*)g.A + (size_t)nxt.pm * tstep : cA; const char* nB = has_next ? (const char*)g.Bt + (size_t)nxt.pn * tstep : cB;
        for (int t = 0; t < nt; t += 2) {
            const bool last = (t == nt - 2);
            const char* a1 = cA + (size_t)(t + 1) * kstep;
            const char* a2 = last ? nA : cA + (size_t)(t + 2) * kstep; const char* b2 = last ? nB : cB + (size_t)(t + 2) * kstep;
            const char* a3 = a2 + kstep; const char* b3 = b2 + kstep;
            if (last && has_next) S.a_ready(nxt);
            PG8_LDB(B0, 0, 0); PG8_SCHED; PG8_LDA(At, 0, 0); PG8_STAGE(PG8_SA(1, 1), a1 + hstep, voffA);
            PG8_WAIT_L(8); PG8_BAR; PG8_WAIT_L(0); PG8_MMA(0, 0, At, B0); PG8_BAR; PG8_SCHED;
            PG8_LDB(B1, 0, 1); PG8_STAGE(PG8_SB(0, 0), b2, voffB);
            PG8_BAR; PG8_WAIT_L(0); PG8_MMA(0, 1, At, B1); PG8_BAR;
            PG8_LDA(At, 0, 1); PG8_STAGE(PG8_SA(0, 0), a2, voffA);
            PG8_BAR; PG8_WAIT_L(0); PG8_MMA(1, 0, At, B0); PG8_BAR; PG8_SCHED;
            PG8_STAGE(PG8_SB(0, 1), b2 + hstep, voffB);
            PG8_WAIT_V(6); PG8_BAR; PG8_MMA(1, 1, At, B1); PG8_BAR;
            PG8_LDB(B0, 1, 0); PG8_SCHED; PG8_LDA(At, 1, 0); PG8_STAGE(PG8_SA(0, 1), a2 + hstep, voffA);
            PG8_WAIT_L(8); PG8_BAR; PG8_WAIT_L(0); PG8_MMA(0, 0, At, B0); PG8_BAR; PG8_SCHED;
            PG8_LDB(B1, 1, 1); PG8_STAGE(PG8_SB(1, 0), b3, voffB);
            PG8_BAR; PG8_WAIT_L(0); PG8_MMA(0, 1, At, B1); PG8_BAR;
            PG8_LDA(At, 1, 1); PG8_STAGE(PG8_SA(1, 0), a3, voffA);
            PG8_BAR; PG8_WAIT_L(0); PG8_MMA(1, 0, At, B0); PG8_BAR; PG8_SCHED;
            PG8_STAGE(PG8_SB(1, 1), b3 + hstep, voffB);
            PG8_WAIT_V(6); PG8_BAR; PG8_MMA(1, 1, At, B1); PG8_BAR;
        }
        PG8_STAMP();
        if constexpr (FP8) { asm volatile("s_nop 15\n\ts_nop 15" ::: "memory");
#pragma unroll
            for (int a = 0; a < 2; ++a)
#pragma unroll
                for (int b = 0; b < 2; ++b)
#pragma unroll
                    for (int m = 0; m < 4; ++m)
#pragma unroll
                        for (int n = 0; n < 2; ++n) asm volatile("" : "+v"(acc[a][b][m][n])); }
        if constexpr (!Epi::AFTER_DRAIN) { E(acc, cur, wr, wc, fr, fq); S.done(cur); }
        PG8_STAMP();
        if (!has_next) break;
#pragma unroll
        for (int a = 0; a < 2; ++a)
#pragma unroll
            for (int b = 0; b < 2; ++b)
#pragma unroll
                for (int m = 0; m < 4; ++m)
#pragma unroll
                    for (int n = 0; n < 2; ++n) acc[a][b][m][n] = (f32x4){0.f, 0.f, 0.f, 0.f};
        cur = nxt; cA = nA; cB = nB; ++ui;
    }
    PG8_WAIT_V(0);
    if (wr == 0) PG8_BAR;
    PG8_BAR;
    if constexpr (Epi::AFTER_DRAIN) { E.fused(acc, cur, wr, wc, fr, fq, lds, wid, lane); S.done(cur); }
    PG8_STAMP();
    if (STAMP && wid == 0) { stamps[lane] = lane < nts ? (((unsigned long long)(unsigned)ts_hi << 32) | (unsigned)ts_lo) : 0ull;
        if (lane == 62) stamps[62] = rt_entry; if (lane == 63) stamps[63] = (unsigned long long)wall_clock64(); }
#undef PG8_STAMP
#undef PG8_SA
#undef PG8_SB
#undef PG8_STAGE
#undef PG8_LDA
#undef PG8_LDB
#undef PG8_MMA
#undef PG8_WAIT_V
#undef PG8_WAIT_L
#undef PG8_BAR
#undef PG8_SCHED
}
}

namespace pg8 {
struct MergeArgs { const bf16_t* A[3]; const bf16_t* Bt[3]; int K[3]; const bf16_t* gates; unsigned char* mb; };
template <class Sched, bool FP8 = false>
__device__ __forceinline__ void gemm_phase_merge(PG8_LAS unsigned char* lds, const MergeArgs g, const Sched& S) {
    int tid_l = threadIdx.x; asm volatile("" : "+v"(tid_l));
    const int tid = tid_l, wid = __builtin_amdgcn_readfirstlane(tid >> 6), lane = tid & 63, wr = wid >> 2, wc = wid & 3, fr = lane & 15, fq = lane >> 4;
    unsigned R2A[2], R2B[2], C2[2];
#pragma unroll
    for (int i = 0; i < 2; ++i) { int R, C; stage_rc(tid * 16 + i * 8192, R, C); const int Rb = (R & ~31) + perm32(R & 31); R2A[i] = (unsigned)R * 2u; R2B[i] = (unsigned)Rb * 2u; C2[i] = (unsigned)C * 2u; }
    const size_t kstep = (size_t)(BK * 2);
    const unsigned ldsw = (unsigned)wid * 1024u;
    const int aoff = lds_byte(wr * 64 + fr, fq * 8), boff = lds_byte(wc * 32 + fr, fq * 8);
#define PG8_SA(b, h) (((b) * 2 + (h)) * HTB)
#define PG8_SB(b, h) ((4 + (b) * 2 + (h)) * HTB)
#define PG8_STAGEK(bufoff, gbase, R2, KK) do { _Pragma("unroll") for (int _i = 0; _i < 2; ++_i) \
        __builtin_amdgcn_global_load_lds((const unsigned*)((const char*)(gbase) + (R2)[_i] * (unsigned)(KK) + C2[_i]), (PG8_LAS unsigned*)(lds + (bufoff) + ldsw + _i * 8192), 16, 0, 0); } while (0)
#define PG8_LDA(dst, b, h) do { if constexpr (FP8) { _Pragma("unroll") for (int m = 0; m < 4; ++m) dst##8[m] = __builtin_shufflevector(*(const PG8_LAS i32x4_*)(lds + PG8_SA(b, h) + aoff + m * 2048), *(const PG8_LAS i32x4_*)(lds + PG8_SA(b, h) + aoff + m * 2048 + 1024), 0, 1, 2, 3, 4, 5, 6, 7); } \
        else { _Pragma("unroll") for (int m = 0; m < 4; ++m) _Pragma("unroll") for (int k = 0; k < 2; ++k) dst[m][k] = *(const PG8_LAS bf16x8*)(lds + PG8_SA(b, h) + aoff + m * 2048 + k * 1024); } } while (0)
#define PG8_LDB(dst, b, h) do { if constexpr (FP8) { _Pragma("unroll") for (int n = 0; n < 2; ++n) dst##8[n] = __builtin_shufflevector(*(const PG8_LAS i32x4_*)(lds + PG8_SB(b, h) + boff + n * 2048), *(const PG8_LAS i32x4_*)(lds + PG8_SB(b, h) + boff + n * 2048 + 1024), 0, 1, 2, 3, 4, 5, 6, 7); } \
        else { _Pragma("unroll") for (int n = 0; n < 2; ++n) _Pragma("unroll") for (int k = 0; k < 2; ++k) dst[n][k] = *(const PG8_LAS bf16x8*)(lds + PG8_SB(b, h) + boff + n * 2048 + k * 1024); } } while (0)
#define PG8_MMA(ai, bj, At, Bt) do { __builtin_amdgcn_s_setprio(1); _Pragma("unroll") for (int m = 0; m < 4; ++m) _Pragma("unroll") for (int n = 0; n < 2; ++n) { \
        if constexpr (FP8) asm volatile("v_mfma_scale_f32_16x16x128_f8f6f4 %0, %1, %2, %0, %3, %4 op_sel_hi:[0,0,0]" : "+v"(acc[ai][bj][m][n]) : "v"(Bt##8[n]), "v"(At##8[m]), "v"(scale_w), "v"(scale_x)); \
        else { _Pragma("unroll") for (int k = 0; k < 2; ++k) acc[ai][bj][m][n] = __builtin_amdgcn_mfma_f32_16x16x32_bf16(Bt[n][k], At[m][k], acc[ai][bj][m][n], 0, 0, 0); } } \
        __builtin_amdgcn_s_setprio(0); } while (0)
#define PG8_WAIT_V(n) asm volatile("s_waitcnt vmcnt(" #n ")" ::: "memory")
#define PG8_WAIT_L(n) asm volatile("s_waitcnt lgkmcnt(" #n ")" ::: "memory")
#define PG8_BAR __builtin_amdgcn_s_barrier()
#define PG8_SCHED __builtin_amdgcn_sched_barrier(0)
    Unit cur, nxt; int ui = 0, seg = 0;
    if (!S.next(0, cur)) return;
    f32x4 acc[2][2][4][2];
#pragma unroll
    for (int a = 0; a < 2; ++a)
#pragma unroll
        for (int b = 0; b < 2; ++b)
#pragma unroll
            for (int m = 0; m < 4; ++m)
#pragma unroll
                for (int n = 0; n < 2; ++n) acc[a][b][m][n] = (f32x4){0.f, 0.f, 0.f, 0.f};
    typedef int i32x4_ __attribute__((ext_vector_type(4))); typedef int i32x8_ __attribute__((ext_vector_type(8)));
    int scale_w = 122, scale_x = 123; asm volatile("" : "+v"(scale_w), "+v"(scale_x));
    bf16x8 At[4][2], B0[2][2], B1[2][2]; i32x8_ At8[4], B08[2], B18[2];
    int Kc = g.K[0];
    const char* cA = (const char*)g.A[0] + (size_t)cur.pm * 512 * Kc; const char* cB = (const char*)g.Bt[0] + (size_t)cur.pn * 512 * Kc;
    {   const size_t hs = (size_t)256 * Kc;
        PG8_STAGEK(PG8_SB(0, 0), cB, R2B, Kc); PG8_STAGEK(PG8_SA(0, 0), cA, R2A, Kc); PG8_STAGEK(PG8_SB(0, 1), cB + hs, R2B, Kc); PG8_STAGEK(PG8_SA(0, 1), cA + hs, R2A, Kc);
        if (wr == 1) PG8_BAR;
        PG8_WAIT_V(4); PG8_BAR;
        PG8_STAGEK(PG8_SB(1, 0), cB + kstep, R2B, Kc); PG8_STAGEK(PG8_SA(1, 0), cA + kstep, R2A, Kc); PG8_STAGEK(PG8_SB(1, 1), cB + hs + kstep, R2B, Kc);
        PG8_WAIT_V(6); PG8_BAR; }
    for (;;) {
        bool has_next_tile = false; int nseg = seg + 1; Unit nu = cur;
        if (nseg == 3) { nseg = 0; has_next_tile = S.next(ui + 1, nxt); nu = nxt; }
        const bool more = (seg < 2) || has_next_tile;
        const int Kn = more ? (nseg == 0 ? g.K[0] : (nseg == 1 ? g.K[1] : g.K[2])) : Kc;
        const bf16_t* gA = nseg == 0 ? g.A[0] : (nseg == 1 ? g.A[1] : g.A[2]); const bf16_t* gB = nseg == 0 ? g.Bt[0] : (nseg == 1 ? g.Bt[1] : g.Bt[2]);
        const char* nA = more ? (const char*)gA + (size_t)nu.pm * 512 * Kn : cA; const char* nB = more ? (const char*)gB + (size_t)nu.pn * 512 * Kn : cB;
        const int nt = Kc / BK; const size_t hsc = (size_t)256 * Kc, hsn = (size_t)256 * Kn;
        for (int t = 0; t < nt; t += 2) {
            const bool last = (t == nt - 2);
            const char* a1 = cA + (size_t)(t + 1) * kstep;
            const char* a2 = last ? nA : cA + (size_t)(t + 2) * kstep; const char* b2 = last ? nB : cB + (size_t)(t + 2) * kstep;
            const char* a3 = a2 + kstep; const char* b3 = b2 + kstep;
            const int K2 = last ? Kn : Kc; const size_t hs2 = last ? hsn : hsc;
            PG8_LDB(B0, 0, 0); PG8_SCHED; PG8_LDA(At, 0, 0); PG8_STAGEK(PG8_SA(1, 1), a1 + hsc, R2A, Kc);
            PG8_WAIT_L(8); PG8_BAR; PG8_WAIT_L(0); PG8_MMA(0, 0, At, B0); PG8_BAR; PG8_SCHED;
            PG8_LDB(B1, 0, 1); PG8_STAGEK(PG8_SB(0, 0), b2, R2B, K2);
            PG8_BAR; PG8_WAIT_L(0); PG8_MMA(0, 1, At, B1); PG8_BAR;
            PG8_LDA(At, 0, 1); PG8_STAGEK(PG8_SA(0, 0), a2, R2A, K2);
            PG8_BAR; PG8_WAIT_L(0); PG8_MMA(1, 0, At, B0); PG8_BAR; PG8_SCHED;
            PG8_STAGEK(PG8_SB(0, 1), b2 + hs2, R2B, K2);
            PG8_WAIT_V(6); PG8_BAR; PG8_MMA(1, 1, At, B1); PG8_BAR;
            PG8_LDB(B0, 1, 0); PG8_SCHED; PG8_LDA(At, 1, 0); PG8_STAGEK(PG8_SA(0, 1), a2 + hs2, R2A, K2);
            PG8_WAIT_L(8); PG8_BAR; PG8_WAIT_L(0); PG8_MMA(0, 0, At, B0); PG8_BAR; PG8_SCHED;
            PG8_LDB(B1, 1, 1); PG8_STAGEK(PG8_SB(1, 0), b3, R2B, K2);
            PG8_BAR; PG8_WAIT_L(0); PG8_MMA(0, 1, At, B1); PG8_BAR;
            PG8_LDA(At, 1, 1); PG8_STAGEK(PG8_SA(1, 0), a3, R2A, K2);
            PG8_BAR; PG8_WAIT_L(0); PG8_MMA(1, 0, At, B0); PG8_BAR; PG8_SCHED;
            PG8_STAGEK(PG8_SB(1, 1), b3 + hs2, R2B, K2);
            PG8_WAIT_V(6); PG8_BAR; PG8_MMA(1, 1, At, B1); PG8_BAR;
        }
        if constexpr (FP8) { asm volatile("s_nop 15\n\ts_nop 15" ::: "memory");
#pragma unroll
            for (int a = 0; a < 2; ++a)
#pragma unroll
                for (int b = 0; b < 2; ++b)
#pragma unroll
                    for (int mm = 0; mm < 4; ++mm)
#pragma unroll
                        for (int n = 0; n < 2; ++n) asm volatile("" : "+v"(acc[a][b][mm][n])); }
        {   const int row0 = cur.pm * 256 + wr * 64 + fr, col0 = cur.pn * 256 + wc * 32 + 8 * fq;
            const unsigned char* gb_s = (const unsigned char*)g.gates + ((size_t)(seg * 128 + cur.pm) * 4 + cur.pn) * 65536 + (size_t)tid * 16;
            const unsigned char* gb_n = gb_s + (size_t)128 * 4 * 65536;
            u32x4 GS[2][2], GN[2][2]; typedef float f32x2_m __attribute__((ext_vector_type(2)));
#define MRG_LOAD(buf, bt) do { _Pragma("unroll") for (int cp = 0; cp < 2; ++cp) { GS[buf][cp] = *(const u32x4*)(gb_s + (size_t)(((bt) * 2 + cp) * 512) * 16); \
                GN[buf][cp] = (seg < 2) ? *(const u32x4*)(gb_n + (size_t)(((bt) * 2 + cp) * 512) * 16) : (u32x4){0x38383838u, 0x38383838u, 0x38383838u, 0x38383838u}; } } while (0)
#define MRG_APPLY(buf, bt) do { _Pragma("unroll") for (int c = 0; c < 4; ++c) { const int idx = (bt) * 4 + c, ai = idx >> 3, m = (idx >> 1) & 3, bj = idx & 1; \
                const unsigned gs0 = bj ? GS[buf][c >> 1].z : GS[buf][c >> 1].x, gs1 = bj ? GS[buf][c >> 1].w : GS[buf][c >> 1].y, gn0 = bj ? GN[buf][c >> 1].z : GN[buf][c >> 1].x, gn1 = bj ? GN[buf][c >> 1].w : GN[buf][c >> 1].y; \
                const f32x2_m fa = __builtin_amdgcn_cvt_pk_f32_fp8((int)gs0, false), fb = __builtin_amdgcn_cvt_pk_f32_fp8((int)gs0, true), fc = __builtin_amdgcn_cvt_pk_f32_fp8((int)gs1, false), fd = __builtin_amdgcn_cvt_pk_f32_fp8((int)gs1, true); \
                const f32x2_m da = __builtin_amdgcn_cvt_pk_f32_fp8((int)gn0, false), db = __builtin_amdgcn_cvt_pk_f32_fp8((int)gn0, true), dc = __builtin_amdgcn_cvt_pk_f32_fp8((int)gn1, false), dd = __builtin_amdgcn_cvt_pk_f32_fp8((int)gn1, true); \
                float f[8] = {fa.x, fa.y, fb.x, fb.y, fc.x, fc.y, fd.x, fd.y}; const float d[8] = {da.x, da.y, db.x, db.y, dc.x, dc.y, dd.x, dd.y}; \
                _Pragma("unroll") for (int j = 0; j < 8; ++j) f[j] = d[j] * __builtin_amdgcn_rcpf(f[j]);        \
                f32x4 v0 = acc[ai][bj][m][0], v1 = acc[ai][bj][m][1]; \
                v0[0] *= f[0]; v0[1] *= f[1]; v0[2] *= f[2]; v0[3] *= f[3]; v1[0] *= f[4]; v1[1] *= f[5]; v1[2] *= f[6]; v1[3] *= f[7]; \
                if (seg < 2) { acc[ai][bj][m][0] = v0; acc[ai][bj][m][1] = v1; } \
                else { typedef unsigned u32x2_ __attribute__((ext_vector_type(2))); u32x2_ w; int t8 = 0; t8 = __builtin_amdgcn_cvt_pk_fp8_f32(v0[0] * 0.25f, v0[1] * 0.25f, t8, false); t8 = __builtin_amdgcn_cvt_pk_fp8_f32(v0[2] * 0.25f, v0[3] * 0.25f, t8, true); w.x = (unsigned)t8; \
                    t8 = 0; t8 = __builtin_amdgcn_cvt_pk_fp8_f32(v1[0] * 0.25f, v1[1] * 0.25f, t8, false); t8 = __builtin_amdgcn_cvt_pk_fp8_f32(v1[2] * 0.25f, v1[3] * 0.25f, t8, true); w.y = (unsigned)t8; \
                    *(u32x2_*)(g.mb + (size_t)(row0 + ai * 128 + m * 16) * 1024 + col0 + bj * 128) = w;        \
                    acc[ai][bj][m][0] = (f32x4){0.f, 0.f, 0.f, 0.f}; acc[ai][bj][m][1] = (f32x4){0.f, 0.f, 0.f, 0.f}; } } } while (0)
            MRG_LOAD(0, 0);
#pragma unroll
            for (int bt = 0; bt < 4; bt += 2) {
                MRG_LOAD(1, bt + 1); asm volatile("" ::: "memory"); MRG_APPLY(0, bt);
                if (bt + 2 < 4) { MRG_LOAD(0, bt + 2); } asm volatile("" ::: "memory"); MRG_APPLY(1, bt + 1); }
#undef MRG_LOAD
#undef MRG_APPLY
        }
        if (!more) break;
        if (nseg == 0) { cur = nxt; ++ui; }
        seg = nseg; Kc = Kn; cA = nA; cB = nB;
    }
    PG8_WAIT_V(0);
    if (wr == 0) PG8_BAR;
    PG8_BAR;
#undef PG8_SA
#undef PG8_SB
#undef PG8_STAGEK
#undef PG8_LDA
#undef PG8_LDB
#undef PG8_MMA
#undef PG8_WAIT_V
#undef PG8_WAIT_L
#undef PG8_BAR
#undef PG8_SCHED
}
}
#define XB_TMO      128
#define XB_XCNT(j)  (256  + 64 * (j))
#define XB_XSUB(j)  (1280 + 64 * (j))
#define XB_XGEN(j)  (2304 + 64 * (j))
#define XB_TOP      3328
#define XB_TOPGEN   3392
#define XCD_BAR_WORDS 3456
#define XB_SPIN_CAP (1u << 18)
#define LAS __attribute__((address_space(3)))

__device__ __forceinline__ unsigned xb_ld(unsigned* p)              { return __hip_atomic_load(p, __ATOMIC_RELAXED, __HIP_MEMORY_SCOPE_AGENT); }
__device__ __forceinline__ unsigned xb_add(unsigned* p, unsigned v) { return __hip_atomic_fetch_add(p, v, __ATOMIC_RELAXED, __HIP_MEMORY_SCOPE_AGENT); }
__device__ __forceinline__ unsigned xb_xcc_id() { return (unsigned)__builtin_amdgcn_s_getreg((3 << 11) | 20) & 0xFu; }
#define XB_SPIN(cond, bar) do { unsigned _sp = 0; while (cond) { __builtin_amdgcn_s_sleep(1); \
    if ((++_sp & 255u) == 0u) { if (xb_ld(&(bar)[XB_TMO])) break; if (_sp > XB_SPIN_CAP) { atomicAdd(&(bar)[XB_TMO], 1u); break; } } } } while (0)

struct XcdBarrier {
    unsigned* bar; unsigned x;
    volatile LAS unsigned* st;
};

__device__ __forceinline__ XcdBarrier xcd_barrier_post(unsigned* bar, volatile LAS unsigned* st) {
    XcdBarrier b; b.bar = bar; b.x = xb_xcc_id(); b.st = st;
    if (threadIdx.x == 0) (void)xb_add(&bar[XB_XCNT(b.x)], 1u);
    return b;
}
__device__ __forceinline__ void xcd_barrier_complete(unsigned* bar, unsigned x, unsigned& nloc, unsigned& nx) {
    const unsigned G = gridDim.x * gridDim.y * gridDim.z;
    unsigned sum, cnt, mine, sp = 0u;
    for (;;) {
        sum = 0u; cnt = 0u; mine = 0u;
#pragma unroll
        for (unsigned j = 0; j < 16; ++j) { const unsigned c = xb_ld(&bar[XB_XCNT(j)]); sum += c; cnt += (c > 0u) ? 1u : 0u; mine = (j == x) ? c : mine; }
        if (sum == G) break;
        __builtin_amdgcn_s_sleep(1);
        if ((++sp & 255u) == 0u) { if (xb_ld(&bar[XB_TMO])) break; if (sp > XB_SPIN_CAP) { atomicAdd(&bar[XB_TMO], 1u); break; } }
    }
    nloc = mine > 0u ? mine : 1u; nx = cnt > 0u ? cnt : 1u;
}

__device__ __forceinline__ void xcd_barrier(const XcdBarrier& b) {
    asm volatile("s_waitcnt vmcnt(0)" ::: "memory");
    __syncthreads();
    if (threadIdx.x == 0) {
        unsigned* bar = b.bar;
        __builtin_amdgcn_s_waitcnt(0);
        unsigned nloc = b.st[0], nx = b.st[1];
        if (nloc == 0u) { xcd_barrier_complete(bar, b.x, nloc, nx); b.st[0] = nloc; b.st[1] = nx; }
        const unsigned old = xb_add(&bar[XB_XSUB(b.x)], 1u);
        const unsigned gen = old / nloc;
        if (old + 1u == (gen + 1u) * nloc) {
            __builtin_amdgcn_fence(__ATOMIC_RELEASE, "agent");
            asm volatile("s_waitcnt vmcnt(0)" ::: "memory");
            const unsigned og = xb_add(&bar[XB_TOP], 1u);
            const unsigned tg = og / nx;
            if (og + 1u == (tg + 1u) * nx) xb_add(&bar[XB_TOPGEN], 1u);
            else XB_SPIN(xb_ld(&bar[XB_TOPGEN]) == tg, bar);
            __builtin_amdgcn_fence(__ATOMIC_ACQUIRE, "agent");
            xb_add(&bar[XB_XGEN(b.x)], 1u);
            asm volatile("s_waitcnt vmcnt(0)" ::: "memory");
        } else {
            XB_SPIN(xb_ld(&bar[XB_XGEN(b.x)]) == gen, bar);
            __builtin_amdgcn_fence(__ATOMIC_ACQUIRE, "agent");
            asm volatile("s_waitcnt vmcnt(0)" ::: "memory");
        }
    }
    __syncthreads();
}


typedef unsigned short bf16_t;
typedef float f32x4 __attribute__((ext_vector_type(4)));
typedef unsigned u32x4 __attribute__((ext_vector_type(4)));
typedef unsigned u32x2 __attribute__((ext_vector_type(2)));
typedef __bf16 bf16x2_t __attribute__((ext_vector_type(2)));
constexpr int D = 1024, BATCH = 8, SEQ = 4096, T = BATCH * SEQ, MEMLEN = 256;
constexpr int HQW = 3584, GW = 3072, INW = 6656, NEXP = 16384;
constexpr int C_AQ = 0, C_AK = 768, C_AV = 1536, C_BQ = 2304, C_BK = 2816, C_BV = 2944, C_CQ = 3072;
constexpr float ALPHA = 1.189207115002721f, LOG2E = 1.4426950408889634f, LN2F = 0.6931471805599453f, LN_EPS = 1e-5f, NEGBIG = -1e30f;
constexpr size_t MiB = 1u << 20;
#ifndef DBG_CHECK
#define DBG_CHECK 0
#endif
#ifndef DBG_DROP
#define DBG_DROP 0
#endif
constexpr size_t WS_CTL = 0, WS_WMEMKV = 1 * MiB, WS_WA = 3 * MiB, WS_WB = WS_WA + MiB / 2, WS_WC = WS_WB + MiB, WS_WOUT = WS_WC + MiB, WS_WQ = WS_WOUT + 2 * MiB,
                 WS_SUBK = WS_WQ + 2 * MiB, WS_MEMB = 10 * MiB, WS_KVM = 14 * MiB, WS_STATS = 18 * MiB, WS_LSE = 19 * MiB;
constexpr size_t WS_RA = 24 * MiB, WS_RB = 248 * MiB, WS_RC = 440 * MiB, WS_END = 504 * MiB;
constexpr size_t WS_HQ = WS_RA, WS_GATES = WS_RB, WS_XB = WS_RC;
constexpr size_t WS_MF = WS_RA, WS_MB = WS_RA + 128 * MiB;
constexpr size_t WS_Z = WS_RB, WS_X1B = WS_RB + 128 * MiB;
constexpr size_t WS_Q = WS_RA, WS_EIDX = WS_RA + 88 * MiB - 24 * MiB, WS_GATE = WS_EIDX + 16 * MiB;
constexpr size_t WS_UB = WS_RC, WS_VB = WS_RC + 32 * MiB;
constexpr size_t DO_WINT = 0;
constexpr size_t DO_OA = 0, DO_YB = 48 * MiB, DO_YC = 80 * MiB, DO_YA = 112 * MiB;

__device__ __forceinline__ size_t hq_off64(int slot, size_t tok) { return ((size_t)slot * T + tok) * 64; }
__device__ __forceinline__ size_t hq_offc(int head, size_t tok) { return (size_t)48 * T * 64 + ((size_t)head * T + tok) * 128; }
__device__ const unsigned char kBucket[3][132] = {
{0,1,2,3,4,5,6,7,8,9,10,11,12,13,14,15,16,16,16,16,16,16,17,17,17,17,17,17,17,17,18,18,18,18,18,18,18,18,18,18,19,19,19,19,19,19,19,19,19,19,19,19,19,19,20,20,20,20,20,20,20,20,20,20,20,20,20,20,20,20,20,20,20,21,21,21,21,21,21,21,21,21,21,21,21,21,21,21,21,21,21,21,21,21,21,21,21,21,21,22,22,22,22,22,22,22,22,22,22,22,22,22,22,22,22,22,22,22,22,22,22,22,22,22,22,22,22,22,22,22,22,22},
{0,4,8,12,16,16,17,17,18,18,19,19,19,19,20,20,20,20,20,21,21,21,21,21,21,22,22,22,22,22,22,22,22,22,23,23,23,23,23,23,23,23,23,23,23,23,24,24,24,24,24,24,24,24,24,24,24,24,24,24,24,24,25,25,25,25,25,25,25,25,25,25,25,25,25,25,25,25,25,25,25,25,25,26,26,26,26,26,26,26,26,26,26,26,26,26,26,26,26,26,26,26,26,26,26,26,26,26,26,26,26,26,26,27,27,27,27,27,27,27,27,27,27,27,27,27,27,27,27,27,27,27},
{0,16,18,19,20,21,21,22,22,23,23,23,24,24,24,24,25,25,25,25,25,26,26,26,26,26,26,26,26,27,27,27,27,27,27,27,27,27,27,28,28,28,28,28,28,28,28,28,28,28,28,28,29,29,29,29,29,29,29,29,29,29,29,29,29,29,29,29,29,29,30,30,30,30,30,30,30,30,30,30,30,30,30,30,30,30,30,30,30,30,30,30,30,30,30,31,31,31,31,31,31,31,31,31,31,31,31,31,31,31,31,31,31,31,31,31,31,31,31,31,31,31,31,31,31,31,31,31,31,31,31,31}};

__device__ __forceinline__ bf16_t f2bf(float x) { unsigned u = __float_as_uint(x); u += 0x7fffu + ((u >> 16) & 1u); return (bf16_t)(u >> 16); }
__device__ __forceinline__ float bf2f(bf16_t h) { return __uint_as_float((unsigned)h << 16); }
__device__ __forceinline__ float bflo(unsigned w) { return __uint_as_float(w << 16); }
__device__ __forceinline__ float bfhi(unsigned w) { return __uint_as_float(w & 0xffff0000u); }
__device__ __forceinline__ unsigned pk2(float lo, float hi) { bf16x2_t v; v.x = (__bf16)lo; v.y = (__bf16)hi; return __builtin_bit_cast(unsigned, v); }
__device__ __forceinline__ float dot2bf(unsigned a, unsigned b, float acc) { return __builtin_amdgcn_fdot2_f32_bf16(__builtin_bit_cast(bf16x2_t, a), __builtin_bit_cast(bf16x2_t, b), acc, false); }
__device__ __forceinline__ float wave_sum(float v) { for (int o = 32; o >= 1; o >>= 1) v += __shfl_xor(v, o, 64); return v; }
__device__ __forceinline__ float wave_max(float v) { for (int o = 32; o >= 1; o >>= 1) v = fmaxf(v, __shfl_xor(v, o, 64)); return v; }

struct EpiIn {
    static constexpr bool PERM = true, AFTER_DRAIN = false;
    bf16_t* hq; bf16_t* gates; const float* bgate;
    __device__ __forceinline__ void operator()(const pg8::f32x4 (&acc)[2][2][4][2], const pg8::Unit& u, int wr, int wc, int fr, int fq) const {
        const int row0 = u.pm * 256 + wr * 64 + fr;
        if (u.pn < 14) {
            const float sc = (u.pn < 3 || u.pn == 9 || u.pn == 10) ? 0.125f * LOG2E : ((u.pn >= 12) ? 0.08838834764831845f * LOG2E : 1.0f);
            const int col0 = u.pn * 256 + wc * 32 + 8 * fq;
#pragma unroll
            for (int ai = 0; ai < 2; ++ai)
#pragma unroll
                for (int m = 0; m < 4; ++m) { const size_t tok = (size_t)(row0 + ai * 128 + m * 16);
#pragma unroll
                    for (int bj = 0; bj < 2; ++bj) { const pg8::f32x4 v0 = acc[ai][bj][m][0] * sc, v1 = acc[ai][bj][m][1] * sc; const int col = col0 + bj * 128;
                        u32x4 w; w.x = pk2(v0[0], v0[1]); w.y = pk2(v0[2], v0[3]); w.z = pk2(v1[0], v1[1]); w.w = pk2(v1[2], v1[3]);
                        bf16_t* dst = (col < 3072) ? hq + hq_off64(col >> 6, tok) + (col & 63) : hq + hq_offc((col - 3072) >> 7, tok) + ((col - 3072) & 127);
                        *(u32x4*)dst = w; } }
        } else {
            const int gi = u.pn - 14, s = gi >> 2, pn = gi & 3, col0 = gi * 256 + wc * 32 + 8 * fq, tid = (wr * 4 + wc) * 64 + fq * 16 + fr;
            unsigned char* blk = (unsigned char*)gates + ((size_t)(s * 128 + u.pm) * 4 + pn) * 65536 + (size_t)tid * 16;
            pg8::f32x4 bv[2][2];
#pragma unroll
            for (int bj = 0; bj < 2; ++bj)
#pragma unroll
                for (int n = 0; n < 2; ++n) bv[bj][n] = *(const pg8::f32x4*)(bgate + col0 + bj * 128 + 4 * n) * (-LOG2E);
#pragma unroll
            for (int ai = 0; ai < 2; ++ai)
#pragma unroll
                for (int m = 0; m < 4; ++m) { u32x4 w;
#pragma unroll
                    for (int bj = 0; bj < 2; ++bj) { pg8::f32x4 v0 = acc[ai][bj][m][0] * (-LOG2E) + bv[bj][0], v1 = acc[ai][bj][m][1] * (-LOG2E) + bv[bj][1];
#pragma unroll
                        for (int j = 0; j < 4; ++j) { v0[j] = fminf(__builtin_amdgcn_exp2f(v0[j]), 16384.0f) * 0.015625f + 0.015625f; v1[j] = fminf(__builtin_amdgcn_exp2f(v1[j]), 16384.0f) * 0.015625f + 0.015625f; }
                        int t8 = 0; t8 = __builtin_amdgcn_cvt_pk_fp8_f32(v0[0], v0[1], t8, false); t8 = __builtin_amdgcn_cvt_pk_fp8_f32(v0[2], v0[3], t8, true); w[2 * bj] = (unsigned)t8;
                        t8 = 0; t8 = __builtin_amdgcn_cvt_pk_fp8_f32(v1[0], v1[1], t8, false); t8 = __builtin_amdgcn_cvt_pk_fp8_f32(v1[2], v1[3], t8, true); w[2 * bj + 1] = (unsigned)t8; }
                    *(u32x4*)(blk + (size_t)((ai * 4 + m) * 512) * 16) = w; }
        }
    }
};
struct EpiPlain {
    static constexpr bool PERM = true, AFTER_DRAIN = false;
    bf16_t* O; int ldc;
    __device__ __forceinline__ void operator()(const pg8::f32x4 (&acc)[2][2][4][2], const pg8::Unit& u, int wr, int wc, int fr, int fq) const {
        const int row0 = u.pm * 256 + wr * 64 + fr, col0 = u.pn * 256 + wc * 32 + 8 * fq;
#pragma unroll
        for (int ai = 0; ai < 2; ++ai)
#pragma unroll
            for (int m = 0; m < 4; ++m) { bf16_t* rowp = O + (size_t)(row0 + ai * 128 + m * 16) * ldc + col0;
#pragma unroll
                for (int bj = 0; bj < 2; ++bj) { const pg8::f32x4 v0 = acc[ai][bj][m][0], v1 = acc[ai][bj][m][1];
                    u32x4 w; w.x = pk2(v0[0], v0[1]); w.y = pk2(v0[2], v0[3]); w.z = pk2(v1[0], v1[1]); w.w = pk2(v1[2], v1[3]);
                    *(u32x4*)(rowp + bj * 128) = w; } }
    }
};
struct EpiOut {
    static constexpr bool PERM = true, AFTER_DRAIN = false;
    const float* x; bf16_t* z; float* stats;
    __device__ __forceinline__ void operator()(const pg8::f32x4 (&acc)[2][2][4][2], const pg8::Unit& u, int wr, int wc, int fr, int fq) const {
        const int row0 = u.pm * 256 + wr * 64 + fr, col0 = u.pn * 256 + wc * 32 + 8 * fq;
#pragma unroll
        for (int ai = 0; ai < 2; ++ai)
#pragma unroll
            for (int m = 0; m < 4; ++m) { const size_t row = (size_t)(row0 + ai * 128 + m * 16); float s = 0.f, ss = 0.f;
#pragma unroll
                for (int bj = 0; bj < 2; ++bj) { const size_t o = row * D + col0 + bj * 128;
                    pg8::f32x4 v0 = *(const pg8::f32x4*)(x + o) * ALPHA + acc[ai][bj][m][0], v1 = *(const pg8::f32x4*)(x + o + 4) * ALPHA + acc[ai][bj][m][1];
                    { u32x4 w; w.x = pk2(v0[0], v0[1]); w.y = pk2(v0[2], v0[3]); w.z = pk2(v1[0], v1[1]); w.w = pk2(v1[2], v1[3]); *(u32x4*)(z + o) = w; }
#pragma unroll
                    for (int j = 0; j < 4; ++j) { s += v0[j] + v1[j]; ss += v0[j] * v0[j] + v1[j] * v1[j]; } }
                s += __shfl_xor(s, 16, 64); ss += __shfl_xor(ss, 16, 64); s += __shfl_xor(s, 32, 64); ss += __shfl_xor(ss, 32, 64);
                if (fq == 0) { atomicAdd(stats + row * 2, s); atomicAdd(stats + row * 2 + 1, ss); } }
    }
};

__device__ __forceinline__ void t_mix(size_t i, const bf16_t* __restrict__ oA, const float* __restrict__ lseA, bf16_t* __restrict__ ya) {
    const size_t t = i >> 5; const int col = (int)(i & 31) * 8, h = col >> 6; const size_t e = t * 256 + col;
    const float l0 = lseA[((size_t)0 * T + t) * 4 + h], l1 = lseA[((size_t)1 * T + t) * 4 + h], l2 = lseA[((size_t)2 * T + t) * 4 + h];
    const u32x4 a = *(const u32x4*)(oA + e), b = *(const u32x4*)(oA + (size_t)T * 256 + e), c = *(const u32x4*)(oA + (size_t)2 * T * 256 + e);
    const float mx = fmaxf(l0, fmaxf(l1, l2)), e0 = __expf(l0 - mx), e1 = __expf(l1 - mx), e2 = __expf(l2 - mx), inv = 1.f / (e0 + e1 + e2); float w0 = e0 * inv, w1 = e1 * inv, w2 = e2 * inv;
    w0 *= 16.f; w1 *= 16.f; w2 *= 16.f;
    u32x2 o; int t8 = 0;
    t8 = __builtin_amdgcn_cvt_pk_fp8_f32(w0 * bflo(a.x) + w1 * bflo(b.x) + w2 * bflo(c.x), w0 * bfhi(a.x) + w1 * bfhi(b.x) + w2 * bfhi(c.x), t8, false); t8 = __builtin_amdgcn_cvt_pk_fp8_f32(w0 * bflo(a.y) + w1 * bflo(b.y) + w2 * bflo(c.y), w0 * bfhi(a.y) + w1 * bfhi(b.y) + w2 * bfhi(c.y), t8, true); o.x = (unsigned)t8;
    t8 = 0; t8 = __builtin_amdgcn_cvt_pk_fp8_f32(w0 * bflo(a.z) + w1 * bflo(b.z) + w2 * bflo(c.z), w0 * bfhi(a.z) + w1 * bfhi(b.z) + w2 * bfhi(c.z), t8, false); t8 = __builtin_amdgcn_cvt_pk_fp8_f32(w0 * bflo(a.w) + w1 * bflo(b.w) + w2 * bflo(c.w), w0 * bfhi(a.w) + w1 * bfhi(b.w) + w2 * bfhi(c.w), t8, true); o.y = (unsigned)t8;
    *(u32x2*)((unsigned char*)ya + e) = o;
}
template <int NT>
__device__ __forceinline__ void t_res_ln1(size_t t0, size_t tstride, const float* __restrict__ x, const bf16_t* __restrict__ mo, const float* g, const float* b, bf16_t* __restrict__ x1b) {
    const int lane = threadIdx.x & 63, c = 16 * lane;
    f32x4 xv[NT][4]; u32x4 mv[NT][2];
#pragma unroll
    for (int k = 0; k < NT; ++k) { const size_t t = t0 + k * tstride;
#pragma unroll
        for (int q = 0; q < 4; ++q) xv[k][q] = *(const f32x4*)(x + t * D + c + 4 * q);
        mv[k][0] = *(const u32x4*)(mo + t * D + c); mv[k][1] = *(const u32x4*)(mo + t * D + c + 8); }
    f32x4 gg[4], bb[4];
#pragma unroll
    for (int q = 0; q < 4; ++q) { gg[q] = *(const f32x4*)(g + c + 4 * q); bb[q] = *(const f32x4*)(b + c + 4 * q); }
#pragma unroll
    for (int k = 0; k < NT; ++k) { const size_t t = t0 + k * tstride;
        const float mm[16] = {bflo(mv[k][0].x), bfhi(mv[k][0].x), bflo(mv[k][0].y), bfhi(mv[k][0].y), bflo(mv[k][0].z), bfhi(mv[k][0].z), bflo(mv[k][0].w), bfhi(mv[k][0].w),
                              bflo(mv[k][1].x), bfhi(mv[k][1].x), bflo(mv[k][1].y), bfhi(mv[k][1].y), bflo(mv[k][1].z), bfhi(mv[k][1].z), bflo(mv[k][1].w), bfhi(mv[k][1].w)};
        float zz[16]; float s = 0.f;
#pragma unroll
        for (int i = 0; i < 16; ++i) { zz[i] = ALPHA * xv[k][i >> 2][i & 3] + mm[i]; s += zz[i]; }
        const float mean = wave_sum(s) * (1.f / D); float ss = 0.f;
#pragma unroll
        for (int i = 0; i < 16; ++i) { const float d = zz[i] - mean; ss += d * d; }
        const float rstd = rsqrtf(wave_sum(ss) * (1.f / D) + LN_EPS);
        float y[16];
#pragma unroll
        for (int i = 0; i < 16; ++i) y[i] = (zz[i] - mean) * rstd * gg[i >> 2][i & 3] + bb[i >> 2][i & 3];
        u32x4 w0, w1; w0.x = pk2(y[0], y[1]); w0.y = pk2(y[2], y[3]); w0.z = pk2(y[4], y[5]); w0.w = pk2(y[6], y[7]); w1.x = pk2(y[8], y[9]); w1.y = pk2(y[10], y[11]); w1.z = pk2(y[12], y[13]); w1.w = pk2(y[14], y[15]);
        *(u32x4*)(x1b + t * D + c) = w0; *(u32x4*)(x1b + t * D + c + 8) = w1; }
}
typedef float f32x2 __attribute__((ext_vector_type(2)));
__device__ __forceinline__ void cvt_row_fp8_finish(const f32x4 a, const f32x4 b, const f32x4 c, const f32x4 d, unsigned char* __restrict__ dst, float* __restrict__ inv_scale, int row, int lane) {
    float mx = 0.f;
#pragma unroll
    for (int j = 0; j < 4; ++j) mx = fmaxf(mx, fmaxf(fmaxf(fabsf(a[j]), fabsf(b[j])), fmaxf(fabsf(c[j]), fabsf(d[j]))));
    mx = wave_max(mx);
    const unsigned E = (__float_as_uint(mx) >> 23) & 255u;
    const float sc = (E == 0u || E > 250u) ? 1.0f : __uint_as_float((260u - E) << 23), isc = (E == 0u || E > 250u) ? 1.0f : __uint_as_float((E - 6u) << 23);
    u32x4 w; int t;
    t = 0; t = __builtin_amdgcn_cvt_pk_fp8_f32(a[0] * sc, a[1] * sc, t, false); t = __builtin_amdgcn_cvt_pk_fp8_f32(a[2] * sc, a[3] * sc, t, true); w.x = (unsigned)t;
    t = 0; t = __builtin_amdgcn_cvt_pk_fp8_f32(b[0] * sc, b[1] * sc, t, false); t = __builtin_amdgcn_cvt_pk_fp8_f32(b[2] * sc, b[3] * sc, t, true); w.y = (unsigned)t;
    t = 0; t = __builtin_amdgcn_cvt_pk_fp8_f32(c[0] * sc, c[1] * sc, t, false); t = __builtin_amdgcn_cvt_pk_fp8_f32(c[2] * sc, c[3] * sc, t, true); w.z = (unsigned)t;
    t = 0; t = __builtin_amdgcn_cvt_pk_fp8_f32(d[0] * sc, d[1] * sc, t, false); t = __builtin_amdgcn_cvt_pk_fp8_f32(d[2] * sc, d[3] * sc, t, true); w.w = (unsigned)t;
    *(u32x4*)(dst + (size_t)row * D + 16 * lane) = w;
    if (lane == 0) inv_scale[row] = isc;
}
__device__ __forceinline__ void cvt_rows_fp8(const float* __restrict__ pu, const float* __restrict__ pv, unsigned char* __restrict__ ub8, unsigned char* __restrict__ vb8, float* __restrict__ usc, float* __restrict__ vsc, int r0, int r1) {
    const int lane = threadIdx.x & 63;
    const float* s0 = pu + (size_t)r0 * D + 16 * lane; const float* s1 = pv + (size_t)r0 * D + 16 * lane; const float* s2 = pu + (size_t)r1 * D + 16 * lane; const float* s3 = pv + (size_t)r1 * D + 16 * lane;
    f32x4 q[4][4];
#pragma unroll
    for (int j = 0; j < 4; ++j) { q[0][j] = ((const f32x4*)s0)[j]; q[1][j] = ((const f32x4*)s1)[j]; q[2][j] = ((const f32x4*)s2)[j]; q[3][j] = ((const f32x4*)s3)[j]; }
    cvt_row_fp8_finish(q[0][0], q[0][1], q[0][2], q[0][3], ub8, usc, r0, lane); cvt_row_fp8_finish(q[1][0], q[1][1], q[1][2], q[1][3], vb8, vsc, r0, lane);
    cvt_row_fp8_finish(q[2][0], q[2][1], q[2][2], q[2][3], ub8, usc, r1, lane); cvt_row_fp8_finish(q[3][0], q[3][1], q[3][2], q[3][3], vb8, vsc, r1, lane);
}
__device__ __forceinline__ float xsel_add(float keep_lo, float keep_hi, bool hi, int mask) {
    const float send = hi ? keep_lo : keep_hi, keep = hi ? keep_hi : keep_lo; return keep + __shfl_xor(send, mask, 64);
}

typedef short s16x4 __attribute__((ext_vector_type(4)));
constexpr int NTHREADS_ = 512;
#define ATT_M0 (-30000.0f)
__device__ __forceinline__ float red_max_16_32(float x) { typedef unsigned u2_ __attribute__((ext_vector_type(2)));
    u2_ r = __builtin_amdgcn_permlane16_swap(__float_as_uint(x), __float_as_uint(x), false, false); x = fmaxf(__uint_as_float(r.x), __uint_as_float(r.y));
    r = __builtin_amdgcn_permlane32_swap(__float_as_uint(x), __float_as_uint(x), false, false); return fmaxf(__uint_as_float(r.x), __uint_as_float(r.y)); }
__device__ __forceinline__ float red_sum_16_32(float x) { typedef unsigned u2_ __attribute__((ext_vector_type(2)));
    u2_ r = __builtin_amdgcn_permlane16_swap(__float_as_uint(x), __float_as_uint(x), false, false); x = __uint_as_float(r.x) + __uint_as_float(r.y);
    r = __builtin_amdgcn_permlane32_swap(__float_as_uint(x), __float_as_uint(x), false, false); return __uint_as_float(r.x) + __uint_as_float(r.y); }
template <int DH, int PITCH, class MaskF>
__device__ __forceinline__ void attn_step(const pg8::bf16x8 (&qf)[DH / 32], LAS unsigned char* kl, LAS unsigned char* vl, int t0, int t1, const MaskF& mf, float& m, float& l, f32x4 (&oT)[DH / 16]) {
    const int lane = threadIdx.x & 63, r16 = lane & 15, kq = lane >> 4;
    f32x4 s0 = {0.f, 0.f, 0.f, 0.f}, s1 = {0.f, 0.f, 0.f, 0.f};
    LAS unsigned char* ka0 = kl + (16 * t0 + r16) * PITCH + 16 * kq; LAS unsigned char* ka1 = kl + (16 * t1 + r16) * PITCH + 16 * kq;
#pragma unroll
    for (int s = 0; s < DH / 32; ++s) { const pg8::bf16x8 a0 = *(const LAS pg8::bf16x8*)(ka0 + 64 * s), a1 = *(const LAS pg8::bf16x8*)(ka1 + 64 * s);
        s0 = __builtin_amdgcn_mfma_f32_16x16x32_bf16(a0, qf[s], s0, 0, 0, 0); s1 = __builtin_amdgcn_mfma_f32_16x16x32_bf16(a1, qf[s], s1, 0, 0, 0); }
    float mx = -1e30f;
#pragma unroll
    for (int j = 0; j < 4; ++j) { s0[j] = mf(t0, 4 * kq + j, s0[j]); s1[j] = mf(t1, 4 * kq + j, s1[j]); mx = fmaxf(mx, fmaxf(s0[j], s1[j])); }
    mx = red_max_16_32(mx);
    const float mn = fmaxf(m, mx), sc = __builtin_amdgcn_exp2f(m - mn);
    float rs = 0.f;
#pragma unroll
    for (int j = 0; j < 4; ++j) { s0[j] = __builtin_amdgcn_exp2f(s0[j] - mn); s1[j] = __builtin_amdgcn_exp2f(s1[j] - mn); rs += s0[j] + s1[j]; }
    rs = red_sum_16_32(rs);
    l = l * sc + rs; m = mn;
    u32x4 pw; pw.x = pk2(s0[0], s0[1]); pw.y = pk2(s0[2], s0[3]); pw.z = pk2(s1[0], s1[1]); pw.w = pk2(s1[2], s1[3]);
    const pg8::bf16x8 pb = __builtin_bit_cast(pg8::bf16x8, pw);
    const int q = r16 >> 2, p = r16 & 3;
    LAS unsigned char* va0 = vl + (16 * t0 + 4 * kq + q) * PITCH + 8 * p; LAS unsigned char* va1 = vl + (16 * t1 + 4 * kq + q) * PITCH + 8 * p;
#pragma unroll
    for (int dt = 0; dt < DH / 16; ++dt) {
        const s16x4 lo = __builtin_amdgcn_ds_read_tr16_b64_v4i16((LAS s16x4*)(va0 + 32 * dt)), hi = __builtin_amdgcn_ds_read_tr16_b64_v4i16((LAS s16x4*)(va1 + 32 * dt));
        const pg8::bf16x8 va = __builtin_shufflevector(lo, hi, 0, 1, 2, 3, 4, 5, 6, 7);
        oT[dt] = oT[dt] * sc; oT[dt] = __builtin_amdgcn_mfma_f32_16x16x32_bf16(va, pb, oT[dt], 0, 0, 0); }
}
__device__ __forceinline__ void lds_put16(LAS unsigned char* dst, const bf16_t* src) { *(LAS u32x4*)dst = src ? *(const u32x4*)src : (u32x4){0u, 0u, 0u, 0u}; }

constexpr int ATT_KV64 = 272 * 160;
__device__ __forceinline__ void attnA_fetch(int u, int tid, u32x4 (&pfc)[8], float& tabv, const bf16_t* __restrict__ hq, const float* __restrict__ relb) {
    asm volatile("" : "+v"(tid));
    const int h = u & 3, rn = (u >> 2) & 31, b = (u >> 7) & 7, g = u >> 10;
    const int r = (g == 0) ? 1 : (g == 1 ? 4 : 16), nblk = 32 / r, rho = rn / nblk, n = rn % nblk, tb = b * SEQ;
    const bf16_t* kcol = hq + hq_off64(12 + g * 4 + h, 0); const bf16_t* vcol = hq + hq_off64(24 + g * 4 + h, 0);
#pragma unroll
    for (int i = 0; i < 8; ++i) { const int idx = tid + NTHREADS_ * i, isv = idx >> 11, i2 = idx & 2047, row = i2 >> 3, ch = i2 & 7, pos = (n - 1) * 128 + row;
        pfc[i] = (pos >= 0) ? *(const u32x4*)((isv ? vcol : kcol) + (size_t)(tb + rho + r * pos) * 64 + ch * 8) : (u32x4){0u, 0u, 0u, 0u}; }
    tabv = (tid < 129) ? relb[kBucket[g][tid] * 20 + g * 4 + h] * LOG2E : 0.f;
}
__device__ __forceinline__ void attnAB_store(int tid, const u32x4 (&pfc)[8], float tabv, LAS unsigned char* lds, int ntab) {
    asm volatile("" : "+v"(tid));
    LAS unsigned char* kl = lds; LAS unsigned char* vl = lds + ATT_KV64; LAS float* tab = (LAS float*)(lds + 2 * ATT_KV64);
#pragma unroll
    for (int i = 0; i < 8; ++i) { const int idx = tid + NTHREADS_ * i, isv = idx >> 11, i2 = idx & 2047, row = i2 >> 3, ch = i2 & 7; *(LAS u32x4*)((isv ? vl : kl) + row * 160 + ch * 16) = pfc[i]; }
    if (tid < 320) { const int isv = tid >= 160, i2 = isv ? tid - 160 : tid; *(LAS u32x4*)((isv ? vl : kl) + 256 * 160 + i2 * 16) = (u32x4){0u, 0u, 0u, 0u}; }
    if (tid < ntab) tab[tid] = tabv;
}
__device__ __forceinline__ void attnA_compute(int u, int tid, LAS unsigned char* lds, const bf16_t* __restrict__ hq, bf16_t* __restrict__ oA, float* __restrict__ lseA) {
    asm volatile("" : "+v"(tid));
    const int h = u & 3, rn = (u >> 2) & 31, b = (u >> 7) & 7, g = u >> 10;
    const int r = (g == 0) ? 1 : (g == 1 ? 4 : 16), nblk = 32 / r, rho = rn / nblk, n = rn % nblk, tb = b * SEQ;
    LAS unsigned char* kl = lds; LAS unsigned char* vl = lds + ATT_KV64; LAS float* tab = (LAS float*)(lds + 2 * ATT_KV64);
    const int w = tid >> 6, lane = tid & 63, r16 = lane & 15, kq = lane >> 4, qi = 16 * w + r16, kmin = (n == 0) ? 128 : 0;
    const size_t tq = (size_t)(tb + rho + r * (n * 128 + qi));
    pg8::bf16x8 qf[2];
#pragma unroll
    for (int s = 0; s < 2; ++s) qf[s] = *(const pg8::bf16x8*)(hq + hq_off64(g * 4 + h, tq) + 32 * s + 8 * kq);
    float m = ATT_M0, l = 0.f; f32x4 oT[4];
#pragma unroll
    for (int dt = 0; dt < 4; ++dt) oT[dt] = (f32x4){0.f, 0.f, 0.f, 0.f};
    auto mf = [&](int tile, int kr, float s) -> float { const int kk = 16 * tile + kr, off = qi + 128 - kk; const bool ok = (off >= 0) && (off <= 128) && (kk >= kmin);
        const int oc = off < 0 ? 0 : (off > 128 ? 128 : off); return ok ? s + tab[oc] : -1e30f; };
    auto mfi = [&](int tile, int kr, float s) -> float { return s + tab[qi + 128 - 16 * tile - kr]; };
    attn_step<64, 160>(qf, kl, vl, w, w + 1, mf, m, l, oT);
    if (n != 0) { for (int st = 1; st < 4; ++st) attn_step<64, 160>(qf, kl, vl, w + 2 * st, w + 2 * st + 1, mfi, m, l, oT); }
    else { for (int st = 1; st < 4; ++st) attn_step<64, 160>(qf, kl, vl, w + 2 * st, w + 2 * st + 1, mf, m, l, oT); }
    attn_step<64, 160>(qf, kl, vl, w + 8, w + 9, mf, m, l, oT);
    const float inv = 1.0f / l;
    bf16_t* op = oA + ((size_t)g * T + tq) * 256 + h * 64 + 4 * kq;
#pragma unroll
    for (int dt = 0; dt < 4; ++dt) { u32x2 wv; wv.x = pk2(oT[dt][0] * inv, oT[dt][1] * inv); wv.y = pk2(oT[dt][2] * inv, oT[dt][3] * inv); *(u32x2*)(op + 16 * dt) = wv; }
    if (kq == 0) lseA[((size_t)g * T + tq) * 4 + h] = (m + __builtin_amdgcn_logf(l)) * LN2F;
}
__device__ __forceinline__ void attnB_fetch(int u, int tid, u32x4 (&pfc)[8], float& tabv, const bf16_t* __restrict__ hq, const float* __restrict__ relb) {
    asm volatile("" : "+v"(tid));
    const int kvh = u & 1, n = (u >> 1) & 31, b = u >> 6, tb = b * SEQ;
    const bf16_t* kcol = hq + hq_off64(44 + kvh, 0); const bf16_t* vcol = hq + hq_off64(46 + kvh, 0);
#pragma unroll
    for (int i = 0; i < 8; ++i) { const int idx = tid + NTHREADS_ * i, isv = idx >> 11, i2 = idx & 2047, row = i2 >> 3, ch = i2 & 7, pos = (n - 1) * 128 + row;
        pfc[i] = (pos >= 0) ? *(const u32x4*)((isv ? vcol : kcol) + (size_t)(tb + pos) * 64 + ch * 8) : (u32x4){0u, 0u, 0u, 0u}; }
    { const int hd = tid >> 7, off = tid & 127; tabv = relb[kBucket[0][off] * 20 + 12 + kvh * 4 + hd] * LOG2E; }
}
__device__ __forceinline__ void attnB_compute(int u, int tid, LAS unsigned char* lds, const bf16_t* __restrict__ hq, const float* __restrict__ sinks, bf16_t* __restrict__ yb) {
    asm volatile("" : "+v"(tid));
    const int kvh = u & 1, n = (u >> 1) & 31, b = u >> 6, tb = b * SEQ;
    LAS unsigned char* kl = lds; LAS unsigned char* vl = lds + ATT_KV64; LAS float* tab = (LAS float*)(lds + 2 * ATT_KV64);
    const int w = tid >> 6, lane = tid & 63, r16 = lane & 15, kq = lane >> 4, kmin = (n == 0) ? 128 : 0;
    for (int i = 0; i < 4; ++i) {
        const int task = w + 8 * i, hd = task >> 3, sub = task & 7, head = kvh * 4 + hd, qi = 16 * sub + r16;
        const size_t tq = (size_t)(tb + n * 128 + qi);
        pg8::bf16x8 qf[2];
#pragma unroll
        for (int s = 0; s < 2; ++s) qf[s] = *(const pg8::bf16x8*)(hq + hq_off64(36 + head, tq) + 32 * s + 8 * kq);
        float m = sinks[head] * LOG2E, l = 1.0f; f32x4 oT[4];
#pragma unroll
        for (int dt = 0; dt < 4; ++dt) oT[dt] = (f32x4){0.f, 0.f, 0.f, 0.f};
        LAS float* tb_h = tab + hd * 128;
        auto mf = [&](int tile, int kr, float s) -> float { const int kk = 16 * tile + kr, off = qi + 128 - kk; const bool ok = (off >= 0) && (off <= 127) && (kk >= kmin);
            const int oc = off < 0 ? 0 : (off > 127 ? 127 : off); return ok ? s + tb_h[oc] : -1e30f; };
        auto mfi = [&](int tile, int kr, float s) -> float { return s + tb_h[qi + 128 - 16 * tile - kr]; };
        attn_step<64, 160>(qf, kl, vl, sub, sub + 1, mf, m, l, oT);
        if (n != 0) { for (int st = 1; st < 4; ++st) attn_step<64, 160>(qf, kl, vl, sub + 2 * st, sub + 2 * st + 1, mfi, m, l, oT); }
        else { for (int st = 1; st < 4; ++st) attn_step<64, 160>(qf, kl, vl, sub + 2 * st, sub + 2 * st + 1, mf, m, l, oT); }
        attn_step<64, 160>(qf, kl, vl, sub + 8, sub + 9, mf, m, l, oT);
        const float inv = 1.0f / l;
        const float inv16 = inv * 16.f; unsigned char* op = (unsigned char*)yb + tq * 512 + head * 64 + 4 * kq;
#pragma unroll
        for (int dt = 0; dt < 4; ++dt) { int t8 = 0; t8 = __builtin_amdgcn_cvt_pk_fp8_f32(oT[dt][0] * inv16, oT[dt][1] * inv16, t8, false); t8 = __builtin_amdgcn_cvt_pk_fp8_f32(oT[dt][2] * inv16, oT[dt][3] * inv16, t8, true); *(unsigned*)(op + 16 * dt) = (unsigned)t8; }
    }
}
__device__ __forceinline__ void attnAB_phase(LAS unsigned char* lds, const bf16_t* __restrict__ hq, const float* __restrict__ relb, const float* __restrict__ sinks, bf16_t* __restrict__ oA, float* __restrict__ lseA, bf16_t* __restrict__ yb) {
    int tid = threadIdx.x; asm volatile("" : "+v"(tid));
    u32x4 pfc[8]; float tabv = 0.f;
    int u = blockIdx.x;
    if (u < 3072) attnA_fetch(u, tid, pfc, tabv, hq, relb);
    for (; u < 3072; u += gridDim.x) {
        attnAB_store(tid, pfc, tabv, lds, 129);
        __syncthreads();
        const int un = u + gridDim.x;
        if (un < 3072) attnA_fetch(un, tid, pfc, tabv, hq, relb); else if ((int)blockIdx.x < 512) attnB_fetch((int)blockIdx.x, tid, pfc, tabv, hq, relb);
        attnA_compute(u, tid, lds, hq, oA, lseA);
        __syncthreads();
    }
    u = blockIdx.x;
    if (3072 <= (int)blockIdx.x && u < 512) attnB_fetch(u, tid, pfc, tabv, hq, relb);
    for (; u < 512; u += gridDim.x) {
        attnAB_store(tid, pfc, tabv, lds, 512);
        __syncthreads();
        const int un = u + gridDim.x;
        if (un < 512) attnB_fetch(un, tid, pfc, tabv, hq, relb);
        attnB_compute(u, tid, lds, hq, sinks, yb);
        __syncthreads();
    }
}
__device__ __forceinline__ void attnC_unit(int u, LAS unsigned char* lds, const bf16_t* __restrict__ hq, const bf16_t* __restrict__ kvm, bf16_t* __restrict__ yc) {
    int tid = threadIdx.x; asm volatile("" : "+v"(tid));
    const int qc = u & 7, head = (u >> 3) & 3, b = u >> 5, tb = b * SEQ;
    constexpr int CP = 272, IMG = 256 * CP;
    LAS unsigned char* kl = lds; LAS unsigned char* vl = lds + IMG;
    for (int idx = tid; idx < 8192; idx += NTHREADS_) { const int isv = idx >> 12, i2 = idx & 4095, row = i2 >> 4, ch = i2 & 15;
        lds_put16((isv ? vl : kl) + row * CP + ch * 16, kvm + (size_t)(b * MEMLEN + row) * 1024 + isv * 512 + head * 128 + ch * 8); }
    __syncthreads();
    const int w = tid >> 6, lane = tid & 63, r16 = lane & 15, kq = lane >> 4;
    auto mf = [&](int, int, float s) -> float { return s; };
    for (int qt = 0; qt < 4; ++qt) {
        const size_t tq = (size_t)(tb + qc * 512 + qt * 128 + 16 * w + r16);
        pg8::bf16x8 qf[4];
#pragma unroll
        for (int s = 0; s < 4; ++s) qf[s] = *(const pg8::bf16x8*)(hq + hq_offc(head, tq) + 32 * s + 8 * kq);
        float m = ATT_M0, l = 0.f; f32x4 oT[8];
#pragma unroll
        for (int dt = 0; dt < 8; ++dt) oT[dt] = (f32x4){0.f, 0.f, 0.f, 0.f};
        for (int st = 0; st < 8; ++st) attn_step<128, CP>(qf, kl, vl, 2 * st, 2 * st + 1, mf, m, l, oT);
        const float inv = 1.0f / l;
        const float inv16 = inv * 16.f; unsigned char* op = (unsigned char*)yc + tq * 512 + head * 128 + 4 * kq;
#pragma unroll
        for (int dt = 0; dt < 8; ++dt) { int t8 = 0; t8 = __builtin_amdgcn_cvt_pk_fp8_f32(oT[dt][0] * inv16, oT[dt][1] * inv16, t8, false); t8 = __builtin_amdgcn_cvt_pk_fp8_f32(oT[dt][2] * inv16, oT[dt][3] * inv16, t8, true); *(unsigned*)(op + 16 * dt) = (unsigned)t8; }
    }
    __syncthreads();
}

#define CE_DESC(a, b) do { const unsigned _mx = (a) > (b) ? (a) : (b), _mn = (a) > (b) ? (b) : (a); (a) = _mx; (b) = _mn; } while (0)
__device__ __forceinline__ void sort16_desc(unsigned (&v)[16]) {
    CE_DESC(v[0], v[13]); CE_DESC(v[1], v[12]); CE_DESC(v[2], v[15]); CE_DESC(v[3], v[14]); CE_DESC(v[4], v[8]); CE_DESC(v[5], v[6]); CE_DESC(v[7], v[11]); CE_DESC(v[9], v[10]);
    CE_DESC(v[0], v[5]); CE_DESC(v[1], v[7]); CE_DESC(v[2], v[9]); CE_DESC(v[3], v[4]); CE_DESC(v[6], v[13]); CE_DESC(v[8], v[14]); CE_DESC(v[10], v[15]); CE_DESC(v[11], v[12]);
    CE_DESC(v[0], v[1]); CE_DESC(v[2], v[3]); CE_DESC(v[4], v[5]); CE_DESC(v[6], v[8]); CE_DESC(v[7], v[9]); CE_DESC(v[10], v[11]); CE_DESC(v[12], v[13]); CE_DESC(v[14], v[15]);
    CE_DESC(v[0], v[2]); CE_DESC(v[1], v[3]); CE_DESC(v[4], v[10]); CE_DESC(v[5], v[11]); CE_DESC(v[6], v[7]); CE_DESC(v[8], v[9]); CE_DESC(v[12], v[14]); CE_DESC(v[13], v[15]);
    CE_DESC(v[1], v[2]); CE_DESC(v[3], v[12]); CE_DESC(v[4], v[6]); CE_DESC(v[5], v[7]); CE_DESC(v[8], v[10]); CE_DESC(v[9], v[11]); CE_DESC(v[13], v[14]);
    CE_DESC(v[1], v[4]); CE_DESC(v[2], v[6]); CE_DESC(v[5], v[8]); CE_DESC(v[7], v[10]); CE_DESC(v[9], v[13]); CE_DESC(v[11], v[14]);
    CE_DESC(v[2], v[4]); CE_DESC(v[3], v[6]); CE_DESC(v[9], v[12]); CE_DESC(v[11], v[13]);
    CE_DESC(v[3], v[5]); CE_DESC(v[6], v[8]); CE_DESC(v[7], v[9]); CE_DESC(v[10], v[12]);
    CE_DESC(v[3], v[4]); CE_DESC(v[5], v[6]); CE_DESC(v[7], v[8]); CE_DESC(v[9], v[10]); CE_DESC(v[11], v[12]);
    CE_DESC(v[6], v[7]); CE_DESC(v[8], v[9]);
}
__device__ __forceinline__ void bitonic_merge16_desc(unsigned (&v)[16]) {
#pragma unroll
    for (int j = 8; j > 0; j >>= 1)
#pragma unroll
        for (int i = 0; i < 16; ++i) { const int p = i ^ j; if (p > i) CE_DESC(v[i], v[p]); }
}
__device__ __forceinline__ void top16_merge(unsigned (&a)[16], const unsigned (&b)[16]) {
#pragma unroll
    for (int i = 0; i < 16; ++i) a[i] = a[i] > b[15 - i] ? a[i] : b[15 - i];
    bitonic_merge16_desc(a);
}
__device__ __forceinline__ unsigned f2key(float f) { const unsigned u = __float_as_uint(f); return u ^ ((unsigned)((int)u >> 31) | 0x80000000u); }
__device__ __forceinline__ float key2f(unsigned k) { return __uint_as_float((k & 0x80000000u) ? (k ^ 0x80000000u) : ~k); }

typedef unsigned u2_tk __attribute__((ext_vector_type(2)));
constexpr int TK_KIMG = 128 * 144;
__device__ __forceinline__ void topk_unit(int u, LAS unsigned char* lds, const bf16_t* __restrict__ qb, const bf16_t* __restrict__ subk, unsigned short* __restrict__ eidx, float* __restrict__ gate) {
    int tid = threadIdx.x; asm volatile("" : "+v"(tid));
    const int h = u & 7, tile = u >> 3;
    typedef float f32x16 __attribute__((ext_vector_type(16)));
    for (int idx = tid; idx < 2048; idx += NTHREADS_) { const int row = idx >> 3, ch = idx & 7;
        *(LAS u32x4*)(lds + row * 144 + ch * 16) = *(const u32x4*)(subk + ((size_t)(h * 256 + row)) * 64 + ch * 8); }
    __syncthreads();
    const int w = tid >> 6, lane = tid & 63, r32 = lane & 31, hh = lane >> 5;
    const size_t tok = (size_t)tile * 256 + w * 32 + r32;
    unsigned top[2][16];
#pragma unroll
    for (int c = 0; c < 2; ++c) {
        pg8::bf16x8 qf[4];
#pragma unroll
        for (int s = 0; s < 4; ++s) qf[s] = *(const pg8::bf16x8*)(qb + tok * D + h * 128 + c * 64 + 16 * s + 8 * hh);
        unsigned key[4][16];
#pragma unroll
        for (int kt = 0; kt < 4; ++kt) { f32x16 acc;
#pragma unroll
            for (int i = 0; i < 16; ++i) acc[i] = 0.f;
#pragma unroll
            for (int s = 0; s < 4; ++s) { const pg8::bf16x8 a = *(const LAS pg8::bf16x8*)(lds + c * TK_KIMG + (32 * kt + r32) * 144 + (16 * s + 8 * hh) * 2);
                acc = __builtin_amdgcn_mfma_f32_32x32x16_bf16(a, qf[s], acc, 0, 0, 0); }
            const unsigned lowb = 127u - 4u * hh - 32u * kt;
#pragma unroll
            for (int i = 0; i < 16; ++i) key[kt][i] = (f2key(acc[i]) & 0xFFFFFF80u) | (lowb - (unsigned)((i & 3) + 8 * (i >> 2)));
            sort16_desc(key[kt]); }
        top16_merge(key[0], key[1]); top16_merge(key[2], key[3]); top16_merge(key[0], key[2]);
        unsigned other[16];
#pragma unroll
        for (int i = 0; i < 16; ++i) { const u2_tk r = __builtin_amdgcn_permlane32_swap(key[0][i], key[0][i], false, false); other[i] = hh ? r.x : r.y; }
        top16_merge(key[0], other);
#pragma unroll
        for (int i = 0; i < 16; ++i) top[c][i] = key[0][i];
    }
    float v0[16], v1[16];
#pragma unroll
    for (int i = 0; i < 16; ++i) { v0[i] = key2f(top[0][i] & 0xFFFFFF80u); v1[i] = key2f(top[1][i] & 0xFFFFFF80u); }
    float ca[16], cb[16];
#pragma unroll
    for (int i = 0; i < 16; ++i) { ca[i] = hh ? v1[i] : v0[i]; cb[i] = hh ? v0[i] : v1[i]; }
    unsigned cand[2][16];
#define CANDX(g, e, i, j) cand[g][e] = (f2key(ca[i] + cb[j]) & 0xFFFFFF00u) | (hh ? (unsigned)(255 - ((j) * 16 + (i))) : (unsigned)(255 - ((i) * 16 + (j))))
#define CANDD(g, e, i) cand[g][e] = hh ? 0u : ((f2key(ca[i] + cb[i]) & 0xFFFFFF00u) | (unsigned)(255 - ((i) * 17)))
    CANDX(1, 0, 0, 1); CANDX(1, 1, 0, 2); CANDX(1, 2, 0, 3); CANDX(1, 3, 0, 4); CANDX(1, 4, 0, 5); CANDX(1, 5, 0, 6); CANDX(1, 6, 0, 7); CANDX(1, 7, 0, 8);
    CANDX(1, 8, 0, 9); CANDX(1, 9, 0, 10); CANDX(1, 10, 0, 11); CANDX(1, 11, 0, 12); CANDX(1, 12, 0, 13); CANDX(1, 13, 0, 14); CANDX(1, 14, 0, 15); cand[1][15] = 0u;
    CANDD(0, 0, 0); CANDD(0, 1, 1); CANDD(0, 2, 2); CANDD(0, 3, 3);
    CANDX(0, 4, 1, 2); CANDX(0, 5, 1, 3); CANDX(0, 6, 1, 4); CANDX(0, 7, 1, 5); CANDX(0, 8, 1, 6); CANDX(0, 9, 1, 7); CANDX(0, 10, 2, 3); CANDX(0, 11, 2, 4);
    cand[0][12] = 0u; cand[0][13] = 0u; cand[0][14] = 0u; cand[0][15] = 0u;
#undef CANDX
#undef CANDD
    sort16_desc(cand[0]); top16_merge(cand[0], cand[1]);
    { unsigned oth[16];
#pragma unroll
      for (int i = 0; i < 16; ++i) { const u2_tk r = __builtin_amdgcn_permlane32_swap(cand[0][i], cand[0][i], false, false); oth[i] = hh ? r.x : r.y; }
      top16_merge(cand[0], oth); }
    float ev[16]; const float vmax = key2f(cand[0][0] & 0xFFFFFF00u); float esum = 0.f;
#pragma unroll
    for (int k = 0; k < 16; ++k) { ev[k] = __builtin_amdgcn_exp2f((key2f(cand[0][k] & 0xFFFFFF00u) - vmax) * LOG2E); esum += ev[k]; }
    const float einv = 1.0f / esum;
    LAS unsigned char* st = lds + 2 * TK_KIMG + (w * 64 + lane) * 32;
#pragma unroll
    for (int g4 = 0; g4 < 4; ++g4) { unsigned d0 = 0u, d1 = 0u;
#pragma unroll
        for (int e = 0; e < 4; ++e) { d0 |= (127u - (top[0][4 * g4 + e] & 127u)) << (8 * e); d1 |= (127u - (top[1][4 * g4 + e] & 127u)) << (8 * e); }
        *(LAS unsigned*)(st + 4 * g4) = d0; *(LAS unsigned*)(st + 16 + 4 * g4) = d1; }
    int eo[16];
#pragma unroll
    for (int k = 0; k < 16; ++k) { const unsigned code = 255u - (cand[0][k] & 255u); eo[k] = (int)st[code >> 4] * 128 + (int)st[16 + (code & 15u)]; }
    if (hh == 0) {
        u32x4 o0, o1;
        o0.x = (unsigned)eo[0] | ((unsigned)eo[1] << 16); o0.y = (unsigned)eo[2] | ((unsigned)eo[3] << 16); o0.z = (unsigned)eo[4] | ((unsigned)eo[5] << 16); o0.w = (unsigned)eo[6] | ((unsigned)eo[7] << 16);
        o1.x = (unsigned)eo[8] | ((unsigned)eo[9] << 16); o1.y = (unsigned)eo[10] | ((unsigned)eo[11] << 16); o1.z = (unsigned)eo[12] | ((unsigned)eo[13] << 16); o1.w = (unsigned)eo[14] | ((unsigned)eo[15] << 16);
        *(u32x4*)(eidx + tok * 128 + h * 16) = o0; *(u32x4*)(eidx + tok * 128 + h * 16 + 8) = o1;
    } else {
#pragma unroll
        for (int k4 = 0; k4 < 4; ++k4) { f32x4 o; o[0] = ev[4 * k4] * einv; o[1] = ev[4 * k4 + 1] * einv; o[2] = ev[4 * k4 + 2] * einv; o[3] = ev[4 * k4 + 3] * einv;
            *(f32x4*)(gate + tok * 128 + h * 16 + 4 * k4) = o; }
    }
    __syncthreads();
}

__device__ __forceinline__ float fp8dot16(const u32x4 w, const f32x2 (&xp)[8]) {
    f32x2 a0 = __builtin_amdgcn_cvt_pk_f32_fp8((int)w.x, false) * xp[0];
    a0 = __builtin_elementwise_fma(__builtin_amdgcn_cvt_pk_f32_fp8((int)w.x, true), xp[1], a0);
    a0 = __builtin_elementwise_fma(__builtin_amdgcn_cvt_pk_f32_fp8((int)w.y, false), xp[2], a0); a0 = __builtin_elementwise_fma(__builtin_amdgcn_cvt_pk_f32_fp8((int)w.y, true), xp[3], a0);
    a0 = __builtin_elementwise_fma(__builtin_amdgcn_cvt_pk_f32_fp8((int)w.z, false), xp[4], a0); a0 = __builtin_elementwise_fma(__builtin_amdgcn_cvt_pk_f32_fp8((int)w.z, true), xp[5], a0);
    a0 = __builtin_elementwise_fma(__builtin_amdgcn_cvt_pk_f32_fp8((int)w.w, false), xp[6], a0); a0 = __builtin_elementwise_fma(__builtin_amdgcn_cvt_pk_f32_fp8((int)w.w, true), xp[7], a0);
    return a0.x + a0.y;
}
typedef int i32x4 __attribute__((ext_vector_type(4)));
#define PEER_EIDX16(dst, t_) do { const unsigned short* ep_ = eidx + (size_t)(t_) * 128 + 16 * grp; const u32x4 e0_ = *(const u32x4*)ep_, e1_ = *(const u32x4*)(ep_ + 8); \
        dst[0] = (int)(e0_.x & 0xffffu); dst[1] = (int)(e0_.x >> 16); dst[2] = (int)(e0_.y & 0xffffu); dst[3] = (int)(e0_.y >> 16); dst[4] = (int)(e0_.z & 0xffffu); dst[5] = (int)(e0_.z >> 16); dst[6] = (int)(e0_.w & 0xffffu); dst[7] = (int)(e0_.w >> 16); \
        dst[8] = (int)(e1_.x & 0xffffu); dst[9] = (int)(e1_.x >> 16); dst[10] = (int)(e1_.y & 0xffffu); dst[11] = (int)(e1_.y >> 16); dst[12] = (int)(e1_.z & 0xffffu); dst[13] = (int)(e1_.z >> 16); dst[14] = (int)(e1_.w & 0xffffu); dst[15] = (int)(e1_.w >> 16); } while (0)
#define PEER_GATHER16(BUF, base, ev) _Pragma("unroll") for (int i_ = 0; i_ < 16; ++i_) BUF[i_] = *(const u32x4*)((base) + (unsigned)(((unsigned)(ev)[i_] << 10) + (unsigned)colbase))
template <int CTRL> __device__ __forceinline__ float xsel_addf_dpp(float keep_lo, float keep_hi, bool hi) { const float send = hi ? keep_lo : keep_hi, keep = hi ? keep_hi : keep_lo;
    return keep + __uint_as_float(__builtin_amdgcn_update_dpp(0u, __float_as_uint(send), CTRL, 0xf, 0xf, false)); }
__device__ __forceinline__ float swap32_add(float lo, float hi) { typedef unsigned u2_ __attribute__((ext_vector_type(2))); const u2_ r = __builtin_amdgcn_permlane32_swap(__float_as_uint(lo), __float_as_uint(hi), false, false); return __uint_as_float(r.x) + __uint_as_float(r.y); }
__device__ __forceinline__ float swap16_add(float lo, float hi) { typedef unsigned u2_ __attribute__((ext_vector_type(2))); const u2_ r = __builtin_amdgcn_permlane16_swap(__float_as_uint(lo), __float_as_uint(hi), false, false); return __uint_as_float(r.x) + __uint_as_float(r.y); }
#define PEER_GATHER4(R, o, base, E, p) _Pragma("unroll") for (int j_ = 0; j_ < 4; ++j_) R[(o) + j_] = *(const u32x4*)((base) + (unsigned)(((unsigned)(E)[4 * (p) + j_] << 10) + (unsigned)colbase))
__device__ __forceinline__ void peerU_phase(int slice, int tok0, int tok1, const bf16_t* __restrict__ x1b,
                                            const unsigned short* __restrict__ eidx, const unsigned char* __restrict__ ub8, bf16_t* __restrict__ hp) {
    int tid = threadIdx.x; asm volatile("" : "+v"(tid));
    const int wave = tid >> 6, lane = tid & 63, sub = lane & 7, grp = lane >> 3, colbase = 128 * slice + 16 * sub;
    if (tok0 + wave >= tok1) return;
    const bool l0 = lane & 1, l1 = lane & 2, l2 = lane & 4;
    const int tfirst = tok0 + wave, tlast = tfirst + ((tok1 - 1 - tfirst) >> 3) * 8;
    const bf16_t* xl = x1b + colbase;
    const int hoff = 16 * grp + ((lane & 4) ? 8 : 0) + ((lane & 2) ? 4 : 0) + ((lane & 1) ? 2 : 0);
#define TOKC(i) ((tfirst + 8 * (i)) <= tlast ? (tfirst + 8 * (i)) : tlast)
    u32x4 R[32]; int EA[16], EB[16]; u32x4 xrA0, xrA1, xrB0, xrB1;
    { const int t0 = TOKC(0), t1 = TOKC(1);
      PEER_EIDX16(EA, t0); PEER_EIDX16(EB, t1);
      xrA0 = *(const u32x4*)(xl + (size_t)t0 * D); xrA1 = *(const u32x4*)(xl + (size_t)t0 * D + 8); xrB0 = *(const u32x4*)(xl + (size_t)t1 * D); xrB1 = *(const u32x4*)(xl + (size_t)t1 * D + 8);
#pragma unroll
      for (int p = 0; p < 4; ++p) { PEER_GATHER4(R, 4 * p, ub8, EA, p); }
#pragma unroll
      for (int p = 0; p < 4; ++p) { PEER_GATHER4(R, 16 + 4 * p, ub8, EB, p); }
      const int t2 = TOKC(2), t3 = TOKC(3); PEER_EIDX16(EA, t2); PEER_EIDX16(EB, t3); }
    for (int i = 0;; i += 2) {
#define PEER_U_TOKEN(RO, E, xr0, xr1, ti, tnext2, tnext4) do { \
        f32x2 xp[8]; \
        xp[0] = (f32x2){bflo(xr0.x), bfhi(xr0.x)}; xp[1] = (f32x2){bflo(xr0.y), bfhi(xr0.y)}; xp[2] = (f32x2){bflo(xr0.z), bfhi(xr0.z)}; xp[3] = (f32x2){bflo(xr0.w), bfhi(xr0.w)}; \
        xp[4] = (f32x2){bflo(xr1.x), bfhi(xr1.x)}; xp[5] = (f32x2){bflo(xr1.y), bfhi(xr1.y)}; xp[6] = (f32x2){bflo(xr1.z), bfhi(xr1.z)}; xp[7] = (f32x2){bflo(xr1.w), bfhi(xr1.w)}; \
        xr0 = *(const u32x4*)(xl + (size_t)(tnext2) * D); xr1 = *(const u32x4*)(xl + (size_t)(tnext2) * D + 8);        \
        float pd[16]; \
        _Pragma("unroll") for (int p = 0; p < 4; ++p) { \
            _Pragma("unroll") for (int j = 0; j < 4; ++j) pd[4 * p + j] = fp8dot16(R[(RO) + 4 * p + j], xp); \
            PEER_GATHER4(R, (RO) + 4 * p, ub8, E, p); } \
        PEER_EIDX16(E, tnext4); \
        float q8[8]; \
        _Pragma("unroll") for (int k = 0; k < 8; ++k) q8[k] = xsel_addf_dpp<0x141>(pd[k], pd[k + 8], l2);            \
        const float r0 = xsel_addf_dpp<0x4E>(q8[0], q8[4], l1), r1 = xsel_addf_dpp<0x4E>(q8[1], q8[5], l1), r2 = xsel_addf_dpp<0x4E>(q8[2], q8[6], l1), r3 = xsel_addf_dpp<0x4E>(q8[3], q8[7], l1);     \
        f32x2 o; o.x = xsel_addf_dpp<0xB1>(r0, r2, l0); o.y = xsel_addf_dpp<0xB1>(r1, r3, l0);                       \
        if ((tfirst + 8 * (ti)) <= tlast) *(unsigned*)(hp + ((size_t)slice * T + (size_t)(tfirst + 8 * (ti))) * 128 + hoff) = pk2(o.x, o.y); } while (0)
        { const int tn2 = TOKC(i + 2), tn4 = TOKC(i + 4); PEER_U_TOKEN(0, EA, xrA0, xrA1, i, tn2, tn4); }
        { const int tn2 = TOKC(i + 3), tn4 = TOKC(i + 5); PEER_U_TOKEN(16, EB, xrB0, xrB1, i + 1, tn2, tn4); }
        if (tfirst + 8 * (i + 2) > tlast) break;
    }
#undef PEER_U_TOKEN
#undef TOKC
}
#ifdef PROBE_EXP
__device__ __forceinline__ void probe_gather(int slice, int tok0, int tok1, const unsigned short* __restrict__ eidx, const unsigned char* __restrict__ ub8, float* __restrict__ dummy) {
    int tid = threadIdx.x; asm volatile("" : "+v"(tid));
    const int wave = tid >> 6, lane = tid & 63, sub = lane & 7, grp = lane >> 3, colbase = 128 * slice + 16 * sub;
    if (tok0 + wave >= tok1) return;
    const unsigned char* ubl = ub8;
    const int tlast = tok0 + wave + ((tok1 - 1 - tok0 - wave) >> 3) * 8;
    int EA[16], EB[16]; u32x4 UA[16], UB[16];
    int ta = tok0 + wave, tb = ta + 8 <= tlast ? ta + 8 : tlast;
    PEER_EIDX16(EA, ta); PEER_EIDX16(EB, tb);
    PEER_GATHER16(UA, ubl, EA);
    unsigned accx = 0u;
    for (;;) {
        PEER_GATHER16(UB, ubl, EB);
        const int ta2 = ta + 16 <= tlast ? ta + 16 : tlast; PEER_EIDX16(EA, ta2);
#pragma unroll
        for (int i = 0; i < 16; ++i) accx ^= UA[i].x ^ UA[i].y ^ UA[i].z ^ UA[i].w;
        PEER_GATHER16(UA, ubl, EA);
        const int tb2 = ta + 24 <= tlast ? ta + 24 : tlast; PEER_EIDX16(EB, tb2);
#pragma unroll
        for (int i = 0; i < 16; ++i) accx ^= UB[i].x ^ UB[i].y ^ UB[i].z ^ UB[i].w;
        if (ta + 16 > tlast) break;
        ta = ta2; tb = tb2;
    }
    dummy[(size_t)blockIdx.x * 512 + tid] = __uint_as_float(accx & 0x3fffffffu);
}
#endif

#if defined(PROBE_EXP) && PROBE_EXP >= 10 && PROBE_EXP < 20
__device__ __forceinline__ void probe_valu(float* __restrict__ dummy) {
    int tid = threadIdx.x; asm volatile("" : "+v"(tid));
    unsigned w[8]; f32x2 a[8];
#pragma unroll
    for (int i = 0; i < 8; ++i) { w[i] = (unsigned)tid * 2654435761u + i * 40503u; a[i] = (f32x2){(float)i, 1.0f}; }
    for (int it = 0; it < 2048; ++it) {
#pragma unroll
        for (int r = 0; r < 4; ++r)
#pragma unroll
            for (int i = 0; i < 8; ++i) {
#if PROBE_EXP == 10
                asm volatile("v_cvt_pk_f32_fp8_e32 %0, %1" : "=v"(a[i]) : "v"(w[i]));
#elif PROBE_EXP == 11
                asm volatile("v_pk_fma_f32 %0, %1, %1, %0" : "+v"(a[i]) : "v"(a[(i + 1) & 7]));
#elif PROBE_EXP == 12
                asm volatile("v_cvt_f32_ubyte0_e32 %0, %1" : "=v"(a[i].x) : "v"(w[i]));
#elif PROBE_EXP == 13
                asm volatile("v_dot4_i32_i8 %0, %1, %1, %0" : "+v"(w[i]) : "v"(w[(i + 1) & 7]));
#elif PROBE_EXP == 14
                asm volatile("v_fma_f32 %0, %1, %1, %0" : "+v"(a[i].x) : "v"(a[(i + 1) & 7].y));
#elif PROBE_EXP == 15
                asm volatile("v_dot2_f32_bf16 %0, %1, %1, %0" : "+v"(a[i].x) : "v"(w[i]));
#endif
            }
    }
    float s = 0.f;
#pragma unroll
    for (int i = 0; i < 8; ++i) s += a[i].x + a[i].y + __uint_as_float(w[i] & 0x3fffffffu);
    dummy[(size_t)blockIdx.x * 512 + tid] = s;
}
#endif
__device__ __forceinline__ void peerR_phase(const bf16_t* __restrict__ hp, const unsigned short* __restrict__ eidx, const float* __restrict__ gate, const float* __restrict__ usc, const float* __restrict__ vsc, bf16_t* __restrict__ cb) {
    for (size_t i = (size_t)blockIdx.x * 512 + threadIdx.x; i < (size_t)T * 32; i += (size_t)gridDim.x * 512) {
        f32x4 h = (f32x4){0.f, 0.f, 0.f, 0.f};
#pragma unroll
        for (int j = 0; j < 8; ++j) { const u32x2 w = *(const u32x2*)(hp + (size_t)j * T * 128 + 4 * i); h += (f32x4){bflo(w.x), bfhi(w.x), bflo(w.y), bfhi(w.y)}; }
        const u32x2 ew = *(const u32x2*)(eidx + 4 * i); const int e[4] = {(int)(ew.x & 0xffffu), (int)(ew.x >> 16), (int)(ew.y & 0xffffu), (int)(ew.y >> 16)};
        const f32x4 gt = *(const f32x4*)(gate + 4 * i); float c[4];
#pragma unroll
        for (int j = 0; j < 4; ++j) { const float hh = h[j] * usc[e[j]]; const pg8::f32x2 ge = pg8::gelu_pk((pg8::f32x2){hh, hh}); c[j] = gt[j] * ge.x * vsc[e[j]]; }
        u32x2 cw; cw.x = pk2(c[0], c[1]); cw.y = pk2(c[2], c[3]); *(u32x2*)(cb + 4 * i) = cw; }
}
__device__ __forceinline__ void peerV_phase(int slice, int tok0, int tok1, const bf16_t* __restrict__ cb, const unsigned short* __restrict__ eidx, const unsigned char* __restrict__ vb8, bf16_t* __restrict__ yp) {
    int tid = threadIdx.x; asm volatile("" : "+v"(tid));
    const int wave = tid >> 6, lane = tid & 63, sub = lane & 7, grp = lane >> 3, colbase = 128 * slice + 16 * sub;
    if (tok0 + wave >= tok1) return;
    const bool l3 = lane & 8, l4 = lane & 16, l5 = lane & 32;
    const int tfirst = tok0 + wave, tlast = tfirst + ((tok1 - 1 - tfirst) >> 3) * 8;
    const bf16_t* cl = cb + 16 * grp;
    const int yoff = colbase + ((lane & 32) ? 8 : 0) + ((lane & 16) ? 4 : 0) + ((lane & 8) ? 2 : 0);
#define TOKC(i) ((tfirst + 8 * (i)) <= tlast ? (tfirst + 8 * (i)) : tlast)
#define PEER_C16(dst, t_) do { const bf16_t* cp_ = cl + (size_t)(t_) * 128; dst[0] = *(const u32x4*)cp_; dst[1] = *(const u32x4*)(cp_ + 8); } while (0)
    u32x4 R[32]; int EA[16], EB[16]; u32x4 cA[2], cB[2];
    { const int t0 = TOKC(0), t1 = TOKC(1);
      PEER_EIDX16(EA, t0); PEER_EIDX16(EB, t1); PEER_C16(cA, t0); PEER_C16(cB, t1);
#pragma unroll
      for (int p = 0; p < 4; ++p) { PEER_GATHER4(R, 4 * p, vb8, EA, p); }
#pragma unroll
      for (int p = 0; p < 4; ++p) { PEER_GATHER4(R, 16 + 4 * p, vb8, EB, p); }
      const int t2 = TOKC(2), t3 = TOKC(3); PEER_EIDX16(EA, t2); PEER_EIDX16(EB, t3); }
    for (int i = 0;; i += 2) {
#define PEER_V_TOKEN(RO, E, cc, ti, tnext2, tnext4) do { \
        const u32x4 c0_ = cc[0], c1_ = cc[1]; \
        const float cv[16] = {bflo(c0_.x), bfhi(c0_.x), bflo(c0_.y), bfhi(c0_.y), bflo(c0_.z), bfhi(c0_.z), bflo(c0_.w), bfhi(c0_.w), bflo(c1_.x), bfhi(c1_.x), bflo(c1_.y), bfhi(c1_.y), bflo(c1_.z), bfhi(c1_.z), bflo(c1_.w), bfhi(c1_.w)}; \
        PEER_C16(cc, tnext2);                                        \
        f32x2 acc[8]; \
        _Pragma("unroll") for (int k = 0; k < 8; ++k) acc[k] = (f32x2){0.f, 0.f}; \
        _Pragma("unroll") for (int p = 0; p < 4; ++p) { \
            _Pragma("unroll") for (int j = 0; j < 4; ++j) { const u32x4 w = R[(RO) + 4 * p + j]; const f32x2 c2v = (f32x2){cv[4 * p + j], cv[4 * p + j]}; \
                acc[0] = __builtin_elementwise_fma(__builtin_amdgcn_cvt_pk_f32_fp8((int)w.x, false), c2v, acc[0]); acc[1] = __builtin_elementwise_fma(__builtin_amdgcn_cvt_pk_f32_fp8((int)w.x, true), c2v, acc[1]); \
                acc[2] = __builtin_elementwise_fma(__builtin_amdgcn_cvt_pk_f32_fp8((int)w.y, false), c2v, acc[2]); acc[3] = __builtin_elementwise_fma(__builtin_amdgcn_cvt_pk_f32_fp8((int)w.y, true), c2v, acc[3]); \
                acc[4] = __builtin_elementwise_fma(__builtin_amdgcn_cvt_pk_f32_fp8((int)w.z, false), c2v, acc[4]); acc[5] = __builtin_elementwise_fma(__builtin_amdgcn_cvt_pk_f32_fp8((int)w.z, true), c2v, acc[5]); \
                acc[6] = __builtin_elementwise_fma(__builtin_amdgcn_cvt_pk_f32_fp8((int)w.w, false), c2v, acc[6]); acc[7] = __builtin_elementwise_fma(__builtin_amdgcn_cvt_pk_f32_fp8((int)w.w, true), c2v, acc[7]); } \
            PEER_GATHER4(R, (RO) + 4 * p, vb8, E, p); } \
        PEER_EIDX16(E, tnext4); \
        const float a[16] = {acc[0].x, acc[0].y, acc[1].x, acc[1].y, acc[2].x, acc[2].y, acc[3].x, acc[3].y, acc[4].x, acc[4].y, acc[5].x, acc[5].y, acc[6].x, acc[6].y, acc[7].x, acc[7].y}; \
        float q8[8]; \
        _Pragma("unroll") for (int k = 0; k < 8; ++k) q8[k] = swap32_add(a[k], a[k + 8]); \
        const float r0 = swap16_add(q8[0], q8[4]), r1 = swap16_add(q8[1], q8[5]), r2 = swap16_add(q8[2], q8[6]), r3 = swap16_add(q8[3], q8[7]); \
        f32x2 o; o.x = xsel_addf_dpp<0x128>(r0, r2, l3); o.y = xsel_addf_dpp<0x128>(r1, r3, l3);               \
        if ((tfirst + 8 * (ti)) <= tlast) *(unsigned*)(yp + (size_t)(tfirst + 8 * (ti)) * D + yoff) = pk2(o.x, o.y); } while (0)
        { const int tn2 = TOKC(i + 2), tn4 = TOKC(i + 4); PEER_V_TOKEN(0, EA, cA, i, tn2, tn4); }
        { const int tn2 = TOKC(i + 3), tn4 = TOKC(i + 5); PEER_V_TOKEN(16, EB, cB, i + 1, tn2, tn4); }
        if (tfirst + 8 * (i + 2) > tlast) break;
    }
#undef PEER_V_TOKEN
#undef PEER_C16
#undef TOKC
}
template <int NT>
__device__ __forceinline__ void peerL_token(size_t t0, size_t tstride, const bf16_t* __restrict__ x1b, const bf16_t* __restrict__ yp, const float* g2, const float* b2, float* __restrict__ out) {
    const int lane = threadIdx.x & 63;
    u32x4 xw[NT][2], yw[NT][2];
#pragma unroll
    for (int k = 0; k < NT; ++k) { const size_t t = t0 + k * tstride;
#pragma unroll
        for (int hlf = 0; hlf < 2; ++hlf) { const int c = 16 * lane + 8 * hlf; xw[k][hlf] = *(const u32x4*)(x1b + t * D + c); yw[k][hlf] = *(const u32x4*)(yp + t * D + c); } }
#pragma unroll
    for (int k = 0; k < NT; ++k) { const size_t t = t0 + k * tstride;
        float y[16]; float s = 0.f;
#pragma unroll
        for (int hlf = 0; hlf < 2; ++hlf) { const u32x4 xq = xw[k][hlf], yq = yw[k][hlf];
            const float xx[8] = {bflo(xq.x), bfhi(xq.x), bflo(xq.y), bfhi(xq.y), bflo(xq.z), bfhi(xq.z), bflo(xq.w), bfhi(xq.w)}, yy[8] = {bflo(yq.x), bfhi(yq.x), bflo(yq.y), bfhi(yq.y), bflo(yq.z), bfhi(yq.z), bflo(yq.w), bfhi(yq.w)};
#pragma unroll
            for (int j = 0; j < 8; ++j) { const float v = ALPHA * xx[j] + yy[j]; y[8 * hlf + j] = v; s += v; } }
        const float mean2 = wave_sum(s) * (1.f / D); float ss = 0.f;
#pragma unroll
        for (int i = 0; i < 16; ++i) { const float dlt = y[i] - mean2; ss += dlt * dlt; }
        const float rstd2 = rsqrtf(wave_sum(ss) * (1.f / D) + LN_EPS);
#pragma unroll
        for (int q = 0; q < 4; ++q) { const int c = 16 * lane + 4 * q; const f32x4 gg = *(const f32x4*)(g2 + c), bb = *(const f32x4*)(b2 + c); f32x4 o;
#pragma unroll
            for (int j = 0; j < 4; ++j) o[j] = (y[4 * q + j] - mean2) * rstd2 * gg[j] + bb[j];
            *(f32x4*)(out + t * D + c) = o; } }
}

constexpr int NTHREADS = 512, NWAVES = 8;
constexpr int LDS_BYTES = 147456;
constexpr int LDS_MISC = 131072;
constexpr int LDS_XB = LDS_BYTES - 16;
constexpr size_t CTL_ZERO_BYTES = 16384;

struct Params {
    const float *x, *mem, *relb, *w_in, *b_gate, *w_memkv, *sinks, *w_a, *w_b, *w_c, *w_out, *ln1g, *ln1b, *w_q, *subk, *pu, *pv, *ln2g, *ln2b;
    float* out; char* ws; int lo, hi;
};

__device__ __forceinline__ void g_cvt(const float* __restrict__ src, bf16_t* __restrict__ dst, size_t n8) {
    for (size_t i = (size_t)blockIdx.x * NTHREADS + threadIdx.x; i < n8; i += (size_t)gridDim.x * NTHREADS) {
        const f32x4 a = ((const f32x4*)src)[2 * i], b = ((const f32x4*)src)[2 * i + 1];
        u32x4 w; w.x = pk2(a[0], a[1]); w.y = pk2(a[2], a[3]); w.z = pk2(b[0], b[1]); w.w = pk2(b[2], b[3]);
        ((u32x4*)dst)[i] = w; }
}


__device__ __forceinline__ void g_cvt8(const float* __restrict__ src, unsigned char* __restrict__ dst, size_t n16, float sc) {
    for (size_t i = (size_t)blockIdx.x * NTHREADS + threadIdx.x; i < n16; i += (size_t)gridDim.x * NTHREADS) {
        const f32x4 a = ((const f32x4*)src)[4 * i], b = ((const f32x4*)src)[4 * i + 1], c = ((const f32x4*)src)[4 * i + 2], d = ((const f32x4*)src)[4 * i + 3];
        u32x4 w; int t;
        t = 0; t = __builtin_amdgcn_cvt_pk_fp8_f32(a[0] * sc, a[1] * sc, t, false); t = __builtin_amdgcn_cvt_pk_fp8_f32(a[2] * sc, a[3] * sc, t, true); w.x = (unsigned)t;
        t = 0; t = __builtin_amdgcn_cvt_pk_fp8_f32(b[0] * sc, b[1] * sc, t, false); t = __builtin_amdgcn_cvt_pk_fp8_f32(b[2] * sc, b[3] * sc, t, true); w.y = (unsigned)t;
        t = 0; t = __builtin_amdgcn_cvt_pk_fp8_f32(c[0] * sc, c[1] * sc, t, false); t = __builtin_amdgcn_cvt_pk_fp8_f32(c[2] * sc, c[3] * sc, t, true); w.z = (unsigned)t;
        t = 0; t = __builtin_amdgcn_cvt_pk_fp8_f32(d[0] * sc, d[1] * sc, t, false); t = __builtin_amdgcn_cvt_pk_fp8_f32(d[2] * sc, d[3] * sc, t, true); w.w = (unsigned)t;
        ((u32x4*)dst)[i] = w; }
}

template <bool FP8>
__device__ __forceinline__ void transpose_tile_wave(const float* __restrict__ src, int K, int N, void* __restrict__ dstv, int tn, int tk, LAS float* tile, float sc) {
    const int lane = threadIdx.x & 63, n0 = tn * 64, k0 = tk * 64, rq = lane >> 4, c4 = (lane & 15) * 4;
    f32x4 v[16];
#pragma unroll
    for (int i = 0; i < 16; ++i) v[i] = *(const f32x4*)(src + (size_t)(k0 + 4 * i + rq) * N + n0 + c4);
#pragma unroll
    for (int i = 0; i < 16; ++i) *(LAS f32x4*)(tile + (4 * i + rq) * 68 + c4) = v[i];
    asm volatile("s_waitcnt lgkmcnt(0)" ::: "memory");
    float y[64];
#pragma unroll
    for (int k = 0; k < 64; ++k) y[k] = tile[k * 68 + lane];
    if constexpr (FP8) { unsigned char* dst = (unsigned char*)dstv + (size_t)(n0 + lane) * K + k0;
#pragma unroll
        for (int q = 0; q < 4; ++q) { u32x4 w; int t;
#pragma unroll
            for (int d = 0; d < 4; ++d) { t = 0; t = __builtin_amdgcn_cvt_pk_fp8_f32(y[16 * q + 4 * d] * sc, y[16 * q + 4 * d + 1] * sc, t, false); t = __builtin_amdgcn_cvt_pk_fp8_f32(y[16 * q + 4 * d + 2] * sc, y[16 * q + 4 * d + 3] * sc, t, true); w[d] = (unsigned)t; }
            *(u32x4*)(dst + 16 * q) = w; } }
    else { bf16_t* dst = (bf16_t*)dstv + (size_t)(n0 + lane) * K + k0;
#pragma unroll
        for (int q = 0; q < 8; ++q) { u32x4 w; w.x = pk2(y[8 * q], y[8 * q + 1]); w.y = pk2(y[8 * q + 2], y[8 * q + 3]); w.z = pk2(y[8 * q + 4], y[8 * q + 5]); w.w = pk2(y[8 * q + 6], y[8 * q + 7]); *(u32x4*)(dst + 8 * q) = w; } }
    asm volatile("s_waitcnt lgkmcnt(0)" ::: "memory");
}
#define W_ws (p.ws)
#define W_dout ((char*)p.out)
#define W_wmemkv_t ((bf16_t*)(W_ws + WS_WMEMKV))
#define W_wA_t ((bf16_t*)(W_ws + WS_WA))
#define W_wB_t ((bf16_t*)(W_ws + WS_WB))
#define W_wC_t ((bf16_t*)(W_ws + WS_WC))
#define W_wout_t ((bf16_t*)(W_ws + WS_WOUT))
#define W_wq_t ((bf16_t*)(W_ws + WS_WQ))
#define W_subkb ((bf16_t*)(W_ws + WS_SUBK))
#define W_memb ((bf16_t*)(W_ws + WS_MEMB))
#define W_kvm ((bf16_t*)(W_ws + WS_KVM))
#define W_stats ((float*)(W_ws + WS_STATS))
#define W_lseA ((float*)(W_ws + WS_LSE))
#define W_hq ((bf16_t*)(W_ws + WS_HQ))
#define W_gates ((bf16_t*)(W_ws + WS_GATES))
#define W_xb ((bf16_t*)(W_ws + WS_XB))
#define W_mf ((float*)(W_ws + WS_MF))
#define W_mb ((unsigned char*)(W_ws + WS_MB))
#define W_z ((bf16_t*)(W_ws + WS_Z))
#define W_x1b ((bf16_t*)(W_ws + WS_X1B))
#define W_qb ((bf16_t*)(W_ws + WS_Q))
#define W_eidx ((unsigned short*)(W_ws + WS_EIDX))
#define W_gate ((float*)(W_ws + WS_GATE))
#define W_ub8 ((unsigned char*)(W_ws + WS_UB))
#define W_vb8 ((unsigned char*)(W_ws + WS_UB + 16 * MiB))
#define W_usc ((float*)(W_ws + WS_UB + 32 * MiB))
#define W_vsc (W_usc + NEXP)
#define W_w_in_t ((bf16_t*)(W_dout + DO_WINT))
#define W_oA ((bf16_t*)(W_dout + DO_OA))
#define W_yb ((bf16_t*)(W_dout + DO_YB))
#define W_yc ((bf16_t*)(W_dout + DO_YC))
#define W_ya ((bf16_t*)(W_dout + DO_YA))
#define W_x8 ((unsigned char*)W_dout)
#define W_hp ((bf16_t*)(W_ws + 120 * MiB))
#define W_cbuf ((bf16_t*)(W_ws + 24 * MiB))
#define W_yp W_hp
__global__ void __launch_bounds__(NTHREADS, 2) mk_fwd(Params p) {
    extern __shared__ __attribute__((aligned(16))) unsigned char lds[];
#define LAUNDER_TID int tid = threadIdx.x; asm volatile("" : "+v"(tid)); const int wave = tid >> 6; const int gw = blockIdx.x * NWAVES + wave, nw = gridDim.x * NWAVES; (void)wave; (void)gw; (void)nw;
    if (threadIdx.x == 0) *(uint4*)(lds + LDS_XB) = make_uint4(0u, 0u, 0u, 0u);
    __syncthreads();
    XcdBarrier bar = xcd_barrier_post((unsigned*)(W_ws + WS_CTL), (volatile LAS unsigned*)(lds + LDS_XB));
#define PH(k) (p.lo <= (k) && (k) < p.hi)
#define SEAM(k) do { if (PH(k) && PH((k) + 1)) xcd_barrier(bar); } while (0)

    if (PH(0)) { LAUNDER_TID
        g_cvt8(p.x, (unsigned char*)W_xb, (size_t)T * D / 16, 1.0f);
        g_cvt8(p.mem, (unsigned char*)W_memb, (size_t)BATCH * MEMLEN * D / 16, 1.0f);
        g_cvt(p.subk, W_subkb, (size_t)8 * 2 * 128 * 64 / 8);
        LAS float* tile = (LAS float*)((LAS unsigned char*)lds + wave * (64 * 68 * 4));
        for (int u = gw; u < 2752; u += nw) {
            if (u < 1664) transpose_tile_wave<true>(p.w_in, D, INW, W_w_in_t, u % 104, u / 104, tile, 32.0f);
            else if (u < 1920) { const int v = u - 1664; transpose_tile_wave<true>(p.w_memkv, D, 1024, W_wmemkv_t, v & 15, v >> 4, tile, 32.0f); }
            else if (u < 1984) { const int v = u - 1920; transpose_tile_wave<true>(p.w_a, 256, 1024, W_wA_t, v & 15, v >> 4, tile, 32.0f); }
            else if (u < 2112) { const int v = u - 1984; transpose_tile_wave<true>(p.w_b, 512, 1024, W_wB_t, v & 15, v >> 4, tile, 32.0f); }
            else if (u < 2240) { const int v = u - 2112; transpose_tile_wave<true>(p.w_c, 512, 1024, W_wC_t, v & 15, v >> 4, tile, 32.0f); }
            else if (u < 2496) { const int v = u - 2240; transpose_tile_wave<true>(p.w_out, D, 1024, W_wout_t, v & 15, v >> 4, tile, 32.0f); }
            else { const int v = u - 2496; transpose_tile_wave<false>(p.w_q, D, 1024, W_wq_t, v & 15, v >> 4, tile, 1.f); }
        }
    }
    SEAM(0);
    if (PH(1)) {
        { pg8::Gemm g; g.A = W_memb; g.Bt = W_wmemkv_t; g.M = BATCH * MEMLEN; g.N = 1024; g.K = D / 2; EpiPlain E; E.O = W_kvm; E.ldc = 1024;
          pg8::StaticOrder S; S.init(g.M, g.N, (int)gridDim.x, (int)blockIdx.x); pg8::gemm_phase<EpiPlain, pg8::StaticOrder, false, true>((PG8_LAS unsigned char*)lds, g, S, E, nullptr); }
        __syncthreads();
        { pg8::Gemm g; g.A = W_xb; g.Bt = W_w_in_t; g.M = T; g.N = INW; g.K = D / 2; EpiIn E; E.hq = W_hq; E.gates = W_gates; E.bgate = p.b_gate;
          pg8::StaticOrder S; S.init(g.M, g.N, (int)gridDim.x, (int)blockIdx.x); pg8::gemm_phase<EpiIn, pg8::StaticOrder, false, true>((PG8_LAS unsigned char*)lds, g, S, E, nullptr); }
    }
    SEAM(1);
    if (PH(2)) { LAUNDER_TID
        LAS unsigned char* L = (LAS unsigned char*)lds;
        attnAB_phase(L, W_hq, p.relb, p.sinks, W_oA, W_lseA, W_yb);
        for (int u = blockIdx.x; u < 256; u += gridDim.x) attnC_unit(u, L, W_hq, W_kvm, W_yc);
        for (int row = gw; row < NEXP / 2; row += nw) cvt_rows_fp8(p.pu, p.pv, W_ub8, W_vb8, W_usc, W_vsc, row, row + NEXP / 2);
    }
    SEAM(2);
    if (PH(3)) { LAUNDER_TID for (size_t i = (size_t)blockIdx.x * NTHREADS + tid; i < (size_t)T * 32; i += (size_t)gridDim.x * NTHREADS) t_mix(i, W_oA, W_lseA, W_ya); }
    SEAM(3);
    if (PH(4)) {
        pg8::MergeArgs g; g.A[0] = W_ya; g.A[1] = W_yb; g.A[2] = W_yc; g.Bt[0] = W_wA_t; g.Bt[1] = W_wB_t; g.Bt[2] = W_wC_t; g.K[0] = 128; g.K[1] = 256; g.K[2] = 256; g.gates = W_gates; g.mb = W_mb;
        pg8::StaticOrder S; S.init(T, D, (int)gridDim.x, (int)blockIdx.x); pg8::gemm_phase_merge<pg8::StaticOrder, true>((PG8_LAS unsigned char*)lds, g, S);
    }
    SEAM(4);
    if (PH(5)) {
        pg8::Gemm g; g.A = (const bf16_t*)W_mb; g.Bt = W_wout_t; g.M = T; g.N = D; g.K = D / 2; EpiPlain E; E.O = W_z; E.ldc = 1024;
        pg8::StaticOrder S; S.init(g.M, g.N, (int)gridDim.x, (int)blockIdx.x); pg8::gemm_phase<EpiPlain, pg8::StaticOrder, false, true, 123>((PG8_LAS unsigned char*)lds, g, S, E, nullptr);
    }
    SEAM(5);
    if (PH(6)) { LAUNDER_TID int t = gw; for (; t + 3 * nw < T; t += 4 * nw) t_res_ln1<4>((size_t)t, (size_t)nw, p.x, W_z, p.ln1g, p.ln1b, W_x1b);
        for (; t < T; t += nw) t_res_ln1<1>((size_t)t, (size_t)nw, p.x, W_z, p.ln1g, p.ln1b, W_x1b); }
    SEAM(6);
    if (PH(7)) {
        pg8::Gemm g; g.A = W_x1b; g.Bt = W_wq_t; g.M = T; g.N = D; g.K = D; EpiPlain E; E.O = W_qb; E.ldc = 1024;
        pg8::StaticOrder S; S.init(g.M, g.N, (int)gridDim.x, (int)blockIdx.x); pg8::gemm_phase<EpiPlain, pg8::StaticOrder, false>((PG8_LAS unsigned char*)lds, g, S, E, nullptr);
    }
    SEAM(7);
    if (PH(8)) { for (int u = blockIdx.x; u < (T / 256) * 8; u += gridDim.x) topk_unit(u, (LAS unsigned char*)lds, W_qb, W_subkb, W_eidx, W_gate); }
    SEAM(8);
    if (PH(9)) { const int ngrp = (int)(gridDim.x >> 3), tpc = ((T + ngrp - 1) / ngrp + 7) & ~7, sl_tok0 = (int)(blockIdx.x >> 3) * tpc, sl_tok1 = ((int)(blockIdx.x >> 3) < ngrp) ? (sl_tok0 + tpc < T ? sl_tok0 + tpc : T) : 0; peerU_phase((int)(blockIdx.x & 7), sl_tok0, sl_tok1, W_x1b, W_eidx, W_ub8, W_hp); }
    SEAM(9);
    if (PH(10)) { peerR_phase(W_hp, W_eidx, W_gate, W_usc, W_vsc, W_cbuf); }
    SEAM(10);
    if (PH(11)) { const int ngrp = (int)(gridDim.x >> 3), tpc = ((T + ngrp - 1) / ngrp + 7) & ~7, sl_tok0 = (int)(blockIdx.x >> 3) * tpc, sl_tok1 = ((int)(blockIdx.x >> 3) < ngrp) ? (sl_tok0 + tpc < T ? sl_tok0 + tpc : T) : 0; peerV_phase((int)(blockIdx.x & 7), sl_tok0, sl_tok1, W_cbuf, W_eidx, W_vb8, W_yp); }
    SEAM(11);
#ifdef PROBE_EXP
    if (PH(13)) { const int ngrp = (int)(gridDim.x >> 3), tpc = ((T + ngrp - 1) / ngrp + 7) & ~7, sl_tok0 = (int)(blockIdx.x >> 3) * tpc, sl_tok1 = ((int)(blockIdx.x >> 3) < ngrp) ? (sl_tok0 + tpc < T ? sl_tok0 + tpc : T) : 0;
        const int sl = (PROBE_EXP == 0) ? (int)(blockIdx.x & 7) : (int)((blockIdx.x + (blockIdx.x >> 3)) & 7);
#if PROBE_EXP == 20
        for (int rep = 0; rep < 20; ++rep) xcd_barrier(bar); (void)sl; (void)sl_tok0; (void)sl_tok1; }
#elif PROBE_EXP >= 10
        probe_valu((float*)(W_ws + 24 * MiB)); (void)sl; (void)sl_tok0; (void)sl_tok1; }
#else
        probe_gather(sl, sl_tok0, sl_tok1, W_eidx, W_ub8, (float*)(W_ws + 24 * MiB)); }
#endif
#endif
    if (PH(12)) { LAUNDER_TID int t = gw; for (; t + 3 * nw < T; t += 4 * nw) peerL_token<4>((size_t)t, (size_t)nw, W_x1b, W_yp, p.ln2g, p.ln2b, p.out);
        for (; t < T; t += nw) peerL_token<1>((size_t)t, (size_t)nw, W_x1b, W_yp, p.ln2g, p.ln2b, p.out); }
}

#ifndef MK_CUTS
#define MK_CUTS 0
#endif
extern "C" void kernel_launch(void* const* d_in, const int* in_sizes, int n_in, void* d_out, int out_size, void* d_ws, size_t ws_size, hipStream_t stream) {
    if (n_in != 19 || in_sizes[0] != T * D || out_size != T * D || ws_size < WS_END) { fprintf(stderr, "kernel_launch: unexpected shapes / workspace (%d inputs, ws %zu)\n", n_in, ws_size); return; }
    static int grid = 0;
    if (!grid) {
        int dev = 0, cus = 0, per_cu = 0;
        if (hipGetDevice(&dev) != hipSuccess || hipDeviceGetAttribute(&cus, hipDeviceAttributeMultiprocessorCount, dev) != hipSuccess) { fprintf(stderr, "kernel_launch: device query failed\n"); return; }
        if (hipFuncSetAttribute((const void*)mk_fwd, hipFuncAttributeMaxDynamicSharedMemorySize, LDS_BYTES) != hipSuccess) { fprintf(stderr, "kernel_launch: hipFuncSetAttribute failed\n"); return; }
        if (hipOccupancyMaxActiveBlocksPerMultiprocessor(&per_cu, (const void*)mk_fwd, NTHREADS, LDS_BYTES) != hipSuccess || per_cu < 1) { fprintf(stderr, "kernel_launch: occupancy query says %d\n", per_cu); return; }
        grid = cus;
    }
    Params p{};
    p.x = (const float*)d_in[0]; p.mem = (const float*)d_in[1]; p.relb = (const float*)d_in[2]; p.w_in = (const float*)d_in[3]; p.b_gate = (const float*)d_in[4]; p.w_memkv = (const float*)d_in[5];
    p.sinks = (const float*)d_in[6]; p.w_a = (const float*)d_in[7]; p.w_b = (const float*)d_in[8]; p.w_c = (const float*)d_in[9]; p.w_out = (const float*)d_in[10]; p.ln1g = (const float*)d_in[11];
    p.ln1b = (const float*)d_in[12]; p.w_q = (const float*)d_in[13]; p.subk = (const float*)d_in[14]; p.pu = (const float*)d_in[15]; p.pv = (const float*)d_in[16]; p.ln2g = (const float*)d_in[17];
    p.ln2b = (const float*)d_in[18]; p.out = (float*)d_out; p.ws = (char*)d_ws;
    if (hipMemsetAsync((char*)d_ws + WS_CTL, 0, CTL_ZERO_BYTES, stream) != hipSuccess) { fprintf(stderr, "kernel_launch: memset failed\n"); return; }
#if MK_CUTS
    for (int k = 0; k < 13; ++k) { p.lo = k; p.hi = k + 1; hipLaunchKernelGGL(mk_fwd, dim3(grid), dim3(NTHREADS), LDS_BYTES, stream, p); }
#else
#ifdef PROBE_SPLITK
    p.lo = 0; p.hi = PROBE_SPLITK + 1; hipLaunchKernelGGL(mk_fwd, dim3(grid), dim3(NTHREADS), LDS_BYTES, stream, p);
#ifndef PROBE_SPLITK_BASE
    (void)hipMemsetAsync((char*)d_ws + WS_CTL, 0, CTL_ZERO_BYTES, stream);
    p.lo = PROBE_SPLITK; p.hi = PROBE_SPLITK + 1; hipLaunchKernelGGL(mk_fwd, dim3(grid), dim3(NTHREADS), LDS_BYTES, stream, p);
#endif
    (void)hipMemsetAsync((char*)d_ws + WS_CTL, 0, CTL_ZERO_BYTES, stream);
    p.lo = PROBE_SPLITK + 1; p.hi = 13; hipLaunchKernelGGL(mk_fwd, dim3(grid), dim3(NTHREADS), LDS_BYTES, stream, p);
#else
    p.lo = 0; p.hi = 13; hipLaunchKernelGGL(mk_fwd, dim3(grid), dim3(NTHREADS), LDS_BYTES, stream, p);
#endif
#endif
#ifdef PROBE_EXP
    (void)hipMemsetAsync((char*)d_ws + WS_CTL, 0, CTL_ZERO_BYTES, stream);
    p.lo = 13; p.hi = 14; hipLaunchKernelGGL(mk_fwd, dim3(grid), dim3(NTHREADS), LDS_BYTES, stream, p);
#endif
#ifdef PROBE_RELAUNCH
    p.lo = PROBE_RELAUNCH; p.hi = PROBE_RELAUNCH + 1; hipLaunchKernelGGL(mk_fwd, dim3(grid), dim3(NTHREADS), LDS_BYTES, stream, p);
#endif
}
```
